# Optimizing an MI355X kernel written in HIP

```python
import jax
import jax.numpy as jnp
from jax import lax
import numpy as np


D_MODEL = 1024
BATCH = 8
SEQ = 4096
DEPTH = 2

HEAD_DIM = 64
N_HEADS_A = 4
N_HEADS_C = 4
N_HEADS_D = 4
CONV_CH = 4 * HEAD_DIM
CONV_K = 3
MIX_WIDTH = (N_HEADS_A + N_HEADS_C + N_HEADS_D) * HEAD_DIM + CONV_CH
N_GROUPS = MIX_WIDTH // HEAD_DIM
BLOCK = 128
CMP_LEN = 32
CMP_STRIDE = 16
CMP_HIDDEN = 256
SEL_BLOCK = 64
N_SELECT = 16
NSA_WINDOW = 512
N_NSA_BRANCH = 3
DILATED_CONFIGS = ((128, 1), (512, 4), (2048, 16))
D_FF = -(-(8 * D_MODEL) // (3 * 256)) * 256
A_COLS = N_HEADS_A * HEAD_DIM + 6 * HEAD_DIM + N_NSA_BRANCH * N_HEADS_A
IN_COLS = A_COLS + 3 * CONV_CH + 3 * N_HEADS_C * HEAD_DIM + 3 * N_HEADS_D * HEAD_DIM
COL_WIDTHS = (N_HEADS_A * HEAD_DIM, HEAD_DIM, HEAD_DIM, HEAD_DIM, HEAD_DIM, HEAD_DIM, HEAD_DIM,
              N_NSA_BRANCH * N_HEADS_A,
              CONV_CH, CONV_CH, CONV_CH,
              N_HEADS_C * HEAD_DIM, N_HEADS_C * HEAD_DIM, N_HEADS_C * HEAD_DIM,
              N_HEADS_D * HEAD_DIM, N_HEADS_D * HEAD_DIM, N_HEADS_D * HEAD_DIM)
NEG_INF = -1e30
FORCE_SCORE = 1e6
RMS_EPS = 1e-6

kernel_name = 'hybrid_nsa_conv_stickbreak_dilated'


def rms_norm(x, g):
    xf = x.astype(jnp.float32)
    y = xf * lax.rsqrt(jnp.mean(xf * xf, axis=-1, keepdims=True) + RMS_EPS)
    return (y * g.astype(jnp.float32)).astype(x.dtype)


def to_heads(t, n):
    b, s, _ = t.shape
    return t.reshape(b, s, n, HEAD_DIM).transpose(0, 2, 1, 3)


def alibi_slopes(n):
    return jnp.exp2(-8.0 * jnp.arange(1, n + 1, dtype=jnp.float32) / n)


def banded_attention(q, k, v, max_back, dist_scale, slopes):
    n, h, l, hd = q.shape
    g = k.shape[1]
    r = h // g
    nb = l // BLOCK
    n_prev = -(-max_back // BLOCK)
    w = (n_prev + 1) * BLOCK
    qb = q.reshape(n, g, r, nb, BLOCK, hd)

    def band(t):
        tb = t.reshape(n, g, nb, BLOCK, hd)
        tp = jnp.pad(tb, ((0, 0), (0, 0), (n_prev, 0), (0, 0), (0, 0)))
        return jnp.concatenate([tp[:, :, i:i + nb] for i in range(n_prev + 1)], axis=3)

    kb, vb = band(k), band(v)
    rows = jnp.arange(BLOCK)
    diff = rows[:, None] + n_prev * BLOCK - jnp.arange(w)[None, :]
    key_idx = jnp.arange(nb)[:, None, None] * BLOCK + rows[None, :, None] - diff[None]
    mask = (diff >= 0) & (diff <= max_back) & (key_idx >= 0)
    s = jnp.einsum('ngrbqd,ngbkd->ngrbqk', qb, kb).astype(jnp.float32) * (HEAD_DIM ** -0.5)
    s = s - slopes.reshape(g, r)[None, :, :, None, None, None] * (diff * dist_scale).astype(jnp.float32)
    s = jnp.where(mask, s, NEG_INF)
    lse = jax.nn.logsumexp(s, axis=-1)
    p = jnp.exp(s - lse[..., None])
    o = jnp.einsum('ngrbqk,ngbkd->ngrbqd', p.astype(v.dtype), vb)
    return o.reshape(n, h, l, hd), lse.reshape(n, h, l)


def compress_tokens(t, pe, w1, w2):
    b, s, _ = t.shape
    n_cmp = (s - CMP_LEN) // CMP_STRIDE + 1
    idx = jnp.arange(n_cmp)[:, None] * CMP_STRIDE + jnp.arange(CMP_LEN)[None, :]
    blocks = (t[:, idx] + pe).reshape(b, n_cmp, CMP_LEN * HEAD_DIM)
    return jax.nn.gelu(blocks @ w1) @ w2


def nsa_mixer(q_tok, kc_tok, vc_tok, ks_tok, vs_tok, kw_tok, vw_tok, gate_logits, b_gate,
              g_q, g_kc, g_ks, g_kw, pe_k, pe_v, w1_k, w2_k, w1_v, w2_v, slopes):
    b, s, _ = q_tok.shape
    h = N_HEADS_A
    scale = HEAD_DIM ** -0.5
    q = rms_norm(to_heads(q_tok, h), g_q)
    kc = rms_norm(compress_tokens(kc_tok, pe_k, w1_k, w2_k), g_kc)
    vc = compress_tokens(vc_tok, pe_v, w1_v, w2_v)
    n_cmp = kc.shape[1]
    cmp_end = jnp.arange(n_cmp) * CMP_STRIDE + CMP_LEN - 1
    n_sel = s // SEL_BLOCK
    top = min(N_SELECT, n_sel)
    ratio = SEL_BLOCK // CMP_STRIDE
    ks = rms_norm(ks_tok, g_ks).reshape(b, n_sel, SEL_BLOCK, HEAD_DIM)
    vs = vs_tok.reshape(b, n_sel, SEL_BLOCK, HEAD_DIM)
    blk_ids = jnp.arange(n_sel)
    bidx = jnp.arange(b)[:, None, None]
    nc = s // BLOCK
    q_chunks = q.reshape(b, h, nc, BLOCK, HEAD_DIM).transpose(2, 0, 1, 3, 4)

    def chunk(args):
        qi, c = args
        t = c * BLOCK + jnp.arange(BLOCK)
        dist_c = t[:, None] - cmp_end[None, :]
        vis = dist_c >= 0
        sc = jnp.einsum('bhqd,bnd->bhqn', qi, kc).astype(jnp.float32) * scale
        sc = jnp.where(vis, sc - slopes[:, None, None] * dist_c.astype(jnp.float32), NEG_INF)
        p_cmp = jax.nn.softmax(sc, axis=-1) * vis
        o_cmp = jnp.einsum('bhqn,bnd->bhqd', p_cmp.astype(vc.dtype), vc)
        imp = jnp.pad(p_cmp.sum(1), ((0, 0), (0, 0), (0, ratio * n_sel - n_cmp)))
        imp_ov = imp
        for sh in range(1, CMP_LEN // CMP_STRIDE):
            imp_ov = imp_ov + jnp.pad(imp[..., :-sh], ((0, 0), (0, 0), (sh, 0)))
        imp_blk = imp_ov.reshape(b, BLOCK, n_sel, ratio).sum(-1)
        cur = t // SEL_BLOCK
        forced = (blk_ids[None] == 0) | (blk_ids[None] == cur[:, None]) | (blk_ids[None] == cur[:, None] - 1)
        valid = blk_ids[None] * SEL_BLOCK <= t[:, None]
        score = jnp.where(forced, FORCE_SCORE, jnp.where(valid, imp_blk, -FORCE_SCORE))
        _, idx = lax.top_k(score, top)
        kg = ks[bidx, idx]
        vg = vs[bidx, idx]
        pos = idx[..., None] * SEL_BLOCK + jnp.arange(SEL_BLOCK)
        dist_s = t[None, :, None, None] - pos
        ss = jnp.einsum('bhqd,bqkjd->bhqkj', qi, kg).astype(jnp.float32) * scale
        ss = ss - slopes[None, :, None, None, None] * dist_s[:, None].astype(jnp.float32)
        ss = jnp.where((dist_s >= 0)[:, None], ss, NEG_INF)
        p_slc = jax.nn.softmax(ss.reshape(b, h, BLOCK, top * SEL_BLOCK), axis=-1).reshape(ss.shape)
        o_slc = jnp.einsum('bhqkj,bqkjd->bhqd', p_slc.astype(vg.dtype), vg)
        return o_cmp, o_slc

    o_cmp, o_slc = lax.map(chunk, (q_chunks, jnp.arange(nc)))
    o_cmp = o_cmp.transpose(1, 2, 0, 3, 4).reshape(b, h, s, HEAD_DIM)
    o_slc = o_slc.transpose(1, 2, 0, 3, 4).reshape(b, h, s, HEAD_DIM)
    o_win, _ = banded_attention(q, rms_norm(kw_tok, g_kw)[:, None], vw_tok[:, None], NSA_WINDOW - 1, 1, slopes)
    gates = jax.nn.sigmoid(gate_logits + b_gate).reshape(b, s, h, N_NSA_BRANCH).transpose(0, 2, 1, 3)
    return gates[..., 0:1] * o_cmp + gates[..., 1:2] * o_slc + gates[..., 2:3] * o_win


def short_conv_mixer(gate_b, gate_c, u, conv_w):
    y = lax.conv_general_dilated(gate_c * u, conv_w[:, None, :], window_strides=(1,),
                                 padding=[(CONV_K - 1, 0)], dimension_numbers=('NWC', 'WIO', 'NWC'),
                                 feature_group_count=CONV_CH)
    return gate_b * y


def stick_breaking_attention(q, k, v):
    b, h, s, hd = q.shape
    nc = s // BLOCK
    q_chunks = q.reshape(b, h, nc, BLOCK, hd).transpose(2, 0, 1, 3, 4)
    key_pos = jnp.arange(s)

    def chunk(args):
        qi, c = args
        t = c * BLOCK + jnp.arange(BLOCK)
        z = jnp.einsum('bhqd,bhsd->bhqs', qi, k).astype(jnp.float32) * (hd ** -0.5)
        past = key_pos[None, :] < t[:, None]
        neg_log_keep = jnp.where(past, jax.nn.softplus(z), 0.0)
        between = lax.cumsum(neg_log_keep, axis=3, reverse=True) - neg_log_keep
        attn = jnp.where(past, jnp.exp(jax.nn.log_sigmoid(z) - between), 0.0)
        return jnp.einsum('bhqs,bhsd->bhqd', attn.astype(v.dtype), v)

    o = lax.map(chunk, (q_chunks, jnp.arange(nc)))
    return o.transpose(1, 2, 0, 3, 4).reshape(b, h, s, hd)


def dilated_attention(q, k, v, window, dil, slopes):
    b, h, s, hd = q.shape
    span = dil * BLOCK
    sp = -(-s // span) * span
    l = sp // dil

    def fold(t):
        t = jnp.pad(t, ((0, 0), (0, 0), (0, sp - s), (0, 0)))
        return t.reshape(b, h, l, dil, hd).transpose(0, 3, 1, 2, 4).reshape(b * dil, h, l, hd)

    o, lse = banded_attention(fold(q), fold(k), fold(v), window // dil, dil, slopes)
    o = o.reshape(b, dil, h, l, hd).transpose(0, 2, 3, 1, 4).reshape(b, h, sp, hd)[:, :, :s]
    lse = lse.reshape(b, dil, h, l).transpose(0, 2, 3, 1).reshape(b, h, sp)[:, :, :s]
    return o, lse


def hybrid_layer(x, g_mix, w_in, b_gate, g_q_nsa, g_k_cmp, g_k_slc, g_k_win, pe_k_cmp, pe_v_cmp,
                 w1_k_cmp, w2_k_cmp, w1_v_cmp, w2_v_cmp, conv_w, g_q_dil, g_k_dil, g_out, w_out,
                 g_ffn, w_gate, w_up, w_down):
    b, s, _ = x.shape
    hn = rms_norm(x, g_mix)
    proj = hn @ w_in
    cuts = [int(c) for c in np.cumsum(COL_WIDTHS)[:-1]]
    (qa, kca, vca, ksa, vsa, kwa, vwa, gta, cvb, cvc, cvu,
     qc, kc, vc, qd, kd, vd) = jnp.split(proj, cuts, axis=-1)
    slopes = alibi_slopes(N_HEADS_A + N_HEADS_D)
    slopes_a, slopes_d = slopes[0::2], slopes[1::2]
    o_a = nsa_mixer(qa, kca, vca, ksa, vsa, kwa, vwa, gta, b_gate, g_q_nsa, g_k_cmp, g_k_slc, g_k_win,
                    pe_k_cmp, pe_v_cmp, w1_k_cmp, w2_k_cmp, w1_v_cmp, w2_v_cmp, slopes_a)
    o_b = short_conv_mixer(cvb, cvc, cvu, conv_w).reshape(b, s, CONV_CH // HEAD_DIM, HEAD_DIM)
    o_c = stick_breaking_attention(to_heads(qc, N_HEADS_C), to_heads(kc, N_HEADS_C), to_heads(vc, N_HEADS_C))
    qdh = rms_norm(to_heads(qd, N_HEADS_D), g_q_dil)
    kdh = rms_norm(to_heads(kd, N_HEADS_D), g_k_dil)
    vdh = to_heads(vd, N_HEADS_D)
    outs, lses = [], []
    for window, dil in DILATED_CONFIGS:
        o_i, lse_i = dilated_attention(qdh, kdh, vdh, window, dil, slopes_d)
        outs.append(o_i)
        lses.append(lse_i)
    mix_w = jax.nn.softmax(jnp.stack(lses, axis=0), axis=0)
    o_d = jnp.sum(mix_w[..., None].astype(vdh.dtype) * jnp.stack(outs, axis=0), axis=0)
    groups = jnp.concatenate([o_a.transpose(0, 2, 1, 3), o_b, o_c.transpose(0, 2, 1, 3),
                              o_d.transpose(0, 2, 1, 3)], axis=2)
    groups = rms_norm(groups, g_out.reshape(N_GROUPS, HEAD_DIM)).reshape(b, s, MIX_WIDTH)
    x = x + groups @ w_out
    h2 = rms_norm(x, g_ffn)
    return x + (jax.nn.silu(h2 @ w_gate) * (h2 @ w_up)) @ w_down


def setup_inputs(seed: int = 0) -> dict:
    key = jax.random.key(seed)
    ks = jax.random.split(key, 23)
    L = DEPTH
    hd = HEAD_DIM

    def nrm(k, shape, scale):
        return jax.random.normal(k, shape, jnp.float32) * scale

    def gain(k, shape):
        return 1.0 + 0.02 * jax.random.normal(k, shape, jnp.float32)

    return {
        'x': nrm(ks[0], (BATCH, SEQ, D_MODEL), 1.0),
        'g_mix': gain(ks[1], (L, D_MODEL)),
        'w_in': nrm(ks[2], (L, D_MODEL, IN_COLS), D_MODEL ** -0.5),
        'b_gate': nrm(ks[3], (L, N_NSA_BRANCH * N_HEADS_A), 0.1),
        'g_q_nsa': gain(ks[4], (L, hd)),
        'g_k_cmp': gain(ks[5], (L, hd)),
        'g_k_slc': gain(ks[6], (L, hd)),
        'g_k_win': gain(ks[7], (L, hd)),
        'pe_k_cmp': nrm(ks[8], (L, CMP_LEN, hd), 0.1),
        'pe_v_cmp': nrm(ks[9], (L, CMP_LEN, hd), 0.1),
        'w1_k_cmp': nrm(ks[10], (L, CMP_LEN * hd, CMP_HIDDEN), (CMP_LEN * hd) ** -0.5),
        'w2_k_cmp': nrm(ks[11], (L, CMP_HIDDEN, hd), CMP_HIDDEN ** -0.5),
        'w1_v_cmp': nrm(ks[12], (L, CMP_LEN * hd, CMP_HIDDEN), (CMP_LEN * hd) ** -0.5),
        'w2_v_cmp': nrm(ks[13], (L, CMP_HIDDEN, hd), CMP_HIDDEN ** -0.5),
        'conv_w': nrm(ks[14], (L, CONV_K, CONV_CH), CONV_K ** -0.5),
        'g_q_dil': gain(ks[15], (L, hd)),
        'g_k_dil': gain(ks[16], (L, hd)),
        'g_out': gain(ks[17], (L, MIX_WIDTH)),
        'w_out': nrm(ks[18], (L, MIX_WIDTH, D_MODEL), MIX_WIDTH ** -0.5),
        'g_ffn': gain(ks[19], (L, D_MODEL)),
        'w_gate': nrm(ks[20], (L, D_MODEL, D_FF), D_MODEL ** -0.5),
        'w_up': nrm(ks[21], (L, D_MODEL, D_FF), D_MODEL ** -0.5),
        'w_down': nrm(ks[22], (L, D_FF, D_MODEL), D_FF ** -0.5),
    }


def reference(x, g_mix, w_in, b_gate, g_q_nsa, g_k_cmp, g_k_slc, g_k_win, pe_k_cmp, pe_v_cmp,
              w1_k_cmp, w2_k_cmp, w1_v_cmp, w2_v_cmp, conv_w, g_q_dil, g_k_dil, g_out, w_out,
              g_ffn, w_gate, w_up, w_down):
    for l in range(DEPTH):
        x = hybrid_layer(x, g_mix[l], w_in[l], b_gate[l], g_q_nsa[l], g_k_cmp[l], g_k_slc[l], g_k_win[l],
                         pe_k_cmp[l], pe_v_cmp[l], w1_k_cmp[l], w2_k_cmp[l], w1_v_cmp[l], w2_v_cmp[l],
                         conv_w[l], g_q_dil[l], g_k_dil[l], g_out[l], w_out[l], g_ffn[l],
                         w_gate[l], w_up[l], w_down[l])
    return x
```

```cpp
#include <hip/hip_runtime.h>
#include <hip/hip_cooperative_groups.h>
#include <cstdio>
#include <cstdint>
namespace cg = cooperative_groups;
namespace pg8 {
#define PG8_LAS __attribute__((address_space(3)))
typedef unsigned short bf16_t;
typedef short bf16x8 __attribute__((ext_vector_type(8)));
typedef float f32x4 __attribute__((ext_vector_type(4)));
typedef unsigned u32x4 __attribute__((ext_vector_type(4)));
constexpr int BM = 256, BK = 64, HALF = 128, HTB = HALF * BK * 2  , STAGE_BYTES = 8 * HTB, NXCD = 8, WGM = 8;

__host__ __device__ __forceinline__ int lds_byte(int r, int c) { const int st = (r >> 4) * 2 + (c >> 5), rr = r & 15, cc = c & 31, ob = rr * 64 + cc * 2; return st * 1024 + (ob ^ (((ob >> 9) & 1) << 5)); }
__host__ __device__ __forceinline__ void stage_rc(int b, int& R, int& C) { const int st = b / 1024, sb = b % 1024, swz = sb ^ (((sb >> 9) & 1) << 5); R = (st >> 1) * 16 + swz / 64; C = (st & 1) * 32 + (swz % 64) / 2; }
__host__ __device__ __forceinline__ int perm32(int rho) { const int n = rho >> 4, i = rho & 15; return 8 * (i >> 2) + 4 * n + (i & 3); }

struct Unit { int pm, pn; };
struct Gemm { const bf16_t* A; const bf16_t* Bt; int M, N, K; };

struct StaticOrder {
    int nM, nN, nwg, G, c;
    __host__ __device__ void init(int M, int N, int G_, int c_) { nM = M / BM; nN = N / BM; nwg = nM * nN; G = G_; c = c_; }
    __host__ __device__ bool next(int i, Unit& u) const {
        const long L = (long)i * G + c; if (L >= nwg) return false;
        int wgid = (int)L; { const int q = nwg / NXCD, r = nwg % NXCD, xcd = wgid % NXCD, off = wgid / NXCD; wgid = (xcd < r ? xcd * (q + 1) : r * (q + 1) + (xcd - r) * q) + off; }
        const int nig = WGM * nN, gid = wgid / nig, fm = gid * WGM, gsz = (nM - fm) < WGM ? (nM - fm) : WGM;
        u.pm = fm + ((wgid % nig) % gsz); u.pn = (wgid % nig) / gsz; return true;
    }
    __device__ __forceinline__ void a_ready(const Unit&) const {}
    __device__ __forceinline__ void done(const Unit&) const {}
};

__device__ __forceinline__ unsigned cvt_pk_bf16(float lo, float hi) { unsigned r; asm volatile("v_cvt_pk_bf16_f32 %0, %1, %2" : "=v"(r) : "v"(lo), "v"(hi)); return r; }
template <class Epi, class Sched, bool ALIGN_EPI = false, bool SP2 = false>
__device__ __forceinline__ void gemm_phase(PG8_LAS unsigned char* lds, const Gemm g, const Sched& S, const Epi& E) {
    int tid_l = threadIdx.x; asm volatile("" : "+v"(tid_l));
    const int tid = tid_l, wid = __builtin_amdgcn_readfirstlane(tid >> 6), lane = tid & 63, wr = wid >> 2, wc = wid & 3, fr = lane & 15, fq = lane >> 4;
    const int K = g.K, nt = K / BK;
    unsigned voffA[2], voffB[2];
#pragma unroll
    for (int i = 0; i < 2; ++i) { int R, C; stage_rc(tid * 16 + i * 8192, R, C); const int Rb = Epi::PERM ? ((R & ~31) + perm32(R & 31)) : R;
        voffA[i] = (unsigned)(R * K + C) * 2u; voffB[i] = (unsigned)(Rb * K + C) * 2u; }
    const size_t kstep = (size_t)(BK * 2);
    const size_t hstep = (size_t)HALF * K * 2;
    const size_t tstep = 2 * hstep;
    const unsigned ldsw = (unsigned)wid * 1024u;
    const int aoff = lds_byte(wr * 64 + fr, fq * 8), boff = lds_byte(wc * 32 + fr, fq * 8);
#define PG8_SA(b, h) (((b) * 2 + (h)) * HTB)
#define PG8_SB(b, h) ((4 + (b) * 2 + (h)) * HTB)
#define PG8_STAGE(bufoff, gbase, voff) do { _Pragma("unroll") for (int _i = 0; _i < 2; ++_i) \
        __builtin_amdgcn_global_load_lds((const unsigned*)((const char*)(gbase) + (voff)[_i]), (PG8_LAS unsigned*)(lds + (bufoff) + ldsw + _i * 8192), 16, 0, 0); } while (0)
#define PG8_LDA(dst, b, h) do { _Pragma("unroll") for (int m = 0; m < 4; ++m) _Pragma("unroll") for (int k = 0; k < 2; ++k) dst[m][k] = *(const PG8_LAS bf16x8*)(lds + PG8_SA(b, h) + aoff + m * 2048 + k * 1024); } while (0)
#define PG8_LDB(dst, b, h) do { _Pragma("unroll") for (int n = 0; n < 2; ++n) _Pragma("unroll") for (int k = 0; k < 2; ++k) dst[n][k] = *(const PG8_LAS bf16x8*)(lds + PG8_SB(b, h) + boff + n * 2048 + k * 1024); } while (0)
#define PG8_MMA(ai, bj, At, Bt) do { __builtin_amdgcn_s_setprio(1); _Pragma("unroll") for (int m = 0; m < 4; ++m) _Pragma("unroll") for (int n = 0; n < 2; ++n) _Pragma("unroll") for (int k = 0; k < 2; ++k) \
        acc[ai][bj][m][n] = __builtin_amdgcn_mfma_f32_16x16x32_bf16(Bt[n][k], At[m][k], acc[ai][bj][m][n], 0, 0, 0); __builtin_amdgcn_s_setprio(0); } while (0)
#define PG8_WAIT_V(n) asm volatile("s_waitcnt vmcnt(" #n ")" ::: "memory")
#define PG8_WAIT_L(n) asm volatile("s_waitcnt lgkmcnt(" #n ")" ::: "memory")
#define PG8_BAR __builtin_amdgcn_s_barrier()
#define PG8_SCHED __builtin_amdgcn_sched_barrier(0)
    Unit cur, nxt; int ui = 0;
    if (!S.next(0, cur)) return;
    f32x4 acc[2][2][4][2];
#pragma unroll
    for (int a = 0; a < 2; ++a)
#pragma unroll
        for (int b = 0; b < 2; ++b)
#pragma unroll
            for (int m = 0; m < 4; ++m)
#pragma unroll
                for (int n = 0; n < 2; ++n) acc[a][b][m][n] = (f32x4){0.f, 0.f, 0.f, 0.f};
    bf16x8 At[4][2], B0[2][2], B1[2][2];
    const char* cA = (const char*)g.A + (size_t)cur.pm * tstep; const char* cB = (const char*)g.Bt + (size_t)cur.pn * tstep;
    S.a_ready(cur);
    if constexpr (SP2) {
        PG8_STAGE(PG8_SB(0, 0), cB, voffB); PG8_STAGE(PG8_SB(0, 1), cB + hstep, voffB); PG8_STAGE(PG8_SA(0, 0), cA, voffA); PG8_STAGE(PG8_SA(0, 1), cA + hstep, voffA);
        if (wr == 1) PG8_BAR;
        PG8_WAIT_V(2); PG8_BAR;
        PG8_STAGE(PG8_SB(1, 0), cB + kstep, voffB); PG8_STAGE(PG8_SA(1, 0), cA + kstep, voffA); PG8_STAGE(PG8_SB(1, 1), cB + hstep + kstep, voffB);
        PG8_WAIT_V(6); PG8_BAR;
    } else {
        PG8_STAGE(PG8_SB(0, 0), cB, voffB); PG8_STAGE(PG8_SA(0, 0), cA, voffA); PG8_STAGE(PG8_SB(0, 1), cB + hstep, voffB); PG8_STAGE(PG8_SA(0, 1), cA + hstep, voffA);
        if (wr == 1) PG8_BAR;
        PG8_WAIT_V(4); PG8_BAR;
        PG8_STAGE(PG8_SB(1, 0), cB + kstep, voffB); PG8_STAGE(PG8_SA(1, 0), cA + kstep, voffA); PG8_STAGE(PG8_SB(1, 1), cB + hstep + kstep, voffB);
        PG8_WAIT_V(6); PG8_BAR;
    }
    for (;;) {
        const bool has_next = S.next(ui + 1, nxt);
        const char* nA = has_next ? (const char*)g.A + (size_t)nxt.pm * tstep : cA; const char* nB = has_next ? (const char*)g.Bt + (size_t)nxt.pn * tstep : cB;
        for (int t = 0; t < nt; t += 2) {
            const bool last = (t == nt - 2);
            const char* a1 = cA + (size_t)(t + 1) * kstep;
            const char* a2 = last ? nA : cA + (size_t)(t + 2) * kstep; const char* b2 = last ? nB : cB + (size_t)(t + 2) * kstep;
            const char* a3 = a2 + kstep; const char* b3 = b2 + kstep;
            if (last && has_next) S.a_ready(nxt);
            if constexpr (SP2) {
            PG8_LDB(B0, 0, 0); PG8_LDB(B1, 0, 1); PG8_SCHED; PG8_LDA(At, 0, 0); PG8_STAGE(PG8_SA(1, 1), a1 + hstep, voffA);
            PG8_WAIT_V(8); PG8_WAIT_L(0); PG8_BAR; PG8_MMA(0, 0, At, B0); PG8_MMA(0, 1, At, B1); PG8_BAR; PG8_SCHED;
            PG8_LDA(At, 0, 1); PG8_STAGE(PG8_SB(0, 0), b2, voffB); PG8_STAGE(PG8_SB(0, 1), b2 + hstep, voffB); PG8_STAGE(PG8_SA(0, 0), a2, voffA);
            PG8_WAIT_V(8); PG8_WAIT_L(0); PG8_BAR; PG8_MMA(1, 0, At, B0); PG8_MMA(1, 1, At, B1); PG8_BAR; PG8_SCHED;
            PG8_LDB(B0, 1, 0); PG8_LDB(B1, 1, 1); PG8_SCHED; PG8_LDA(At, 1, 0); PG8_STAGE(PG8_SA(0, 1), a2 + hstep, voffA);
            PG8_WAIT_V(8); PG8_WAIT_L(0); PG8_BAR; PG8_MMA(0, 0, At, B0); PG8_MMA(0, 1, At, B1); PG8_BAR; PG8_SCHED;
            PG8_LDA(At, 1, 1); PG8_STAGE(PG8_SB(1, 0), b3, voffB); PG8_STAGE(PG8_SB(1, 1), b3 + hstep, voffB); PG8_STAGE(PG8_SA(1, 0), a3, voffA);
            PG8_WAIT_V(8); PG8_WAIT_L(0); PG8_BAR; PG8_MMA(1, 0, At, B0); PG8_MMA(1, 1, At, B1); PG8_BAR; PG8_SCHED;
            } else {
            PG8_LDB(B0, 0, 0); PG8_SCHED; PG8_LDA(At, 0, 0); PG8_STAGE(PG8_SA(1, 1), a1 + hstep, voffA);
            PG8_WAIT_L(8); PG8_BAR; PG8_WAIT_L(0); PG8_MMA(0, 0, At, B0); PG8_BAR; PG8_SCHED;
            PG8_LDB(B1, 0, 1); PG8_STAGE(PG8_SB(0, 0), b2, voffB);
            PG8_BAR; PG8_WAIT_L(0); PG8_MMA(0, 1, At, B1); PG8_BAR;
            PG8_LDA(At, 0, 1); PG8_STAGE(PG8_SA(0, 0), a2, voffA);
            PG8_BAR; PG8_WAIT_L(0); PG8_MMA(1, 0, At, B0); PG8_BAR; PG8_SCHED;
            PG8_STAGE(PG8_SB(0, 1), b2 + hstep, voffB);
            PG8_WAIT_V(6); PG8_BAR; PG8_MMA(1, 1, At, B1); PG8_BAR;
            PG8_LDB(B0, 1, 0); PG8_SCHED; PG8_LDA(At, 1, 0); PG8_STAGE(PG8_SA(0, 1), a2 + hstep, voffA);
            PG8_WAIT_L(8); PG8_BAR; PG8_WAIT_L(0); PG8_MMA(0, 0, At, B0); PG8_BAR; PG8_SCHED;
            PG8_LDB(B1, 1, 1); PG8_STAGE(PG8_SB(1, 0), b3, voffB);
            PG8_BAR; PG8_WAIT_L(0); PG8_MMA(0, 1, At, B1); PG8_BAR;
            PG8_LDA(At, 1, 1); PG8_STAGE(PG8_SA(1, 0), a3, voffA);
            PG8_BAR; PG8_WAIT_L(0); PG8_MMA(1, 0, At, B0); PG8_BAR; PG8_SCHED;
            PG8_STAGE(PG8_SB(1, 1), b3 + hstep, voffB);
            PG8_WAIT_V(6); PG8_BAR; PG8_MMA(1, 1, At, B1); PG8_BAR;
            }
        }
        if constexpr (ALIGN_EPI) { if (wr == 0) PG8_BAR; }
        if constexpr (!Epi::AFTER_DRAIN) { E(acc, cur, wr, wc, fr, fq); S.done(cur); }
        if (!has_next) break;
#pragma unroll
        for (int a = 0; a < 2; ++a)
#pragma unroll
            for (int b = 0; b < 2; ++b)
#pragma unroll
                for (int m = 0; m < 4; ++m)
#pragma unroll
                    for (int n = 0; n < 2; ++n) acc[a][b][m][n] = (f32x4){0.f, 0.f, 0.f, 0.f};
        cur = nxt; cA = nA; cB = nB; ++ui;
        if constexpr (ALIGN_EPI) { if (wr == 1) PG8_BAR; }
    }
    PG8_WAIT_V(0);
    if constexpr (!ALIGN_EPI) { if (wr == 0) PG8_BAR; }
    PG8_BAR;
    if constexpr (Epi::AFTER_DRAIN) { E.fused(acc, cur, wr, wc, fr, fq, lds, wid, lane); S.done(cur); }
#undef PG8_SA
#undef PG8_SB
#undef PG8_STAGE
#undef PG8_LDA
#undef PG8_LDB
#undef PG8_MMA
#undef PG8_WAIT_V
#undef PG8_WAIT_L
#undef PG8_BAR
#undef PG8_SCHED
}
}

typedef unsigned short bf16_t;
typedef unsigned u32x4 __attribute__((ext_vector_type(4)));
typedef unsigned u32x2 __attribute__((ext_vector_type(2)));
typedef float f32x4 __attribute__((ext_vector_type(4)));
#define LAS __attribute__((address_space(3)))

constexpr int NB = 8, SEQ = 4096, M = NB * SEQ, DM = 1024, NP = 3072, FF = 2816, NGU = 2 * FF, INC = 2956;
constexpr int C_QA = 0, C_KCA = 256, C_VCA = 320, C_KSA = 384, C_VSA = 448, C_KWA = 512, C_VWA = 576, C_CVB = 640, C_CVC = 896, C_CVU = 1152,
              C_QC = 1408, C_KC = 1664, C_VC = 1920, C_QD = 2176, C_KD = 2432, C_VD = 2688, C_GT = 2944;
constexpr float EPS = 1e-6f;
constexpr size_t MiB = 1u << 20;
constexpr size_t WS_SS = 0, WS_KCN = 1 * MiB, WS_VCC = 1 * MiB + 512 * 1024, WS_W = 2 * MiB;
constexpr size_t W_IN = 0, W_OUT = 6 * MiB, W_GU = 8 * MiB, W_DN = 19 * MiB, W_LAYER = 24 * MiB + 512 * 1024;
constexpr size_t WS_XB = 52 * MiB, WS_GR = 116 * MiB, WS_PROJ = 180 * MiB, WS_X1 = 372 * MiB, WS_W1T = 500 * MiB, WS_W2T = 504 * MiB, WS_CB = 504 * MiB + 256 * 1024, WS_BAR = 504 * MiB + 512 * 1024, WS_END = 505 * MiB;
constexpr size_t DO_PO = 0, DO_LSE = 48 * MiB;
constexpr int LDS_BYTES = 143360;

struct Params { const float* in[23]; float* out; unsigned char* ws; };

__device__ __forceinline__ float blo(unsigned u) { return __uint_as_float(u << 16); }
__device__ __forceinline__ float bhi(unsigned u) { return __uint_as_float(u & 0xffff0000u); }
__device__ __forceinline__ float bf2f(bf16_t h) { return __uint_as_float((unsigned)h << 16); }
__device__ __forceinline__ unsigned pk2(float lo, float hi) { return pg8::cvt_pk_bf16(lo, hi); }
template <int K> __device__ __forceinline__ unsigned swz_u(unsigned v) { return (unsigned)__builtin_amdgcn_ds_swizzle((int)v, (K << 10) | 0x1f); }
template <int K> __device__ __forceinline__ float swz_f(float v) { return __uint_as_float(swz_u<K>(__float_as_uint(v))); }
__device__ __forceinline__ float sum32(float v) { auto rr = __builtin_amdgcn_permlane32_swap(__float_as_uint(v), __float_as_uint(v), false, false); return __uint_as_float(rr[0]) + __uint_as_float(rr[1]); }
__device__ __forceinline__ float max32(float v) { auto rr = __builtin_amdgcn_permlane32_swap(__float_as_uint(v), __float_as_uint(v), false, false); return fmaxf(__uint_as_float(rr[0]), __uint_as_float(rr[1])); }
__device__ __forceinline__ unsigned or32(unsigned v) { auto rr = __builtin_amdgcn_permlane32_swap(v, v, false, false); return rr[0] | rr[1]; }
__device__ __forceinline__ float partner32(float v, int hh) { auto rr = __builtin_amdgcn_permlane32_swap(__float_as_uint(v), __float_as_uint(v), false, false); return __uint_as_float(hh ? rr[0] : rr[1]); }
__device__ __forceinline__ float wave_sum(float v) {
    v += swz_f<1>(v); v += swz_f<2>(v); v += swz_f<4>(v); v += swz_f<8>(v); v += swz_f<16>(v); return sum32(v);
}
#define LDS_WAIT() asm volatile("s_waitcnt lgkmcnt(0)" ::: "memory")
#define CFENCE() asm volatile("" ::: "memory")

struct EpiProj {
    static constexpr bool PERM = true, AFTER_DRAIN = false;
    bf16_t* O; const float* ss;
    __device__ __forceinline__ void operator()(const pg8::f32x4 (&acc)[2][2][4][2], const pg8::Unit& u, int wr, int wc, int fr, int fq) const {
        const int row0 = u.pm * 256 + wr * 64 + fr, col0 = u.pn * 256 + wc * 32 + 8 * fq;
#pragma unroll
        for (int ai = 0; ai < 2; ++ai)
#pragma unroll
            for (int m = 0; m < 4; ++m) {
                const int row = row0 + ai * 128 + m * 16; const float rs = rsqrtf(ss[row] * (1.f / DM) + EPS);
                bf16_t* rowp = O + (size_t)row * NP + col0;
#pragma unroll
                for (int bj = 0; bj < 2; ++bj) { const pg8::f32x4 v0 = acc[ai][bj][m][0] * rs, v1 = acc[ai][bj][m][1] * rs;
                    u32x4 w; w.x = pk2(v0[0], v0[1]); w.y = pk2(v0[2], v0[3]); w.z = pk2(v1[0], v1[1]); w.w = pk2(v1[2], v1[3]);
                    *(u32x4*)(rowp + bj * 128) = w; }
            }
    }
};
struct EpiSwiGLU {
    static constexpr bool PERM = true, AFTER_DRAIN = false;
    bf16_t* H; const float* ss;
    __device__ __forceinline__ void operator()(const pg8::f32x4 (&acc)[2][2][4][2], const pg8::Unit& u, int wr, int wc, int fr, int fq) const {
        const int row0 = u.pm * 256 + wr * 64 + fr, col0 = u.pn * 128 + wc * 32 + 8 * fq;
#pragma unroll
        for (int ai = 0; ai < 2; ++ai)
#pragma unroll
            for (int m = 0; m < 4; ++m) {
                const int row = row0 + ai * 128 + m * 16; const float rs = rsqrtf(ss[row] * (1.f / DM) + EPS);
                float hv[8];
#pragma unroll
                for (int n = 0; n < 2; ++n)
#pragma unroll
                    for (int j = 0; j < 4; ++j) { const float g = acc[ai][0][m][n][j] * rs, up = acc[ai][1][m][n][j] * rs;
                        hv[4 * n + j] = g * up / (1.f + __expf(-g)); }
                u32x4 w; w.x = pk2(hv[0], hv[1]); w.y = pk2(hv[2], hv[3]); w.z = pk2(hv[4], hv[5]); w.w = pk2(hv[6], hv[7]);
                *(u32x4*)(H + (size_t)row * FF + col0) = w;
            }
    }
};
struct EpiResid {
    static constexpr bool PERM = false, AFTER_DRAIN = false;
    const float* xin; const bf16_t* xin_b; float* xout; bf16_t* xb; float* ss;
    __device__ __forceinline__ void operator()(const pg8::f32x4 (&acc)[2][2][4][2], const pg8::Unit& u, int wr, int wc, int fr, int fq) const {
        const int row0 = u.pm * 256 + wr * 64 + fr, col0 = u.pn * 256 + wc * 32 + 4 * fq;
#pragma unroll
        for (int ai = 0; ai < 2; ++ai)
#pragma unroll
            for (int m = 0; m < 4; ++m) {
                const int row = row0 + ai * 128 + m * 16; const size_t off = (size_t)row * DM + col0; float sq = 0.f;
#pragma unroll
                for (int bj = 0; bj < 2; ++bj)
#pragma unroll
                    for (int n = 0; n < 2; ++n) { const size_t o = off + bj * 128 + n * 16; f32x4 xi;
                        if (xin) xi = *(const f32x4*)(xin + o);
                        else { const u32x2 r2 = *(const u32x2*)(xin_b + o); xi[0] = blo(r2.x); xi[1] = bhi(r2.x); xi[2] = blo(r2.y); xi[3] = bhi(r2.y); }
                        f32x4 v;
                        v[0] = xi[0] + acc[ai][bj][m][n][0]; v[1] = xi[1] + acc[ai][bj][m][n][1]; v[2] = xi[2] + acc[ai][bj][m][n][2]; v[3] = xi[3] + acc[ai][bj][m][n][3];
                        if (xout) *(f32x4*)(xout + o) = v;
                        if (xb) { u32x2 w; w.x = pk2(v[0], v[1]); w.y = pk2(v[2], v[3]); *(u32x2*)(xb + o) = w; }
                        sq += (v[0] * v[0] + v[1] * v[1]) + (v[2] * v[2] + v[3] * v[3]); }
                if (ss) { sq += swz_f<16>(sq); sq = sum32(sq); if (fq == 0) atomicAdd(ss + row, sq); }
            }
    }
};

#ifndef REP_PW
#define REP_PW 1
#endif
#ifndef REP_PC
#define REP_PC 1
#endif
#ifndef REP_PX
#define REP_PX 1
#endif
template <int MAP> __device__ __forceinline__ int dst_row(int c) {
    if (MAP == 0) return c < 640 ? c : (c < 652 ? 2944 + (c - 640) : c - 12);
    if (MAP == 1) return c;
    if (MAP == 2) return 256 * (c >> 7) + (c & 127);
    return 256 * (c >> 7) + 128 + (c & 127);
}
template <int MAP> __device__ __forceinline__ void transpose_item(const float* W, int K, int N, const float* gk, bf16_t* WT, LAS float* scr, int item, int lane) {
    const int nblk = (N + 63) / 64, kb = item / nblk, nb = item % nblk, k0 = 64 * kb, n0 = 64 * nb;
    const int nn = n0 + lane; const bool okn = nn < N;
#pragma unroll
    for (int i = 0; i < 64; ++i) { float v = okn ? W[(size_t)(k0 + i) * N + nn] : 0.f; if (gk) v *= gk[k0 + i]; scr[i * 65 + lane] = v; }
    LDS_WAIT();
    const int c = lane & 7;
#pragma unroll
    for (int j = 0; j < 8; ++j) { const int n = (lane >> 3) + 8 * j; const LAS float* s = scr + (8 * c) * 65 + n;
        if (n0 + n < N) { u32x4 o; o.x = pk2(s[0 * 65], s[1 * 65]); o.y = pk2(s[2 * 65], s[3 * 65]); o.z = pk2(s[4 * 65], s[5 * 65]); o.w = pk2(s[6 * 65], s[7 * 65]);
            if (MAP == 4) { const int nn2 = n0 + n, kk2 = k0 + 8 * c; *(u32x4*)(WT + ((size_t)(((nn2 >> 5) * (K >> 4) + (kk2 >> 4)) * 64 + ((kk2 >> 3) & 1) * 32 + (nn2 & 31)) * 8)) = o; }
            else *(u32x4*)(WT + (size_t)dst_row<MAP>(n0 + n) * K + k0 + 8 * c) = o; } }
    LDS_WAIT();
}
__device__ __forceinline__ void prologue(const Params& p, LAS unsigned char* lds, int gw, int NGW, int wave, int lane) {
    LAS float* scr = (LAS float*)(lds + wave * 16640);
    constexpr int I_IN = 16 * 47, I_OUT = 16 * 16, I_G = 16 * 44, I_DN = 44 * 16, I_L = I_IN + I_OUT + 2 * I_G + I_DN, I_Z = 116;
    for (int rw_ = 0; rw_ < REP_PW; ++rw_)
    for (int it = gw; it < 2 * (I_L + I_Z); it += NGW) {
        const int l = it / (I_L + I_Z); int r = it % (I_L + I_Z);
        unsigned char* wl = p.ws + WS_W + (size_t)l * W_LAYER;
        if (r < I_IN) { transpose_item<0>(p.in[2] + (size_t)l * DM * INC, DM, INC, p.in[1] + l * DM, (bf16_t*)(wl + W_IN), scr, r, lane); continue; } r -= I_IN;
        if (r < I_OUT) { transpose_item<1>(p.in[18] + (size_t)l * DM * DM, DM, DM, nullptr, (bf16_t*)(wl + W_OUT), scr, r, lane); continue; } r -= I_OUT;
        if (r < I_G) { transpose_item<2>(p.in[20] + (size_t)l * DM * FF, DM, FF, p.in[19] + l * DM, (bf16_t*)(wl + W_GU), scr, r, lane); continue; } r -= I_G;
        if (r < I_G) { transpose_item<3>(p.in[21] + (size_t)l * DM * FF, DM, FF, p.in[19] + l * DM, (bf16_t*)(wl + W_GU), scr, r, lane); continue; } r -= I_G;
        if (r < I_DN) { transpose_item<1>(p.in[22] + (size_t)l * FF * DM, FF, DM, nullptr, (bf16_t*)(wl + W_DN), scr, r, lane); continue; } r -= I_DN;
        { u32x4 z = {0u, 0u, 0u, 0u}; u32x4* d = (u32x4*)((bf16_t*)(wl + W_IN) + (size_t)(INC + r) * DM) + lane * 2; d[0] = z; d[1] = z; }
    }
    for (int rc_ = 0; rc_ < REP_PC; ++rc_)
    for (int it = gw; it < 4 * (128 + 4 + 32); it += NGW) {
        const int mi = it / 164, r = it % 164, l = mi >> 1, kv = mi & 1;
        const float* w1 = p.in[kv ? 12 : 10] + (size_t)l * 2048 * 256; const float* w2 = p.in[kv ? 13 : 11] + (size_t)l * 256 * 64; const float* pe = p.in[kv ? 9 : 8] + l * 2048;
        if (r < 128) transpose_item<4>(w1, 2048, 256, nullptr, (bf16_t*)(p.ws + WS_W1T) + (size_t)mi * 256 * 2048, scr, r, lane);
        else if (r < 132) transpose_item<1>(w2, 256, 64, nullptr, (bf16_t*)(p.ws + WS_W2T) + (size_t)mi * 64 * 256, scr, r - 128, lane);
        else { const int c = (r - 132) * 8 + (lane & 7), rg = lane >> 3; float acc = 0.f;
#pragma unroll 32
            for (int i = rg * 256; i < rg * 256 + 256; ++i) acc += pe[i] * w1[(size_t)i * 256 + c];
            acc += swz_f<8>(acc); acc += swz_f<16>(acc); acc = sum32(acc);
            if (rg == 0) ((float*)(p.ws + WS_CB))[mi * 256 + c] = acc; }
    }
    float* ss = (float*)(p.ws + WS_SS); bf16_t* xb = (bf16_t*)(p.ws + WS_XB);
    for (int rx_ = 0; rx_ < REP_PX; ++rx_)
    for (int m0 = gw; m0 < M; m0 += 4 * NGW) {
        f32x4 v[4][4];
#pragma unroll
        for (int rr = 0; rr < 4; ++rr) { const int m = m0 + rr * NGW; const f32x4* xr = (const f32x4*)(p.in[0] + (size_t)(m < M ? m : 0) * DM) + lane;
#pragma unroll
            for (int j = 0; j < 4; ++j) v[rr][j] = xr[64 * j]; }
#pragma unroll
        for (int rr = 0; rr < 4; ++rr) { const int m = m0 + rr * NGW; if (m < M) { u32x2* o8 = (u32x2*)(xb + (size_t)m * DM) + lane; float s = 0.f;
#pragma unroll
            for (int j = 0; j < 4; ++j) { const f32x4 t = v[rr][j]; s += (t[0] * t[0] + t[1] * t[1]) + (t[2] * t[2] + t[3] * t[3]); u32x2 w; w.x = pk2(t[0], t[1]); w.y = pk2(t[2], t[3]); o8[64 * j] = w; }
            s = wave_sum(s);
            if (lane == 0) { ss[m] = s; ss[M + m] = 0.f; ss[2 * M + m] = 0.f; ss[3 * M + m] = 0.f; } } }
    }
}

#define UNPACK8(v, k) const float k##0 = blo(v.x), k##1 = bhi(v.x), k##2 = blo(v.y), k##3 = bhi(v.y), k##4 = blo(v.z), k##5 = bhi(v.z), k##6 = blo(v.w), k##7 = bhi(v.w)
__device__ __forceinline__ void load_row64(float (&q)[64], const bf16_t* p) {
#pragma unroll
    for (int c = 0; c < 8; ++c) { const u32x4 v = *(const u32x4*)(p + 8 * c); UNPACK8(v, k);
        q[8 * c] = k0; q[8 * c + 1] = k1; q[8 * c + 2] = k2; q[8 * c + 3] = k3; q[8 * c + 4] = k4; q[8 * c + 5] = k5; q[8 * c + 6] = k6; q[8 * c + 7] = k7; }
}
template <bool SS> __device__ __forceinline__ float dot_row(const float (&q)[64], const bf16_t* p, float& kss) {
    float z = 0.f, s = 0.f;
#pragma unroll
    for (int c = 0; c < 8; ++c) { const u32x4 v = *(const u32x4*)(p + 8 * c); UNPACK8(v, k);
        z += (q[8 * c] * k0 + q[8 * c + 1] * k1) + (q[8 * c + 2] * k2 + q[8 * c + 3] * k3) + (q[8 * c + 4] * k4 + q[8 * c + 5] * k5) + (q[8 * c + 6] * k6 + q[8 * c + 7] * k7);
        if (SS) s += (k0 * k0 + k1 * k1) + (k2 * k2 + k3 * k3) + (k4 * k4 + k5 * k5) + (k6 * k6 + k7 * k7);
        if (c == 3) CFENCE(); }
    kss = s; return z;
}
__device__ __forceinline__ void axpy_row(float (&o)[64], float w, const bf16_t* p) {
#pragma unroll
    for (int c = 0; c < 8; ++c) { const u32x4 v = *(const u32x4*)(p + 8 * c); UNPACK8(v, k);
        o[8 * c] += w * k0; o[8 * c + 1] += w * k1; o[8 * c + 2] += w * k2; o[8 * c + 3] += w * k3; o[8 * c + 4] += w * k4; o[8 * c + 5] += w * k5; o[8 * c + 6] += w * k6; o[8 * c + 7] += w * k7;
        if (c == 3) CFENCE(); }
}
__device__ __forceinline__ float dot_row_f32(const float (&q)[64], const float* p) {
    float z = 0.f;
#pragma unroll
    for (int c = 0; c < 16; ++c) { const f32x4 v = *(const f32x4*)(p + 4 * c); z += (q[4 * c] * v[0] + q[4 * c + 1] * v[1]) + (q[4 * c + 2] * v[2] + q[4 * c + 3] * v[3]); if (c == 7) CFENCE(); }
    return z;
}
__device__ __forceinline__ void axpy_row_f32(float (&o)[64], float w, const float* p) {
#pragma unroll
    for (int c = 0; c < 16; ++c) { const f32x4 v = *(const f32x4*)(p + 4 * c); o[4 * c] += w * v[0]; o[4 * c + 1] += w * v[1]; o[4 * c + 2] += w * v[2]; o[4 * c + 3] += w * v[3]; if (c == 7) CFENCE(); }
}
__device__ __forceinline__ void store_group(const float (&o)[64], const float* g, bf16_t* dst) {
    float ss = 0.f;
#pragma unroll
    for (int d = 0; d < 64; ++d) ss += o[d] * o[d];
    const float rs = rsqrtf(ss * (1.f / 64.f) + EPS);
#pragma unroll
    for (int c = 0; c < 8; ++c) { u32x4 w;
        w.x = pk2(o[8 * c] * rs * g[8 * c], o[8 * c + 1] * rs * g[8 * c + 1]); w.y = pk2(o[8 * c + 2] * rs * g[8 * c + 2], o[8 * c + 3] * rs * g[8 * c + 3]);
        w.z = pk2(o[8 * c + 4] * rs * g[8 * c + 4], o[8 * c + 5] * rs * g[8 * c + 5]); w.w = pk2(o[8 * c + 6] * rs * g[8 * c + 6], o[8 * c + 7] * rs * g[8 * c + 7]);
        *(u32x4*)(dst + 8 * c) = w; }
}
__device__ __forceinline__ void load_q_norm(float (&q)[64], const bf16_t* p, const float* gq, const float* gx) {
    load_row64(q, p); float ss = 0.f;
#pragma unroll
    for (int d = 0; d < 64; ++d) ss += q[d] * q[d];
    const float rs = rsqrtf(ss * (1.f / 64.f) + EPS) * 0.125f;
#pragma unroll
    for (int d = 0; d < 64; ++d) q[d] = q[d] * rs * gq[d] * (gx ? gx[d] : 1.f);
}

__device__ __forceinline__ void stick_naive(const bf16_t* proj, bf16_t* groups, const float* g_out, int item, int lane) {
    const int tile = item & 63, h = (item >> 6) & 3, b = item >> 8, t = tile * 64 + lane;
    const bf16_t* base = proj + (size_t)b * SEQ * NP;
    float q[64]; load_row64(q, base + (size_t)t * NP + C_QC + h * 64);
#pragma unroll
    for (int d = 0; d < 64; ++d) q[d] *= 0.125f;
    float o[64];
#pragma unroll
    for (int d = 0; d < 64; ++d) o[d] = 0.f;
    float between = 0.f;
    for (int s = tile * 64 + 62; s >= 0; --s) {
        const bf16_t* kr = base + (size_t)s * NP + C_KC + h * 64; float dummy;
        const float z = dot_row<false>(q, kr, dummy); CFENCE();
        const bool act = s < t;
        const float sp = fmaxf(z, 0.f) + __logf(1.f + __expf(-fabsf(z)));
        const float w = act ? __expf((z - sp) - between) : 0.f;
        axpy_row(o, w, base + (size_t)s * NP + C_VC + h * 64); CFENCE();
        between += act ? sp : 0.f;
        if (s < tile * 64 && __all(between > 104.f)) break;
    }
    store_group(o, g_out + 512 + h * 64, groups + (size_t)(b * SEQ + t) * DM + 512 + h * 64);
}

__device__ __forceinline__ void dil_naive(const bf16_t* proj, bf16_t* groups, const float* gq, const float* gk, const float* g_out, int item, int lane) {
    const int tile = item & 63, h = (item >> 6) & 3, b = item >> 8, t = tile * 64 + lane;
    const bf16_t* base = proj + (size_t)b * SEQ * NP;
    float q[64]; load_q_norm(q, base + (size_t)t * NP + C_QD + h * 64, gq, gk);
    const float slope = exp2f(-(float)(2 * h + 2));
    float o[64];
#pragma unroll
    for (int d = 0; d < 64; ++d) o[d] = 0.f;
    float mx = -1e30f, l = 0.f;
    for (int cfg = 0; cfg < 3; ++cfg) {
        const int dil = cfg == 0 ? 1 : (cfg == 1 ? 4 : 16);
        for (int j = 0; j <= 128; ++j) {
            const int s = t - j * dil; const bool act = s >= 0;
            if (!__any(act)) break;
            if (act) {
                float kss; const float z = dot_row<true>(q, base + (size_t)s * NP + C_KD + h * 64, kss); CFENCE();
                const float sc = z * rsqrtf(kss * (1.f / 64.f) + EPS) - slope * (float)(j * dil);
                if (sc > mx) { const float corr = __expf(mx - sc); l *= corr;
#pragma unroll
                    for (int d = 0; d < 64; ++d) o[d] *= corr;
                    mx = sc; }
                const float pw = __expf(sc - mx); l += pw;
                axpy_row(o, pw, base + (size_t)s * NP + C_VD + h * 64); CFENCE();
            }
        }
    }
    const float inv = 1.f / l;
#pragma unroll
    for (int d = 0; d < 64; ++d) o[d] *= inv;
    store_group(o, g_out + 768 + h * 64, groups + (size_t)(b * SEQ + t) * DM + 768 + h * 64);
}

template <int NI> __device__ __forceinline__ void conv_items(const bf16_t* proj, bf16_t* groups, const float* cw, const float* g_out, int item0, int stride, int lane) {
    const int ch = (lane & 31) * 8;
    u32x4 cv[NI][3], uv[NI][3], bv[NI];
#pragma unroll
    for (int n = 0; n < NI; ++n) { const int token = (item0 + n * stride) * 2 + (lane >> 5), tpos = token & (SEQ - 1); const bf16_t* row = proj + (size_t)token * NP;
#pragma unroll
        for (int k = 0; k < 3; ++k) { const int back = 2 - k;
            if (tpos >= back) { cv[n][k] = *(const u32x4*)(row - (size_t)back * NP + C_CVC + ch); uv[n][k] = *(const u32x4*)(row - (size_t)back * NP + C_CVU + ch); }
            else { cv[n][k] = (u32x4){0u, 0u, 0u, 0u}; uv[n][k] = cv[n][k]; } }
        bv[n] = *(const u32x4*)(row + C_CVB + ch); }
    float wk[3][8];
#pragma unroll
    for (int k = 0; k < 3; ++k)
#pragma unroll
        for (int i = 0; i < 8; ++i) wk[k][i] = cw[k * 256 + ch + i];
    const float* go = g_out + 256 + ch;
#pragma unroll
    for (int n = 0; n < NI; ++n) { const int token = (item0 + n * stride) * 2 + (lane >> 5);
        float acc[8];
#pragma unroll
        for (int i = 0; i < 8; ++i) acc[i] = 0.f;
#pragma unroll
        for (int k = 0; k < 3; ++k) { UNPACK8(cv[n][k], c); UNPACK8(uv[n][k], u);
            acc[0] += wk[k][0] * (c0 * u0); acc[1] += wk[k][1] * (c1 * u1); acc[2] += wk[k][2] * (c2 * u2); acc[3] += wk[k][3] * (c3 * u3);
            acc[4] += wk[k][4] * (c4 * u4); acc[5] += wk[k][5] * (c5 * u5); acc[6] += wk[k][6] * (c6 * u6); acc[7] += wk[k][7] * (c7 * u7); }
        UNPACK8(bv[n], g);
        float y[8] = {g0 * acc[0], g1 * acc[1], g2 * acc[2], g3 * acc[3], g4 * acc[4], g5 * acc[5], g6 * acc[6], g7 * acc[7]};
        float ss = 0.f;
#pragma unroll
        for (int i = 0; i < 8; ++i) ss += y[i] * y[i];
        ss += swz_f<1>(ss); ss += swz_f<2>(ss); ss += swz_f<4>(ss);
        const float rs = rsqrtf(ss * (1.f / 64.f) + EPS);
        u32x4 w; w.x = pk2(y[0] * rs * go[0], y[1] * rs * go[1]); w.y = pk2(y[2] * rs * go[2], y[3] * rs * go[3]);
        w.z = pk2(y[4] * rs * go[4], y[5] * rs * go[5]); w.w = pk2(y[6] * rs * go[6], y[7] * rs * go[7]);
        *(u32x4*)(groups + (size_t)token * DM + 256 + ch) = w; }
}

typedef short bf16x8 __attribute__((ext_vector_type(8)));
typedef short s16x4 __attribute__((ext_vector_type(4)));
typedef float f32x16 __attribute__((ext_vector_type(16)));
typedef float f32x2_t __attribute__((ext_vector_type(2)));
typedef __bf16 bf16x2_t __attribute__((ext_vector_type(2)));
__device__ __forceinline__ unsigned cvtpk(float lo, float hi) { f32x2_t v = {lo, hi}; bf16x2_t b = __builtin_convertvector(v, bf16x2_t); return __builtin_bit_cast(unsigned, b); }
#define MFMA32(a, b, c) __builtin_amdgcn_mfma_f32_32x32x16_bf16((a), (b), (c), 0, 0, 0)
#define EXP2(x) __builtin_amdgcn_exp2f(x)
constexpr float LOG2E = 1.4426950408889634f;
constexpr int KSB = 144, VTB = 136, KS_BYTES = 64 * KSB, VT_BYTES = 64 * VTB;
__device__ __forceinline__ int crow(int i, int h) { return (i & 3) + 8 * (i >> 2) + 4 * h; }

struct KVSrc { const bf16_t* k; const bf16_t* v; long pitch; int first, lo, hi; };
__device__ __forceinline__ void kv_fetch(const KVSrc& s, int tid, u32x4& kc, u32x4& vc) {
    const int kl = tid >> 3, ch = tid & 7, i = s.first + kl;
    if (i >= s.lo && i < s.hi) { kc = *(const u32x4*)(s.k + (long)i * s.pitch + 8 * ch); vc = *(const u32x4*)(s.v + (long)i * s.pitch + 8 * ch); }
    else { kc = (u32x4){0u, 0u, 0u, 0u}; vc = kc; }
}
template <bool NORM> __device__ __forceinline__ void kv_store(u32x4 kc, u32x4 vc, const float (&g)[8], LAS unsigned char* ksb, LAS unsigned char* vtb, int tid) {
    const int kl = tid >> 3, ch = tid & 7;
    if (NORM) { UNPACK8(kc, k); float ss = (k0 * k0 + k1 * k1) + (k2 * k2 + k3 * k3) + (k4 * k4 + k5 * k5) + (k6 * k6 + k7 * k7);
        ss += swz_f<1>(ss); ss += swz_f<2>(ss); ss += swz_f<4>(ss);
        const float rs = rsqrtf(ss * (1.f / 64.f) + EPS);
        kc.x = cvtpk(k0 * rs * g[0], k1 * rs * g[1]); kc.y = cvtpk(k2 * rs * g[2], k3 * rs * g[3]); kc.z = cvtpk(k4 * rs * g[4], k5 * rs * g[5]); kc.w = cvtpk(k6 * rs * g[6], k7 * rs * g[7]); }
    *(LAS u32x4*)(ksb + kl * KSB + ch * 16) = kc;
    LAS unsigned short* vp = (LAS unsigned short*)(vtb + (8 * ch) * VTB + kl * 2);
    vp[0 * (VTB / 2)] = (unsigned short)(vc.x & 0xffffu); vp[1 * (VTB / 2)] = (unsigned short)(vc.x >> 16);
    vp[2 * (VTB / 2)] = (unsigned short)(vc.y & 0xffffu); vp[3 * (VTB / 2)] = (unsigned short)(vc.y >> 16);
    vp[4 * (VTB / 2)] = (unsigned short)(vc.z & 0xffffu); vp[5 * (VTB / 2)] = (unsigned short)(vc.z >> 16);
    vp[6 * (VTB / 2)] = (unsigned short)(vc.w & 0xffffu); vp[7 * (VTB / 2)] = (unsigned short)(vc.w >> 16);
}
template <bool NORM> __device__ __forceinline__ void load_qfrag(bf16x8 (&qf)[4], const bf16_t* qrow, const float* g1, const float* g2, float sc, int hh) {
    float f[32];
#pragma unroll
    for (int s = 0; s < 4; ++s) { const u32x4 v = *(const u32x4*)(qrow + 16 * s + 8 * hh); UNPACK8(v, k);
        f[8 * s] = k0; f[8 * s + 1] = k1; f[8 * s + 2] = k2; f[8 * s + 3] = k3; f[8 * s + 4] = k4; f[8 * s + 5] = k5; f[8 * s + 6] = k6; f[8 * s + 7] = k7; }
    if (NORM) { float ss = 0.f;
#pragma unroll
        for (int i = 0; i < 32; ++i) ss += f[i] * f[i];
        ss = sum32(ss); sc *= rsqrtf(ss * (1.f / 64.f) + EPS); }
#pragma unroll
    for (int s = 0; s < 4; ++s) { float v[8];
#pragma unroll
        for (int j = 0; j < 8; ++j) { const int d = 16 * s + 8 * hh + j; v[j] = f[8 * s + j] * sc * (g1 ? g1[d] : 1.f) * (g2 ? g2[d] : 1.f); }
        u32x4 w; w.x = cvtpk(v[0], v[1]); w.y = cvtpk(v[2], v[3]); w.z = cvtpk(v[4], v[5]); w.w = cvtpk(v[6], v[7]);
        qf[s] = __builtin_bit_cast(bf16x8, w); }
}

struct SfCmp { int tq, nvis, j0; float slope; __device__ __forceinline__ float operator()(float s, int kl) const { const int j = j0 + kl; return j < nvis ? s - slope * (float)(tq - 16 * j - 31) : -INFINITY; } };
struct SfSlc { int tq, key0; float slope; bool sel; __device__ __forceinline__ float operator()(float s, int kl) const { const int key = key0 + kl; return (sel && key <= tq) ? s - slope * (float)(tq - key) : -INFINITY; } };
struct SfWin { int tq, key0; float slope; __device__ __forceinline__ float operator()(float s, int kl) const { const int key = key0 + kl; return (key <= tq && tq - key <= 511) ? s - slope * (float)(tq - key) : -INFINITY; } };

__device__ __forceinline__ void pv_accum(const f32x16& s0, const f32x16& s1, f32x16& o0, f32x16& o1, LAS const unsigned char* vtb, int r, int hh) {
    __builtin_amdgcn_s_setprio(1);
#pragma unroll
    for (int kt = 0; kt < 2; ++kt)
#pragma unroll
        for (int sp = 0; sp < 2; ++sp) { u32x4 w;
            if (kt == 0) { w.x = cvtpk(s0[8 * sp], s0[8 * sp + 1]); w.y = cvtpk(s0[8 * sp + 2], s0[8 * sp + 3]); w.z = cvtpk(s0[8 * sp + 4], s0[8 * sp + 5]); w.w = cvtpk(s0[8 * sp + 6], s0[8 * sp + 7]); }
            else         { w.x = cvtpk(s1[8 * sp], s1[8 * sp + 1]); w.y = cvtpk(s1[8 * sp + 2], s1[8 * sp + 3]); w.z = cvtpk(s1[8 * sp + 4], s1[8 * sp + 5]); w.w = cvtpk(s1[8 * sp + 6], s1[8 * sp + 7]); }
            const bf16x8 pb = __builtin_bit_cast(bf16x8, w); const int ko = 32 * kt + 16 * sp + 4 * hh;
            { const s16x4 lo = *(LAS const s16x4*)(vtb + r * VTB + ko * 2), hi = *(LAS const s16x4*)(vtb + r * VTB + (ko + 8) * 2);
              o0 = MFMA32(__builtin_shufflevector(lo, hi, 0, 1, 2, 3, 4, 5, 6, 7), pb, o0); }
            { const s16x4 lo = *(LAS const s16x4*)(vtb + (32 + r) * VTB + ko * 2), hi = *(LAS const s16x4*)(vtb + (32 + r) * VTB + (ko + 8) * 2);
              o1 = MFMA32(__builtin_shufflevector(lo, hi, 0, 1, 2, 3, 4, 5, 6, 7), pb, o1); } }
    __builtin_amdgcn_s_setprio(0);
}
template <int KT> __device__ __forceinline__ void pv_half(const f32x16& p, f32x16& o0, f32x16& o1, LAS const unsigned char* vtb, int r, int hh) {
    s16x4 lo0[2], hi0[2], lo1[2], hi1[2]; bf16x8 pb[2];
#pragma unroll
    for (int sp = 0; sp < 2; ++sp) { u32x4 w; w.x = cvtpk(p[8 * sp], p[8 * sp + 1]); w.y = cvtpk(p[8 * sp + 2], p[8 * sp + 3]); w.z = cvtpk(p[8 * sp + 4], p[8 * sp + 5]); w.w = cvtpk(p[8 * sp + 6], p[8 * sp + 7]);
        pb[sp] = __builtin_bit_cast(bf16x8, w); const int ko = 32 * KT + 16 * sp + 4 * hh;
        lo0[sp] = *(LAS const s16x4*)(vtb + r * VTB + ko * 2); hi0[sp] = *(LAS const s16x4*)(vtb + r * VTB + (ko + 8) * 2);
        lo1[sp] = *(LAS const s16x4*)(vtb + (32 + r) * VTB + ko * 2); hi1[sp] = *(LAS const s16x4*)(vtb + (32 + r) * VTB + (ko + 8) * 2); }
    __builtin_amdgcn_s_setprio(1);
#pragma unroll
    for (int sp = 0; sp < 2; ++sp) { o0 = MFMA32(__builtin_shufflevector(lo0[sp], hi0[sp], 0, 1, 2, 3, 4, 5, 6, 7), pb[sp], o0);
        o1 = MFMA32(__builtin_shufflevector(lo1[sp], hi1[sp], 0, 1, 2, 3, 4, 5, 6, 7), pb[sp], o1); }
    __builtin_amdgcn_s_setprio(0);
}
template <int MODE, class SF>
__device__ __forceinline__ void attn_block(const bf16x8 (&qf)[4], f32x16& o0, f32x16& o1, float& m, float& l, LAS const unsigned char* ksb, LAS const unsigned char* vtb, int r, int hh, const SF sf,
                                           float msafe_f, float inv_f, LAS float* imprw, int nbase, float& carry) {
    f32x16 s0, s1;
#pragma unroll
    for (int i = 0; i < 16; ++i) { s0[i] = 0.f; s1[i] = 0.f; }
    bf16x8 ka[4], kb2[4];
#pragma unroll
    for (int s = 0; s < 4; ++s) { ka[s] = *(LAS const bf16x8*)(ksb + r * KSB + (16 * s + 8 * hh) * 2); kb2[s] = *(LAS const bf16x8*)(ksb + (32 + r) * KSB + (16 * s + 8 * hh) * 2); }
    __builtin_amdgcn_s_setprio(1);
#pragma unroll
    for (int s = 0; s < 4; ++s) { s0 = MFMA32(ka[s], qf[s], s0); s1 = MFMA32(kb2[s], qf[s], s1); }
    __builtin_amdgcn_s_setprio(0);
    __builtin_amdgcn_sched_barrier(0);
#pragma unroll
    for (int i = 0; i < 16; ++i) { s0[i] = sf(s0[i], crow(i, hh)); s1[i] = sf(s1[i], 32 + crow(i, hh)); }
    if (MODE != 2) {
        float mloc = fmaxf(s0[0], s1[0]);
#pragma unroll
        for (int i = 1; i < 16; ++i) mloc = fmaxf(mloc, fmaxf(s0[i], s1[i]));
        mloc = max32(mloc);
        const float mnew = fmaxf(m, mloc), msafe = mnew == -INFINITY ? 0.f : mnew, corr = EXP2(m - msafe);
        float psum = 0.f;
#pragma unroll
        for (int i = 0; i < 16; ++i) { s0[i] = EXP2(s0[i] - msafe); s1[i] = EXP2(s1[i] - msafe); psum += s0[i] + s1[i]; }
        psum = sum32(psum);
        l = l * corr + psum; m = mnew;
        if (MODE == 0 && !__all(corr == 1.f)) {
#pragma unroll
            for (int i = 0; i < 16; ++i) { o0[i] *= corr; o1[i] *= corr; } }
    } else {
#pragma unroll
        for (int i = 0; i < 16; ++i) { s0[i] = EXP2(s0[i] - msafe_f) * inv_f; s1[i] = EXP2(s1[i] - msafe_f) * inv_f; }
#pragma unroll
        for (int kt = 0; kt < 2; ++kt) { float A[4], T[4], R[4];
#pragma unroll
            for (int g = 0; g < 4; ++g) { const float p0 = kt ? s1[4 * g] : s0[4 * g], p1 = kt ? s1[4 * g + 1] : s0[4 * g + 1], p2 = kt ? s1[4 * g + 2] : s0[4 * g + 2], p3 = kt ? s1[4 * g + 3] : s0[4 * g + 3];
                A[g] = 2.f * ((p0 + p1) + p2) + p3; T[g] = p3; R[g] = partner32(p3, hh); }
#pragma unroll
            for (int g = 0; g < 4; ++g) { const float prev = hh ? R[g] : (g ? R[g - 1] : carry);
                imprw[nbase + 8 * kt + 2 * g + hh] = A[g] + prev; }
            carry = R[3]; (void)T; }
    }
    __builtin_amdgcn_sched_barrier(0);
    if (MODE != 1) pv_accum(s0, s1, o0, o1, vtb, r, hh);
}


__device__ __forceinline__ void attn_block_full(const bf16x8 (&qf)[4], f32x16& o0, f32x16& o1, float& m, float& l, LAS const unsigned char* ksb, LAS const unsigned char* vtb, int r, int hh, float b0, float sl) {
    f32x16 s0, s1;
#pragma unroll
    for (int i = 0; i < 16; ++i) { s0[i] = 0.f; s1[i] = 0.f; }
    bf16x8 ka[4], kb2[4];
#pragma unroll
    for (int s = 0; s < 4; ++s) { ka[s] = *(LAS const bf16x8*)(ksb + r * KSB + (16 * s + 8 * hh) * 2); kb2[s] = *(LAS const bf16x8*)(ksb + (32 + r) * KSB + (16 * s + 8 * hh) * 2); }
    __builtin_amdgcn_s_setprio(1);
#pragma unroll
    for (int s = 0; s < 4; ++s) { s0 = MFMA32(ka[s], qf[s], s0); s1 = MFMA32(kb2[s], qf[s], s1); }
    __builtin_amdgcn_s_setprio(0);
    __builtin_amdgcn_sched_barrier(0);
#pragma unroll
    for (int i = 0; i < 16; ++i) { const float c = (float)((i & 3) + 8 * (i >> 2)); s0[i] = fmaf(sl, c, s0[i]); s1[i] = fmaf(sl, c + 32.f, s1[i]); }
    float mloc = fmaxf(s0[0], s1[0]);
#pragma unroll
    for (int i = 1; i < 16; ++i) mloc = fmaxf(mloc, fmaxf(s0[i], s1[i]));
    mloc = max32(mloc + b0);
    const float mnew = fmaxf(m, mloc), msafe = mnew == -INFINITY ? 0.f : mnew, corr = EXP2(m - msafe), c0 = b0 - msafe;
    if (!__all(corr == 1.f)) {
#pragma unroll
        for (int i = 0; i < 16; ++i) { o0[i] *= corr; o1[i] *= corr; } }
    float psum = 0.f;
#pragma unroll
    for (int i = 0; i < 16; ++i) { s0[i] = EXP2(s0[i] + c0); psum += s0[i]; }
    pv_half<0>(s0, o0, o1, vtb, r, hh);
#pragma unroll
    for (int i = 0; i < 16; ++i) { s1[i] = EXP2(s1[i] + c0); psum += s1[i]; }
    pv_half<1>(s1, o0, o1, vtb, r, hh);
    psum = sum32(psum);
    l = l * corr + psum; m = mnew;
}

#define KV_PIPELINE(FIRST, NEXT, SRC, NORM, GAIN, ...) do { \
    __syncthreads(); \
    int nxt_ = (FIRST), par_ = 0; u32x4 kc_, vc_; float g8_[8]; \
    { const float* gp_ = (GAIN); _Pragma("unroll") for (int j_ = 0; j_ < 8; ++j_) g8_[j_] = gp_ ? gp_[8 * (tid & 7) + j_] : 1.f; } \
    if (nxt_ >= 0) { const int id = nxt_; const KVSrc src_ = SRC; kv_fetch(src_, tid, kc_, vc_); } \
    while (nxt_ >= 0) { const int cur_ = nxt_; \
        LAS unsigned char* ksb = lds + par_ * KS_BYTES; LAS unsigned char* vtb = lds + 2 * KS_BYTES + par_ * VT_BYTES; \
        kv_store<NORM>(kc_, vc_, g8_, ksb, vtb, tid); \
        __syncthreads(); \
        { const int cur = cur_; nxt_ = (NEXT); } \
        if (nxt_ >= 0) { const int id = nxt_; const KVSrc src_ = SRC; kv_fetch(src_, tid, kc_, vc_); } \
        { const int id = cur_; __VA_ARGS__; } \
        par_ ^= 1; } } while (0)


__device__ __forceinline__ void kv_store_pre(u32x4 kc, u32x4 vc, LAS unsigned char* ksb, LAS unsigned char* vtb, int tid) {
    *(LAS u32x4*)(ksb + (tid >> 3) * KSB + (tid & 7) * 16) = kc;
    LAS u32x2* vp = (LAS u32x2*)(vtb + (tid >> 3) * VTB + (tid & 7) * 16); u32x2 a = {vc.x, vc.y}, b2 = {vc.z, vc.w}; vp[0] = a; vp[1] = b2;
}
#define KV_PIPELINE_PRE(FIRST, NEXT, KTILE, VTILE, ...) do { \
    __syncthreads(); \
    int nxt_ = (FIRST), par_ = 0; u32x4 kc_, vc_; \
    if (nxt_ >= 0) { const int id = nxt_; kc_ = *(const u32x4*)((KTILE) + tid * 8); vc_ = *(const u32x4*)((VTILE) + tid * 8); } \
    while (nxt_ >= 0) { const int cur_ = nxt_; \
        LAS unsigned char* ksb = lds + par_ * KS_BYTES; LAS unsigned char* vtb = lds + 2 * KS_BYTES + par_ * VT_BYTES; \
        kv_store_pre(kc_, vc_, ksb, vtb, tid); \
        __syncthreads(); \
        { const int cur = cur_; nxt_ = (NEXT); } \
        if (nxt_ >= 0) { const int id = nxt_; kc_ = *(const u32x4*)((KTILE) + tid * 8); vc_ = *(const u32x4*)((VTILE) + tid * 8); } \
        { const int id = cur_; __VA_ARGS__; } \
        par_ ^= 1; } } while (0)

__device__ __forceinline__ void nsa_prep_item(const bf16_t* proj, bf16_t* kn, bf16_t* vtn, const float* g_ks, const float* g_kw, int item, LAS unsigned char* scr, int lane) {
    const int b = item >> 7, which = (item >> 6) & 1, n = item & 63, ch = lane & 7, row0 = lane >> 3;
    const bf16_t* src = proj + ((size_t)b * SEQ + 64 * n) * NP + (which ? C_KWA : C_KSA) + 8 * ch;
    const float* g = (which ? g_kw : g_ks) + 8 * ch;
    float gg[8];
#pragma unroll
    for (int i = 0; i < 8; ++i) gg[i] = g[i];
    u32x4 kc[8], vc[8];
#pragma unroll
    for (int j = 0; j < 8; ++j) { const bf16_t* rp = src + (size_t)(row0 + 8 * j) * NP; kc[j] = *(const u32x4*)rp; vc[j] = *(const u32x4*)(rp + 64); }
    bf16_t* kdst = kn + (((size_t)b * 2 + which) * SEQ + 64 * n) * 64 + 8 * ch;
#pragma unroll
    for (int j = 0; j < 8; ++j) { const int row = row0 + 8 * j; UNPACK8(kc[j], k);
        float ss = (k0 * k0 + k1 * k1) + (k2 * k2 + k3 * k3) + (k4 * k4 + k5 * k5) + (k6 * k6 + k7 * k7);
        ss += swz_f<1>(ss); ss += swz_f<2>(ss); ss += swz_f<4>(ss);
        const float rs = rsqrtf(ss * (1.f / 64.f) + EPS); u32x4 o;
        o.x = cvtpk(k0 * rs * gg[0], k1 * rs * gg[1]); o.y = cvtpk(k2 * rs * gg[2], k3 * rs * gg[3]); o.z = cvtpk(k4 * rs * gg[4], k5 * rs * gg[5]); o.w = cvtpk(k6 * rs * gg[6], k7 * rs * gg[7]);
        *(u32x4*)(kdst + (size_t)row * 64) = o;
        LAS unsigned short* vp = (LAS unsigned short*)(scr + (8 * ch) * 144 + row * 2); const u32x4 v = vc[j];
        vp[0 * 72] = (unsigned short)(v.x & 0xffffu); vp[1 * 72] = (unsigned short)(v.x >> 16); vp[2 * 72] = (unsigned short)(v.y & 0xffffu); vp[3 * 72] = (unsigned short)(v.y >> 16);
        vp[4 * 72] = (unsigned short)(v.z & 0xffffu); vp[5 * 72] = (unsigned short)(v.z >> 16); vp[6 * 72] = (unsigned short)(v.w & 0xffffu); vp[7 * 72] = (unsigned short)(v.w >> 16); }
    LDS_WAIT();
    bf16_t* vdst = vtn + ((((size_t)b * 2 + which) * 64 + n) * 64 + lane) * 64;
#pragma unroll
    for (int c = 0; c < 8; ++c) *(u32x4*)(vdst + 8 * c) = *(LAS const u32x4*)(scr + lane * 144 + 16 * c);
    LDS_WAIT();
}

struct NsaArgs { const bf16_t* proj; bf16_t* groups; const bf16_t *kcn, *vcc; const float *b_gate, *g_q, *g_ks, *g_kw, *g_out; const bf16_t *kn, *vtn; };
constexpr int NSA_SLAB = 2 * KS_BYTES + 2 * VT_BYTES, NSA_ISUM = NSA_SLAB + 4 * 64 * 65 * 4, NSA_MASK = NSA_ISUM + 64 * 65 * 4, NSA_UMASK = NSA_MASK + 512;
__device__ __forceinline__ void nsa_item(const NsaArgs& A, int b, int tl, LAS unsigned char* lds, int tid) {
    asm volatile("" : "+v"(tid));
    const int lane = tid & 63, w = __builtin_amdgcn_readfirstlane(tid >> 6), head = w & 3, half = w >> 2, r = lane & 31, hh = lane >> 5;
    const int tq = tl * 64 + 32 * half + r, tokl = 32 * half + r; const size_t token = (size_t)b * SEQ + tq;
    const bf16_t* base = A.proj + (size_t)b * SEQ * NP;
    LAS float* slab = (LAS float*)(lds + NSA_SLAB); LAS float* isum = (LAS float*)(lds + NSA_ISUM);
    LAS unsigned* masks = (LAS unsigned*)(lds + NSA_MASK); LAS unsigned* umask = (LAS unsigned*)(lds + NSA_UMASK);
    const float slope = exp2f(-(float)(2 * head + 1)) * LOG2E;
    bf16x8 qf[4]; load_qfrag<true>(qf, base + (size_t)tq * NP + C_QA + head * 64, A.g_q, nullptr, 0.125f * LOG2E, hh);
    float gl[3];
#pragma unroll
    for (int br = 0; br < 3; ++br) { const float x = bf2f(base[(size_t)tq * NP + C_GT + head * 3 + br]) + A.b_gate[head * 3 + br]; gl[br] = 1.f / (1.f + __expf(-x)); }
    f32x16 of0, of1, o0, o1;
#pragma unroll
    for (int i = 0; i < 16; ++i) { of0[i] = 0.f; of1[i] = 0.f; }
    float dummy = 0.f;
    {
        const int nbc = (tl >> 4) + 1, nvis = tq >= 31 ? ((tq - 31) >> 4) + 1 : 0;
        const bf16_t* kc = A.kcn + (size_t)b * 256 * 64; const bf16_t* vc = A.vcc + (size_t)b * 256 * 64;
        float m = -INFINITY, l = 0.f;
        KV_PIPELINE_PRE(0, (cur + 1 < nbc ? cur + 1 : -1), kc + (size_t)id * 4096, vc + (size_t)id * 4096,
            { const SfCmp sf{tq, nvis, 64 * id, slope}; attn_block<1>(qf, o0, o1, m, l, ksb, vtb, r, hh, sf, 0.f, 0.f, nullptr, 0, dummy); });
        const float inv = l > 0.f ? 1.f / l : 0.f, msafe = m == -INFINITY ? 0.f : m; float carry = 0.f;
#pragma unroll
        for (int i = 0; i < 16; ++i) { o0[i] = 0.f; o1[i] = 0.f; }
        LAS float* imprw = slab + (head * 64 + tokl) * 65;
        KV_PIPELINE_PRE(0, (cur + 1 < nbc ? cur + 1 : -1), kc + (size_t)id * 4096, vc + (size_t)id * 4096,
            { const SfCmp sf{tq, nvis, 64 * id, slope}; attn_block<2>(qf, o0, o1, m, l, ksb, vtb, r, hh, sf, msafe, inv, imprw, 16 * id, carry); });
#pragma unroll
        for (int i = 0; i < 16; ++i) { of0[i] += gl[0] * o0[i]; of1[i] += gl[0] * o1[i]; }
    }
    __syncthreads();
    if (tl > 15) {
        for (int e = tid; e < 64 * 64; e += 512) { const int tk = e >> 6, n = e & 63, o = tk * 65 + n; isum[o] = ((slab[o] + slab[64 * 65 + o]) + slab[2 * 64 * 65 + o]) + slab[3 * 64 * 65 + o]; }
        __syncthreads();
        const int tk = tid >> 3, sub = tid & 7; float v[8]; int cnt[8];
#pragma unroll
        for (int k = 0; k < 8; ++k) { v[k] = isum[tk * 65 + 8 * sub + k]; cnt[k] = 0; }
        for (int mm = 1; mm <= tl - 2; ++mm) { const float vm = isum[tk * 65 + mm];
#pragma unroll
            for (int k = 0; k < 8; ++k) cnt[k] += (vm > v[k] || (vm == v[k] && mm < 8 * sub + k)) ? 1 : 0; }
        unsigned bits = 0u;
#pragma unroll
        for (int k = 0; k < 8; ++k) { const int n = 8 * sub + k; if (n >= 1 && n <= tl - 2 && cnt[k] < 13) bits |= 1u << k; }
        unsigned lo = sub < 4 ? bits << (8 * sub) : 0u, hi = sub >= 4 ? bits << (8 * (sub - 4)) : 0u;
        lo |= swz_u<1>(lo); hi |= swz_u<1>(hi); lo |= swz_u<2>(lo); hi |= swz_u<2>(hi); lo |= swz_u<4>(lo); hi |= swz_u<4>(hi);
        const unsigned long long mk = ((unsigned long long)hi << 32 | lo) | 1ull | (3ull << (tl - 1));
        if (sub == 0) { masks[2 * tk] = (unsigned)mk; masks[2 * tk + 1] = (unsigned)(mk >> 32); }
    } else if (tid < 64) { const unsigned long long mk = (2ull << tl) - 1ull; masks[2 * tid] = (unsigned)mk; masks[2 * tid + 1] = (unsigned)(mk >> 32); }
    __syncthreads();
    if (tid < 64) { unsigned lo = masks[2 * tid], hi = masks[2 * tid + 1];
        lo |= swz_u<1>(lo); hi |= swz_u<1>(hi); lo |= swz_u<2>(lo); hi |= swz_u<2>(hi); lo |= swz_u<4>(lo); hi |= swz_u<4>(hi);
        lo |= swz_u<8>(lo); hi |= swz_u<8>(hi); lo |= swz_u<16>(lo); hi |= swz_u<16>(hi); lo = or32(lo); hi = or32(hi);
        if (tid == 0) { umask[0] = lo; umask[1] = hi; } }
    __syncthreads();
    const unsigned long long um = (unsigned long long)umask[1] << 32 | umask[0];
    const unsigned long long mymask = (unsigned long long)masks[2 * tokl + 1] << 32 | masks[2 * tokl];
    LAS float* park = slab + w * 2048 + lane;
#pragma unroll
    for (int i = 0; i < 16; ++i) { park[i * 64] = of0[i]; park[(16 + i) * 64] = of1[i]; }
    {
        float m = -INFINITY, l = 0.f;
#pragma unroll
        for (int i = 0; i < 16; ++i) { o0[i] = 0.f; o1[i] = 0.f; }
        const bf16_t* kp = A.kn + (size_t)(b * 2) * SEQ * 64; const bf16_t* vp = A.vtn + (size_t)(b * 2) * 64 * 4096;
#define NSA_NEXTBIT(c) ({ const unsigned long long rem_ = ((c) >= 63) ? 0ull : (um & ~((2ull << (c)) - 1ull)); rem_ ? (int)__builtin_ctzll(rem_) : -1; })
        KV_PIPELINE_PRE((int)__builtin_ctzll(um), NSA_NEXTBIT(cur), kp + (size_t)id * 4096, vp + (size_t)id * 4096,
            { const bool sel = (mymask >> id) & 1ull;
              if (__any(sel)) {
                  if (id < tl) attn_block_full(qf, o0, o1, m, l, ksb, vtb, r, hh, sel ? -slope * (float)(tq - 64 * id - 4 * hh) : -INFINITY, slope);
                  else { const SfSlc sf{tq, 64 * id, slope, sel}; attn_block<0>(qf, o0, o1, m, l, ksb, vtb, r, hh, sf, 0.f, 0.f, nullptr, 0, dummy); } } });
        const float sc = gl[1] / l;
#pragma unroll
        for (int i = 0; i < 16; ++i) { park[i * 64] += sc * o0[i]; park[(16 + i) * 64] += sc * o1[i]; }
    }
    {
        float m = -INFINITY, l = 0.f;
#pragma unroll
        for (int i = 0; i < 16; ++i) { o0[i] = 0.f; o1[i] = 0.f; }
        const bf16_t* kp = A.kn + (size_t)(b * 2 + 1) * SEQ * 64; const bf16_t* vp = A.vtn + (size_t)(b * 2 + 1) * 64 * 4096; const int nlo = tl >= 8 ? tl - 8 : 0;
        KV_PIPELINE_PRE(nlo, (cur + 1 <= tl ? cur + 1 : -1), kp + (size_t)id * 4096, vp + (size_t)id * 4096,
            { if (id < tl && id >= tl - 7) attn_block_full(qf, o0, o1, m, l, ksb, vtb, r, hh, -slope * (float)(tq - 64 * id - 4 * hh), slope);
              else { const SfWin sf{tq, 64 * id, slope}; attn_block<0>(qf, o0, o1, m, l, ksb, vtb, r, hh, sf, 0.f, 0.f, nullptr, 0, dummy); } });
        const float sc = gl[2] / l;
#pragma unroll
        for (int i = 0; i < 16; ++i) { of0[i] = park[i * 64] + sc * o0[i]; of1[i] = park[(16 + i) * 64] + sc * o1[i]; }
    }
    {
        float ss = 0.f;
#pragma unroll
        for (int i = 0; i < 16; ++i) ss += of0[i] * of0[i] + of1[i] * of1[i];
        ss = sum32(ss);
        const float rs = rsqrtf(ss * (1.f / 64.f) + EPS); const float* go = A.g_out + head * 64; bf16_t* dst = A.groups + token * DM + head * 64;
#pragma unroll
        for (int g = 0; g < 4; ++g) { const int d0 = 8 * g + 4 * hh;
            u32x2 wa; wa.x = cvtpk(of0[4 * g] * rs * go[d0], of0[4 * g + 1] * rs * go[d0 + 1]); wa.y = cvtpk(of0[4 * g + 2] * rs * go[d0 + 2], of0[4 * g + 3] * rs * go[d0 + 3]);
            *(u32x2*)(dst + d0) = wa;
            u32x2 wb; wb.x = cvtpk(of1[4 * g] * rs * go[32 + d0], of1[4 * g + 1] * rs * go[32 + d0 + 1]); wb.y = cvtpk(of1[4 * g + 2] * rs * go[32 + d0 + 2], of1[4 * g + 3] * rs * go[32 + d0 + 3]);
            *(u32x2*)(dst + 32 + d0) = wb; }
    }
    __syncthreads();
}

struct SfDil { int iq, key0; float sl; __device__ __forceinline__ float operator()(float s, int kl) const { const int df = iq - key0 - kl; return (df >= 0 && df <= 128) ? s - sl * (float)df : -INFINITY; } };
struct DilArgs { const bf16_t* proj; bf16_t* po; float* plse; const float *g_q, *g_k; };
__device__ __forceinline__ void dil_item(const DilArgs& A, int item, LAS unsigned char* lds, int tid) {
    asm volatile("" : "+v"(tid));
    const int cfg = item >> 9, rem = item & 511, b = rem >> 6, head = (rem >> 4) & 3, sub = rem & 15;
    const int dil = cfg == 0 ? 1 : (cfg == 1 ? 4 : 16), nq = 16 / dil, c = sub / nq, qt = sub % nq, i0 = 256 * qt, L = SEQ / dil;
    const int lane = tid & 63, w = __builtin_amdgcn_readfirstlane(tid >> 6), r = lane & 31, hh = lane >> 5;
    const int iq = i0 + 32 * w + r, tq = c + dil * iq; const size_t token = (size_t)b * SEQ + tq;
    const bf16_t* base = A.proj + (size_t)b * SEQ * NP;
    const float slope = exp2f(-(float)(2 * head + 2)) * (float)dil * LOG2E;
    bf16x8 qf[4]; load_qfrag<true>(qf, base + (size_t)tq * NP + C_QD + head * 64, A.g_q, nullptr, 0.125f * LOG2E, hh);
    const bf16_t* kp = base + (size_t)c * NP + C_KD + head * 64; const bf16_t* vp = base + (size_t)c * NP + C_VD + head * 64;
    const int kb_lo = (i0 >> 6) >= 2 ? (i0 >> 6) - 2 : 0, kb_hi = (i0 >> 6) + 3, q_lo = i0 + 32 * w;
    f32x16 o0, o1;
#pragma unroll
    for (int i = 0; i < 16; ++i) { o0[i] = 0.f; o1[i] = 0.f; }
    float m = -INFINITY, l = 0.f, dummy = 0.f;
    KV_PIPELINE(kb_lo, (cur + 1 <= kb_hi ? cur + 1 : -1), (KVSrc{kp, vp, (long)dil * NP, 64 * id, 0, L}), true, A.g_k,
        { if (64 * id + 63 >= q_lo - 128 && 64 * id <= q_lo + 31) { const SfDil sf{iq, 64 * id, slope}; attn_block<0>(qf, o0, o1, m, l, ksb, vtb, r, hh, sf, 0.f, 0.f, nullptr, 0, dummy); } });
    const float inv = 1.f / l;
    bf16_t* dst = A.po + ((size_t)cfg * M + token) * 256 + head * 64;
#pragma unroll
    for (int g = 0; g < 4; ++g) { const int d0 = 8 * g + 4 * hh;
        u32x2 wa; wa.x = cvtpk(o0[4 * g] * inv, o0[4 * g + 1] * inv); wa.y = cvtpk(o0[4 * g + 2] * inv, o0[4 * g + 3] * inv); *(u32x2*)(dst + d0) = wa;
        u32x2 wb; wb.x = cvtpk(o1[4 * g] * inv, o1[4 * g + 1] * inv); wb.y = cvtpk(o1[4 * g + 2] * inv, o1[4 * g + 3] * inv); *(u32x2*)(dst + 32 + d0) = wb; }
    if (hh == 0) A.plse[((size_t)cfg * M + token) * 4 + head] = m + __log2f(l);
    __syncthreads();
}
template <int NI> __device__ __forceinline__ void dil_merge_items(const bf16_t* po, const float* plse, bf16_t* groups, const float* g_out, int item0, int stride, int lane) {
    const int pair = lane >> 3, ch = lane & 7, head = pair & 3;
    u32x4 pv[NI][3]; float ls[NI][3];
#pragma unroll
    for (int n = 0; n < NI; ++n) { const size_t token = (size_t)(item0 + n * stride) * 2 + (pair >> 2);
#pragma unroll
        for (int i = 0; i < 3; ++i) { ls[n][i] = plse[((size_t)i * M + token) * 4 + head]; pv[n][i] = *(const u32x4*)(po + ((size_t)i * M + token) * 256 + head * 64 + 8 * ch); } }
    const float* go = g_out + 768 + head * 64 + 8 * ch;
#pragma unroll
    for (int n = 0; n < NI; ++n) { const size_t token = (size_t)(item0 + n * stride) * 2 + (pair >> 2);
        const float mx = fmaxf(ls[n][0], fmaxf(ls[n][1], ls[n][2]));
        const float w0 = EXP2(ls[n][0] - mx), w1 = EXP2(ls[n][1] - mx), w2 = EXP2(ls[n][2] - mx), winv = 1.f / (w0 + w1 + w2);
        float o[8];
#pragma unroll
        for (int j = 0; j < 8; ++j) o[j] = 0.f;
#pragma unroll
        for (int i = 0; i < 3; ++i) { UNPACK8(pv[n][i], k); const float wi = (i == 0 ? w0 : (i == 1 ? w1 : w2)) * winv;
            o[0] += wi * k0; o[1] += wi * k1; o[2] += wi * k2; o[3] += wi * k3; o[4] += wi * k4; o[5] += wi * k5; o[6] += wi * k6; o[7] += wi * k7; }
        float ss = 0.f;
#pragma unroll
        for (int j = 0; j < 8; ++j) ss += o[j] * o[j];
        ss += swz_f<1>(ss); ss += swz_f<2>(ss); ss += swz_f<4>(ss);
        const float rs = rsqrtf(ss * (1.f / 64.f) + EPS);
        u32x4 wv; wv.x = cvtpk(o[0] * rs * go[0], o[1] * rs * go[1]); wv.y = cvtpk(o[2] * rs * go[2], o[3] * rs * go[3]); wv.z = cvtpk(o[4] * rs * go[4], o[5] * rs * go[5]); wv.w = cvtpk(o[6] * rs * go[6], o[7] * rs * go[7]);
        *(u32x4*)(groups + token * DM + 768 + head * 64 + 8 * ch) = wv; }
}

__device__ __forceinline__ void stick_block(const bf16x8 (&qf)[4], f32x16& o0, f32x16& o1, float& carry, LAS const unsigned char* ksb, LAS const unsigned char* vtb, int r, int hh, int tq, int key0) {
    f32x16 s0, s1;
#pragma unroll
    for (int i = 0; i < 16; ++i) { s0[i] = 0.f; s1[i] = 0.f; }
    bf16x8 ka[4], kb2[4];
#pragma unroll
    for (int s = 0; s < 4; ++s) { ka[s] = *(LAS const bf16x8*)(ksb + r * KSB + (16 * s + 8 * hh) * 2); kb2[s] = *(LAS const bf16x8*)(ksb + (32 + r) * KSB + (16 * s + 8 * hh) * 2); }
    __builtin_amdgcn_s_setprio(1);
#pragma unroll
    for (int s = 0; s < 4; ++s) { s0 = MFMA32(ka[s], qf[s], s0); s1 = MFMA32(kb2[s], qf[s], s1); }
    __builtin_amdgcn_s_setprio(0);
    __builtin_amdgcn_sched_barrier(0);
    float acc = carry;
#pragma unroll
    for (int kti = 0; kti < 2; ++kti) { const int kt = 1 - kti; float spm[16], G[4], R[4];
#pragma unroll
        for (int i = 0; i < 16; ++i) { const float z = kt ? s1[i] : s0[i]; const bool act = key0 + 32 * kt + crow(i, hh) < tq;
            const float sp = fmaxf(z, 0.f) + __logf(1.f + __expf(-fabsf(z)));
            spm[i] = act ? sp : 0.f; const float lw = act ? z - sp : -INFINITY; if (kt) s1[i] = lw; else s0[i] = lw; }
#pragma unroll
        for (int g = 0; g < 4; ++g) { G[g] = (spm[4 * g] + spm[4 * g + 1]) + (spm[4 * g + 2] + spm[4 * g + 3]); R[g] = partner32(G[g], hh); }
#pragma unroll
        for (int gi = 0; gi < 4; ++gi) { const int g = 3 - gi; float run = acc + (hh ? 0.f : R[g]);
#pragma unroll
            for (int ki = 0; ki < 4; ++ki) { const int i = 4 * g + 3 - ki; const float lw = kt ? s1[i] : s0[i]; const float wv = __expf(lw - run); if (kt) s1[i] = wv; else s0[i] = wv; run += spm[i]; }
            acc += G[g] + R[g]; } }
    carry = acc;
    __builtin_amdgcn_sched_barrier(0);
    pv_accum(s0, s1, o0, o1, vtb, r, hh);
}
struct StickArgs { const bf16_t* proj; bf16_t* groups; const float* g_out; };
__device__ __forceinline__ void stick_item(const StickArgs& A, int item, LAS unsigned char* lds, int tid) {
    asm volatile("" : "+v"(tid));
    const int b = item >> 6, head = (item >> 4) & 3, qt = item & 15, T0 = 256 * qt;
    const int lane = tid & 63, w = __builtin_amdgcn_readfirstlane(tid >> 6), r = lane & 31, hh = lane >> 5, tq = T0 + 32 * w + r;
    const size_t token = (size_t)b * SEQ + tq;
    const bf16_t* base = A.proj + (size_t)b * SEQ * NP;
    bf16x8 qf[4]; load_qfrag<false>(qf, base + (size_t)tq * NP + C_QC + head * 64, nullptr, nullptr, 0.125f, hh);
    LAS unsigned* flags = (LAS unsigned*)(lds + NSA_SLAB);
    if (tid < 16) flags[tid] = 0u;
    f32x16 o0, o1;
#pragma unroll
    for (int i = 0; i < 16; ++i) { o0[i] = 0.f; o1[i] = 0.f; }
    float carry = 0.f; bool done = false;
    const bf16_t* kp = base + C_KC + head * 64; const bf16_t* vp = base + C_VC + head * 64;
#define STK_NEXT(c) ({ const LAS unsigned* f_ = flags + (par_ ^ 1) * 8; const unsigned ad_ = (f_[0] & f_[1]) & (f_[2] & f_[3]) & (f_[4] & f_[5]) & (f_[6] & f_[7]); ((c) > 0 && !ad_) ? (c) - 1 : -1; })
    KV_PIPELINE((T0 >> 6) + 3, STK_NEXT(cur), (KVSrc{kp, vp, NP, 64 * id, 0, SEQ}), false, nullptr,
        { if (!done && 64 * id <= T0 + 32 * w + 30) { stick_block(qf, o0, o1, carry, ksb, vtb, r, hh, tq, 64 * id); done = __all(carry > 104.f); }
          if (lane == 0) flags[par_ * 8 + w] = done ? 1u : 0u; });
    float ss = 0.f;
#pragma unroll
    for (int i = 0; i < 16; ++i) ss += o0[i] * o0[i] + o1[i] * o1[i];
    ss = sum32(ss);
    const float rs = rsqrtf(ss * (1.f / 64.f) + EPS); const float* go = A.g_out + 512 + head * 64; bf16_t* dst = A.groups + token * DM + 512 + head * 64;
#pragma unroll
    for (int g = 0; g < 4; ++g) { const int d0 = 8 * g + 4 * hh;
        u32x2 wa; wa.x = cvtpk(o0[4 * g] * rs * go[d0], o0[4 * g + 1] * rs * go[d0 + 1]); wa.y = cvtpk(o0[4 * g + 2] * rs * go[d0 + 2], o0[4 * g + 3] * rs * go[d0 + 3]); *(u32x2*)(dst + d0) = wa;
        u32x2 wb; wb.x = cvtpk(o1[4 * g] * rs * go[32 + d0], o1[4 * g + 1] * rs * go[32 + d0 + 1]); wb.y = cvtpk(o1[4 * g + 2] * rs * go[32 + d0 + 2], o1[4 * g + 3] * rs * go[32 + d0 + 3]); *(u32x2*)(dst + 32 + d0) = wb; }
    __syncthreads();
}

struct CmpArgs { const bf16_t* proj; const bf16_t* w1t; const bf16_t* w2t; const float* cb; const float* g_kc; bf16_t* kcn; bf16_t* vcc; };
constexpr int HIDB = 528;
__device__ __forceinline__ void compress_item(const CmpArgs& A, int item, LAS unsigned char* lds, int tid) {
    asm volatile("" : "+v"(tid));
    const int kv = item >> 6, rt = item & 63, b = rt >> 3, j0 = (rt & 7) * 32;
    const int lane = tid & 63, w = __builtin_amdgcn_readfirstlane(tid >> 6), r = lane & 31, hh = lane >> 5;
    { const bf16_t* xsrc = A.proj + (size_t)b * SEQ * NP + (kv ? C_VCA : C_KCA);
      u32x4 stg[9];
#pragma unroll
      for (int q = 0; q < 9; ++q) { const int e2 = tid + 512 * q, t = e2 >> 3, c = e2 & 7; int tk = 16 * j0 + t; tk = tk < SEQ ? tk : SEQ - 1;
          if (e2 < 528 * 8) stg[q] = *(const u32x4*)(xsrc + (size_t)tk * NP + 8 * c); }
#pragma unroll
      for (int q = 0; q < 9; ++q) { const int e2 = tid + 512 * q, t = e2 >> 3, c = e2 & 7;
          if (e2 < 528 * 8) *(LAS u32x4*)(lds + (t ^ ((t >> 7) & 1)) * 128 + ((c ^ ((t >> 4) & 7)) * 16)) = stg[q]; } }
    __syncthreads();
    const bf16_t* wf = A.w1t + (size_t)kv * 256 * 2048 + ((size_t)w * 128 * 64 + lane) * 8;
    f32x16 acc;
#pragma unroll
    for (int i = 0; i < 16; ++i) acc[i] = 0.f;
#pragma unroll 8
    for (int pos = 0; pos < 32; ++pos) { const int t = 16 * r + pos; LAS const unsigned char* arow = lds + (t ^ ((t >> 7) & 1)) * 128; const int sw = (t >> 4) & 7;
#pragma unroll
        for (int q = 0; q < 4; ++q) { const bf16x8 af = *(LAS const bf16x8*)(arow + (((2 * q + hh) ^ sw) * 16)), bfr = *(const bf16x8*)(wf + (size_t)(4 * pos + q) * 512); acc = MFMA32(af, bfr, acc); } }
    __syncthreads();
    { const float bias = A.cb[kv * 256 + 32 * w + r];
#pragma unroll
      for (int i = 0; i < 16; ++i) { const float x = acc[i] + bias; const float hv = 0.5f * x * (1.f + tanhf(0.7978845608028654f * (x + 0.044715f * x * x * x)));
          *(LAS unsigned short*)(lds + crow(i, hh) * HIDB + (32 * w + r) * 2) = (unsigned short)(cvtpk(hv, hv) & 0xffffu); } }
    __syncthreads();
    if (w == 0) {
        f32x16 c0, c1;
#pragma unroll
        for (int i = 0; i < 16; ++i) { c0[i] = 0.f; c1[i] = 0.f; }
        const bf16_t* w2a = A.w2t + ((size_t)kv * 64 + r) * 256 + 8 * hh; const bf16_t* w2b = w2a + 32 * 256;
#pragma unroll
        for (int s = 0; s < 16; ++s) { const bf16x8 af = *(LAS const bf16x8*)(lds + r * HIDB + (16 * s + 8 * hh) * 2);
            c0 = MFMA32(af, *(const bf16x8*)(w2a + 16 * s), c0); c1 = MFMA32(af, *(const bf16x8*)(w2b + 16 * s), c1); }
        const float g0 = A.g_kc[r], g1 = A.g_kc[32 + r]; bf16_t* dst = (kv ? A.vcc : A.kcn) + ((size_t)b * 256 + j0) * 64;
#pragma unroll
        for (int i = 0; i < 16; ++i) { float v0 = c0[i], v1 = c1[i];
            if (!kv) { float ss = v0 * v0 + v1 * v1; ss += swz_f<1>(ss); ss += swz_f<2>(ss); ss += swz_f<4>(ss); ss += swz_f<8>(ss); ss += swz_f<16>(ss);
                const float rs = rsqrtf(ss * (1.f / 64.f) + EPS); v0 *= rs * g0; v1 *= rs * g1; }
            const int row = crow(i, hh);
            if (!kv) { dst[row * 64 + r] = (bf16_t)(cvtpk(v0, v0) & 0xffffu); dst[row * 64 + 32 + r] = (bf16_t)(cvtpk(v1, v1) & 0xffffu); }
            else { const int j = j0 + row; bf16_t* vt = A.vcc + ((size_t)b * 4 + (j >> 6)) * 4096 + (j & 63);
                vt[(size_t)r * 64] = (bf16_t)(cvtpk(v0, v0) & 0xffffu); vt[(size_t)(32 + r) * 64] = (bf16_t)(cvtpk(v1, v1) & 0xffffu); } }
    }
    __syncthreads();
}
#define RLX_AGENT __ATOMIC_RELAXED, __HIP_MEMORY_SCOPE_AGENT
#define XB_TMO      128
#define XB_XCNT(j)  (256  + 64 * (j))
#define XB_XSUB(j)  (1280 + 64 * (j))
#define XB_XGEN(j)  (2304 + 64 * (j))
#define XB_TOP      3328
#define XB_TOPGEN   3392
#define XCD_BAR_WORDS 3456
#define XB_SPIN_CAP (1u << 18)

__device__ __forceinline__ unsigned xb_ld(unsigned* p)              { return __hip_atomic_load(p, __ATOMIC_RELAXED, __HIP_MEMORY_SCOPE_AGENT); }
__device__ __forceinline__ unsigned xb_add(unsigned* p, unsigned v) { return __hip_atomic_fetch_add(p, v, __ATOMIC_RELAXED, __HIP_MEMORY_SCOPE_AGENT); }
__device__ __forceinline__ unsigned xb_xcc_id() { return (unsigned)__builtin_amdgcn_s_getreg((3 << 11) | 20) & 0xFu; }
#define XB_SPIN(cond, bar) do { unsigned _sp = 0; while (cond) { __builtin_amdgcn_s_sleep(1); \
    if ((++_sp & 255u) == 0u) { if (xb_ld(&(bar)[XB_TMO])) break; if (_sp > XB_SPIN_CAP) { atomicAdd(&(bar)[XB_TMO], 1u); break; } } } } while (0)

struct XcdBarrier {
    unsigned* bar; unsigned x;
    volatile LAS unsigned* st;
};

__device__ __forceinline__ XcdBarrier xcd_barrier_post(unsigned* bar, volatile LAS unsigned* st) {
    XcdBarrier b; b.bar = bar; b.x = xb_xcc_id(); b.st = st;
    if (threadIdx.x == 0) (void)xb_add(&bar[XB_XCNT(b.x)], 1u);
    return b;
}
__device__ __forceinline__ void xcd_barrier_complete(unsigned* bar, unsigned x, unsigned& nloc, unsigned& nx) {
    const unsigned G = gridDim.x * gridDim.y * gridDim.z;
    unsigned sum, cnt, mine, sp = 0u;
    for (;;) {
        sum = 0u; cnt = 0u; mine = 0u;
#pragma unroll
        for (unsigned j = 0; j < 16; ++j) { const unsigned c = xb_ld(&bar[XB_XCNT(j)]); sum += c; cnt += (c > 0u) ? 1u : 0u; mine = (j == x) ? c : mine; }
        if (sum == G) break;
        __builtin_amdgcn_s_sleep(1);
        if ((++sp & 255u) == 0u) { if (xb_ld(&bar[XB_TMO])) break; if (sp > XB_SPIN_CAP) { atomicAdd(&bar[XB_TMO], 1u); break; } }
    }
    nloc = mine > 0u ? mine : 1u; nx = cnt > 0u ? cnt : 1u;
}

__device__ __forceinline__ void xcd_barrier(const XcdBarrier& b) {
    asm volatile("s_waitcnt vmcnt(0)" ::: "memory");
    __syncthreads();
    if (threadIdx.x == 0) {
        unsigned* bar = b.bar;
        __builtin_amdgcn_s_waitcnt(0);
        unsigned nloc = b.st[0], nx = b.st[1];
        if (nloc == 0u) { xcd_barrier_complete(bar, b.x, nloc, nx); b.st[0] = nloc; b.st[1] = nx; }
        const unsigned old = xb_add(&bar[XB_XSUB(b.x)], 1u);
        const unsigned gen = old / nloc;
        if (old + 1u == (gen + 1u) * nloc) {
            __builtin_amdgcn_fence(__ATOMIC_RELEASE, "agent");
            asm volatile("s_waitcnt vmcnt(0)" ::: "memory");
            const unsigned og = xb_add(&bar[XB_TOP], 1u);
            const unsigned tg = og / nx;
            if (og + 1u == (tg + 1u) * nx) xb_add(&bar[XB_TOPGEN], 1u);
            else XB_SPIN(xb_ld(&bar[XB_TOPGEN]) == tg, bar);
            __builtin_amdgcn_fence(__ATOMIC_ACQUIRE, "agent");
            xb_add(&bar[XB_XGEN(b.x)], 1u);
            asm volatile("s_waitcnt vmcnt(0)" ::: "memory");
        } else {
            XB_SPIN(xb_ld(&bar[XB_XGEN(b.x)]) == gen, bar);
            __builtin_amdgcn_fence(__ATOMIC_ACQUIRE, "agent");
            asm volatile("s_waitcnt vmcnt(0)" ::: "memory");
        }
    }
    __syncthreads();
}

#ifndef REP_CMP
#define REP_CMP 1
#endif
#ifndef REP_STK
#define REP_STK 1
#endif
#ifndef REP_DIL
#define REP_DIL 1
#endif
#ifndef REP_NSA
#define REP_NSA 1
#endif
#ifndef REP_G1
#define REP_G1 1
#endif
#ifndef REP_G3
#define REP_G3 1
#endif
#ifndef REP_PRO
#define REP_PRO 1
#endif
#ifndef REP_PREP
#define REP_PREP 1
#endif
#ifndef RESID_BF16
#define RESID_BF16 1
#endif
#ifndef REP_CONV
#define REP_CONV 1
#endif
#ifndef REP_G2
#define REP_G2 1
#endif
#ifndef XSYNC
#define XSYNC 0
#endif
__global__ void __launch_bounds__(512, 2) fwd_kernel(Params p) {
    extern __shared__ __attribute__((aligned(16))) unsigned char lds_raw[];
    cg::grid_group grid = cg::this_grid();
    LAS unsigned char* lds = (LAS unsigned char*)lds_raw;
#define TID_SETUP() int tid = threadIdx.x; asm volatile("" : "+v"(tid)); const int lane = tid & 63, wave = __builtin_amdgcn_readfirstlane(tid >> 6), gw = blockIdx.x * 8 + wave; (void)lane; (void)gw
    const int G = gridDim.x, NGW = G * 8;
    unsigned char* ws = p.ws;
    volatile LAS unsigned* misc = (volatile LAS unsigned*)(lds + LDS_BYTES - 64);
    unsigned* barw = (unsigned*)(ws + WS_BAR);
    { int t0 = threadIdx.x; if (t0 < 2) misc[t0] = 0u;
      if (blockIdx.x == 0) for (int i = t0; i < XCD_BAR_WORDS; i += 512) barw[i] = 0u;
      __syncthreads(); }
    float* ss = (float*)(ws + WS_SS); bf16_t* kcn = (bf16_t*)(ws + WS_KCN); bf16_t* vcc = (bf16_t*)(ws + WS_VCC);
    bf16_t* xb = (bf16_t*)(ws + WS_XB); bf16_t* groups = (bf16_t*)(ws + WS_GR); bf16_t* proj = (bf16_t*)(ws + WS_PROJ); bf16_t* hbuf = proj;
    float* x1 = (float*)(ws + WS_X1); bf16_t* nkn = (bf16_t*)(ws + WS_X1); bf16_t* nvt = (bf16_t*)(ws + WS_X1 + 8 * MiB);
    bf16_t* dpo = (bf16_t*)((unsigned char*)p.out + DO_PO); float* dlse = (float*)((unsigned char*)p.out + DO_LSE);

#ifndef SKIP_PRO
    for (int rep_ = 0; rep_ < REP_PRO; ++rep_) { TID_SETUP(); prologue(p, lds, gw, NGW, wave, lane); }
#endif
    grid.sync();
    const XcdBarrier xbar = xcd_barrier_post(barw, misc);
    for (int xs_ = 0; xs_ < XSYNC; ++xs_) xcd_barrier(xbar);

    for (int l = 0; l < 2; ++l) {
        unsigned char* wl = ws + WS_W + (size_t)l * W_LAYER;
#ifndef SKIP_G1
        for (int rep_ = 0; rep_ < REP_G1; ++rep_)
        { pg8::Gemm g{xb, (const bf16_t*)(wl + W_IN), M, NP, DM}; pg8::StaticOrder S; S.init(M, NP, G, (int)blockIdx.x);
          EpiProj E{proj, ss + (size_t)(2 * l) * M};
          pg8::gemm_phase<EpiProj, pg8::StaticOrder, true, true>(lds, g, S, E); }
#endif
        xcd_barrier(xbar);
        {
            TID_SETUP();
            const float* g_out = p.in[17] + l * DM;
            {
              const CmpArgs CA{proj, (const bf16_t*)(ws + WS_W1T) + (size_t)l * 2 * 256 * 2048, (const bf16_t*)(ws + WS_W2T) + (size_t)l * 2 * 64 * 256, (const float*)(ws + WS_CB) + l * 512, p.in[5] + l * 64, kcn, vcc};
              const StickArgs SA{proj, groups, g_out}; const DilArgs DA{proj, dpo, dlse, p.in[15] + l * 64, p.in[16] + l * 64};
              volatile LAS int* slot = (volatile LAS int*)(lds + LDS_BYTES - 32);
              for (;;) { __syncthreads(); if (tid == 0) *slot = (int)atomicAdd(barw + 32 + 64 * l, 1u); __syncthreads(); const int it = *slot; if (it >= 128 + 512 + 1536) break;
                  if (it < 128) compress_item(CA, it, lds, tid); else if (it < 640) stick_item(SA, it - 128, lds, tid); else dil_item(DA, it - 640, lds, tid); } }
            for (int it = gw; it < 1024; it += NGW) nsa_prep_item(proj, nkn, nvt, p.in[6] + l * 64, p.in[7] + l * 64, it, lds + wave * 9216, lane);
            if (G == 256) { for (int it = gw; it < M / 2; it += 4 * NGW) conv_items<4>(proj, groups, p.in[14] + l * 768, g_out, it, NGW, lane); }
            else for (int it = gw; it < M / 2; it += NGW) conv_items<1>(proj, groups, p.in[14] + l * 768, g_out, it, 0, lane);
        }
        xcd_barrier(xbar);
#ifndef SKIP_NSA
#ifndef SKIP_DIL
        for (int rep_ = 0; rep_ < REP_CONV; ++rep_)
        { TID_SETUP(); if (G == 256) { for (int it = gw; it < M / 2; it += 4 * NGW) dil_merge_items<4>(dpo, dlse, groups, p.in[17] + l * DM, it, NGW, lane); }
          else for (int it = gw; it < M / 2; it += NGW) dil_merge_items<1>(dpo, dlse, groups, p.in[17] + l * DM, it, 0, lane); }
#endif
        for (int rep_ = 0; rep_ < REP_NSA; ++rep_)
        { TID_SETUP(); NsaArgs A{proj, groups, kcn, vcc, p.in[3] + l * 12, p.in[4] + l * 64, p.in[6] + l * 64, p.in[7] + l * 64, p.in[17] + l * DM, nkn, nvt};
          volatile LAS int* slot = (volatile LAS int*)(lds + LDS_BYTES - 32);
          for (;;) { __syncthreads(); if (tid == 0) *slot = (int)atomicAdd(barw + 64 * l, 1u); __syncthreads(); const int it = *slot; if (it >= 512) break; nsa_item(A, it & 7, 63 - (it >> 3), lds, tid); } }
#endif
        xcd_barrier(xbar);
#ifndef SKIP_G2
        { pg8::Gemm g{groups, (const bf16_t*)(wl + W_OUT), M, DM, DM}; pg8::StaticOrder S; S.init(M, DM, G, (int)blockIdx.x);
#if RESID_BF16
          EpiResid E{l == 0 ? p.in[0] : nullptr, xb, nullptr, xb, ss + (size_t)(2 * l + 1) * M};
#else
          EpiResid E{l == 0 ? p.in[0] : x1, nullptr, l == 0 ? x1 : p.out, xb, ss + (size_t)(2 * l + 1) * M};
#endif
          pg8::gemm_phase<EpiResid, pg8::StaticOrder, true, true>(lds, g, S, E);
          for (int rep_ = 1; rep_ < REP_G2; ++rep_) { E.ss = nullptr; pg8::gemm_phase<EpiResid, pg8::StaticOrder, true, true>(lds, g, S, E); } }
#endif
        xcd_barrier(xbar);
#ifndef SKIP_G3
        for (int rep_ = 0; rep_ < REP_G3; ++rep_)
        { pg8::Gemm g{xb, (const bf16_t*)(wl + W_GU), M, NGU, DM}; pg8::StaticOrder S; S.init(M, NGU, G, (int)blockIdx.x);
          EpiSwiGLU E{hbuf, ss + (size_t)(2 * l + 1) * M};
          pg8::gemm_phase<EpiSwiGLU, pg8::StaticOrder, true, true>(lds, g, S, E); }
#endif
        xcd_barrier(xbar);
#ifndef SKIP_G4
        { pg8::Gemm g{hbuf, (const bf16_t*)(wl + W_DN), M, DM, FF}; pg8::StaticOrder S; S.init(M, DM, G, (int)blockIdx.x);
          float* xio = l == 0 ? x1 : p.out;
#if RESID_BF16
          EpiResid E{nullptr, xb, l == 0 ? nullptr : p.out, l == 0 ? xb : nullptr, l == 0 ? ss + (size_t)2 * M : nullptr}; (void)xio;
#else
          EpiResid E{xio, nullptr, xio, l == 0 ? xb : nullptr, l == 0 ? ss + (size_t)2 * M : nullptr};
#endif
          pg8::gemm_phase<EpiResid, pg8::StaticOrder, true, true>(lds, g, S, E); }
#endif
        if (l == 0) xcd_barrier(xbar);
    }
}

extern "C" void kernel_launch(void* const* d_in, const int* in_sizes, int n_in, void* d_out, int out_size, void* d_ws, size_t ws_size, hipStream_t stream) {
    static int grid = 0;
    if (grid == 0) {
        if (n_in != 23 || out_size != M * DM || ws_size < WS_END) { fprintf(stderr, "kernel_launch: unexpected shapes (n_in %d, out %d, ws %zu)\n", n_in, out_size, ws_size); grid = -1; return; }
        int dev = 0, cus = 0, per_cu = 0;
        (void)hipGetDevice(&dev); (void)hipDeviceGetAttribute(&cus, hipDeviceAttributeMultiprocessorCount, dev);
        if (hipFuncSetAttribute((const void*)fwd_kernel, hipFuncAttributeMaxDynamicSharedMemorySize, LDS_BYTES) != hipSuccess) { fprintf(stderr, "kernel_launch: hipFuncSetAttribute failed\n"); grid = -1; return; }
        if (hipOccupancyMaxActiveBlocksPerMultiprocessor(&per_cu, (const void*)fwd_kernel, 512, LDS_BYTES) != hipSuccess || per_cu < 1) per_cu = 1;
        (void)hipGetLastError();
        grid = cus * 1;
        (void)per_cu;
    }
    if (grid < 0) return;
    Params p{};
    for (int i = 0; i < 23; ++i) p.in[i] = (const float*)d_in[i];
    p.out = (float*)d_out; p.ws = (unsigned char*)d_ws;
    void* args[] = {&p};
    hipError_t e = hipLaunchCooperativeKernel((const void*)fwd_kernel, dim3(grid), dim3(512), args, LDS_BYTES, stream);
    if (e != hipSuccess) fprintf(stderr, "cooperative launch failed: %s (grid %d)\n", hipGetErrorString(e), grid);
}
```

```cpp
#include <hip/hip_runtime.h>
#include <hip/hip_cooperative_groups.h>
#include <cstdio>
#include <cstdint>
namespace cg = cooperative_groups;
namespace pg8 {
#define PG8_LAS __attribute__((address_space(3)))
typedef unsigned short bf16_t;
typedef short bf16x8 __attribute__((ext_vector_type(8)));
typedef float f32x4 __attribute__((ext_vector_type(4)));
typedef unsigned u32x4 __attribute__((ext_vector_type(4)));
constexpr int BM = 256, BK = 64, HALF = 128, HTB = HALF * BK * 2  , STAGE_BYTES = 8 * HTB, NXCD = 8, WGM = 8;

__host__ __device__ __forceinline__ int lds_byte(int r, int c) { const int st = (r >> 4) * 2 + (c >> 5), rr = r & 15, cc = c & 31, ob = rr * 64 + cc * 2; return st * 1024 + (ob ^ (((ob >> 9) & 1) << 5)); }
__host__ __device__ __forceinline__ void stage_rc(int b, int& R, int& C) { const int st = b / 1024, sb = b % 1024, swz = sb ^ (((sb >> 9) & 1) << 5); R = (st >> 1) * 16 + swz / 64; C = (st & 1) * 32 + (swz % 64) / 2; }
__host__ __device__ __forceinline__ int perm32(int rho) { const int n = rho >> 4, i = rho & 15; return 8 * (i >> 2) + 4 * n + (i & 3); }

struct Unit { int pm, pn; };
struct Gemm { const bf16_t* A; const bf16_t* Bt; int M, N, K; };

struct StaticOrder {
    int nM, nN, nwg, G, c;
    __host__ __device__ void init(int M, int N, int G_, int c_) { nM = M / BM; nN = N / BM; nwg = nM * nN; G = G_; c = c_; }
    __host__ __device__ bool next(int i, Unit& u) const {
        const long L = (long)i * G + c; if (L >= nwg) return false;
        int wgid = (int)L; { const int q = nwg / NXCD, r = nwg % NXCD, xcd = wgid % NXCD, off = wgid / NXCD; wgid = (xcd < r ? xcd * (q + 1) : r * (q + 1) + (xcd - r) * q) + off; }
        const int nig = WGM * nN, gid = wgid / nig, fm = gid * WGM, gsz = (nM - fm) < WGM ? (nM - fm) : WGM;
        u.pm = fm + ((wgid % nig) % gsz); u.pn = (wgid % nig) / gsz; return true;
    }
    __device__ __forceinline__ void a_ready(const Unit&) const {}
    __device__ __forceinline__ void done(const Unit&) const {}
};

__device__ __forceinline__ unsigned cvt_pk_bf16(float lo, float hi) { unsigned r; asm volatile("v_cvt_pk_bf16_f32 %0, %1, %2" : "=v"(r) : "v"(lo), "v"(hi)); return r; }
template <class Epi, class Sched, bool ALIGN_EPI = false, bool SP2 = false>
__device__ __forceinline__ void gemm_phase(PG8_LAS unsigned char* lds, const Gemm g, const Sched& S, const Epi& E) {
    int tid_l = threadIdx.x; asm volatile("" : "+v"(tid_l));
    const int tid = tid_l, wid = __builtin_amdgcn_readfirstlane(tid >> 6), lane = tid & 63, wr = wid >> 2, wc = wid & 3, fr = lane & 15, fq = lane >> 4;
    const int K = g.K, nt = K / BK;
    unsigned voffA[2], voffB[2];
#pragma unroll
    for (int i = 0; i < 2; ++i) { int R, C; stage_rc(tid * 16 + i * 8192, R, C); const int Rb = Epi::PERM ? ((R & ~31) + perm32(R & 31)) : R;
        voffA[i] = (unsigned)(R * K + C) * 2u; voffB[i] = (unsigned)(Rb * K + C) * 2u; }
    const size_t kstep = (size_t)(BK * 2);
    const size_t hstep = (size_t)HALF * K * 2;
    const size_t tstep = 2 * hstep;
    const unsigned ldsw = (unsigned)wid * 1024u;
    const int aoff = lds_byte(wr * 64 + fr, fq * 8), boff = lds_byte(wc * 32 + fr, fq * 8);
#define PG8_SA(b, h) (((b) * 2 + (h)) * HTB)
#define PG8_SB(b, h) ((4 + (b) * 2 + (h)) * HTB)
#define PG8_STAGE(bufoff, gbase, voff) do { _Pragma("unroll") for (int _i = 0; _i < 2; ++_i) \
        __builtin_amdgcn_global_load_lds((const unsigned*)((const char*)(gbase) + (voff)[_i]), (PG8_LAS unsigned*)(lds + (bufoff) + ldsw + _i * 8192), 16, 0, 0); } while (0)
#define PG8_LDA(dst, b, h) do { _Pragma("unroll") for (int m = 0; m < 4; ++m) _Pragma("unroll") for (int k = 0; k < 2; ++k) dst[m][k] = *(const PG8_LAS bf16x8*)(lds + PG8_SA(b, h) + aoff + m * 2048 + k * 1024); } while (0)
#define PG8_LDB(dst, b, h) do { _Pragma("unroll") for (int n = 0; n < 2; ++n) _Pragma("unroll") for (int k = 0; k < 2; ++k) dst[n][k] = *(const PG8_LAS bf16x8*)(lds + PG8_SB(b, h) + boff + n * 2048 + k * 1024); } while (0)
#define PG8_MMA(ai, bj, At, Bt) do { __builtin_amdgcn_s_setprio(1); _Pragma("unroll") for (int m = 0; m < 4; ++m) _Pragma("unroll") for (int n = 0; n < 2; ++n) _Pragma("unroll") for (int k = 0; k < 2; ++k) \
        acc[ai][bj][m][n] = __builtin_amdgcn_mfma_f32_16x16x32_bf16(Bt[n][k], At[m][k], acc[ai][bj][m][n], 0, 0, 0); __builtin_amdgcn_s_setprio(0); } while (0)
#define PG8_WAIT_V(n) asm volatile("s_waitcnt vmcnt(" #n ")" ::: "memory")
#define PG8_WAIT_L(n) asm volatile("s_waitcnt lgkmcnt(" #n ")" ::: "memory")
#define PG8_BAR __builtin_amdgcn_s_barrier()
#define PG8_SCHED __builtin_amdgcn_sched_barrier(0)
    Unit cur, nxt; int ui = 0;
    if (!S.next(0, cur)) return;
    f32x4 acc[2][2][4][2];
#pragma unroll
    for (int a = 0; a < 2; ++a)
#pragma unroll
        for (int b = 0; b < 2; ++b)
#pragma unroll
            for (int m = 0; m < 4; ++m)
#pragma unroll
                for (int n = 0; n < 2; ++n) acc[a][b][m][n] = (f32x4){0.f, 0.f, 0.f, 0.f};
    bf16x8 At[4][2], B0[2][2], B1[2][2];
    const char* cA = (const char*)g.A + (size_t)cur.pm * tstep; const char* cB = (const char*)g.Bt + (size_t)cur.pn * tstep;
    S.a_ready(cur);
    if constexpr (SP2) {
        PG8_STAGE(PG8_SB(0, 0), cB, voffB); PG8_STAGE(PG8_SB(0, 1), cB + hstep, voffB); PG8_STAGE(PG8_SA(0, 0), cA, voffA); PG8_STAGE(PG8_SA(0, 1), cA + hstep, voffA);
        if (wr == 1) PG8_BAR;
        PG8_WAIT_V(2); PG8_BAR;
        PG8_STAGE(PG8_SB(1, 0), cB + kstep, voffB); PG8_STAGE(PG8_SA(1, 0), cA + kstep, voffA); PG8_STAGE(PG8_SB(1, 1), cB + hstep + kstep, voffB);
        PG8_WAIT_V(6); PG8_BAR;
    } else {
        PG8_STAGE(PG8_SB(0, 0), cB, voffB); PG8_STAGE(PG8_SA(0, 0), cA, voffA); PG8_STAGE(PG8_SB(0, 1), cB + hstep, voffB); PG8_STAGE(PG8_SA(0, 1), cA + hstep, voffA);
        if (wr == 1) PG8_BAR;
        PG8_WAIT_V(4); PG8_BAR;
        PG8_STAGE(PG8_SB(1, 0), cB + kstep, voffB); PG8_STAGE(PG8_SA(1, 0), cA + kstep, voffA); PG8_STAGE(PG8_SB(1, 1), cB + hstep + kstep, voffB);
        PG8_WAIT_V(6); PG8_BAR;
    }
    for (;;) {
        const bool has_next = S.next(ui + 1, nxt);
        const char* nA = has_next ? (const char*)g.A + (size_t)nxt.pm * tstep : cA; const char* nB = has_next ? (const char*)g.Bt + (size_t)nxt.pn * tstep : cB;
        for (int t = 0; t < nt; t += 2) {
            const bool last = (t == nt - 2);
            const char* a1 = cA + (size_t)(t + 1) * kstep;
            const char* a2 = last ? nA : cA + (size_t)(t + 2) * kstep; const char* b2 = last ? nB : cB + (size_t)(t + 2) * kstep;
            const char* a3 = a2 + kstep; const char* b3 = b2 + kstep;
            if (last && has_next) S.a_ready(nxt);
            if constexpr (SP2) {
            PG8_LDB(B0, 0, 0); PG8_LDB(B1, 0, 1); PG8_SCHED; PG8_LDA(At, 0, 0); PG8_STAGE(PG8_SA(1, 1), a1 + hstep, voffA);
            PG8_WAIT_V(8); PG8_WAIT_L(0); PG8_BAR; PG8_MMA(0, 0, At, B0); PG8_MMA(0, 1, At, B1); PG8_BAR; PG8_SCHED;
            PG8_LDA(At, 0, 1); PG8_STAGE(PG8_SB(0, 0), b2, voffB); PG8_STAGE(PG8_SB(0, 1), b2 + hstep, voffB); PG8_STAGE(PG8_SA(0, 0), a2, voffA);
            PG8_WAIT_V(8); PG8_WAIT_L(0); PG8_BAR; PG8_MMA(1, 0, At, B0); PG8_MMA(1, 1, At, B1); PG8_BAR; PG8_SCHED;
            PG8_LDB(B0, 1, 0); PG8_LDB(B1, 1, 1); PG8_SCHED; PG8_LDA(At, 1, 0); PG8_STAGE(PG8_SA(0, 1), a2 + hstep, voffA);
            PG8_WAIT_V(8); PG8_WAIT_L(0); PG8_BAR; PG8_MMA(0, 0, At, B0); PG8_MMA(0, 1, At, B1); PG8_BAR; PG8_SCHED;
            PG8_LDA(At, 1, 1); PG8_STAGE(PG8_SB(1, 0), b3, voffB); PG8_STAGE(PG8_SB(1, 1), b3 + hstep, voffB); PG8_STAGE(PG8_SA(1, 0), a3, voffA);
            PG8_WAIT_V(8); PG8_WAIT_L(0); PG8_BAR; PG8_MMA(1, 0, At, B0); PG8_MMA(1, 1, At, B1); PG8_BAR; PG8_SCHED;
            } else {
            PG8_LDB(B0, 0, 0); PG8_SCHED; PG8_LDA(At, 0, 0); PG8_STAGE(PG8_SA(1, 1), a1 + hstep, voffA);
            PG8_WAIT_L(8); PG8_BAR; PG8_WAIT_L(0); PG8_MMA(0, 0, At, B0); PG8_BAR; PG8_SCHED;
            PG8_LDB(B1, 0, 1); PG8_STAGE(PG8_SB(0, 0), b2, voffB);
            PG8_BAR; PG8_WAIT_L(0); PG8_MMA(0, 1, At, B1); PG8_BAR;
            PG8_LDA(At, 0, 1); PG8_STAGE(PG8_SA(0, 0), a2, voffA);
            PG8_BAR; PG8_WAIT_L(0); PG8_MMA(1, 0, At, B0); PG8_BAR; PG8_SCHED;
            PG8_STAGE(PG8_SB(0, 1), b2 + hstep, voffB);
            PG8_WAIT_V(6); PG8_BAR; PG8_MMA(1, 1, At, B1); PG8_BAR;
            PG8_LDB(B0, 1, 0); PG8_SCHED; PG8_LDA(At, 1, 0); PG8_STAGE(PG8_SA(0, 1), a2 + hstep, voffA);
            PG8_WAIT_L(8); PG8_BAR; PG8_WAIT_L(0); PG8_MMA(0, 0, At, B0); PG8_BAR; PG8_SCHED;
            PG8_LDB(B1, 1, 1); PG8_STAGE(PG8_SB(1, 0), b3, voffB);
            PG8_BAR; PG8_WAIT_L(0); PG8_MMA(0, 1, At, B1); PG8_BAR;
            PG8_LDA(At, 1, 1); PG8_STAGE(PG8_SA(1, 0), a3, voffA);
            PG8_BAR; PG8_WAIT_L(0); PG8_MMA(1, 0, At, B0); PG8_BAR; PG8_SCHED;
            PG8_STAGE(PG8_SB(1, 1), b3 + hstep, voffB);
            PG8_WAIT_V(6); PG8_BAR; PG8_MMA(1, 1, At, B1); PG8_BAR;
            }
        }
        if constexpr (ALIGN_EPI) { if (wr == 0) PG8_BAR; }
        if constexpr (!Epi::AFTER_DRAIN) { E(acc, cur, wr, wc, fr, fq); S.done(cur); }
        if (!has_next) break;
#pragma unroll
        for (int a = 0; a < 2; ++a)
#pragma unroll
            for (int b = 0; b < 2; ++b)
#pragma unroll
                for (int m = 0; m < 4; ++m)
#pragma unroll
                    for (int n = 0; n < 2; ++n) acc[a][b][m][n] = (f32x4){0.f, 0.f, 0.f, 0.f};
        cur = nxt; cA = nA; cB = nB; ++ui;
        if constexpr (ALIGN_EPI) { if (wr == 1) PG8_BAR; }
    }
    PG8_WAIT_V(0);
    if constexpr (!ALIGN_EPI) { if (wr == 0) PG8_BAR; }
    PG8_BAR;
    if constexpr (Epi::AFTER_DRAIN) { E.fused(acc, cur, wr, wc, fr, fq, lds, wid, lane); S.done(cur); }
#undef PG8_SA
#undef PG8_SB
#undef PG8_STAGE
#undef PG8_LDA
#undef PG8_LDB
#undef PG8_MMA
#undef PG8_WAIT_V
#undef PG8_WAIT_L
#undef PG8_BAR
#undef PG8_SCHED
}
}

typedef unsigned short bf16_t;
typedef unsigned u32x4 __attribute__((ext_vector_type(4)));
typedef unsigned u32x2 __attribute__((ext_vector_type(2)));
typedef float f32x4 __attribute__((ext_vector_type(4)));
#define LAS __attribute__((address_space(3)))

constexpr int NB = 8, SEQ = 4096, M = NB * SEQ, DM = 1024, NP = 3072, FF = 2816, NGU = 2 * FF, INC = 2956;
constexpr int C_QA = 0, C_KCA = 256, C_VCA = 320, C_KSA = 384, C_VSA = 448, C_KWA = 512, C_VWA = 576, C_CVB = 640, C_CVC = 896, C_CVU = 1152,
              C_QC = 1408, C_KC = 1664, C_VC = 1920, C_QD = 2176, C_KD = 2432, C_VD = 2688, C_GT = 2944;
constexpr float EPS = 1e-6f;
constexpr size_t MiB = 1u << 20;
constexpr size_t WS_SS = 0, WS_KCN = 1 * MiB, WS_VCC = 1 * MiB + 512 * 1024, WS_W = 2 * MiB;
constexpr size_t W_IN = 0, W_OUT = 6 * MiB, W_GU = 8 * MiB, W_DN = 19 * MiB, W_LAYER = 24 * MiB + 512 * 1024;
constexpr size_t WS_XB = 52 * MiB, WS_GR = 116 * MiB, WS_PROJ = 180 * MiB, WS_X1 = 372 * MiB, WS_W1T = 500 * MiB, WS_W2T = 504 * MiB, WS_CB = 504 * MiB + 256 * 1024, WS_BAR = 504 * MiB + 512 * 1024, WS_END = 505 * MiB;
constexpr size_t DO_PO = 0, DO_LSE = 48 * MiB;
constexpr int LDS_BYTES = 143360;

struct Params { const float* in[23]; float* out; unsigned char* ws; };

__device__ __forceinline__ float blo(unsigned u) { return __uint_as_float(u << 16); }
__device__ __forceinline__ float bhi(unsigned u) { return __uint_as_float(u & 0xffff0000u); }
__device__ __forceinline__ float bf2f(bf16_t h) { return __uint_as_float((unsigned)h << 16); }
__device__ __forceinline__ unsigned pk2(float lo, float hi) { return pg8::cvt_pk_bf16(lo, hi); }
template <int K> __device__ __forceinline__ unsigned swz_u(unsigned v) { return (unsigned)__builtin_amdgcn_ds_swizzle((int)v, (K << 10) | 0x1f); }
template <int K> __device__ __forceinline__ float swz_f(float v) { return __uint_as_float(swz_u<K>(__float_as_uint(v))); }
__device__ __forceinline__ float sum32(float v) { auto rr = __builtin_amdgcn_permlane32_swap(__float_as_uint(v), __float_as_uint(v), false, false); return __uint_as_float(rr[0]) + __uint_as_float(rr[1]); }
__device__ __forceinline__ float max32(float v) { auto rr = __builtin_amdgcn_permlane32_swap(__float_as_uint(v), __float_as_uint(v), false, false); return fmaxf(__uint_as_float(rr[0]), __uint_as_float(rr[1])); }
__device__ __forceinline__ unsigned or32(unsigned v) { auto rr = __builtin_amdgcn_permlane32_swap(v, v, false, false); return rr[0] | rr[1]; }
__device__ __forceinline__ float partner32(float v, int hh) { auto rr = __builtin_amdgcn_permlane32_swap(__float_as_uint(v), __float_as_uint(v), false, false); return __uint_as_float(hh ? rr[0] : rr[1]); }
__device__ __forceinline__ float wave_sum(float v) {
    v += swz_f<1>(v); v += swz_f<2>(v); v += swz_f<4>(v); v += swz_f<8>(v); v += swz_f<16>(v); return sum32(v);
}
#define LDS_WAIT() asm volatile("s_waitcnt lgkmcnt(0)" ::: "memory")
#define CFENCE() asm volatile("" ::: "memory")

struct EpiProj {
    static constexpr bool PERM = true, AFTER_DRAIN = false;
    bf16_t* O; const float* ss;
    __device__ __forceinline__ void operator()(const pg8::f32x4 (&acc)[2][2][4][2], const pg8::Unit& u, int wr, int wc, int fr, int fq) const {
        const int row0 = u.pm * 256 + wr * 64 + fr, col0 = u.pn * 256 + wc * 32 + 8 * fq;
#pragma unroll
        for (int ai = 0; ai < 2; ++ai)
#pragma unroll
            for (int m = 0; m < 4; ++m) {
                const int row = row0 + ai * 128 + m * 16; const float rs = rsqrtf(ss[row] * (1.f / DM) + EPS);
                bf16_t* rowp = O + (size_t)row * NP + col0;
#pragma unroll
                for (int bj = 0; bj < 2; ++bj) { const pg8::f32x4 v0 = acc[ai][bj][m][0] * rs, v1 = acc[ai][bj][m][1] * rs;
                    u32x4 w; w.x = pk2(v0[0], v0[1]); w.y = pk2(v0[2], v0[3]); w.z = pk2(v1[0], v1[1]); w.w = pk2(v1[2], v1[3]);
                    *(u32x4*)(rowp + bj * 128) = w; }
            }
    }
};
struct EpiSwiGLU {
    static constexpr bool PERM = true, AFTER_DRAIN = false;
    bf16_t* H; const float* ss;
    __device__ __forceinline__ void operator()(const pg8::f32x4 (&acc)[2][2][4][2], const pg8::Unit& u, int wr, int wc, int fr, int fq) const {
        const int row0 = u.pm * 256 + wr * 64 + fr, col0 = u.pn * 128 + wc * 32 + 8 * fq;
#pragma unroll
        for (int ai = 0; ai < 2; ++ai)
#pragma unroll
            for (int m = 0; m < 4; ++m) {
                const int row = row0 + ai * 128 + m * 16; const float rs = rsqrtf(ss[row] * (1.f / DM) + EPS);
                float hv[8];
#pragma unroll
                for (int n = 0; n < 2; ++n)
#pragma unroll
                    for (int j = 0; j < 4; ++j) { const float g = acc[ai][0][m][n][j] * rs, up = acc[ai][1][m][n][j] * rs;
                        hv[4 * n + j] = g * up / (1.f + __expf(-g)); }
                u32x4 w; w.x = pk2(hv[0], hv[1]); w.y = pk2(hv[2], hv[3]); w.z = pk2(hv[4], hv[5]); w.w = pk2(hv[6], hv[7]);
                *(u32x4*)(H + (size_t)row * FF + col0) = w;
            }
    }
};
struct EpiResid {
    static constexpr bool PERM = false, AFTER_DRAIN = false;
    const float* xin; const bf16_t* xin_b; float* xout; bf16_t* xb; float* ss;
    __device__ __forceinline__ void operator()(const pg8::f32x4 (&acc)[2][2][4][2], const pg8::Unit& u, int wr, int wc, int fr, int fq) const {
        const int row0 = u.pm * 256 + wr * 64 + fr, col0 = u.pn * 256 + wc * 32 + 4 * fq;
#pragma unroll
        for (int ai = 0; ai < 2; ++ai)
#pragma unroll
            for (int m = 0; m < 4; ++m) {
                const int row = row0 + ai * 128 + m * 16; const size_t off = (size_t)row * DM + col0; float sq = 0.f;
#pragma unroll
                for (int bj = 0; bj < 2; ++bj)
#pragma unroll
                    for (int n = 0; n < 2; ++n) { const size_t o = off + bj * 128 + n * 16; f32x4 xi;
                        if (xin) xi = *(const f32x4*)(xin + o);
                        else { const u32x2 r2 = *(const u32x2*)(xin_b + o); xi[0] = blo(r2.x); xi[1] = bhi(r2.x); xi[2] = blo(r2.y); xi[3] = bhi(r2.y); }
                        f32x4 v;
                        v[0] = xi[0] + acc[ai][bj][m][n][0]; v[1] = xi[1] + acc[ai][bj][m][n][1]; v[2] = xi[2] + acc[ai][bj][m][n][2]; v[3] = xi[3] + acc[ai][bj][m][n][3];
                        if (xout) *(f32x4*)(xout + o) = v;
                        if (xb) { u32x2 w; w.x = pk2(v[0], v[1]); w.y = pk2(v[2], v[3]); *(u32x2*)(xb + o) = w; }
                        sq += (v[0] * v[0] + v[1] * v[1]) + (v[2] * v[2] + v[3] * v[3]); }
                if (ss) { sq += swz_f<16>(sq); sq = sum32(sq); if (fq == 0) atomicAdd(ss + row, sq); }
            }
    }
};

#ifndef REP_PW
#define REP_PW 1
#endif
#ifndef REP_PC
#define REP_PC 1
#endif
#ifndef REP_PX
#define REP_PX 1
#endif
template <int MAP> __device__ __forceinline__ int dst_row(int c) {
    if (MAP == 0) return c < 640 ? c : (c < 652 ? 2944 + (c - 640) : c - 12);
    if (MAP == 1) return c;
    if (MAP == 2) return 256 * (c >> 7) + (c & 127);
    return 256 * (c >> 7) + 128 + (c & 127);
}
template <int MAP> __device__ __forceinline__ void transpose_item(const float* W, int K, int N, const float* gk, bf16_t* WT, LAS float* scr, int item, int lane) {
    const int nblk = (N + 63) / 64, kb = item / nblk, nb = item % nblk, k0 = 64 * kb, n0 = 64 * nb;
    const int nn = n0 + lane; const bool okn = nn < N;
#pragma unroll
    for (int i = 0; i < 64; ++i) { float v = okn ? W[(size_t)(k0 + i) * N + nn] : 0.f; if (gk) v *= gk[k0 + i]; scr[i * 65 + lane] = v; }
    LDS_WAIT();
    const int c = lane & 7;
#pragma unroll
    for (int j = 0; j < 8; ++j) { const int n = (lane >> 3) + 8 * j; const LAS float* s = scr + (8 * c) * 65 + n;
        if (n0 + n < N) { u32x4 o; o.x = pk2(s[0 * 65], s[1 * 65]); o.y = pk2(s[2 * 65], s[3 * 65]); o.z = pk2(s[4 * 65], s[5 * 65]); o.w = pk2(s[6 * 65], s[7 * 65]);
            if (MAP == 4) { const int nn2 = n0 + n, kk2 = k0 + 8 * c; *(u32x4*)(WT + ((size_t)(((nn2 >> 5) * (K >> 4) + (kk2 >> 4)) * 64 + ((kk2 >> 3) & 1) * 32 + (nn2 & 31)) * 8)) = o; }
            else *(u32x4*)(WT + (size_t)dst_row<MAP>(n0 + n) * K + k0 + 8 * c) = o; } }
    LDS_WAIT();
}
__device__ __forceinline__ void prologue(const Params& p, LAS unsigned char* lds, int gw, int NGW, int wave, int lane) {
    LAS float* scr = (LAS float*)(lds + wave * 16640);
    constexpr int I_IN = 16 * 47, I_OUT = 16 * 16, I_G = 16 * 44, I_DN = 44 * 16, I_L = I_IN + I_OUT + 2 * I_G + I_DN, I_Z = 116;
    for (int rw_ = 0; rw_ < REP_PW; ++rw_)
    for (int it = gw; it < 2 * (I_L + I_Z); it += NGW) {
        const int l = it / (I_L + I_Z); int r = it % (I_L + I_Z);
        unsigned char* wl = p.ws + WS_W + (size_t)l * W_LAYER;
        if (r < I_IN) { transpose_item<0>(p.in[2] + (size_t)l * DM * INC, DM, INC, p.in[1] + l * DM, (bf16_t*)(wl + W_IN), scr, r, lane); continue; } r -= I_IN;
        if (r < I_OUT) { transpose_item<1>(p.in[18] + (size_t)l * DM * DM, DM, DM, nullptr, (bf16_t*)(wl + W_OUT), scr, r, lane); continue; } r -= I_OUT;
        if (r < I_G) { transpose_item<2>(p.in[20] + (size_t)l * DM * FF, DM, FF, p.in[19] + l * DM, (bf16_t*)(wl + W_GU), scr, r, lane); continue; } r -= I_G;
        if (r < I_G) { transpose_item<3>(p.in[21] + (size_t)l * DM * FF, DM, FF, p.in[19] + l * DM, (bf16_t*)(wl + W_GU), scr, r, lane); continue; } r -= I_G;
        if (r < I_DN) { transpose_item<1>(p.in[22] + (size_t)l * FF * DM, FF, DM, nullptr, (bf16_t*)(wl + W_DN), scr, r, lane); continue; } r -= I_DN;
        { u32x4 z = {0u, 0u, 0u, 0u}; u32x4* d = (u32x4*)((bf16_t*)(wl + W_IN) + (size_t)(INC + r) * DM) + lane * 2; d[0] = z; d[1] = z; }
    }
    for (int rc_ = 0; rc_ < REP_PC; ++rc_)
    for (int it = gw; it < 4 * (128 + 4 + 32); it += NGW) {
        const int mi = it / 164, r = it % 164, l = mi >> 1, kv = mi & 1;
        const float* w1 = p.in[kv ? 12 : 10] + (size_t)l * 2048 * 256; const float* w2 = p.in[kv ? 13 : 11] + (size_t)l * 256 * 64; const float* pe = p.in[kv ? 9 : 8] + l * 2048;
        if (r < 128) transpose_item<4>(w1, 2048, 256, nullptr, (bf16_t*)(p.ws + WS_W1T) + (size_t)mi * 256 * 2048, scr, r, lane);
        else if (r < 132) transpose_item<1>(w2, 256, 64, nullptr, (bf16_t*)(p.ws + WS_W2T) + (size_t)mi * 64 * 256, scr, r - 128, lane);
        else { const int c = (r - 132) * 8 + (lane & 7), rg = lane >> 3; float acc = 0.f;
#pragma unroll 32
            for (int i = rg * 256; i < rg * 256 + 256; ++i) acc += pe[i] * w1[(size_t)i * 256 + c];
            acc += swz_f<8>(acc); acc += swz_f<16>(acc); acc = sum32(acc);
            if (rg == 0) ((float*)(p.ws + WS_CB))[mi * 256 + c] = acc; }
    }
    float* ss = (float*)(p.ws + WS_SS); bf16_t* xb = (bf16_t*)(p.ws + WS_XB);
    for (int rx_ = 0; rx_ < REP_PX; ++rx_)
    for (int m0 = gw; m0 < M; m0 += 4 * NGW) {
        f32x4 v[4][4];
#pragma unroll
        for (int rr = 0; rr < 4; ++rr) { const int m = m0 + rr * NGW; const f32x4* xr = (const f32x4*)(p.in[0] + (size_t)(m < M ? m : 0) * DM) + lane;
#pragma unroll
            for (int j = 0; j < 4; ++j) v[rr][j] = xr[64 * j]; }
#pragma unroll
        for (int rr = 0; rr < 4; ++rr) { const int m = m0 + rr * NGW; if (m < M) { u32x2* o8 = (u32x2*)(xb + (size_t)m * DM) + lane; float s = 0.f;
#pragma unroll
            for (int j = 0; j < 4; ++j) { const f32x4 t = v[rr][j]; s += (t[0] * t[0] + t[1] * t[1]) + (t[2] * t[2] + t[3] * t[3]); u32x2 w; w.x = pk2(t[0], t[1]); w.y = pk2(t[2], t[3]); o8[64 * j] = w; }
            s = wave_sum(s);
            if (lane == 0) { ss[m] = s; ss[M + m] = 0.f; ss[2 * M + m] = 0.f; ss[3 * M + m] = 0.f; } } }
    }
}

#define UNPACK8(v, k) const float k##0 = blo(v.x), k##1 = bhi(v.x), k##2 = blo(v.y), k##3 = bhi(v.y), k##4 = blo(v.z), k##5 = bhi(v.z), k##6 = blo(v.w), k##7 = bhi(v.w)
__device__ __forceinline__ void load_row64(float (&q)[64], const bf16_t* p) {
#pragma unroll
    for (int c = 0; c < 8; ++c) { const u32x4 v = *(const u32x4*)(p + 8 * c); UNPACK8(v, k);
        q[8 * c] = k0; q[8 * c + 1] = k1; q[8 * c + 2] = k2; q[8 * c + 3] = k3; q[8 * c + 4] = k4; q[8 * c + 5] = k5; q[8 * c + 6] = k6; q[8 * c + 7] = k7; }
}
template <bool SS> __device__ __forceinline__ float dot_row(const float (&q)[64], const bf16_t* p, float& kss) {
    float z = 0.f, s = 0.f;
#pragma unroll
    for (int c = 0; c < 8; ++c) { const u32x4 v = *(const u32x4*)(p + 8 * c); UNPACK8(v, k);
        z += (q[8 * c] * k0 + q[8 * c + 1] * k1) + (q[8 * c + 2] * k2 + q[8 * c + 3] * k3) + (q[8 * c + 4] * k4 + q[8 * c + 5] * k5) + (q[8 * c + 6] * k6 + q[8 * c + 7] * k7);
        if (SS) s += (k0 * k0 + k1 * k1) + (k2 * k2 + k3 * k3) + (k4 * k4 + k5 * k5) + (k6 * k6 + k7 * k7);
        if (c == 3) CFENCE(); }
    kss = s; return z;
}
__device__ __forceinline__ void axpy_row(float (&o)[64], float w, const bf16_t* p) {
#pragma unroll
    for (int c = 0; c < 8; ++c) { const u32x4 v = *(const u32x4*)(p + 8 * c); UNPACK8(v, k);
        o[8 * c] += w * k0; o[8 * c + 1] += w * k1; o[8 * c + 2] += w * k2; o[8 * c + 3] += w * k3; o[8 * c + 4] += w * k4; o[8 * c + 5] += w * k5; o[8 * c + 6] += w * k6; o[8 * c + 7] += w * k7;
        if (c == 3) CFENCE(); }
}
__device__ __forceinline__ float dot_row_f32(const float (&q)[64], const float* p) {
    float z = 0.f;
#pragma unroll
    for (int c = 0; c < 16; ++c) { const f32x4 v = *(const f32x4*)(p + 4 * c); z += (q[4 * c] * v[0] + q[4 * c + 1] * v[1]) + (q[4 * c + 2] * v[2] + q[4 * c + 3] * v[3]); if (c == 7) CFENCE(); }
    return z;
}
__device__ __forceinline__ void axpy_row_f32(float (&o)[64], float w, const float* p) {
#pragma unroll
    for (int c = 0; c < 16; ++c) { const f32x4 v = *(const f32x4*)(p + 4 * c); o[4 * c] += w * v[0]; o[4 * c + 1] += w * v[1]; o[4 * c + 2] += w * v[2]; o[4 * c + 3] += w * v[3]; if (c == 7) CFENCE(); }
}
__device__ __forceinline__ void store_group(const float (&o)[64], const float* g, bf16_t* dst) {
    float ss = 0.f;
#pragma unroll
    for (int d = 0; d < 64; ++d) ss += o[d] * o[d];
    const float rs = rsqrtf(ss * (1.f / 64.f) + EPS);
#pragma unroll
    for (int c = 0; c < 8; ++c) { u32x4 w;
        w.x = pk2(o[8 * c] * rs * g[8 * c], o[8 * c + 1] * rs * g[8 * c + 1]); w.y = pk2(o[8 * c + 2] * rs * g[8 * c + 2], o[8 * c + 3] * rs * g[8 * c + 3]);
        w.z = pk2(o[8 * c + 4] * rs * g[8 * c + 4], o[8 * c + 5] * rs * g[8 * c + 5]); w.w = pk2(o[8 * c + 6] * rs * g[8 * c + 6], o[8 * c + 7] * rs * g[8 * c + 7]);
        *(u32x4*)(dst + 8 * c) = w; }
}
__device__ __forceinline__ void load_q_norm(float (&q)[64], const bf16_t* p, const float* gq, const float* gx) {
    load_row64(q, p); float ss = 0.f;
#pragma unroll
    for (int d = 0; d < 64; ++d) ss += q[d] * q[d];
    const float rs = rsqrtf(ss * (1.f / 64.f) + EPS) * 0.125f;
#pragma unroll
    for (int d = 0; d < 64; ++d) q[d] = q[d] * rs * gq[d] * (gx ? gx[d] : 1.f);
}

__device__ __forceinline__ void stick_naive(const bf16_t* proj, bf16_t* groups, const float* g_out, int item, int lane) {
    const int tile = item & 63, h = (item >> 6) & 3, b = item >> 8, t = tile * 64 + lane;
    const bf16_t* base = proj + (size_t)b * SEQ * NP;
    float q[64]; load_row64(q, base + (size_t)t * NP + C_QC + h * 64);
#pragma unroll
    for (int d = 0; d < 64; ++d) q[d] *= 0.125f;
    float o[64];
#pragma unroll
    for (int d = 0; d < 64; ++d) o[d] = 0.f;
    float between = 0.f;
    for (int s = tile * 64 + 62; s >= 0; --s) {
        const bf16_t* kr = base + (size_t)s * NP + C_KC + h * 64; float dummy;
        const float z = dot_row<false>(q, kr, dummy); CFENCE();
        const bool act = s < t;
        const float sp = fmaxf(z, 0.f) + __logf(1.f + __expf(-fabsf(z)));
        const float w = act ? __expf((z - sp) - between) : 0.f;
        axpy_row(o, w, base + (size_t)s * NP + C_VC + h * 64); CFENCE();
        between += act ? sp : 0.f;
        if (s < tile * 64 && __all(between > 104.f)) break;
    }
    store_group(o, g_out + 512 + h * 64, groups + (size_t)(b * SEQ + t) * DM + 512 + h * 64);
}

__device__ __forceinline__ void dil_naive(const bf16_t* proj, bf16_t* groups, const float* gq, const float* gk, const float* g_out, int item, int lane) {
    const int tile = item & 63, h = (item >> 6) & 3, b = item >> 8, t = tile * 64 + lane;
    const bf16_t* base = proj + (size_t)b * SEQ * NP;
    float q[64]; load_q_norm(q, base + (size_t)t * NP + C_QD + h * 64, gq, gk);
    const float slope = exp2f(-(float)(2 * h + 2));
    float o[64];
#pragma unroll
    for (int d = 0; d < 64; ++d) o[d] = 0.f;
    float mx = -1e30f, l = 0.f;
    for (int cfg = 0; cfg < 3; ++cfg) {
        const int dil = cfg == 0 ? 1 : (cfg == 1 ? 4 : 16);
        for (int j = 0; j <= 128; ++j) {
            const int s = t - j * dil; const bool act = s >= 0;
            if (!__any(act)) break;
            if (act) {
                float kss; const float z = dot_row<true>(q, base + (size_t)s * NP + C_KD + h * 64, kss); CFENCE();
                const float sc = z * rsqrtf(kss * (1.f / 64.f) + EPS) - slope * (float)(j * dil);
                if (sc > mx) { const float corr = __expf(mx - sc); l *= corr;
#pragma unroll
                    for (int d = 0; d < 64; ++d) o[d] *= corr;
                    mx = sc; }
                const float pw = __expf(sc - mx); l += pw;
                axpy_row(o, pw, base + (size_t)s * NP + C_VD + h * 64); CFENCE();
            }
        }
    }
    const float inv = 1.f / l;
#pragma unroll
    for (int d = 0; d < 64; ++d) o[d] *= inv;
    store_group(o, g_out + 768 + h * 64, groups + (size_t)(b * SEQ + t) * DM + 768 + h * 64);
}

template <int NI> __device__ __forceinline__ void conv_items(const bf16_t* proj, bf16_t* groups, const float* cw, const float* g_out, int item0, int stride, int lane) {
    const int ch = (lane & 31) * 8;
    u32x4 cv[NI][3], uv[NI][3], bv[NI];
#pragma unroll
    for (int n = 0; n < NI; ++n) { const int token = (item0 + n * stride) * 2 + (lane >> 5), tpos = token & (SEQ - 1); const bf16_t* row = proj + (size_t)token * NP;
#pragma unroll
        for (int k = 0; k < 3; ++k) { const int back = 2 - k;
            if (tpos >= back) { cv[n][k] = *(const u32x4*)(row - (size_t)back * NP + C_CVC + ch); uv[n][k] = *(const u32x4*)(row - (size_t)back * NP + C_CVU + ch); }
            else { cv[n][k] = (u32x4){0u, 0u, 0u, 0u}; uv[n][k] = cv[n][k]; } }
        bv[n] = *(const u32x4*)(row + C_CVB + ch); }
    float wk[3][8];
#pragma unroll
    for (int k = 0; k < 3; ++k)
#pragma unroll
        for (int i = 0; i < 8; ++i) wk[k][i] = cw[k * 256 + ch + i];
    const float* go = g_out + 256 + ch;
#pragma unroll
    for (int n = 0; n < NI; ++n) { const int token = (item0 + n * stride) * 2 + (lane >> 5);
        float acc[8];
#pragma unroll
        for (int i = 0; i < 8; ++i) acc[i] = 0.f;
#pragma unroll
        for (int k = 0; k < 3; ++k) { UNPACK8(cv[n][k], c); UNPACK8(uv[n][k], u);
            acc[0] += wk[k][0] * (c0 * u0); acc[1] += wk[k][1] * (c1 * u1); acc[2] += wk[k][2] * (c2 * u2); acc[3] += wk[k][3] * (c3 * u3);
            acc[4] += wk[k][4] * (c4 * u4); acc[5] += wk[k][5] * (c5 * u5); acc[6] += wk[k][6] * (c6 * u6); acc[7] += wk[k][7] * (c7 * u7); }
        UNPACK8(bv[n], g);
        float y[8] = {g0 * acc[0], g1 * acc[1], g2 * acc[2], g3 * acc[3], g4 * acc[4], g5 * acc[5], g6 * acc[6], g7 * acc[7]};
        float ss = 0.f;
#pragma unroll
        for (int i = 0; i < 8; ++i) ss += y[i] * y[i];
        ss += swz_f<1>(ss); ss += swz_f<2>(ss); ss += swz_f<4>(ss);
        const float rs = rsqrtf(ss * (1.f / 64.f) + EPS);
        u32x4 w; w.x = pk2(y[0] * rs * go[0], y[1] * rs * go[1]); w.y = pk2(y[2] * rs * go[2], y[3] * rs * go[3]);
        w.z = pk2(y[4] * rs * go[4], y[5] * rs * go[5]); w.w = pk2(y[6] * rs * go[6], y[7] * rs * go[7]);
        *(u32x4*)(groups + (size_t)token * DM + 256 + ch) = w; }
}

typedef short bf16x8 __attribute__((ext_vector_type(8)));
typedef short s16x4 __attribute__((ext_vector_type(4)));
typedef float f32x16 __attribute__((ext_vector_type(16)));
typedef float f32x2_t __attribute__((ext_vector_type(2)));
typedef __bf16 bf16x2_t __attribute__((ext_vector_type(2)));
__device__ __forceinline__ unsigned cvtpk(float lo, float hi) { f32x2_t v = {lo, hi}; bf16x2_t b = __builtin_convertvector(v, bf16x2_t); return __builtin_bit_cast(unsigned, b); }
#define MFMA32(a, b, c) __builtin_amdgcn_mfma_f32_32x32x16_bf16((a), (b), (c), 0, 0, 0)
#define EXP2(x) __builtin_amdgcn_exp2f(x)
constexpr float LOG2E = 1.4426950408889634f;
constexpr int KSB = 144, VTB = 136, KS_BYTES = 64 * KSB, VT_BYTES = 64 * VTB;
__device__ __forceinline__ int crow(int i, int h) { return (i & 3) + 8 * (i >> 2) + 4 * h; }

struct KVSrc { const bf16_t* k; const bf16_t* v; long pitch; int first, lo, hi; };
__device__ __forceinline__ void kv_fetch(const KVSrc& s, int tid, u32x4& kc, u32x4& vc) {
    const int kl = tid >> 3, ch = tid & 7, i = s.first + kl;
    if (i >= s.lo && i < s.hi) { kc = *(const u32x4*)(s.k + (long)i * s.pitch + 8 * ch); vc = *(const u32x4*)(s.v + (long)i * s.pitch + 8 * ch); }
    else { kc = (u32x4){0u, 0u, 0u, 0u}; vc = kc; }
}
template <bool NORM> __device__ __forceinline__ void kv_store(u32x4 kc, u32x4 vc, const float (&g)[8], LAS unsigned char* ksb, LAS unsigned char* vtb, int tid) {
    const int kl = tid >> 3, ch = tid & 7;
    if (NORM) { UNPACK8(kc, k); float ss = (k0 * k0 + k1 * k1) + (k2 * k2 + k3 * k3) + (k4 * k4 + k5 * k5) + (k6 * k6 + k7 * k7);
        ss += swz_f<1>(ss); ss += swz_f<2>(ss); ss += swz_f<4>(ss);
        const float rs = rsqrtf(ss * (1.f / 64.f) + EPS);
        kc.x = cvtpk(k0 * rs * g[0], k1 * rs * g[1]); kc.y = cvtpk(k2 * rs * g[2], k3 * rs * g[3]); kc.z = cvtpk(k4 * rs * g[4], k5 * rs * g[5]); kc.w = cvtpk(k6 * rs * g[6], k7 * rs * g[7]); }
    *(LAS u32x4*)(ksb + kl * KSB + ch * 16) = kc;
    LAS unsigned short* vp = (LAS unsigned short*)(vtb + (8 * ch) * VTB + kl * 2);
    vp[0 * (VTB / 2)] = (unsigned short)(vc.x & 0xffffu); vp[1 * (VTB / 2)] = (unsigned short)(vc.x >> 16);
    vp[2 * (VTB / 2)] = (unsigned short)(vc.y & 0xffffu); vp[3 * (VTB / 2)] = (unsigned short)(vc.y >> 16);
    vp[4 * (VTB / 2)] = (unsigned short)(vc.z & 0xffffu); vp[5 * (VTB / 2)] = (unsigned short)(vc.z >> 16);
    vp[6 * (VTB / 2)] = (unsigned short)(vc.w & 0xffffu); vp[7 * (VTB / 2)] = (unsigned short)(vc.w >> 16);
}
template <bool NORM> __device__ __forceinline__ void load_qfrag(bf16x8 (&qf)[4], const bf16_t* qrow, const float* g1, const float* g2, float sc, int hh) {
    float f[32];
#pragma unroll
    for (int s = 0; s < 4; ++s) { const u32x4 v = *(const u32x4*)(qrow + 16 * s + 8 * hh); UNPACK8(v, k);
        f[8 * s] = k0; f[8 * s + 1] = k1; f[8 * s + 2] = k2; f[8 * s + 3] = k3; f[8 * s + 4] = k4; f[8 * s + 5] = k5; f[8 * s + 6] = k6; f[8 * s + 7] = k7; }
    if (NORM) { float ss = 0.f;
#pragma unroll
        for (int i = 0; i < 32; ++i) ss += f[i] * f[i];
        ss = sum32(ss); sc *= rsqrtf(ss * (1.f / 64.f) + EPS); }
#pragma unroll
    for (int s = 0; s < 4; ++s) { float v[8];
#pragma unroll
        for (int j = 0; j < 8; ++j) { const int d = 16 * s + 8 * hh + j; v[j] = f[8 * s + j] * sc * (g1 ? g1[d] : 1.f) * (g2 ? g2[d] : 1.f); }
        u32x4 w; w.x = cvtpk(v[0], v[1]); w.y = cvtpk(v[2], v[3]); w.z = cvtpk(v[4], v[5]); w.w = cvtpk(v[6], v[7]);
        qf[s] = __builtin_bit_cast(bf16x8, w); }
}

struct SfCmp { int tq, nvis, j0; float slope; __device__ __forceinline__ float operator()(float s, int kl) const { const int j = j0 + kl; return j < nvis ? s - slope * (float)(tq - 16 * j - 31) : -INFINITY; } };
struct SfSlc { int tq, key0; float slope; bool sel; __device__ __forceinline__ float operator()(float s, int kl) const { const int key = key0 + kl; return (sel && key <= tq) ? s - slope * (float)(tq - key) : -INFINITY; } };
struct SfWin { int tq, key0; float slope; __device__ __forceinline__ float operator()(float s, int kl) const { const int key = key0 + kl; return (key <= tq && tq - key <= 511) ? s - slope * (float)(tq - key) : -INFINITY; } };

__device__ __forceinline__ void pv_accum(const f32x16& s0, const f32x16& s1, f32x16& o0, f32x16& o1, LAS const unsigned char* vtb, int r, int hh) {
    __builtin_amdgcn_s_setprio(1);
#pragma unroll
    for (int kt = 0; kt < 2; ++kt)
#pragma unroll
        for (int sp = 0; sp < 2; ++sp) { u32x4 w;
            if (kt == 0) { w.x = cvtpk(s0[8 * sp], s0[8 * sp + 1]); w.y = cvtpk(s0[8 * sp + 2], s0[8 * sp + 3]); w.z = cvtpk(s0[8 * sp + 4], s0[8 * sp + 5]); w.w = cvtpk(s0[8 * sp + 6], s0[8 * sp + 7]); }
            else         { w.x = cvtpk(s1[8 * sp], s1[8 * sp + 1]); w.y = cvtpk(s1[8 * sp + 2], s1[8 * sp + 3]); w.z = cvtpk(s1[8 * sp + 4], s1[8 * sp + 5]); w.w = cvtpk(s1[8 * sp + 6], s1[8 * sp + 7]); }
            const bf16x8 pb = __builtin_bit_cast(bf16x8, w); const int ko = 32 * kt + 16 * sp + 4 * hh;
            { const s16x4 lo = *(LAS const s16x4*)(vtb + r * VTB + ko * 2), hi = *(LAS const s16x4*)(vtb + r * VTB + (ko + 8) * 2);
              o0 = MFMA32(__builtin_shufflevector(lo, hi, 0, 1, 2, 3, 4, 5, 6, 7), pb, o0); }
            { const s16x4 lo = *(LAS const s16x4*)(vtb + (32 + r) * VTB + ko * 2), hi = *(LAS const s16x4*)(vtb + (32 + r) * VTB + (ko + 8) * 2);
              o1 = MFMA32(__builtin_shufflevector(lo, hi, 0, 1, 2, 3, 4, 5, 6, 7), pb, o1); } }
    __builtin_amdgcn_s_setprio(0);
}
template <int MODE, class SF>
__device__ __forceinline__ void attn_block(const bf16x8 (&qf)[4], f32x16& o0, f32x16& o1, float& m, float& l, LAS const unsigned char* ksb, LAS const unsigned char* vtb, int r, int hh, const SF sf,
                                           float msafe_f, float inv_f, LAS float* imprw, int nbase, float& carry) {
    f32x16 s0, s1;
#pragma unroll
    for (int i = 0; i < 16; ++i) { s0[i] = 0.f; s1[i] = 0.f; }
    bf16x8 ka[4], kb2[4];
#pragma unroll
    for (int s = 0; s < 4; ++s) { ka[s] = *(LAS const bf16x8*)(ksb + r * KSB + (16 * s + 8 * hh) * 2); kb2[s] = *(LAS const bf16x8*)(ksb + (32 + r) * KSB + (16 * s + 8 * hh) * 2); }
    __builtin_amdgcn_s_setprio(1);
#pragma unroll
    for (int s = 0; s < 4; ++s) { s0 = MFMA32(ka[s], qf[s], s0); s1 = MFMA32(kb2[s], qf[s], s1); }
    __builtin_amdgcn_s_setprio(0);
    __builtin_amdgcn_sched_barrier(0);
#pragma unroll
    for (int i = 0; i < 16; ++i) { s0[i] = sf(s0[i], crow(i, hh)); s1[i] = sf(s1[i], 32 + crow(i, hh)); }
    if (MODE != 2) {
        float mloc = fmaxf(s0[0], s1[0]);
#pragma unroll
        for (int i = 1; i < 16; ++i) mloc = fmaxf(mloc, fmaxf(s0[i], s1[i]));
        mloc = max32(mloc);
        const float mnew = fmaxf(m, mloc), msafe = mnew == -INFINITY ? 0.f : mnew, corr = EXP2(m - msafe);
        float psum = 0.f;
#pragma unroll
        for (int i = 0; i < 16; ++i) { s0[i] = EXP2(s0[i] - msafe); s1[i] = EXP2(s1[i] - msafe); psum += s0[i] + s1[i]; }
        psum = sum32(psum);
        l = l * corr + psum; m = mnew;
        if (MODE == 0 && !__all(corr == 1.f)) {
#pragma unroll
            for (int i = 0; i < 16; ++i) { o0[i] *= corr; o1[i] *= corr; } }
    } else {
#pragma unroll
        for (int i = 0; i < 16; ++i) { s0[i] = EXP2(s0[i] - msafe_f) * inv_f; s1[i] = EXP2(s1[i] - msafe_f) * inv_f; }
#pragma unroll
        for (int kt = 0; kt < 2; ++kt) { float A[4], T[4], R[4];
#pragma unroll
            for (int g = 0; g < 4; ++g) { const float p0 = kt ? s1[4 * g] : s0[4 * g], p1 = kt ? s1[4 * g + 1] : s0[4 * g + 1], p2 = kt ? s1[4 * g + 2] : s0[4 * g + 2], p3 = kt ? s1[4 * g + 3] : s0[4 * g + 3];
                A[g] = 2.f * ((p0 + p1) + p2) + p3; T[g] = p3; R[g] = partner32(p3, hh); }
#pragma unroll
            for (int g = 0; g < 4; ++g) { const float prev = hh ? R[g] : (g ? R[g - 1] : carry);
                imprw[nbase + 8 * kt + 2 * g + hh] = A[g] + prev; }
            carry = R[3]; (void)T; }
    }
    __builtin_amdgcn_sched_barrier(0);
    if (MODE != 1) pv_accum(s0, s1, o0, o1, vtb, r, hh);
}


__device__ __forceinline__ void attn_block_full(const bf16x8 (&qf)[4], f32x16& o0, f32x16& o1, float& m, float& l, LAS const unsigned char* ksb, LAS const unsigned char* vtb, int r, int hh, float b0, float sl) {
    f32x16 s0, s1;
#pragma unroll
    for (int i = 0; i < 16; ++i) { s0[i] = 0.f; s1[i] = 0.f; }
    bf16x8 ka[4], kb2[4];
#pragma unroll
    for (int s = 0; s < 4; ++s) { ka[s] = *(LAS const bf16x8*)(ksb + r * KSB + (16 * s + 8 * hh) * 2); kb2[s] = *(LAS const bf16x8*)(ksb + (32 + r) * KSB + (16 * s + 8 * hh) * 2); }
    __builtin_amdgcn_s_setprio(1);
#pragma unroll
    for (int s = 0; s < 4; ++s) { s0 = MFMA32(ka[s], qf[s], s0); s1 = MFMA32(kb2[s], qf[s], s1); }
    __builtin_amdgcn_s_setprio(0);
    __builtin_amdgcn_sched_barrier(0);
#pragma unroll
    for (int i = 0; i < 16; ++i) { const float c = (float)((i & 3) + 8 * (i >> 2)); s0[i] = fmaf(sl, c, s0[i]); s1[i] = fmaf(sl, c + 32.f, s1[i]); }
    float mloc = fmaxf(s0[0], s1[0]);
#pragma unroll
    for (int i = 1; i < 16; ++i) mloc = fmaxf(mloc, fmaxf(s0[i], s1[i]));
    mloc = max32(mloc + b0);
    const float mnew = fmaxf(m, mloc), msafe = mnew == -INFINITY ? 0.f : mnew, corr = EXP2(m - msafe), c0 = b0 - msafe;
    float psum = 0.f;
#pragma unroll
    for (int i = 0; i < 16; ++i) { s0[i] = EXP2(s0[i] + c0); s1[i] = EXP2(s1[i] + c0); psum += s0[i] + s1[i]; }
    psum = sum32(psum);
    l = l * corr + psum; m = mnew;
#pragma unroll
    for (int i = 0; i < 16; ++i) { o0[i] *= corr; o1[i] *= corr; }
    __builtin_amdgcn_sched_barrier(0);
    pv_accum(s0, s1, o0, o1, vtb, r, hh);
}

#define KV_PIPELINE(FIRST, NEXT, SRC, NORM, GAIN, ...) do { \
    __syncthreads(); \
    int nxt_ = (FIRST), par_ = 0; u32x4 kc_, vc_; float g8_[8]; \
    { const float* gp_ = (GAIN); _Pragma("unroll") for (int j_ = 0; j_ < 8; ++j_) g8_[j_] = gp_ ? gp_[8 * (tid & 7) + j_] : 1.f; } \
    if (nxt_ >= 0) { const int id = nxt_; const KVSrc src_ = SRC; kv_fetch(src_, tid, kc_, vc_); } \
    while (nxt_ >= 0) { const int cur_ = nxt_; \
        LAS unsigned char* ksb = lds + par_ * KS_BYTES; LAS unsigned char* vtb = lds + 2 * KS_BYTES + par_ * VT_BYTES; \
        kv_store<NORM>(kc_, vc_, g8_, ksb, vtb, tid); \
        __syncthreads(); \
        { const int cur = cur_; nxt_ = (NEXT); } \
        if (nxt_ >= 0) { const int id = nxt_; const KVSrc src_ = SRC; kv_fetch(src_, tid, kc_, vc_); } \
        { const int id = cur_; __VA_ARGS__; } \
        par_ ^= 1; } } while (0)


__device__ __forceinline__ void kv_store_pre(u32x4 kc, u32x4 vc, LAS unsigned char* ksb, LAS unsigned char* vtb, int tid) {
    *(LAS u32x4*)(ksb + (tid >> 3) * KSB + (tid & 7) * 16) = kc;
    LAS u32x2* vp = (LAS u32x2*)(vtb + (tid >> 3) * VTB + (tid & 7) * 16); u32x2 a = {vc.x, vc.y}, b2 = {vc.z, vc.w}; vp[0] = a; vp[1] = b2;
}
#define KV_PIPELINE_PRE(FIRST, NEXT, KTILE, VTILE, ...) do { \
    __syncthreads(); \
    int nxt_ = (FIRST), par_ = 0; u32x4 kc_, vc_; \
    if (nxt_ >= 0) { const int id = nxt_; kc_ = *(const u32x4*)((KTILE) + tid * 8); vc_ = *(const u32x4*)((VTILE) + tid * 8); } \
    while (nxt_ >= 0) { const int cur_ = nxt_; \
        LAS unsigned char* ksb = lds + par_ * KS_BYTES; LAS unsigned char* vtb = lds + 2 * KS_BYTES + par_ * VT_BYTES; \
        kv_store_pre(kc_, vc_, ksb, vtb, tid); \
        __syncthreads(); \
        { const int cur = cur_; nxt_ = (NEXT); } \
        if (nxt_ >= 0) { const int id = nxt_; kc_ = *(const u32x4*)((KTILE) + tid * 8); vc_ = *(const u32x4*)((VTILE) + tid * 8); } \
        { const int id = cur_; __VA_ARGS__; } \
        par_ ^= 1; } } while (0)

__device__ __forceinline__ void nsa_prep_item(const bf16_t* proj, bf16_t* kn, bf16_t* vtn, const float* g_ks, const float* g_kw, int item, LAS unsigned char* scr, int lane) {
    const int b = item >> 7, which = (item >> 6) & 1, n = item & 63, ch = lane & 7, row0 = lane >> 3;
    const bf16_t* src = proj + ((size_t)b * SEQ + 64 * n) * NP + (which ? C_KWA : C_KSA) + 8 * ch;
    const float* g = (which ? g_kw : g_ks) + 8 * ch;
    float gg[8];
#pragma unroll
    for (int i = 0; i < 8; ++i) gg[i] = g[i];
    u32x4 kc[8], vc[8];
#pragma unroll
    for (int j = 0; j < 8; ++j) { const bf16_t* rp = src + (size_t)(row0 + 8 * j) * NP; kc[j] = *(const u32x4*)rp; vc[j] = *(const u32x4*)(rp + 64); }
    bf16_t* kdst = kn + (((size_t)b * 2 + which) * SEQ + 64 * n) * 64 + 8 * ch;
#pragma unroll
    for (int j = 0; j < 8; ++j) { const int row = row0 + 8 * j; UNPACK8(kc[j], k);
        float ss = (k0 * k0 + k1 * k1) + (k2 * k2 + k3 * k3) + (k4 * k4 + k5 * k5) + (k6 * k6 + k7 * k7);
        ss += swz_f<1>(ss); ss += swz_f<2>(ss); ss += swz_f<4>(ss);
        const float rs = rsqrtf(ss * (1.f / 64.f) + EPS); u32x4 o;
        o.x = cvtpk(k0 * rs * gg[0], k1 * rs * gg[1]); o.y = cvtpk(k2 * rs * gg[2], k3 * rs * gg[3]); o.z = cvtpk(k4 * rs * gg[4], k5 * rs * gg[5]); o.w = cvtpk(k6 * rs * gg[6], k7 * rs * gg[7]);
        *(u32x4*)(kdst + (size_t)row * 64) = o;
        LAS unsigned short* vp = (LAS unsigned short*)(scr + (8 * ch) * 144 + row * 2); const u32x4 v = vc[j];
        vp[0 * 72] = (unsigned short)(v.x & 0xffffu); vp[1 * 72] = (unsigned short)(v.x >> 16); vp[2 * 72] = (unsigned short)(v.y & 0xffffu); vp[3 * 72] = (unsigned short)(v.y >> 16);
        vp[4 * 72] = (unsigned short)(v.z & 0xffffu); vp[5 * 72] = (unsigned short)(v.z >> 16); vp[6 * 72] = (unsigned short)(v.w & 0xffffu); vp[7 * 72] = (unsigned short)(v.w >> 16); }
    LDS_WAIT();
    bf16_t* vdst = vtn + ((((size_t)b * 2 + which) * 64 + n) * 64 + lane) * 64;
#pragma unroll
    for (int c = 0; c < 8; ++c) *(u32x4*)(vdst + 8 * c) = *(LAS const u32x4*)(scr + lane * 144 + 16 * c);
    LDS_WAIT();
}

struct NsaArgs { const bf16_t* proj; bf16_t* groups; const bf16_t *kcn, *vcc; const float *b_gate, *g_q, *g_ks, *g_kw, *g_out; const bf16_t *kn, *vtn; };
constexpr int NSA_SLAB = 2 * KS_BYTES + 2 * VT_BYTES, NSA_ISUM = NSA_SLAB + 4 * 64 * 65 * 4, NSA_MASK = NSA_ISUM + 64 * 65 * 4, NSA_UMASK = NSA_MASK + 512;
__device__ __forceinline__ void nsa_item(const NsaArgs& A, int b, int tl, LAS unsigned char* lds, int tid) {
    asm volatile("" : "+v"(tid));
    const int lane = tid & 63, w = __builtin_amdgcn_readfirstlane(tid >> 6), head = w & 3, half = w >> 2, r = lane & 31, hh = lane >> 5;
    const int tq = tl * 64 + 32 * half + r, tokl = 32 * half + r; const size_t token = (size_t)b * SEQ + tq;
    const bf16_t* base = A.proj + (size_t)b * SEQ * NP;
    LAS float* slab = (LAS float*)(lds + NSA_SLAB); LAS float* isum = (LAS float*)(lds + NSA_ISUM);
    LAS unsigned* masks = (LAS unsigned*)(lds + NSA_MASK); LAS unsigned* umask = (LAS unsigned*)(lds + NSA_UMASK);
    const float slope = exp2f(-(float)(2 * head + 1)) * LOG2E;
    bf16x8 qf[4]; load_qfrag<true>(qf, base + (size_t)tq * NP + C_QA + head * 64, A.g_q, nullptr, 0.125f * LOG2E, hh);
    float gl[3];
#pragma unroll
    for (int br = 0; br < 3; ++br) { const float x = bf2f(base[(size_t)tq * NP + C_GT + head * 3 + br]) + A.b_gate[head * 3 + br]; gl[br] = 1.f / (1.f + __expf(-x)); }
    f32x16 of0, of1, o0, o1;
#pragma unroll
    for (int i = 0; i < 16; ++i) { of0[i] = 0.f; of1[i] = 0.f; }
    float dummy = 0.f;
    {
        const int nbc = (tl >> 4) + 1, nvis = tq >= 31 ? ((tq - 31) >> 4) + 1 : 0;
        const bf16_t* kc = A.kcn + (size_t)b * 256 * 64; const bf16_t* vc = A.vcc + (size_t)b * 256 * 64;
        float m = -INFINITY, l = 0.f;
        KV_PIPELINE_PRE(0, (cur + 1 < nbc ? cur + 1 : -1), kc + (size_t)id * 4096, vc + (size_t)id * 4096,
            { const SfCmp sf{tq, nvis, 64 * id, slope}; attn_block<1>(qf, o0, o1, m, l, ksb, vtb, r, hh, sf, 0.f, 0.f, nullptr, 0, dummy); });
        const float inv = l > 0.f ? 1.f / l : 0.f, msafe = m == -INFINITY ? 0.f : m; float carry = 0.f;
#pragma unroll
        for (int i = 0; i < 16; ++i) { o0[i] = 0.f; o1[i] = 0.f; }
        LAS float* imprw = slab + (head * 64 + tokl) * 65;
        KV_PIPELINE_PRE(0, (cur + 1 < nbc ? cur + 1 : -1), kc + (size_t)id * 4096, vc + (size_t)id * 4096,
            { const SfCmp sf{tq, nvis, 64 * id, slope}; attn_block<2>(qf, o0, o1, m, l, ksb, vtb, r, hh, sf, msafe, inv, imprw, 16 * id, carry); });
#pragma unroll
        for (int i = 0; i < 16; ++i) { of0[i] += gl[0] * o0[i]; of1[i] += gl[0] * o1[i]; }
    }
    __syncthreads();
    if (tl > 15) {
        for (int e = tid; e < 64 * 64; e += 512) { const int tk = e >> 6, n = e & 63, o = tk * 65 + n; isum[o] = ((slab[o] + slab[64 * 65 + o]) + slab[2 * 64 * 65 + o]) + slab[3 * 64 * 65 + o]; }
        __syncthreads();
        const int tk = tid >> 3, sub = tid & 7; float v[8]; int cnt[8];
#pragma unroll
        for (int k = 0; k < 8; ++k) { v[k] = isum[tk * 65 + 8 * sub + k]; cnt[k] = 0; }
        for (int mm = 1; mm <= tl - 2; ++mm) { const float vm = isum[tk * 65 + mm];
#pragma unroll
            for (int k = 0; k < 8; ++k) cnt[k] += (vm > v[k] || (vm == v[k] && mm < 8 * sub + k)) ? 1 : 0; }
        unsigned bits = 0u;
#pragma unroll
        for (int k = 0; k < 8; ++k) { const int n = 8 * sub + k; if (n >= 1 && n <= tl - 2 && cnt[k] < 13) bits |= 1u << k; }
        unsigned lo = sub < 4 ? bits << (8 * sub) : 0u, hi = sub >= 4 ? bits << (8 * (sub - 4)) : 0u;
        lo |= swz_u<1>(lo); hi |= swz_u<1>(hi); lo |= swz_u<2>(lo); hi |= swz_u<2>(hi); lo |= swz_u<4>(lo); hi |= swz_u<4>(hi);
        const unsigned long long mk = ((unsigned long long)hi << 32 | lo) | 1ull | (3ull << (tl - 1));
        if (sub == 0) { masks[2 * tk] = (unsigned)mk; masks[2 * tk + 1] = (unsigned)(mk >> 32); }
    } else if (tid < 64) { const unsigned long long mk = (2ull << tl) - 1ull; masks[2 * tid] = (unsigned)mk; masks[2 * tid + 1] = (unsigned)(mk >> 32); }
    __syncthreads();
    if (tid < 64) { unsigned lo = masks[2 * tid], hi = masks[2 * tid + 1];
        lo |= swz_u<1>(lo); hi |= swz_u<1>(hi); lo |= swz_u<2>(lo); hi |= swz_u<2>(hi); lo |= swz_u<4>(lo); hi |= swz_u<4>(hi);
        lo |= swz_u<8>(lo); hi |= swz_u<8>(hi); lo |= swz_u<16>(lo); hi |= swz_u<16>(hi); lo = or32(lo); hi = or32(hi);
        if (tid == 0) { umask[0] = lo; umask[1] = hi; } }
    __syncthreads();
    const unsigned long long um = (unsigned long long)umask[1] << 32 | umask[0];
    const unsigned long long mymask = (unsigned long long)masks[2 * tokl + 1] << 32 | masks[2 * tokl];
    LAS float* park = slab + w * 2048 + lane;
#pragma unroll
    for (int i = 0; i < 16; ++i) { park[i * 64] = of0[i]; park[(16 + i) * 64] = of1[i]; }
    {
        float m = -INFINITY, l = 0.f;
#pragma unroll
        for (int i = 0; i < 16; ++i) { o0[i] = 0.f; o1[i] = 0.f; }
        const bf16_t* kp = A.kn + (size_t)(b * 2) * SEQ * 64; const bf16_t* vp = A.vtn + (size_t)(b * 2) * 64 * 4096;
#define NSA_NEXTBIT(c) ({ const unsigned long long rem_ = ((c) >= 63) ? 0ull : (um & ~((2ull << (c)) - 1ull)); rem_ ? (int)__builtin_ctzll(rem_) : -1; })
        KV_PIPELINE_PRE((int)__builtin_ctzll(um), NSA_NEXTBIT(cur), kp + (size_t)id * 4096, vp + (size_t)id * 4096,
            { const bool sel = (mymask >> id) & 1ull;
              if (__any(sel)) {
                  if (id < tl) attn_block_full(qf, o0, o1, m, l, ksb, vtb, r, hh, sel ? -slope * (float)(tq - 64 * id - 4 * hh) : -INFINITY, slope);
                  else { const SfSlc sf{tq, 64 * id, slope, sel}; attn_block<0>(qf, o0, o1, m, l, ksb, vtb, r, hh, sf, 0.f, 0.f, nullptr, 0, dummy); } } });
        const float sc = gl[1] / l;
#pragma unroll
        for (int i = 0; i < 16; ++i) { park[i * 64] += sc * o0[i]; park[(16 + i) * 64] += sc * o1[i]; }
    }
    {
        float m = -INFINITY, l = 0.f;
#pragma unroll
        for (int i = 0; i < 16; ++i) { o0[i] = 0.f; o1[i] = 0.f; }
        const bf16_t* kp = A.kn + (size_t)(b * 2 + 1) * SEQ * 64; const bf16_t* vp = A.vtn + (size_t)(b * 2 + 1) * 64 * 4096; const int nlo = tl >= 8 ? tl - 8 : 0;
        KV_PIPELINE_PRE(nlo, (cur + 1 <= tl ? cur + 1 : -1), kp + (size_t)id * 4096, vp + (size_t)id * 4096,
            { if (id < tl && id >= tl - 7) attn_block_full(qf, o0, o1, m, l, ksb, vtb, r, hh, -slope * (float)(tq - 64 * id - 4 * hh), slope);
              else { const SfWin sf{tq, 64 * id, slope}; attn_block<0>(qf, o0, o1, m, l, ksb, vtb, r, hh, sf, 0.f, 0.f, nullptr, 0, dummy); } });
        const float sc = gl[2] / l;
#pragma unroll
        for (int i = 0; i < 16; ++i) { of0[i] = park[i * 64] + sc * o0[i]; of1[i] = park[(16 + i) * 64] + sc * o1[i]; }
    }
    {
        float ss = 0.f;
#pragma unroll
        for (int i = 0; i < 16; ++i) ss += of0[i] * of0[i] + of1[i] * of1[i];
        ss = sum32(ss);
        const float rs = rsqrtf(ss * (1.f / 64.f) + EPS); const float* go = A.g_out + head * 64; bf16_t* dst = A.groups + token * DM + head * 64;
#pragma unroll
        for (int g = 0; g < 4; ++g) { const int d0 = 8 * g + 4 * hh;
            u32x2 wa; wa.x = cvtpk(of0[4 * g] * rs * go[d0], of0[4 * g + 1] * rs * go[d0 + 1]); wa.y = cvtpk(of0[4 * g + 2] * rs * go[d0 + 2], of0[4 * g + 3] * rs * go[d0 + 3]);
            *(u32x2*)(dst + d0) = wa;
            u32x2 wb; wb.x = cvtpk(of1[4 * g] * rs * go[32 + d0], of1[4 * g + 1] * rs * go[32 + d0 + 1]); wb.y = cvtpk(of1[4 * g + 2] * rs * go[32 + d0 + 2], of1[4 * g + 3] * rs * go[32 + d0 + 3]);
            *(u32x2*)(dst + 32 + d0) = wb; }
    }
    __syncthreads();
}

struct SfDil { int iq, key0; float sl; __device__ __forceinline__ float operator()(float s, int kl) const { const int df = iq - key0 - kl; return (df >= 0 && df <= 128) ? s - sl * (float)df : -INFINITY; } };
struct DilArgs { const bf16_t* proj; bf16_t* po; float* plse; const float *g_q, *g_k; };
__device__ __forceinline__ void dil_item(const DilArgs& A, int item, LAS unsigned char* lds, int tid) {
    asm volatile("" : "+v"(tid));
    const int cfg = item >> 9, rem = item & 511, b = rem >> 6, head = (rem >> 4) & 3, sub = rem & 15;
    const int dil = cfg == 0 ? 1 : (cfg == 1 ? 4 : 16), nq = 16 / dil, c = sub / nq, qt = sub % nq, i0 = 256 * qt, L = SEQ / dil;
    const int lane = tid & 63, w = __builtin_amdgcn_readfirstlane(tid >> 6), r = lane & 31, hh = lane >> 5;
    const int iq = i0 + 32 * w + r, tq = c + dil * iq; const size_t token = (size_t)b * SEQ + tq;
    const bf16_t* base = A.proj + (size_t)b * SEQ * NP;
    const float slope = exp2f(-(float)(2 * head + 2)) * (float)dil * LOG2E;
    bf16x8 qf[4]; load_qfrag<true>(qf, base + (size_t)tq * NP + C_QD + head * 64, A.g_q, nullptr, 0.125f * LOG2E, hh);
    const bf16_t* kp = base + (size_t)c * NP + C_KD + head * 64; const bf16_t* vp = base + (size_t)c * NP + C_VD + head * 64;
    const int kb_lo = (i0 >> 6) >= 2 ? (i0 >> 6) - 2 : 0, kb_hi = (i0 >> 6) + 3, q_lo = i0 + 32 * w;
    f32x16 o0, o1;
#pragma unroll
    for (int i = 0; i < 16; ++i) { o0[i] = 0.f; o1[i] = 0.f; }
    float m = -INFINITY, l = 0.f, dummy = 0.f;
    KV_PIPELINE(kb_lo, (cur + 1 <= kb_hi ? cur + 1 : -1), (KVSrc{kp, vp, (long)dil * NP, 64 * id, 0, L}), true, A.g_k,
        { if (64 * id + 63 >= q_lo - 128 && 64 * id <= q_lo + 31) { const SfDil sf{iq, 64 * id, slope}; attn_block<0>(qf, o0, o1, m, l, ksb, vtb, r, hh, sf, 0.f, 0.f, nullptr, 0, dummy); } });
    const float inv = 1.f / l;
    bf16_t* dst = A.po + ((size_t)cfg * M + token) * 256 + head * 64;
#pragma unroll
    for (int g = 0; g < 4; ++g) { const int d0 = 8 * g + 4 * hh;
        u32x2 wa; wa.x = cvtpk(o0[4 * g] * inv, o0[4 * g + 1] * inv); wa.y = cvtpk(o0[4 * g + 2] * inv, o0[4 * g + 3] * inv); *(u32x2*)(dst + d0) = wa;
        u32x2 wb; wb.x = cvtpk(o1[4 * g] * inv, o1[4 * g + 1] * inv); wb.y = cvtpk(o1[4 * g + 2] * inv, o1[4 * g + 3] * inv); *(u32x2*)(dst + 32 + d0) = wb; }
    if (hh == 0) A.plse[((size_t)cfg * M + token) * 4 + head] = m + __log2f(l);
    __syncthreads();
}
template <int NI> __device__ __forceinline__ void dil_merge_items(const bf16_t* po, const float* plse, bf16_t* groups, const float* g_out, int item0, int stride, int lane) {
    const int pair = lane >> 3, ch = lane & 7, head = pair & 3;
    u32x4 pv[NI][3]; float ls[NI][3];
#pragma unroll
    for (int n = 0; n < NI; ++n) { const size_t token = (size_t)(item0 + n * stride) * 2 + (pair >> 2);
#pragma unroll
        for (int i = 0; i < 3; ++i) { ls[n][i] = plse[((size_t)i * M + token) * 4 + head]; pv[n][i] = *(const u32x4*)(po + ((size_t)i * M + token) * 256 + head * 64 + 8 * ch); } }
    const float* go = g_out + 768 + head * 64 + 8 * ch;
#pragma unroll
    for (int n = 0; n < NI; ++n) { const size_t token = (size_t)(item0 + n * stride) * 2 + (pair >> 2);
        const float mx = fmaxf(ls[n][0], fmaxf(ls[n][1], ls[n][2]));
        const float w0 = EXP2(ls[n][0] - mx), w1 = EXP2(ls[n][1] - mx), w2 = EXP2(ls[n][2] - mx), winv = 1.f / (w0 + w1 + w2);
        float o[8];
#pragma unroll
        for (int j = 0; j < 8; ++j) o[j] = 0.f;
#pragma unroll
        for (int i = 0; i < 3; ++i) { UNPACK8(pv[n][i], k); const float wi = (i == 0 ? w0 : (i == 1 ? w1 : w2)) * winv;
            o[0] += wi * k0; o[1] += wi * k1; o[2] += wi * k2; o[3] += wi * k3; o[4] += wi * k4; o[5] += wi * k5; o[6] += wi * k6; o[7] += wi * k7; }
        float ss = 0.f;
#pragma unroll
        for (int j = 0; j < 8; ++j) ss += o[j] * o[j];
        ss += swz_f<1>(ss); ss += swz_f<2>(ss); ss += swz_f<4>(ss);
        const float rs = rsqrtf(ss * (1.f / 64.f) + EPS);
        u32x4 wv; wv.x = cvtpk(o[0] * rs * go[0], o[1] * rs * go[1]); wv.y = cvtpk(o[2] * rs * go[2], o[3] * rs * go[3]); wv.z = cvtpk(o[4] * rs * go[4], o[5] * rs * go[5]); wv.w = cvtpk(o[6] * rs * go[6], o[7] * rs * go[7]);
        *(u32x4*)(groups + token * DM + 768 + head * 64 + 8 * ch) = wv; }
}

__device__ __forceinline__ void stick_block(const bf16x8 (&qf)[4], f32x16& o0, f32x16& o1, float& carry, LAS const unsigned char* ksb, LAS const unsigned char* vtb, int r, int hh, int tq, int key0) {
    f32x16 s0, s1;
#pragma unroll
    for (int i = 0; i < 16; ++i) { s0[i] = 0.f; s1[i] = 0.f; }
    bf16x8 ka[4], kb2[4];
#pragma unroll
    for (int s = 0; s < 4; ++s) { ka[s] = *(LAS const bf16x8*)(ksb + r * KSB + (16 * s + 8 * hh) * 2); kb2[s] = *(LAS const bf16x8*)(ksb + (32 + r) * KSB + (16 * s + 8 * hh) * 2); }
    __builtin_amdgcn_s_setprio(1);
#pragma unroll
    for (int s = 0; s < 4; ++s) { s0 = MFMA32(ka[s], qf[s], s0); s1 = MFMA32(kb2[s], qf[s], s1); }
    __builtin_amdgcn_s_setprio(0);
    __builtin_amdgcn_sched_barrier(0);
    float acc = carry;
#pragma unroll
    for (int kti = 0; kti < 2; ++kti) { const int kt = 1 - kti; float spm[16], G[4], R[4];
#pragma unroll
        for (int i = 0; i < 16; ++i) { const float z = kt ? s1[i] : s0[i]; const bool act = key0 + 32 * kt + crow(i, hh) < tq;
            const float sp = fmaxf(z, 0.f) + __logf(1.f + __expf(-fabsf(z)));
            spm[i] = act ? sp : 0.f; const float lw = act ? z - sp : -INFINITY; if (kt) s1[i] = lw; else s0[i] = lw; }
#pragma unroll
        for (int g = 0; g < 4; ++g) { G[g] = (spm[4 * g] + spm[4 * g + 1]) + (spm[4 * g + 2] + spm[4 * g + 3]); R[g] = partner32(G[g], hh); }
#pragma unroll
        for (int gi = 0; gi < 4; ++gi) { const int g = 3 - gi; float run = acc + (hh ? 0.f : R[g]);
#pragma unroll
            for (int ki = 0; ki < 4; ++ki) { const int i = 4 * g + 3 - ki; const float lw = kt ? s1[i] : s0[i]; const float wv = __expf(lw - run); if (kt) s1[i] = wv; else s0[i] = wv; run += spm[i]; }
            acc += G[g] + R[g]; } }
    carry = acc;
    __builtin_amdgcn_sched_barrier(0);
    pv_accum(s0, s1, o0, o1, vtb, r, hh);
}
struct StickArgs { const bf16_t* proj; bf16_t* groups; const float* g_out; };
__device__ __forceinline__ void stick_item(const StickArgs& A, int item, LAS unsigned char* lds, int tid) {
    asm volatile("" : "+v"(tid));
    const int b = item >> 6, head = (item >> 4) & 3, qt = item & 15, T0 = 256 * qt;
    const int lane = tid & 63, w = __builtin_amdgcn_readfirstlane(tid >> 6), r = lane & 31, hh = lane >> 5, tq = T0 + 32 * w + r;
    const size_t token = (size_t)b * SEQ + tq;
    const bf16_t* base = A.proj + (size_t)b * SEQ * NP;
    bf16x8 qf[4]; load_qfrag<false>(qf, base + (size_t)tq * NP + C_QC + head * 64, nullptr, nullptr, 0.125f, hh);
    LAS unsigned* flags = (LAS unsigned*)(lds + NSA_SLAB);
    if (tid < 16) flags[tid] = 0u;
    f32x16 o0, o1;
#pragma unroll
    for (int i = 0; i < 16; ++i) { o0[i] = 0.f; o1[i] = 0.f; }
    float carry = 0.f; bool done = false;
    const bf16_t* kp = base + C_KC + head * 64; const bf16_t* vp = base + C_VC + head * 64;
#define STK_NEXT(c) ({ const LAS unsigned* f_ = flags + (par_ ^ 1) * 8; const unsigned ad_ = (f_[0] & f_[1]) & (f_[2] & f_[3]) & (f_[4] & f_[5]) & (f_[6] & f_[7]); ((c) > 0 && !ad_) ? (c) - 1 : -1; })
    KV_PIPELINE((T0 >> 6) + 3, STK_NEXT(cur), (KVSrc{kp, vp, NP, 64 * id, 0, SEQ}), false, nullptr,
        { if (!done && 64 * id <= T0 + 32 * w + 30) { stick_block(qf, o0, o1, carry, ksb, vtb, r, hh, tq, 64 * id); done = __all(carry > 104.f); }
          if (lane == 0) flags[par_ * 8 + w] = done ? 1u : 0u; });
    float ss = 0.f;
#pragma unroll
    for (int i = 0; i < 16; ++i) ss += o0[i] * o0[i] + o1[i] * o1[i];
    ss = sum32(ss);
    const float rs = rsqrtf(ss * (1.f / 64.f) + EPS); const float* go = A.g_out + 512 + head * 64; bf16_t* dst = A.groups + token * DM + 512 + head * 64;
#pragma unroll
    for (int g = 0; g < 4; ++g) { const int d0 = 8 * g + 4 * hh;
        u32x2 wa; wa.x = cvtpk(o0[4 * g] * rs * go[d0], o0[4 * g + 1] * rs * go[d0 + 1]); wa.y = cvtpk(o0[4 * g + 2] * rs * go[d0 + 2], o0[4 * g + 3] * rs * go[d0 + 3]); *(u32x2*)(dst + d0) = wa;
        u32x2 wb; wb.x = cvtpk(o1[4 * g] * rs * go[32 + d0], o1[4 * g + 1] * rs * go[32 + d0 + 1]); wb.y = cvtpk(o1[4 * g + 2] * rs * go[32 + d0 + 2], o1[4 * g + 3] * rs * go[32 + d0 + 3]); *(u32x2*)(dst + 32 + d0) = wb; }
    __syncthreads();
}

struct CmpArgs { const bf16_t* proj; const bf16_t* w1t; const bf16_t* w2t; const float* cb; const float* g_kc; bf16_t* kcn; bf16_t* vcc; };
constexpr int HIDB = 528;
__device__ __forceinline__ void compress_item(const CmpArgs& A, int item, LAS unsigned char* lds, int tid) {
    asm volatile("" : "+v"(tid));
    const int kv = item >> 6, rt = item & 63, b = rt >> 3, j0 = (rt & 7) * 32;
    const int lane = tid & 63, w = __builtin_amdgcn_readfirstlane(tid >> 6), r = lane & 31, hh = lane >> 5;
    { const bf16_t* xsrc = A.proj + (size_t)b * SEQ * NP + (kv ? C_VCA : C_KCA);
      u32x4 stg[9];
#pragma unroll
      for (int q = 0; q < 9; ++q) { const int e2 = tid + 512 * q, t = e2 >> 3, c = e2 & 7; int tk = 16 * j0 + t; tk = tk < SEQ ? tk : SEQ - 1;
          if (e2 < 528 * 8) stg[q] = *(const u32x4*)(xsrc + (size_t)tk * NP + 8 * c); }
#pragma unroll
      for (int q = 0; q < 9; ++q) { const int e2 = tid + 512 * q, t = e2 >> 3, c = e2 & 7;
          if (e2 < 528 * 8) *(LAS u32x4*)(lds + (t ^ ((t >> 7) & 1)) * 128 + ((c ^ ((t >> 4) & 7)) * 16)) = stg[q]; } }
    __syncthreads();
    const bf16_t* wf = A.w1t + (size_t)kv * 256 * 2048 + ((size_t)w * 128 * 64 + lane) * 8;
    f32x16 acc;
#pragma unroll
    for (int i = 0; i < 16; ++i) acc[i] = 0.f;
#pragma unroll 8
    for (int pos = 0; pos < 32; ++pos) { const int t = 16 * r + pos; LAS const unsigned char* arow = lds + (t ^ ((t >> 7) & 1)) * 128; const int sw = (t >> 4) & 7;
#pragma unroll
        for (int q = 0; q < 4; ++q) { const bf16x8 af = *(LAS const bf16x8*)(arow + (((2 * q + hh) ^ sw) * 16)), bfr = *(const bf16x8*)(wf + (size_t)(4 * pos + q) * 512); acc = MFMA32(af, bfr, acc); } }
    __syncthreads();
    { const float bias = A.cb[kv * 256 + 32 * w + r];
#pragma unroll
      for (int i = 0; i < 16; ++i) { const float x = acc[i] + bias; const float hv = 0.5f * x * (1.f + tanhf(0.7978845608028654f * (x + 0.044715f * x * x * x)));
          *(LAS unsigned short*)(lds + crow(i, hh) * HIDB + (32 * w + r) * 2) = (unsigned short)(cvtpk(hv, hv) & 0xffffu); } }
    __syncthreads();
    if (w == 0) {
        f32x16 c0, c1;
#pragma unroll
        for (int i = 0; i < 16; ++i) { c0[i] = 0.f; c1[i] = 0.f; }
        const bf16_t* w2a = A.w2t + ((size_t)kv * 64 + r) * 256 + 8 * hh; const bf16_t* w2b = w2a + 32 * 256;
#pragma unroll
        for (int s = 0; s < 16; ++s) { const bf16x8 af = *(LAS const bf16x8*)(lds + r * HIDB + (16 * s + 8 * hh) * 2);
            c0 = MFMA32(af, *(const bf16x8*)(w2a + 16 * s), c0); c1 = MFMA32(af, *(const bf16x8*)(w2b + 16 * s), c1); }
        const float g0 = A.g_kc[r], g1 = A.g_kc[32 + r]; bf16_t* dst = (kv ? A.vcc : A.kcn) + ((size_t)b * 256 + j0) * 64;
#pragma unroll
        for (int i = 0; i < 16; ++i) { float v0 = c0[i], v1 = c1[i];
            if (!kv) { float ss = v0 * v0 + v1 * v1; ss += swz_f<1>(ss); ss += swz_f<2>(ss); ss += swz_f<4>(ss); ss += swz_f<8>(ss); ss += swz_f<16>(ss);
                const float rs = rsqrtf(ss * (1.f / 64.f) + EPS); v0 *= rs * g0; v1 *= rs * g1; }
            const int row = crow(i, hh);
            if (!kv) { dst[row * 64 + r] = (bf16_t)(cvtpk(v0, v0) & 0xffffu); dst[row * 64 + 32 + r] = (bf16_t)(cvtpk(v1, v1) & 0xffffu); }
            else { const int j = j0 + row; bf16_t* vt = A.vcc + ((size_t)b * 4 + (j >> 6)) * 4096 + (j & 63);
                vt[(size_t)r * 64] = (bf16_t)(cvtpk(v0, v0) & 0xffffu); vt[(size_t)(32 + r) * 64] = (bf16_t)(cvtpk(v1, v1) & 0xffffu); } }
    }
    __syncthreads();
}
#define RLX_AGENT __ATOMIC_RELAXED, __HIP_MEMORY_SCOPE_AGENT
#define XB_TMO      128
#define XB_XCNT(j)  (256  + 64 * (j))
#define XB_XSUB(j)  (1280 + 64 * (j))
#define XB_XGEN(j)  (2304 + 64 * (j))
#define XB_TOP      3328
#define XB_TOPGEN   3392
#define XCD_BAR_WORDS 3456
#define XB_SPIN_CAP (1u << 18)

__device__ __forceinline__ unsigned xb_ld(unsigned* p)              { return __hip_atomic_load(p, __ATOMIC_RELAXED, __HIP_MEMORY_SCOPE_AGENT); }
__device__ __forceinline__ unsigned xb_add(unsigned* p, unsigned v) { return __hip_atomic_fetch_add(p, v, __ATOMIC_RELAXED, __HIP_MEMORY_SCOPE_AGENT); }
__device__ __forceinline__ unsigned xb_xcc_id() { return (unsigned)__builtin_amdgcn_s_getreg((3 << 11) | 20) & 0xFu; }
#define XB_SPIN(cond, bar) do { unsigned _sp = 0; while (cond) { __builtin_amdgcn_s_sleep(1); \
    if ((++_sp & 255u) == 0u) { if (xb_ld(&(bar)[XB_TMO])) break; if (_sp > XB_SPIN_CAP) { atomicAdd(&(bar)[XB_TMO], 1u); break; } } } } while (0)

struct XcdBarrier {
    unsigned* bar; unsigned x;
    volatile LAS unsigned* st;
};

__device__ __forceinline__ XcdBarrier xcd_barrier_post(unsigned* bar, volatile LAS unsigned* st) {
    XcdBarrier b; b.bar = bar; b.x = xb_xcc_id(); b.st = st;
    if (threadIdx.x == 0) (void)xb_add(&bar[XB_XCNT(b.x)], 1u);
    return b;
}
__device__ __forceinline__ void xcd_barrier_complete(unsigned* bar, unsigned x, unsigned& nloc, unsigned& nx) {
    const unsigned G = gridDim.x * gridDim.y * gridDim.z;
    unsigned sum, cnt, mine, sp = 0u;
    for (;;) {
        sum = 0u; cnt = 0u; mine = 0u;
#pragma unroll
        for (unsigned j = 0; j < 16; ++j) { const unsigned c = xb_ld(&bar[XB_XCNT(j)]); sum += c; cnt += (c > 0u) ? 1u : 0u; mine = (j == x) ? c : mine; }
        if (sum == G) break;
        __builtin_amdgcn_s_sleep(1);
        if ((++sp & 255u) == 0u) { if (xb_ld(&bar[XB_TMO])) break; if (sp > XB_SPIN_CAP) { atomicAdd(&bar[XB_TMO], 1u); break; } }
    }
    nloc = mine > 0u ? mine : 1u; nx = cnt > 0u ? cnt : 1u;
}

__device__ __forceinline__ void xcd_barrier(const XcdBarrier& b) {
    asm volatile("s_waitcnt vmcnt(0)" ::: "memory");
    __syncthreads();
    if (threadIdx.x == 0) {
        unsigned* bar = b.bar;
        __builtin_amdgcn_s_waitcnt(0);
        unsigned nloc = b.st[0], nx = b.st[1];
        if (nloc == 0u) { xcd_barrier_complete(bar, b.x, nloc, nx); b.st[0] = nloc; b.st[1] = nx; }
        const unsigned old = xb_add(&bar[XB_XSUB(b.x)], 1u);
        const unsigned gen = old / nloc;
        if (old + 1u == (gen + 1u) * nloc) {
            __builtin_amdgcn_fence(__ATOMIC_RELEASE, "agent");
            asm volatile("s_waitcnt vmcnt(0)" ::: "memory");
            const unsigned og = xb_add(&bar[XB_TOP], 1u);
            const unsigned tg = og / nx;
            if (og + 1u == (tg + 1u) * nx) xb_add(&bar[XB_TOPGEN], 1u);
            else XB_SPIN(xb_ld(&bar[XB_TOPGEN]) == tg, bar);
            __builtin_amdgcn_fence(__ATOMIC_ACQUIRE, "agent");
            xb_add(&bar[XB_XGEN(b.x)], 1u);
            asm volatile("s_waitcnt vmcnt(0)" ::: "memory");
        } else {
            XB_SPIN(xb_ld(&bar[XB_XGEN(b.x)]) == gen, bar);
            __builtin_amdgcn_fence(__ATOMIC_ACQUIRE, "agent");
            asm volatile("s_waitcnt vmcnt(0)" ::: "memory");
        }
    }
    __syncthreads();
}

#ifndef REP_CMP
#define REP_CMP 1
#endif
#ifndef REP_STK
#define REP_STK 1
#endif
#ifndef REP_DIL
#define REP_DIL 1
#endif
#ifndef REP_NSA
#define REP_NSA 1
#endif
#ifndef REP_G1
#define REP_G1 1
#endif
#ifndef REP_G3
#define REP_G3 1
#endif
#ifndef REP_PRO
#define REP_PRO 1
#endif
#ifndef REP_PREP
#define REP_PREP 1
#endif
#ifndef RESID_BF16
#define RESID_BF16 1
#endif
#ifndef REP_CONV
#define REP_CONV 1
#endif
#ifndef REP_G2
#define REP_G2 1
#endif
#ifndef XSYNC
#define XSYNC 0
#endif
__global__ void __launch_bounds__(512, 2) fwd_kernel(Params p) {
    extern __shared__ __attribute__((aligned(16))) unsigned char lds_raw[];
    cg::grid_group grid = cg::this_grid();
    LAS unsigned char* lds = (LAS unsigned char*)lds_raw;
#define TID_SETUP() int tid = threadIdx.x; asm volatile("" : "+v"(tid)); const int lane = tid & 63, wave = __builtin_amdgcn_readfirstlane(tid >> 6), gw = blockIdx.x * 8 + wave; (void)lane; (void)gw
    const int G = gridDim.x, NGW = G * 8;
    unsigned char* ws = p.ws;
    volatile LAS unsigned* misc = (volatile LAS unsigned*)(lds + LDS_BYTES - 64);
    unsigned* barw = (unsigned*)(ws + WS_BAR);
    { int t0 = threadIdx.x; if (t0 < 2) misc[t0] = 0u;
      if (blockIdx.x == 0) for (int i = t0; i < XCD_BAR_WORDS; i += 512) barw[i] = 0u;
      __syncthreads(); }
    float* ss = (float*)(ws + WS_SS); bf16_t* kcn = (bf16_t*)(ws + WS_KCN); bf16_t* vcc = (bf16_t*)(ws + WS_VCC);
    bf16_t* xb = (bf16_t*)(ws + WS_XB); bf16_t* groups = (bf16_t*)(ws + WS_GR); bf16_t* proj = (bf16_t*)(ws + WS_PROJ); bf16_t* hbuf = proj;
    float* x1 = (float*)(ws + WS_X1); bf16_t* nkn = (bf16_t*)(ws + WS_X1); bf16_t* nvt = (bf16_t*)(ws + WS_X1 + 8 * MiB);
    bf16_t* dpo = (bf16_t*)((unsigned char*)p.out + DO_PO); float* dlse = (float*)((unsigned char*)p.out + DO_LSE);

#ifndef SKIP_PRO
    for (int rep_ = 0; rep_ < REP_PRO; ++rep_) { TID_SETUP(); prologue(p, lds, gw, NGW, wave, lane); }
#endif
    grid.sync();
    const XcdBarrier xbar = xcd_barrier_post(barw, misc);
    for (int xs_ = 0; xs_ < XSYNC; ++xs_) xcd_barrier(xbar);

    for (int l = 0; l < 2; ++l) {
        unsigned char* wl = ws + WS_W + (size_t)l * W_LAYER;
#ifndef SKIP_G1
        for (int rep_ = 0; rep_ < REP_G1; ++rep_)
        { pg8::Gemm g{xb, (const bf16_t*)(wl + W_IN), M, NP, DM}; pg8::StaticOrder S; S.init(M, NP, G, (int)blockIdx.x);
          EpiProj E{proj, ss + (size_t)(2 * l) * M};
          pg8::gemm_phase<EpiProj, pg8::StaticOrder, true, true>(lds, g, S, E); }
#endif
        xcd_barrier(xbar);
        {
            TID_SETUP();
            const float* g_out = p.in[17] + l * DM;
            {
              const CmpArgs CA{proj, (const bf16_t*)(ws + WS_W1T) + (size_t)l * 2 * 256 * 2048, (const bf16_t*)(ws + WS_W2T) + (size_t)l * 2 * 64 * 256, (const float*)(ws + WS_CB) + l * 512, p.in[5] + l * 64, kcn, vcc};
              const StickArgs SA{proj, groups, g_out}; const DilArgs DA{proj, dpo, dlse, p.in[15] + l * 64, p.in[16] + l * 64};
              volatile LAS int* slot = (volatile LAS int*)(lds + LDS_BYTES - 32);
              for (;;) { __syncthreads(); if (tid == 0) *slot = (int)atomicAdd(barw + 32 + 64 * l, 1u); __syncthreads(); const int it = *slot; if (it >= 128 + 512 + 1536) break;
                  if (it < 128) compress_item(CA, it, lds, tid); else if (it < 640) stick_item(SA, it - 128, lds, tid); else dil_item(DA, it - 640, lds, tid); } }
            for (int it = gw; it < 1024; it += NGW) nsa_prep_item(proj, nkn, nvt, p.in[6] + l * 64, p.in[7] + l * 64, it, lds + wave * 9216, lane);
            if (G == 256) { for (int it = gw; it < M / 2; it += 4 * NGW) conv_items<4>(proj, groups, p.in[14] + l * 768, g_out, it, NGW, lane); }
            else for (int it = gw; it < M / 2; it += NGW) conv_items<1>(proj, groups, p.in[14] + l * 768, g_out, it, 0, lane);
        }
        xcd_barrier(xbar);
#ifndef SKIP_NSA
#ifndef SKIP_DIL
        for (int rep_ = 0; rep_ < REP_CONV; ++rep_)
        { TID_SETUP(); if (G == 256) { for (int it = gw; it < M / 2; it += 4 * NGW) dil_merge_items<4>(dpo, dlse, groups, p.in[17] + l * DM, it, NGW, lane); }
          else for (int it = gw; it < M / 2; it += NGW) dil_merge_items<1>(dpo, dlse, groups, p.in[17] + l * DM, it, 0, lane); }
#endif
        for (int rep_ = 0; rep_ < REP_NSA; ++rep_)
        { TID_SETUP(); NsaArgs A{proj, groups, kcn, vcc, p.in[3] + l * 12, p.in[4] + l * 64, p.in[6] + l * 64, p.in[7] + l * 64, p.in[17] + l * DM, nkn, nvt};
          volatile LAS int* slot = (volatile LAS int*)(lds + LDS_BYTES - 32);
          const int myx = (int)(xbar.x & 7u);
          for (int kx = 0; kx < 8; ++kx) { const int bq = (myx + kx) & 7;
              for (;;) { __syncthreads(); if (tid == 0) *slot = (int)atomicAdd(barw + 8 * l + bq, 1u); __syncthreads(); const int it = *slot; if (it >= 64) break; nsa_item(A, bq, 63 - it, lds, tid); } } }
#endif
        xcd_barrier(xbar);
#ifndef SKIP_G2
        { pg8::Gemm g{groups, (const bf16_t*)(wl + W_OUT), M, DM, DM}; pg8::StaticOrder S; S.init(M, DM, G, (int)blockIdx.x);
#if RESID_BF16
          EpiResid E{l == 0 ? p.in[0] : nullptr, xb, nullptr, xb, ss + (size_t)(2 * l + 1) * M};
#else
          EpiResid E{l == 0 ? p.in[0] : x1, nullptr, l == 0 ? x1 : p.out, xb, ss + (size_t)(2 * l + 1) * M};
#endif
          pg8::gemm_phase<EpiResid, pg8::StaticOrder, true, true>(lds, g, S, E);
          for (int rep_ = 1; rep_ < REP_G2; ++rep_) { E.ss = nullptr; pg8::gemm_phase<EpiResid, pg8::StaticOrder, true, true>(lds, g, S, E); } }
#endif
        xcd_barrier(xbar);
#ifndef SKIP_G3
        for (int rep_ = 0; rep_ < REP_G3; ++rep_)
        { pg8::Gemm g{xb, (const bf16_t*)(wl + W_GU), M, NGU, DM}; pg8::StaticOrder S; S.init(M, NGU, G, (int)blockIdx.x);
          EpiSwiGLU E{hbuf, ss + (size_t)(2 * l + 1) * M};
          pg8::gemm_phase<EpiSwiGLU, pg8::StaticOrder, true, true>(lds, g, S, E); }
#endif
        xcd_barrier(xbar);
#ifndef SKIP_G4
        { pg8::Gemm g{hbuf, (const bf16_t*)(wl + W_DN), M, DM, FF}; pg8::StaticOrder S; S.init(M, DM, G, (int)blockIdx.x);
          float* xio = l == 0 ? x1 : p.out;
#if RESID_BF16
          EpiResid E{nullptr, xb, l == 0 ? nullptr : p.out, l == 0 ? xb : nullptr, l == 0 ? ss + (size_t)2 * M : nullptr}; (void)xio;
#else
          EpiResid E{xio, nullptr, xio, l == 0 ? xb : nullptr, l == 0 ? ss + (size_t)2 * M : nullptr};
#endif
          pg8::gemm_phase<EpiResid, pg8::StaticOrder, true, true>(lds, g, S, E); }
#endif
        if (l == 0) xcd_barrier(xbar);
    }
}

extern "C" void kernel_launch(void* const* d_in, const int* in_sizes, int n_in, void* d_out, int out_size, void* d_ws, size_t ws_size, hipStream_t stream) {
    static int grid = 0;
    if (grid == 0) {
        if (n_in != 23 || out_size != M * DM || ws_size < WS_END) { fprintf(stderr, "kernel_launch: unexpected shapes (n_in %d, out %d, ws %zu)\n", n_in, out_size, ws_size); grid = -1; return; }
        int dev = 0, cus = 0, per_cu = 0;
        (void)hipGetDevice(&dev); (void)hipDeviceGetAttribute(&cus, hipDeviceAttributeMultiprocessorCount, dev);
        if (hipFuncSetAttribute((const void*)fwd_kernel, hipFuncAttributeMaxDynamicSharedMemorySize, LDS_BYTES) != hipSuccess) { fprintf(stderr, "kernel_launch: hipFuncSetAttribute failed\n"); grid = -1; return; }
        if (hipOccupancyMaxActiveBlocksPerMultiprocessor(&per_cu, (const void*)fwd_kernel, 512, LDS_BYTES) != hipSuccess || per_cu < 1) per_cu = 1;
        (void)hipGetLastError();
        grid = cus * 1;
        (void)per_cu;
    }
    if (grid < 0) return;
    Params p{};
    for (int i = 0; i < 23; ++i) p.in[i] = (const float*)d_in[i];
    p.out = (float*)d_out; p.ws = (unsigned char*)d_ws;
    void* args[] = {&p};
    hipError_t e = hipLaunchCooperativeKernel((const void*)fwd_kernel, dim3(grid), dim3(512), args, LDS_BYTES, stream);
    if (e != hipSuccess) fprintf(stderr, "cooperative launch failed: %s (grid %d)\n", hipGetErrorString(e), grid);
}
```

```cpp
#include <hip/hip_runtime.h>
#include <hip/hip_cooperative_groups.h>
#include <cstdio>
#include <cstdint>
namespace cg = cooperative_groups;
namespace pg8 {
#define PG8_LAS __attribute__((address_space(3)))
typedef unsigned short bf16_t;
typedef short bf16x8 __attribute__((ext_vector_type(8)));
typedef float f32x4 __attribute__((ext_vector_type(4)));
typedef unsigned u32x4 __attribute__((ext_vector_type(4)));
constexpr int BM = 256, BK = 64, HALF = 128, HTB = HALF * BK * 2  , STAGE_BYTES = 8 * HTB, NXCD = 8, WGM = 8;

__host__ __device__ __forceinline__ int lds_byte(int r, int c) { const int st = (r >> 4) * 2 + (c >> 5), rr = r & 15, cc = c & 31, ob = rr * 64 + cc * 2; return st * 1024 + (ob ^ (((ob >> 9) & 1) << 5)); }
__host__ __device__ __forceinline__ void stage_rc(int b, int& R, int& C) { const int st = b / 1024, sb = b % 1024, swz = sb ^ (((sb >> 9) & 1) << 5); R = (st >> 1) * 16 + swz / 64; C = (st & 1) * 32 + (swz % 64) / 2; }
__host__ __device__ __forceinline__ int perm32(int rho) { const int n = rho >> 4, i = rho & 15; return 8 * (i >> 2) + 4 * n + (i & 3); }

struct Unit { int pm, pn; };
struct Gemm { const bf16_t* A; const bf16_t* Bt; int M, N, K; };

struct StaticOrder {
    int nM, nN, nwg, G, c;
    __host__ __device__ void init(int M, int N, int G_, int c_) { nM = M / BM; nN = N / BM; nwg = nM * nN; G = G_; c = c_; }
    __host__ __device__ bool next(int i, Unit& u) const {
        const long L = (long)i * G + c; if (L >= nwg) return false;
        int wgid = (int)L; { const int q = nwg / NXCD, r = nwg % NXCD, xcd = wgid % NXCD, off = wgid / NXCD; wgid = (xcd < r ? xcd * (q + 1) : r * (q + 1) + (xcd - r) * q) + off; }
        const int nig = WGM * nN, gid = wgid / nig, fm = gid * WGM, gsz = (nM - fm) < WGM ? (nM - fm) : WGM;
        u.pm = fm + ((wgid % nig) % gsz); u.pn = (wgid % nig) / gsz; return true;
    }
    __device__ __forceinline__ void a_ready(const Unit&) const {}
    __device__ __forceinline__ void done(const Unit&) const {}
};

__device__ __forceinline__ unsigned cvt_pk_bf16(float lo, float hi) { unsigned r; asm volatile("v_cvt_pk_bf16_f32 %0, %1, %2" : "=v"(r) : "v"(lo), "v"(hi)); return r; }
template <class Epi, class Sched, bool ALIGN_EPI = false, bool SP2 = false>
__device__ __forceinline__ void gemm_phase(PG8_LAS unsigned char* lds, const Gemm g, const Sched& S, const Epi& E) {
    int tid_l = threadIdx.x; asm volatile("" : "+v"(tid_l));
    const int tid = tid_l, wid = __builtin_amdgcn_readfirstlane(tid >> 6), lane = tid & 63, wr = wid >> 2, wc = wid & 3, fr = lane & 15, fq = lane >> 4;
    const int K = g.K, nt = K / BK;
    unsigned voffA[2], voffB[2];
#pragma unroll
    for (int i = 0; i < 2; ++i) { int R, C; stage_rc(tid * 16 + i * 8192, R, C); const int Rb = Epi::PERM ? ((R & ~31) + perm32(R & 31)) : R;
        voffA[i] = (unsigned)(R * K + C) * 2u; voffB[i] = (unsigned)(Rb * K + C) * 2u; }
    const size_t kstep = (size_t)(BK * 2);
    const size_t hstep = (size_t)HALF * K * 2;
    const size_t tstep = 2 * hstep;
    const unsigned ldsw = (unsigned)wid * 1024u;
    const int aoff = lds_byte(wr * 64 + fr, fq * 8), boff = lds_byte(wc * 32 + fr, fq * 8);
#define PG8_SA(b, h) (((b) * 2 + (h)) * HTB)
#define PG8_SB(b, h) ((4 + (b) * 2 + (h)) * HTB)
#define PG8_STAGE(bufoff, gbase, voff) do { _Pragma("unroll") for (int _i = 0; _i < 2; ++_i) \
        __builtin_amdgcn_global_load_lds((const unsigned*)((const char*)(gbase) + (voff)[_i]), (PG8_LAS unsigned*)(lds + (bufoff) + ldsw + _i * 8192), 16, 0, 0); } while (0)
#define PG8_LDA(dst, b, h) do { _Pragma("unroll") for (int m = 0; m < 4; ++m) _Pragma("unroll") for (int k = 0; k < 2; ++k) dst[m][k] = *(const PG8_LAS bf16x8*)(lds + PG8_SA(b, h) + aoff + m * 2048 + k * 1024); } while (0)
#define PG8_LDB(dst, b, h) do { _Pragma("unroll") for (int n = 0; n < 2; ++n) _Pragma("unroll") for (int k = 0; k < 2; ++k) dst[n][k] = *(const PG8_LAS bf16x8*)(lds + PG8_SB(b, h) + boff + n * 2048 + k * 1024); } while (0)
#define PG8_MMA(ai, bj, At, Bt) do { __builtin_amdgcn_s_setprio(1); _Pragma("unroll") for (int m = 0; m < 4; ++m) _Pragma("unroll") for (int n = 0; n < 2; ++n) _Pragma("unroll") for (int k = 0; k < 2; ++k) \
        acc[ai][bj][m][n] = __builtin_amdgcn_mfma_f32_16x16x32_bf16(Bt[n][k], At[m][k], acc[ai][bj][m][n], 0, 0, 0); __builtin_amdgcn_s_setprio(0); } while (0)
#define PG8_WAIT_V(n) asm volatile("s_waitcnt vmcnt(" #n ")" ::: "memory")
#define PG8_WAIT_L(n) asm volatile("s_waitcnt lgkmcnt(" #n ")" ::: "memory")
#define PG8_BAR __builtin_amdgcn_s_barrier()
#define PG8_SCHED __builtin_amdgcn_sched_barrier(0)
    Unit cur, nxt; int ui = 0;
    if (!S.next(0, cur)) return;
    f32x4 acc[2][2][4][2];
#pragma unroll
    for (int a = 0; a < 2; ++a)
#pragma unroll
        for (int b = 0; b < 2; ++b)
#pragma unroll
            for (int m = 0; m < 4; ++m)
#pragma unroll
                for (int n = 0; n < 2; ++n) acc[a][b][m][n] = (f32x4){0.f, 0.f, 0.f, 0.f};
    bf16x8 At[4][2], B0[2][2], B1[2][2];
    const char* cA = (const char*)g.A + (size_t)cur.pm * tstep; const char* cB = (const char*)g.Bt + (size_t)cur.pn * tstep;
    S.a_ready(cur);
    if constexpr (SP2) {
        PG8_STAGE(PG8_SB(0, 0), cB, voffB); PG8_STAGE(PG8_SB(0, 1), cB + hstep, voffB); PG8_STAGE(PG8_SA(0, 0), cA, voffA); PG8_STAGE(PG8_SA(0, 1), cA + hstep, voffA);
        if (wr == 1) PG8_BAR;
        PG8_WAIT_V(2); PG8_BAR;
        PG8_STAGE(PG8_SB(1, 0), cB + kstep, voffB); PG8_STAGE(PG8_SA(1, 0), cA + kstep, voffA); PG8_STAGE(PG8_SB(1, 1), cB + hstep + kstep, voffB);
        PG8_WAIT_V(6); PG8_BAR;
    } else {
        PG8_STAGE(PG8_SB(0, 0), cB, voffB); PG8_STAGE(PG8_SA(0, 0), cA, voffA); PG8_STAGE(PG8_SB(0, 1), cB + hstep, voffB); PG8_STAGE(PG8_SA(0, 1), cA + hstep, voffA);
        if (wr == 1) PG8_BAR;
        PG8_WAIT_V(4); PG8_BAR;
        PG8_STAGE(PG8_SB(1, 0), cB + kstep, voffB); PG8_STAGE(PG8_SA(1, 0), cA + kstep, voffA); PG8_STAGE(PG8_SB(1, 1), cB + hstep + kstep, voffB);
        PG8_WAIT_V(6); PG8_BAR;
    }
    for (;;) {
        const bool has_next = S.next(ui + 1, nxt);
        const char* nA = has_next ? (const char*)g.A + (size_t)nxt.pm * tstep : cA; const char* nB = has_next ? (const char*)g.Bt + (size_t)nxt.pn * tstep : cB;
        for (int t = 0; t < nt; t += 2) {
            const bool last = (t == nt - 2);
            const char* a1 = cA + (size_t)(t + 1) * kstep;
            const char* a2 = last ? nA : cA + (size_t)(t + 2) * kstep; const char* b2 = last ? nB : cB + (size_t)(t + 2) * kstep;
            const char* a3 = a2 + kstep; const char* b3 = b2 + kstep;
            if (last && has_next) S.a_ready(nxt);
            if constexpr (SP2) {
            PG8_LDB(B0, 0, 0); PG8_LDB(B1, 0, 1); PG8_SCHED; PG8_LDA(At, 0, 0); PG8_STAGE(PG8_SA(1, 1), a1 + hstep, voffA);
            PG8_WAIT_V(8); PG8_WAIT_L(0); PG8_BAR; PG8_MMA(0, 0, At, B0); PG8_MMA(0, 1, At, B1); PG8_BAR; PG8_SCHED;
            PG8_LDA(At, 0, 1); PG8_STAGE(PG8_SB(0, 0), b2, voffB); PG8_STAGE(PG8_SB(0, 1), b2 + hstep, voffB); PG8_STAGE(PG8_SA(0, 0), a2, voffA);
            PG8_WAIT_V(8); PG8_WAIT_L(0); PG8_BAR; PG8_MMA(1, 0, At, B0); PG8_MMA(1, 1, At, B1); PG8_BAR; PG8_SCHED;
            PG8_LDB(B0, 1, 0); PG8_LDB(B1, 1, 1); PG8_SCHED; PG8_LDA(At, 1, 0); PG8_STAGE(PG8_SA(0, 1), a2 + hstep, voffA);
            PG8_WAIT_V(8); PG8_WAIT_L(0); PG8_BAR; PG8_MMA(0, 0, At, B0); PG8_MMA(0, 1, At, B1); PG8_BAR; PG8_SCHED;
            PG8_LDA(At, 1, 1); PG8_STAGE(PG8_SB(1, 0), b3, voffB); PG8_STAGE(PG8_SB(1, 1), b3 + hstep, voffB); PG8_STAGE(PG8_SA(1, 0), a3, voffA);
            PG8_WAIT_V(8); PG8_WAIT_L(0); PG8_BAR; PG8_MMA(1, 0, At, B0); PG8_MMA(1, 1, At, B1); PG8_BAR; PG8_SCHED;
            } else {
            PG8_LDB(B0, 0, 0); PG8_SCHED; PG8_LDA(At, 0, 0); PG8_STAGE(PG8_SA(1, 1), a1 + hstep, voffA);
            PG8_WAIT_L(8); PG8_BAR; PG8_WAIT_L(0); PG8_MMA(0, 0, At, B0); PG8_BAR; PG8_SCHED;
            PG8_LDB(B1, 0, 1); PG8_STAGE(PG8_SB(0, 0), b2, voffB);
            PG8_BAR; PG8_WAIT_L(0); PG8_MMA(0, 1, At, B1); PG8_BAR;
            PG8_LDA(At, 0, 1); PG8_STAGE(PG8_SA(0, 0), a2, voffA);
            PG8_BAR; PG8_WAIT_L(0); PG8_MMA(1, 0, At, B0); PG8_BAR; PG8_SCHED;
            PG8_STAGE(PG8_SB(0, 1), b2 + hstep, voffB);
            PG8_WAIT_V(6); PG8_BAR; PG8_MMA(1, 1, At, B1); PG8_BAR;
            PG8_LDB(B0, 1, 0); PG8_SCHED; PG8_LDA(At, 1, 0); PG8_STAGE(PG8_SA(0, 1), a2 + hstep, voffA);
            PG8_WAIT_L(8); PG8_BAR; PG8_WAIT_L(0); PG8_MMA(0, 0, At, B0); PG8_BAR; PG8_SCHED;
            PG8_LDB(B1, 1, 1); PG8_STAGE(PG8_SB(1, 0), b3, voffB);
            PG8_BAR; PG8_WAIT_L(0); PG8_MMA(0, 1, At, B1); PG8_BAR;
            PG8_LDA(At, 1, 1); PG8_STAGE(PG8_SA(1, 0), a3, voffA);
            PG8_BAR; PG8_WAIT_L(0); PG8_MMA(1, 0, At, B0); PG8_BAR; PG8_SCHED;
            PG8_STAGE(PG8_SB(1, 1), b3 + hstep, voffB);
            PG8_WAIT_V(6); PG8_BAR; PG8_MMA(1, 1, At, B1); PG8_BAR;
            }
        }
        if constexpr (ALIGN_EPI) { if (wr == 0) PG8_BAR; }
        if constexpr (!Epi::AFTER_DRAIN) { E(acc, cur, wr, wc, fr, fq); S.done(cur); }
        if (!has_next) break;
#pragma unroll
        for (int a = 0; a < 2; ++a)
#pragma unroll
            for (int b = 0; b < 2; ++b)
#pragma unroll
                for (int m = 0; m < 4; ++m)
#pragma unroll
                    for (int n = 0; n < 2; ++n) acc[a][b][m][n] = (f32x4){0.f, 0.f, 0.f, 0.f};
        cur = nxt; cA = nA; cB = nB; ++ui;
        if constexpr (ALIGN_EPI) { if (wr == 1) PG8_BAR; }
    }
    PG8_WAIT_V(0);
    if constexpr (!ALIGN_EPI) { if (wr == 0) PG8_BAR; }
    PG8_BAR;
    if constexpr (Epi::AFTER_DRAIN) { E.fused(acc, cur, wr, wc, fr, fq, lds, wid, lane); S.done(cur); }
#undef PG8_SA
#undef PG8_SB
#undef PG8_STAGE
#undef PG8_LDA
#undef PG8_LDB
#undef PG8_MMA
#undef PG8_WAIT_V
#undef PG8_WAIT_L
#undef PG8_BAR
#undef PG8_SCHED
}
}

typedef unsigned short bf16_t;
typedef unsigned u32x4 __attribute__((ext_vector_type(4)));
typedef unsigned u32x2 __attribute__((ext_vector_type(2)));
typedef float f32x4 __attribute__((ext_vector_type(4)));
#define LAS __attribute__((address_space(3)))

constexpr int NB = 8, SEQ = 4096, M = NB * SEQ, DM = 1024, NP = 3072, FF = 2816, NGU = 2 * FF, INC = 2956;
constexpr int C_QA = 0, C_KCA = 256, C_VCA = 320, C_KSA = 384, C_VSA = 448, C_KWA = 512, C_VWA = 576, C_CVB = 640, C_CVC = 896, C_CVU = 1152,
              C_QC = 1408, C_KC = 1664, C_VC = 1920, C_QD = 2176, C_KD = 2432, C_VD = 2688, C_GT = 2944;
constexpr float EPS = 1e-6f;
constexpr size_t MiB = 1u << 20;
constexpr size_t WS_SS = 0, WS_KCN = 1 * MiB, WS_VCC = 1 * MiB + 512 * 1024, WS_W = 2 * MiB;
constexpr size_t W_IN = 0, W_OUT = 6 * MiB, W_GU = 8 * MiB, W_DN = 19 * MiB, W_LAYER = 24 * MiB + 512 * 1024;
constexpr size_t WS_XB = 52 * MiB, WS_GR = 116 * MiB, WS_PROJ = 180 * MiB, WS_X1 = 372 * MiB, WS_W1T = 500 * MiB, WS_W2T = 504 * MiB, WS_CB = 504 * MiB + 256 * 1024, WS_BAR = 504 * MiB + 512 * 1024, WS_END = 505 * MiB;
constexpr size_t DO_PO = 0, DO_LSE = 48 * MiB;
constexpr int LDS_BYTES = 143360;

struct Params { const float* in[23]; float* out; unsigned char* ws; };

__device__ __forceinline__ float blo(unsigned u) { return __uint_as_float(u << 16); }
__device__ __forceinline__ float bhi(unsigned u) { return __uint_as_float(u & 0xffff0000u); }
__device__ __forceinline__ float bf2f(bf16_t h) { return __uint_as_float((unsigned)h << 16); }
__device__ __forceinline__ unsigned pk2(float lo, float hi) { return pg8::cvt_pk_bf16(lo, hi); }
template <int K> __device__ __forceinline__ unsigned swz_u(unsigned v) { return (unsigned)__builtin_amdgcn_ds_swizzle((int)v, (K << 10) | 0x1f); }
template <int K> __device__ __forceinline__ float swz_f(float v) { return __uint_as_float(swz_u<K>(__float_as_uint(v))); }
__device__ __forceinline__ float sum32(float v) { auto rr = __builtin_amdgcn_permlane32_swap(__float_as_uint(v), __float_as_uint(v), false, false); return __uint_as_float(rr[0]) + __uint_as_float(rr[1]); }
__device__ __forceinline__ float max32(float v) { auto rr = __builtin_amdgcn_permlane32_swap(__float_as_uint(v), __float_as_uint(v), false, false); return fmaxf(__uint_as_float(rr[0]), __uint_as_float(rr[1])); }
__device__ __forceinline__ unsigned or32(unsigned v) { auto rr = __builtin_amdgcn_permlane32_swap(v, v, false, false); return rr[0] | rr[1]; }
__device__ __forceinline__ float partner32(float v, int hh) { auto rr = __builtin_amdgcn_permlane32_swap(__float_as_uint(v), __float_as_uint(v), false, false); return __uint_as_float(hh ? rr[0] : rr[1]); }
__device__ __forceinline__ float wave_sum(float v) {
    v += swz_f<1>(v); v += swz_f<2>(v); v += swz_f<4>(v); v += swz_f<8>(v); v += swz_f<16>(v); return sum32(v);
}
#define LDS_WAIT() asm volatile("s_waitcnt lgkmcnt(0)" ::: "memory")
#define CFENCE() asm volatile("" ::: "memory")

struct EpiProj {
    static constexpr bool PERM = true, AFTER_DRAIN = false;
    bf16_t* O; const float* ss;
    __device__ __forceinline__ void operator()(const pg8::f32x4 (&acc)[2][2][4][2], const pg8::Unit& u, int wr, int wc, int fr, int fq) const {
        const int row0 = u.pm * 256 + wr * 64 + fr, col0 = u.pn * 256 + wc * 32 + 8 * fq;
#pragma unroll
        for (int ai = 0; ai < 2; ++ai)
#pragma unroll
            for (int m = 0; m < 4; ++m) {
                const int row = row0 + ai * 128 + m * 16; const float rs = rsqrtf(ss[row] * (1.f / DM) + EPS);
                bf16_t* rowp = O + (size_t)row * NP + col0;
#pragma unroll
                for (int bj = 0; bj < 2; ++bj) { const pg8::f32x4 v0 = acc[ai][bj][m][0] * rs, v1 = acc[ai][bj][m][1] * rs;
                    u32x4 w; w.x = pk2(v0[0], v0[1]); w.y = pk2(v0[2], v0[3]); w.z = pk2(v1[0], v1[1]); w.w = pk2(v1[2], v1[3]);
                    *(u32x4*)(rowp + bj * 128) = w; }
            }
    }
};
struct EpiSwiGLU {
    static constexpr bool PERM = true, AFTER_DRAIN = false;
    bf16_t* H; const float* ss;
    __device__ __forceinline__ void operator()(const pg8::f32x4 (&acc)[2][2][4][2], const pg8::Unit& u, int wr, int wc, int fr, int fq) const {
        const int row0 = u.pm * 256 + wr * 64 + fr, col0 = u.pn * 128 + wc * 32 + 8 * fq;
#pragma unroll
        for (int ai = 0; ai < 2; ++ai)
#pragma unroll
            for (int m = 0; m < 4; ++m) {
                const int row = row0 + ai * 128 + m * 16; const float rs = rsqrtf(ss[row] * (1.f / DM) + EPS);
                float hv[8];
#pragma unroll
                for (int n = 0; n < 2; ++n)
#pragma unroll
                    for (int j = 0; j < 4; ++j) { const float g = acc[ai][0][m][n][j] * rs, up = acc[ai][1][m][n][j] * rs;
                        hv[4 * n + j] = g * up / (1.f + __expf(-g)); }
                u32x4 w; w.x = pk2(hv[0], hv[1]); w.y = pk2(hv[2], hv[3]); w.z = pk2(hv[4], hv[5]); w.w = pk2(hv[6], hv[7]);
                *(u32x4*)(H + (size_t)row * FF + col0) = w;
            }
    }
};
struct EpiResid {
    static constexpr bool PERM = false, AFTER_DRAIN = false;
    const float* xin; const bf16_t* xin_b; float* xout; bf16_t* xb; float* ss;
    __device__ __forceinline__ void operator()(const pg8::f32x4 (&acc)[2][2][4][2], const pg8::Unit& u, int wr, int wc, int fr, int fq) const {
        const int row0 = u.pm * 256 + wr * 64 + fr, col0 = u.pn * 256 + wc * 32 + 4 * fq;
#pragma unroll
        for (int ai = 0; ai < 2; ++ai)
#pragma unroll
            for (int m = 0; m < 4; ++m) {
                const int row = row0 + ai * 128 + m * 16; const size_t off = (size_t)row * DM + col0; float sq = 0.f;
#pragma unroll
                for (int bj = 0; bj < 2; ++bj)
#pragma unroll
                    for (int n = 0; n < 2; ++n) { const size_t o = off + bj * 128 + n * 16; f32x4 xi;
                        if (xin) xi = *(const f32x4*)(xin + o);
                        else { const u32x2 r2 = *(const u32x2*)(xin_b + o); xi[0] = blo(r2.x); xi[1] = bhi(r2.x); xi[2] = blo(r2.y); xi[3] = bhi(r2.y); }
                        f32x4 v;
                        v[0] = xi[0] + acc[ai][bj][m][n][0]; v[1] = xi[1] + acc[ai][bj][m][n][1]; v[2] = xi[2] + acc[ai][bj][m][n][2]; v[3] = xi[3] + acc[ai][bj][m][n][3];
                        if (xout) *(f32x4*)(xout + o) = v;
                        if (xb) { u32x2 w; w.x = pk2(v[0], v[1]); w.y = pk2(v[2], v[3]); *(u32x2*)(xb + o) = w; }
                        sq += (v[0] * v[0] + v[1] * v[1]) + (v[2] * v[2] + v[3] * v[3]); }
                if (ss) { sq += swz_f<16>(sq); sq = sum32(sq); if (fq == 0) atomicAdd(ss + row, sq); }
            }
    }
};

#ifndef REP_PW
#define REP_PW 1
#endif
#ifndef REP_PC
#define REP_PC 1
#endif
#ifndef REP_PX
#define REP_PX 1
#endif
template <int MAP> __device__ __forceinline__ int dst_row(int c) {
    if (MAP == 0) return c < 640 ? c : (c < 652 ? 2944 + (c - 640) : c - 12);
    if (MAP == 1) return c;
    if (MAP == 2) return 256 * (c >> 7) + (c & 127);
    return 256 * (c >> 7) + 128 + (c & 127);
}
template <int MAP> __device__ __forceinline__ void transpose_item(const float* W, int K, int N, const float* gk, bf16_t* WT, LAS float* scr, int item, int lane) {
    const int nblk = (N + 63) / 64, kb = item / nblk, nb = item % nblk, k0 = 64 * kb, n0 = 64 * nb;
    const int nn = n0 + lane; const bool okn = nn < N;
#pragma unroll
    for (int i = 0; i < 64; ++i) { float v = okn ? W[(size_t)(k0 + i) * N + nn] : 0.f; if (gk) v *= gk[k0 + i]; scr[i * 65 + lane] = v; }
    LDS_WAIT();
    const int c = lane & 7;
#pragma unroll
    for (int j = 0; j < 8; ++j) { const int n = (lane >> 3) + 8 * j; const LAS float* s = scr + (8 * c) * 65 + n;
        if (n0 + n < N) { u32x4 o; o.x = pk2(s[0 * 65], s[1 * 65]); o.y = pk2(s[2 * 65], s[3 * 65]); o.z = pk2(s[4 * 65], s[5 * 65]); o.w = pk2(s[6 * 65], s[7 * 65]);
            if (MAP == 4) { const int nn2 = n0 + n, kk2 = k0 + 8 * c; *(u32x4*)(WT + ((size_t)(((nn2 >> 5) * (K >> 4) + (kk2 >> 4)) * 64 + ((kk2 >> 3) & 1) * 32 + (nn2 & 31)) * 8)) = o; }
            else *(u32x4*)(WT + (size_t)dst_row<MAP>(n0 + n) * K + k0 + 8 * c) = o; } }
    LDS_WAIT();
}
__device__ __forceinline__ void prologue(const Params& p, LAS unsigned char* lds, int gw, int NGW, int wave, int lane) {
    LAS float* scr = (LAS float*)(lds + wave * 16640);
    constexpr int I_IN = 16 * 47, I_OUT = 16 * 16, I_G = 16 * 44, I_DN = 44 * 16, I_L = I_IN + I_OUT + 2 * I_G + I_DN, I_Z = 116;
    for (int rw_ = 0; rw_ < REP_PW; ++rw_)
    for (int it = gw; it < 2 * (I_L + I_Z); it += NGW) {
        const int l = it / (I_L + I_Z); int r = it % (I_L + I_Z);
        unsigned char* wl = p.ws + WS_W + (size_t)l * W_LAYER;
        if (r < I_IN) { transpose_item<0>(p.in[2] + (size_t)l * DM * INC, DM, INC, p.in[1] + l * DM, (bf16_t*)(wl + W_IN), scr, r, lane); continue; } r -= I_IN;
        if (r < I_OUT) { transpose_item<1>(p.in[18] + (size_t)l * DM * DM, DM, DM, nullptr, (bf16_t*)(wl + W_OUT), scr, r, lane); continue; } r -= I_OUT;
        if (r < I_G) { transpose_item<2>(p.in[20] + (size_t)l * DM * FF, DM, FF, p.in[19] + l * DM, (bf16_t*)(wl + W_GU), scr, r, lane); continue; } r -= I_G;
        if (r < I_G) { transpose_item<3>(p.in[21] + (size_t)l * DM * FF, DM, FF, p.in[19] + l * DM, (bf16_t*)(wl + W_GU), scr, r, lane); continue; } r -= I_G;
        if (r < I_DN) { transpose_item<1>(p.in[22] + (size_t)l * FF * DM, FF, DM, nullptr, (bf16_t*)(wl + W_DN), scr, r, lane); continue; } r -= I_DN;
        { u32x4 z = {0u, 0u, 0u, 0u}; u32x4* d = (u32x4*)((bf16_t*)(wl + W_IN) + (size_t)(INC + r) * DM) + lane * 2; d[0] = z; d[1] = z; }
    }
    for (int rc_ = 0; rc_ < REP_PC; ++rc_)
    for (int it = gw; it < 4 * (128 + 4 + 32); it += NGW) {
        const int mi = it / 164, r = it % 164, l = mi >> 1, kv = mi & 1;
        const float* w1 = p.in[kv ? 12 : 10] + (size_t)l * 2048 * 256; const float* w2 = p.in[kv ? 13 : 11] + (size_t)l * 256 * 64; const float* pe = p.in[kv ? 9 : 8] + l * 2048;
        if (r < 128) transpose_item<4>(w1, 2048, 256, nullptr, (bf16_t*)(p.ws + WS_W1T) + (size_t)mi * 256 * 2048, scr, r, lane);
        else if (r < 132) transpose_item<1>(w2, 256, 64, nullptr, (bf16_t*)(p.ws + WS_W2T) + (size_t)mi * 64 * 256, scr, r - 128, lane);
        else { const int c = (r - 132) * 8 + (lane & 7), rg = lane >> 3; float acc = 0.f;
#pragma unroll 32
            for (int i = rg * 256; i < rg * 256 + 256; ++i) acc += pe[i] * w1[(size_t)i * 256 + c];
            acc += swz_f<8>(acc); acc += swz_f<16>(acc); acc = sum32(acc);
            if (rg == 0) ((float*)(p.ws + WS_CB))[mi * 256 + c] = acc; }
    }
    float* ss = (float*)(p.ws + WS_SS); bf16_t* xb = (bf16_t*)(p.ws + WS_XB);
    for (int rx_ = 0; rx_ < REP_PX; ++rx_)
    for (int m0 = gw; m0 < M; m0 += 4 * NGW) {
        f32x4 v[4][4];
#pragma unroll
        for (int rr = 0; rr < 4; ++rr) { const int m = m0 + rr * NGW; const f32x4* xr = (const f32x4*)(p.in[0] + (size_t)(m < M ? m : 0) * DM) + lane;
#pragma unroll
            for (int j = 0; j < 4; ++j) v[rr][j] = xr[64 * j]; }
#pragma unroll
        for (int rr = 0; rr < 4; ++rr) { const int m = m0 + rr * NGW; if (m < M) { u32x2* o8 = (u32x2*)(xb + (size_t)m * DM) + lane; float s = 0.f;
#pragma unroll
            for (int j = 0; j < 4; ++j) { const f32x4 t = v[rr][j]; s += (t[0] * t[0] + t[1] * t[1]) + (t[2] * t[2] + t[3] * t[3]); u32x2 w; w.x = pk2(t[0], t[1]); w.y = pk2(t[2], t[3]); o8[64 * j] = w; }
            s = wave_sum(s);
            if (lane == 0) { ss[m] = s; ss[M + m] = 0.f; ss[2 * M + m] = 0.f; ss[3 * M + m] = 0.f; } } }
    }
}

#define UNPACK8(v, k) const float k##0 = blo(v.x), k##1 = bhi(v.x), k##2 = blo(v.y), k##3 = bhi(v.y), k##4 = blo(v.z), k##5 = bhi(v.z), k##6 = blo(v.w), k##7 = bhi(v.w)
__device__ __forceinline__ void load_row64(float (&q)[64], const bf16_t* p) {
#pragma unroll
    for (int c = 0; c < 8; ++c) { const u32x4 v = *(const u32x4*)(p + 8 * c); UNPACK8(v, k);
        q[8 * c] = k0; q[8 * c + 1] = k1; q[8 * c + 2] = k2; q[8 * c + 3] = k3; q[8 * c + 4] = k4; q[8 * c + 5] = k5; q[8 * c + 6] = k6; q[8 * c + 7] = k7; }
}
template <bool SS> __device__ __forceinline__ float dot_row(const float (&q)[64], const bf16_t* p, float& kss) {
    float z = 0.f, s = 0.f;
#pragma unroll
    for (int c = 0; c < 8; ++c) { const u32x4 v = *(const u32x4*)(p + 8 * c); UNPACK8(v, k);
        z += (q[8 * c] * k0 + q[8 * c + 1] * k1) + (q[8 * c + 2] * k2 + q[8 * c + 3] * k3) + (q[8 * c + 4] * k4 + q[8 * c + 5] * k5) + (q[8 * c + 6] * k6 + q[8 * c + 7] * k7);
        if (SS) s += (k0 * k0 + k1 * k1) + (k2 * k2 + k3 * k3) + (k4 * k4 + k5 * k5) + (k6 * k6 + k7 * k7);
        if (c == 3) CFENCE(); }
    kss = s; return z;
}
__device__ __forceinline__ void axpy_row(float (&o)[64], float w, const bf16_t* p) {
#pragma unroll
    for (int c = 0; c < 8; ++c) { const u32x4 v = *(const u32x4*)(p + 8 * c); UNPACK8(v, k);
        o[8 * c] += w * k0; o[8 * c + 1] += w * k1; o[8 * c + 2] += w * k2; o[8 * c + 3] += w * k3; o[8 * c + 4] += w * k4; o[8 * c + 5] += w * k5; o[8 * c + 6] += w * k6; o[8 * c + 7] += w * k7;
        if (c == 3) CFENCE(); }
}
__device__ __forceinline__ float dot_row_f32(const float (&q)[64], const float* p) {
    float z = 0.f;
#pragma unroll
    for (int c = 0; c < 16; ++c) { const f32x4 v = *(const f32x4*)(p + 4 * c); z += (q[4 * c] * v[0] + q[4 * c + 1] * v[1]) + (q[4 * c + 2] * v[2] + q[4 * c + 3] * v[3]); if (c == 7) CFENCE(); }
    return z;
}
__device__ __forceinline__ void axpy_row_f32(float (&o)[64], float w, const float* p) {
#pragma unroll
    for (int c = 0; c < 16; ++c) { const f32x4 v = *(const f32x4*)(p + 4 * c); o[4 * c] += w * v[0]; o[4 * c + 1] += w * v[1]; o[4 * c + 2] += w * v[2]; o[4 * c + 3] += w * v[3]; if (c == 7) CFENCE(); }
}
__device__ __forceinline__ void store_group(const float (&o)[64], const float* g, bf16_t* dst) {
    float ss = 0.f;
#pragma unroll
    for (int d = 0; d < 64; ++d) ss += o[d] * o[d];
    const float rs = rsqrtf(ss * (1.f / 64.f) + EPS);
#pragma unroll
    for (int c = 0; c < 8; ++c) { u32x4 w;
        w.x = pk2(o[8 * c] * rs * g[8 * c], o[8 * c + 1] * rs * g[8 * c + 1]); w.y = pk2(o[8 * c + 2] * rs * g[8 * c + 2], o[8 * c + 3] * rs * g[8 * c + 3]);
        w.z = pk2(o[8 * c + 4] * rs * g[8 * c + 4], o[8 * c + 5] * rs * g[8 * c + 5]); w.w = pk2(o[8 * c + 6] * rs * g[8 * c + 6], o[8 * c + 7] * rs * g[8 * c + 7]);
        *(u32x4*)(dst + 8 * c) = w; }
}
__device__ __forceinline__ void load_q_norm(float (&q)[64], const bf16_t* p, const float* gq, const float* gx) {
    load_row64(q, p); float ss = 0.f;
#pragma unroll
    for (int d = 0; d < 64; ++d) ss += q[d] * q[d];
    const float rs = rsqrtf(ss * (1.f / 64.f) + EPS) * 0.125f;
#pragma unroll
    for (int d = 0; d < 64; ++d) q[d] = q[d] * rs * gq[d] * (gx ? gx[d] : 1.f);
}

__device__ __forceinline__ void stick_naive(const bf16_t* proj, bf16_t* groups, const float* g_out, int item, int lane) {
    const int tile = item & 63, h = (item >> 6) & 3, b = item >> 8, t = tile * 64 + lane;
    const bf16_t* base = proj + (size_t)b * SEQ * NP;
    float q[64]; load_row64(q, base + (size_t)t * NP + C_QC + h * 64);
#pragma unroll
    for (int d = 0; d < 64; ++d) q[d] *= 0.125f;
    float o[64];
#pragma unroll
    for (int d = 0; d < 64; ++d) o[d] = 0.f;
    float between = 0.f;
    for (int s = tile * 64 + 62; s >= 0; --s) {
        const bf16_t* kr = base + (size_t)s * NP + C_KC + h * 64; float dummy;
        const float z = dot_row<false>(q, kr, dummy); CFENCE();
        const bool act = s < t;
        const float sp = fmaxf(z, 0.f) + __logf(1.f + __expf(-fabsf(z)));
        const float w = act ? __expf((z - sp) - between) : 0.f;
        axpy_row(o, w, base + (size_t)s * NP + C_VC + h * 64); CFENCE();
        between += act ? sp : 0.f;
        if (s < tile * 64 && __all(between > 104.f)) break;
    }
    store_group(o, g_out + 512 + h * 64, groups + (size_t)(b * SEQ + t) * DM + 512 + h * 64);
}

__device__ __forceinline__ void dil_naive(const bf16_t* proj, bf16_t* groups, const float* gq, const float* gk, const float* g_out, int item, int lane) {
    const int tile = item & 63, h = (item >> 6) & 3, b = item >> 8, t = tile * 64 + lane;
    const bf16_t* base = proj + (size_t)b * SEQ * NP;
    float q[64]; load_q_norm(q, base + (size_t)t * NP + C_QD + h * 64, gq, gk);
    const float slope = exp2f(-(float)(2 * h + 2));
    float o[64];
#pragma unroll
    for (int d = 0; d < 64; ++d) o[d] = 0.f;
    float mx = -1e30f, l = 0.f;
    for (int cfg = 0; cfg < 3; ++cfg) {
        const int dil = cfg == 0 ? 1 : (cfg == 1 ? 4 : 16);
        for (int j = 0; j <= 128; ++j) {
            const int s = t - j * dil; const bool act = s >= 0;
            if (!__any(act)) break;
            if (act) {
                float kss; const float z = dot_row<true>(q, base + (size_t)s * NP + C_KD + h * 64, kss); CFENCE();
                const float sc = z * rsqrtf(kss * (1.f / 64.f) + EPS) - slope * (float)(j * dil);
                if (sc > mx) { const float corr = __expf(mx - sc); l *= corr;
#pragma unroll
                    for (int d = 0; d < 64; ++d) o[d] *= corr;
                    mx = sc; }
                const float pw = __expf(sc - mx); l += pw;
                axpy_row(o, pw, base + (size_t)s * NP + C_VD + h * 64); CFENCE();
            }
        }
    }
    const float inv = 1.f / l;
#pragma unroll
    for (int d = 0; d < 64; ++d) o[d] *= inv;
    store_group(o, g_out + 768 + h * 64, groups + (size_t)(b * SEQ + t) * DM + 768 + h * 64);
}

template <int NI> __device__ __forceinline__ void conv_items(const bf16_t* proj, bf16_t* groups, const float* cw, const float* g_out, int item0, int stride, int lane) {
    const int ch = (lane & 31) * 8;
    u32x4 cv[NI][3], uv[NI][3], bv[NI];
#pragma unroll
    for (int n = 0; n < NI; ++n) { const int token = (item0 + n * stride) * 2 + (lane >> 5), tpos = token & (SEQ - 1); const bf16_t* row = proj + (size_t)token * NP;
#pragma unroll
        for (int k = 0; k < 3; ++k) { const int back = 2 - k;
            if (tpos >= back) { cv[n][k] = *(const u32x4*)(row - (size_t)back * NP + C_CVC + ch); uv[n][k] = *(const u32x4*)(row - (size_t)back * NP + C_CVU + ch); }
            else { cv[n][k] = (u32x4){0u, 0u, 0u, 0u}; uv[n][k] = cv[n][k]; } }
        bv[n] = *(const u32x4*)(row + C_CVB + ch); }
    float wk[3][8];
#pragma unroll
    for (int k = 0; k < 3; ++k)
#pragma unroll
        for (int i = 0; i < 8; ++i) wk[k][i] = cw[k * 256 + ch + i];
    const float* go = g_out + 256 + ch;
#pragma unroll
    for (int n = 0; n < NI; ++n) { const int token = (item0 + n * stride) * 2 + (lane >> 5);
        float acc[8];
#pragma unroll
        for (int i = 0; i < 8; ++i) acc[i] = 0.f;
#pragma unroll
        for (int k = 0; k < 3; ++k) { UNPACK8(cv[n][k], c); UNPACK8(uv[n][k], u);
            acc[0] += wk[k][0] * (c0 * u0); acc[1] += wk[k][1] * (c1 * u1); acc[2] += wk[k][2] * (c2 * u2); acc[3] += wk[k][3] * (c3 * u3);
            acc[4] += wk[k][4] * (c4 * u4); acc[5] += wk[k][5] * (c5 * u5); acc[6] += wk[k][6] * (c6 * u6); acc[7] += wk[k][7] * (c7 * u7); }
        UNPACK8(bv[n], g);
        float y[8] = {g0 * acc[0], g1 * acc[1], g2 * acc[2], g3 * acc[3], g4 * acc[4], g5 * acc[5], g6 * acc[6], g7 * acc[7]};
        float ss = 0.f;
#pragma unroll
        for (int i = 0; i < 8; ++i) ss += y[i] * y[i];
        ss += swz_f<1>(ss); ss += swz_f<2>(ss); ss += swz_f<4>(ss);
        const float rs = rsqrtf(ss * (1.f / 64.f) + EPS);
        u32x4 w; w.x = pk2(y[0] * rs * go[0], y[1] * rs * go[1]); w.y = pk2(y[2] * rs * go[2], y[3] * rs * go[3]);
        w.z = pk2(y[4] * rs * go[4], y[5] * rs * go[5]); w.w = pk2(y[6] * rs * go[6], y[7] * rs * go[7]);
        *(u32x4*)(groups + (size_t)token * DM + 256 + ch) = w; }
}

typedef short bf16x8 __attribute__((ext_vector_type(8)));
typedef short s16x4 __attribute__((ext_vector_type(4)));
typedef float f32x16 __attribute__((ext_vector_type(16)));
typedef float f32x2_t __attribute__((ext_vector_type(2)));
typedef __bf16 bf16x2_t __attribute__((ext_vector_type(2)));
__device__ __forceinline__ unsigned cvtpk(float lo, float hi) { f32x2_t v = {lo, hi}; bf16x2_t b = __builtin_convertvector(v, bf16x2_t); return __builtin_bit_cast(unsigned, b); }
#define MFMA32(a, b, c) __builtin_amdgcn_mfma_f32_32x32x16_bf16((a), (b), (c), 0, 0, 0)
#define EXP2(x) __builtin_amdgcn_exp2f(x)
constexpr float LOG2E = 1.4426950408889634f;
constexpr int KSB = 144, VTB = 136, KS_BYTES = 64 * KSB, VT_BYTES = 64 * VTB;
__device__ __forceinline__ int crow(int i, int h) { return (i & 3) + 8 * (i >> 2) + 4 * h; }

struct KVSrc { const bf16_t* k; const bf16_t* v; long pitch; int first, lo, hi; };
__device__ __forceinline__ void kv_fetch(const KVSrc& s, int tid, u32x4& kc, u32x4& vc) {
    const int kl = tid >> 3, ch = tid & 7, i = s.first + kl;
    if (i >= s.lo && i < s.hi) { kc = *(const u32x4*)(s.k + (long)i * s.pitch + 8 * ch); vc = *(const u32x4*)(s.v + (long)i * s.pitch + 8 * ch); }
    else { kc = (u32x4){0u, 0u, 0u, 0u}; vc = kc; }
}
template <bool NORM> __device__ __forceinline__ void kv_store(u32x4 kc, u32x4 vc, const float (&g)[8], LAS unsigned char* ksb, LAS unsigned char* vtb, int tid) {
    const int kl = tid >> 3, ch = tid & 7;
    if (NORM) { UNPACK8(kc, k); float ss = (k0 * k0 + k1 * k1) + (k2 * k2 + k3 * k3) + (k4 * k4 + k5 * k5) + (k6 * k6 + k7 * k7);
        ss += swz_f<1>(ss); ss += swz_f<2>(ss); ss += swz_f<4>(ss);
        const float rs = rsqrtf(ss * (1.f / 64.f) + EPS);
        kc.x = cvtpk(k0 * rs * g[0], k1 * rs * g[1]); kc.y = cvtpk(k2 * rs * g[2], k3 * rs * g[3]); kc.z = cvtpk(k4 * rs * g[4], k5 * rs * g[5]); kc.w = cvtpk(k6 * rs * g[6], k7 * rs * g[7]); }
    *(LAS u32x4*)(ksb + kl * KSB + ch * 16) = kc;
    LAS unsigned short* vp = (LAS unsigned short*)(vtb + (8 * ch) * VTB + kl * 2);
    vp[0 * (VTB / 2)] = (unsigned short)(vc.x & 0xffffu); vp[1 * (VTB / 2)] = (unsigned short)(vc.x >> 16);
    vp[2 * (VTB / 2)] = (unsigned short)(vc.y & 0xffffu); vp[3 * (VTB / 2)] = (unsigned short)(vc.y >> 16);
    vp[4 * (VTB / 2)] = (unsigned short)(vc.z & 0xffffu); vp[5 * (VTB / 2)] = (unsigned short)(vc.z >> 16);
    vp[6 * (VTB / 2)] = (unsigned short)(vc.w & 0xffffu); vp[7 * (VTB / 2)] = (unsigned short)(vc.w >> 16);
}
template <bool NORM> __device__ __forceinline__ void load_qfrag(bf16x8 (&qf)[4], const bf16_t* qrow, const float* g1, const float* g2, float sc, int hh) {
    float f[32];
#pragma unroll
    for (int s = 0; s < 4; ++s) { const u32x4 v = *(const u32x4*)(qrow + 16 * s + 8 * hh); UNPACK8(v, k);
        f[8 * s] = k0; f[8 * s + 1] = k1; f[8 * s + 2] = k2; f[8 * s + 3] = k3; f[8 * s + 4] = k4; f[8 * s + 5] = k5; f[8 * s + 6] = k6; f[8 * s + 7] = k7; }
    if (NORM) { float ss = 0.f;
#pragma unroll
        for (int i = 0; i < 32; ++i) ss += f[i] * f[i];
        ss = sum32(ss); sc *= rsqrtf(ss * (1.f / 64.f) + EPS); }
#pragma unroll
    for (int s = 0; s < 4; ++s) { float v[8];
#pragma unroll
        for (int j = 0; j < 8; ++j) { const int d = 16 * s + 8 * hh + j; v[j] = f[8 * s + j] * sc * (g1 ? g1[d] : 1.f) * (g2 ? g2[d] : 1.f); }
        u32x4 w; w.x = cvtpk(v[0], v[1]); w.y = cvtpk(v[2], v[3]); w.z = cvtpk(v[4], v[5]); w.w = cvtpk(v[6], v[7]);
        qf[s] = __builtin_bit_cast(bf16x8, w); }
}

struct SfCmp { int tq, nvis, j0; float slope; __device__ __forceinline__ float operator()(float s, int kl) const { const int j = j0 + kl; return j < nvis ? s - slope * (float)(tq - 16 * j - 31) : -INFINITY; } };
struct SfSlc { int tq, key0; float slope; bool sel; __device__ __forceinline__ float operator()(float s, int kl) const { const int key = key0 + kl; return (sel && key <= tq) ? s - slope * (float)(tq - key) : -INFINITY; } };
struct SfWin { int tq, key0; float slope; __device__ __forceinline__ float operator()(float s, int kl) const { const int key = key0 + kl; return (key <= tq && tq - key <= 511) ? s - slope * (float)(tq - key) : -INFINITY; } };

__device__ __forceinline__ void pv_accum(const f32x16& s0, const f32x16& s1, f32x16& o0, f32x16& o1, LAS const unsigned char* vtb, int r, int hh) {
    __builtin_amdgcn_s_setprio(1);
#pragma unroll
    for (int kt = 0; kt < 2; ++kt)
#pragma unroll
        for (int sp = 0; sp < 2; ++sp) { u32x4 w;
            if (kt == 0) { w.x = cvtpk(s0[8 * sp], s0[8 * sp + 1]); w.y = cvtpk(s0[8 * sp + 2], s0[8 * sp + 3]); w.z = cvtpk(s0[8 * sp + 4], s0[8 * sp + 5]); w.w = cvtpk(s0[8 * sp + 6], s0[8 * sp + 7]); }
            else         { w.x = cvtpk(s1[8 * sp], s1[8 * sp + 1]); w.y = cvtpk(s1[8 * sp + 2], s1[8 * sp + 3]); w.z = cvtpk(s1[8 * sp + 4], s1[8 * sp + 5]); w.w = cvtpk(s1[8 * sp + 6], s1[8 * sp + 7]); }
            const bf16x8 pb = __builtin_bit_cast(bf16x8, w); const int ko = 32 * kt + 16 * sp + 4 * hh;
            { const s16x4 lo = *(LAS const s16x4*)(vtb + r * VTB + ko * 2), hi = *(LAS const s16x4*)(vtb + r * VTB + (ko + 8) * 2);
              o0 = MFMA32(__builtin_shufflevector(lo, hi, 0, 1, 2, 3, 4, 5, 6, 7), pb, o0); }
            { const s16x4 lo = *(LAS const s16x4*)(vtb + (32 + r) * VTB + ko * 2), hi = *(LAS const s16x4*)(vtb + (32 + r) * VTB + (ko + 8) * 2);
              o1 = MFMA32(__builtin_shufflevector(lo, hi, 0, 1, 2, 3, 4, 5, 6, 7), pb, o1); } }
    __builtin_amdgcn_s_setprio(0);
}
template <int MODE, class SF>
__device__ __forceinline__ void attn_block(const bf16x8 (&qf)[4], f32x16& o0, f32x16& o1, float& m, float& l, LAS const unsigned char* ksb, LAS const unsigned char* vtb, int r, int hh, const SF sf,
                                           float msafe_f, float inv_f, LAS float* imprw, int nbase, float& carry) {
    f32x16 s0, s1;
#pragma unroll
    for (int i = 0; i < 16; ++i) { s0[i] = 0.f; s1[i] = 0.f; }
    bf16x8 ka[4], kb2[4];
#pragma unroll
    for (int s = 0; s < 4; ++s) { ka[s] = *(LAS const bf16x8*)(ksb + r * KSB + (16 * s + 8 * hh) * 2); kb2[s] = *(LAS const bf16x8*)(ksb + (32 + r) * KSB + (16 * s + 8 * hh) * 2); }
    __builtin_amdgcn_s_setprio(1);
#pragma unroll
    for (int s = 0; s < 4; ++s) { s0 = MFMA32(ka[s], qf[s], s0); s1 = MFMA32(kb2[s], qf[s], s1); }
    __builtin_amdgcn_s_setprio(0);
    __builtin_amdgcn_sched_barrier(0);
#pragma unroll
    for (int i = 0; i < 16; ++i) { s0[i] = sf(s0[i], crow(i, hh)); s1[i] = sf(s1[i], 32 + crow(i, hh)); }
    if (MODE != 2) {
        float mloc = fmaxf(s0[0], s1[0]);
#pragma unroll
        for (int i = 1; i < 16; ++i) mloc = fmaxf(mloc, fmaxf(s0[i], s1[i]));
        mloc = max32(mloc);
        const float mnew = fmaxf(m, mloc), msafe = mnew == -INFINITY ? 0.f : mnew, corr = EXP2(m - msafe);
        float psum = 0.f;
#pragma unroll
        for (int i = 0; i < 16; ++i) { s0[i] = EXP2(s0[i] - msafe); s1[i] = EXP2(s1[i] - msafe); psum += s0[i] + s1[i]; }
        psum = sum32(psum);
        l = l * corr + psum; m = mnew;
        if (MODE == 0 && !__all(corr == 1.f)) {
#pragma unroll
            for (int i = 0; i < 16; ++i) { o0[i] *= corr; o1[i] *= corr; } }
    } else {
#pragma unroll
        for (int i = 0; i < 16; ++i) { s0[i] = EXP2(s0[i] - msafe_f) * inv_f; s1[i] = EXP2(s1[i] - msafe_f) * inv_f; }
#pragma unroll
        for (int kt = 0; kt < 2; ++kt) { float A[4], T[4], R[4];
#pragma unroll
            for (int g = 0; g < 4; ++g) { const float p0 = kt ? s1[4 * g] : s0[4 * g], p1 = kt ? s1[4 * g + 1] : s0[4 * g + 1], p2 = kt ? s1[4 * g + 2] : s0[4 * g + 2], p3 = kt ? s1[4 * g + 3] : s0[4 * g + 3];
                A[g] = 2.f * ((p0 + p1) + p2) + p3; T[g] = p3; R[g] = partner32(p3, hh); }
#pragma unroll
            for (int g = 0; g < 4; ++g) { const float prev = hh ? R[g] : (g ? R[g - 1] : carry);
                imprw[nbase + 8 * kt + 2 * g + hh] = A[g] + prev; }
            carry = R[3]; (void)T; }
    }
    __builtin_amdgcn_sched_barrier(0);
    if (MODE != 1) pv_accum(s0, s1, o0, o1, vtb, r, hh);
}


__device__ __forceinline__ void attn_block_full(const bf16x8 (&qf)[4], f32x16& o0, f32x16& o1, float& m, float& l, LAS const unsigned char* ksb, LAS const unsigned char* vtb, int r, int hh, float b0, float sl) {
    f32x16 s0, s1;
#pragma unroll
    for (int i = 0; i < 16; ++i) { s0[i] = 0.f; s1[i] = 0.f; }
    bf16x8 ka[4], kb2[4];
#pragma unroll
    for (int s = 0; s < 4; ++s) { ka[s] = *(LAS const bf16x8*)(ksb + r * KSB + (16 * s + 8 * hh) * 2); kb2[s] = *(LAS const bf16x8*)(ksb + (32 + r) * KSB + (16 * s + 8 * hh) * 2); }
    __builtin_amdgcn_s_setprio(1);
#pragma unroll
    for (int s = 0; s < 4; ++s) { s0 = MFMA32(ka[s], qf[s], s0); s1 = MFMA32(kb2[s], qf[s], s1); }
    __builtin_amdgcn_s_setprio(0);
    __builtin_amdgcn_sched_barrier(0);
#pragma unroll
    for (int i = 0; i < 16; ++i) { const float c = (float)((i & 3) + 8 * (i >> 2)); s0[i] = fmaf(sl, c, s0[i]); s1[i] = fmaf(sl, c + 32.f, s1[i]); }
    float mloc = fmaxf(s0[0], s1[0]);
#pragma unroll
    for (int i = 1; i < 16; ++i) mloc = fmaxf(mloc, fmaxf(s0[i], s1[i]));
    mloc = max32(mloc + b0);
    const float mnew = fmaxf(m, mloc), msafe = mnew == -INFINITY ? 0.f : mnew, corr = EXP2(m - msafe), c0 = b0 - msafe;
    float psum = 0.f;
#pragma unroll
    for (int i = 0; i < 16; ++i) { s0[i] = EXP2(s0[i] + c0); s1[i] = EXP2(s1[i] + c0); psum += s0[i] + s1[i]; }
    psum = sum32(psum);
    l = l * corr + psum; m = mnew;
#pragma unroll
    for (int i = 0; i < 16; ++i) { o0[i] *= corr; o1[i] *= corr; }
    __builtin_amdgcn_sched_barrier(0);
    pv_accum(s0, s1, o0, o1, vtb, r, hh);
}

#define KV_PIPELINE(FIRST, NEXT, SRC, NORM, GAIN, ...) do { \
    __syncthreads(); \
    int nxt_ = (FIRST), par_ = 0; u32x4 kc_, vc_; float g8_[8]; \
    { const float* gp_ = (GAIN); _Pragma("unroll") for (int j_ = 0; j_ < 8; ++j_) g8_[j_] = gp_ ? gp_[8 * (tid & 7) + j_] : 1.f; } \
    if (nxt_ >= 0) { const int id = nxt_; const KVSrc src_ = SRC; kv_fetch(src_, tid, kc_, vc_); } \
    while (nxt_ >= 0) { const int cur_ = nxt_; \
        LAS unsigned char* ksb = lds + par_ * KS_BYTES; LAS unsigned char* vtb = lds + 2 * KS_BYTES + par_ * VT_BYTES; \
        kv_store<NORM>(kc_, vc_, g8_, ksb, vtb, tid); \
        __syncthreads(); \
        { const int cur = cur_; nxt_ = (NEXT); } \
        if (nxt_ >= 0) { const int id = nxt_; const KVSrc src_ = SRC; kv_fetch(src_, tid, kc_, vc_); } \
        { const int id = cur_; __VA_ARGS__; } \
        par_ ^= 1; } } while (0)


__device__ __forceinline__ void kv_store_pre(u32x4 kc, u32x4 vc, LAS unsigned char* ksb, LAS unsigned char* vtb, int tid) {
    *(LAS u32x4*)(ksb + (tid >> 3) * KSB + (tid & 7) * 16) = kc;
    LAS u32x2* vp = (LAS u32x2*)(vtb + (tid >> 3) * VTB + (tid & 7) * 16); u32x2 a = {vc.x, vc.y}, b2 = {vc.z, vc.w}; vp[0] = a; vp[1] = b2;
}
#define KV_PIPELINE_PRE(FIRST, NEXT, KTILE, VTILE, ...) do { \
    __syncthreads(); \
    int nxt_ = (FIRST), par_ = 0; u32x4 kc_, vc_; \
    if (nxt_ >= 0) { const int id = nxt_; kc_ = *(const u32x4*)((KTILE) + tid * 8); vc_ = *(const u32x4*)((VTILE) + tid * 8); } \
    while (nxt_ >= 0) { const int cur_ = nxt_; \
        LAS unsigned char* ksb = lds + par_ * KS_BYTES; LAS unsigned char* vtb = lds + 2 * KS_BYTES + par_ * VT_BYTES; \
        kv_store_pre(kc_, vc_, ksb, vtb, tid); \
        __syncthreads(); \
        { const int cur = cur_; nxt_ = (NEXT); } \
        if (nxt_ >= 0) { const int id = nxt_; kc_ = *(const u32x4*)((KTILE) + tid * 8); vc_ = *(const u32x4*)((VTILE) + tid * 8); } \
        { const int id = cur_; __VA_ARGS__; } \
        par_ ^= 1; } } while (0)

__device__ __forceinline__ void nsa_prep_item(const bf16_t* proj, bf16_t* kn, bf16_t* vtn, const float* g_ks, const float* g_kw, int item, LAS unsigned char* scr, int lane) {
    const int b = item >> 7, which = (item >> 6) & 1, n = item & 63, ch = lane & 7, row0 = lane >> 3;
    const bf16_t* src = proj + ((size_t)b * SEQ + 64 * n) * NP + (which ? C_KWA : C_KSA) + 8 * ch;
    const float* g = (which ? g_kw : g_ks) + 8 * ch;
    float gg[8];
#pragma unroll
    for (int i = 0; i < 8; ++i) gg[i] = g[i];
    u32x4 kc[8], vc[8];
#pragma unroll
    for (int j = 0; j < 8; ++j) { const bf16_t* rp = src + (size_t)(row0 + 8 * j) * NP; kc[j] = *(const u32x4*)rp; vc[j] = *(const u32x4*)(rp + 64); }
    bf16_t* kdst = kn + (((size_t)b * 2 + which) * SEQ + 64 * n) * 64 + 8 * ch;
#pragma unroll
    for (int j = 0; j < 8; ++j) { const int row = row0 + 8 * j; UNPACK8(kc[j], k);
        float ss = (k0 * k0 + k1 * k1) + (k2 * k2 + k3 * k3) + (k4 * k4 + k5 * k5) + (k6 * k6 + k7 * k7);
        ss += swz_f<1>(ss); ss += swz_f<2>(ss); ss += swz_f<4>(ss);
        const float rs = rsqrtf(ss * (1.f / 64.f) + EPS); u32x4 o;
        o.x = cvtpk(k0 * rs * gg[0], k1 * rs * gg[1]); o.y = cvtpk(k2 * rs * gg[2], k3 * rs * gg[3]); o.z = cvtpk(k4 * rs * gg[4], k5 * rs * gg[5]); o.w = cvtpk(k6 * rs * gg[6], k7 * rs * gg[7]);
        *(u32x4*)(kdst + (size_t)row * 64) = o;
        LAS unsigned short* vp = (LAS unsigned short*)(scr + (8 * ch) * 144 + row * 2); const u32x4 v = vc[j];
        vp[0 * 72] = (unsigned short)(v.x & 0xffffu); vp[1 * 72] = (unsigned short)(v.x >> 16); vp[2 * 72] = (unsigned short)(v.y & 0xffffu); vp[3 * 72] = (unsigned short)(v.y >> 16);
        vp[4 * 72] = (unsigned short)(v.z & 0xffffu); vp[5 * 72] = (unsigned short)(v.z >> 16); vp[6 * 72] = (unsigned short)(v.w & 0xffffu); vp[7 * 72] = (unsigned short)(v.w >> 16); }
    LDS_WAIT();
    bf16_t* vdst = vtn + ((((size_t)b * 2 + which) * 64 + n) * 64 + lane) * 64;
#pragma unroll
    for (int c = 0; c < 8; ++c) *(u32x4*)(vdst + 8 * c) = *(LAS const u32x4*)(scr + lane * 144 + 16 * c);
    LDS_WAIT();
}

struct NsaArgs { const bf16_t* proj; bf16_t* groups; const bf16_t *kcn, *vcc; const float *b_gate, *g_q, *g_ks, *g_kw, *g_out; const bf16_t *kn, *vtn; };
constexpr int NSA_SLAB = 2 * KS_BYTES + 2 * VT_BYTES, NSA_ISUM = NSA_SLAB + 4 * 64 * 65 * 4, NSA_MASK = NSA_ISUM + 64 * 65 * 4, NSA_UMASK = NSA_MASK + 512;
__device__ __forceinline__ void nsa_item(const NsaArgs& A, int b, int tl, LAS unsigned char* lds, int tid) {
    asm volatile("" : "+v"(tid));
    const int lane = tid & 63, w = __builtin_amdgcn_readfirstlane(tid >> 6), head = w & 3, half = w >> 2, r = lane & 31, hh = lane >> 5;
    const int tq = tl * 64 + 32 * half + r, tokl = 32 * half + r; const size_t token = (size_t)b * SEQ + tq;
    const bf16_t* base = A.proj + (size_t)b * SEQ * NP;
    LAS float* slab = (LAS float*)(lds + NSA_SLAB); LAS float* isum = (LAS float*)(lds + NSA_ISUM);
    LAS unsigned* masks = (LAS unsigned*)(lds + NSA_MASK); LAS unsigned* umask = (LAS unsigned*)(lds + NSA_UMASK);
    const float slope = exp2f(-(float)(2 * head + 1)) * LOG2E;
    bf16x8 qf[4]; load_qfrag<true>(qf, base + (size_t)tq * NP + C_QA + head * 64, A.g_q, nullptr, 0.125f * LOG2E, hh);
    float gl[3];
#pragma unroll
    for (int br = 0; br < 3; ++br) { const float x = bf2f(base[(size_t)tq * NP + C_GT + head * 3 + br]) + A.b_gate[head * 3 + br]; gl[br] = 1.f / (1.f + __expf(-x)); }
    f32x16 of0, of1, o0, o1;
#pragma unroll
    for (int i = 0; i < 16; ++i) { of0[i] = 0.f; of1[i] = 0.f; }
    float dummy = 0.f;
    {
        const int nbc = (tl >> 4) + 1, nvis = tq >= 31 ? ((tq - 31) >> 4) + 1 : 0;
        const bf16_t* kc = A.kcn + (size_t)b * 256 * 64; const bf16_t* vc = A.vcc + (size_t)b * 256 * 64;
        float m = -INFINITY, l = 0.f;
        KV_PIPELINE_PRE(0, (cur + 1 < nbc ? cur + 1 : -1), kc + (size_t)id * 4096, vc + (size_t)id * 4096,
            { const SfCmp sf{tq, nvis, 64 * id, slope}; attn_block<1>(qf, o0, o1, m, l, ksb, vtb, r, hh, sf, 0.f, 0.f, nullptr, 0, dummy); });
        const float inv = l > 0.f ? 1.f / l : 0.f, msafe = m == -INFINITY ? 0.f : m; float carry = 0.f;
#pragma unroll
        for (int i = 0; i < 16; ++i) { o0[i] = 0.f; o1[i] = 0.f; }
        LAS float* imprw = slab + (head * 64 + tokl) * 65;
        KV_PIPELINE_PRE(0, (cur + 1 < nbc ? cur + 1 : -1), kc + (size_t)id * 4096, vc + (size_t)id * 4096,
            { const SfCmp sf{tq, nvis, 64 * id, slope}; attn_block<2>(qf, o0, o1, m, l, ksb, vtb, r, hh, sf, msafe, inv, imprw, 16 * id, carry); });
#pragma unroll
        for (int i = 0; i < 16; ++i) { of0[i] += gl[0] * o0[i]; of1[i] += gl[0] * o1[i]; }
    }
    __syncthreads();
    if (tl > 15) {
        for (int e = tid; e < 64 * 64; e += 512) { const int tk = e >> 6, n = e & 63, o = tk * 65 + n; isum[o] = ((slab[o] + slab[64 * 65 + o]) + slab[2 * 64 * 65 + o]) + slab[3 * 64 * 65 + o]; }
        __syncthreads();
        const int tk = tid >> 3, sub = tid & 7; float v[8]; int cnt[8];
#pragma unroll
        for (int k = 0; k < 8; ++k) { v[k] = isum[tk * 65 + 8 * sub + k]; cnt[k] = 0; }
        for (int mm = 1; mm <= tl - 2; ++mm) { const float vm = isum[tk * 65 + mm];
#pragma unroll
            for (int k = 0; k < 8; ++k) cnt[k] += (vm > v[k] || (vm == v[k] && mm < 8 * sub + k)) ? 1 : 0; }
        unsigned bits = 0u;
#pragma unroll
        for (int k = 0; k < 8; ++k) { const int n = 8 * sub + k; if (n >= 1 && n <= tl - 2 && cnt[k] < 13) bits |= 1u << k; }
        unsigned lo = sub < 4 ? bits << (8 * sub) : 0u, hi = sub >= 4 ? bits << (8 * (sub - 4)) : 0u;
        lo |= swz_u<1>(lo); hi |= swz_u<1>(hi); lo |= swz_u<2>(lo); hi |= swz_u<2>(hi); lo |= swz_u<4>(lo); hi |= swz_u<4>(hi);
        const unsigned long long mk = ((unsigned long long)hi << 32 | lo) | 1ull | (3ull << (tl - 1));
        if (sub == 0) { masks[2 * tk] = (unsigned)mk; masks[2 * tk + 1] = (unsigned)(mk >> 32); }
    } else if (tid < 64) { const unsigned long long mk = (2ull << tl) - 1ull; masks[2 * tid] = (unsigned)mk; masks[2 * tid + 1] = (unsigned)(mk >> 32); }
    __syncthreads();
    if (tid < 64) { unsigned lo = masks[2 * tid], hi = masks[2 * tid + 1];
        lo |= swz_u<1>(lo); hi |= swz_u<1>(hi); lo |= swz_u<2>(lo); hi |= swz_u<2>(hi); lo |= swz_u<4>(lo); hi |= swz_u<4>(hi);
        lo |= swz_u<8>(lo); hi |= swz_u<8>(hi); lo |= swz_u<16>(lo); hi |= swz_u<16>(hi); lo = or32(lo); hi = or32(hi);
        if (tid == 0) { umask[0] = lo; umask[1] = hi; } }
    __syncthreads();
    const unsigned long long um = (unsigned long long)umask[1] << 32 | umask[0];
    const unsigned long long mymask = (unsigned long long)masks[2 * tokl + 1] << 32 | masks[2 * tokl];
    LAS float* park = slab + w * 2048 + lane;
#pragma unroll
    for (int i = 0; i < 16; ++i) { park[i * 64] = of0[i]; park[(16 + i) * 64] = of1[i]; }
    {
        float m = -INFINITY, l = 0.f;
#pragma unroll
        for (int i = 0; i < 16; ++i) { o0[i] = 0.f; o1[i] = 0.f; }
        const bf16_t* kp = A.kn + (size_t)(b * 2) * SEQ * 64; const bf16_t* vp = A.vtn + (size_t)(b * 2) * 64 * 4096;
#define NSA_NEXTBIT(c) ({ const unsigned long long rem_ = ((c) >= 63) ? 0ull : (um & ~((2ull << (c)) - 1ull)); rem_ ? (int)__builtin_ctzll(rem_) : -1; })
        KV_PIPELINE_PRE((int)__builtin_ctzll(um), NSA_NEXTBIT(cur), kp + (size_t)id * 4096, vp + (size_t)id * 4096,
            { const bool sel = (mymask >> id) & 1ull;
              if (__any(sel)) {
                  if (id < tl) attn_block_full(qf, o0, o1, m, l, ksb, vtb, r, hh, sel ? -slope * (float)(tq - 64 * id - 4 * hh) : -INFINITY, slope);
                  else { const SfSlc sf{tq, 64 * id, slope, sel}; attn_block<0>(qf, o0, o1, m, l, ksb, vtb, r, hh, sf, 0.f, 0.f, nullptr, 0, dummy); } } });
        const float sc = gl[1] / l;
#pragma unroll
        for (int i = 0; i < 16; ++i) { park[i * 64] += sc * o0[i]; park[(16 + i) * 64] += sc * o1[i]; }
    }
    {
        float m = -INFINITY, l = 0.f;
#pragma unroll
        for (int i = 0; i < 16; ++i) { o0[i] = 0.f; o1[i] = 0.f; }
        const bf16_t* kp = A.kn + (size_t)(b * 2 + 1) * SEQ * 64; const bf16_t* vp = A.vtn + (size_t)(b * 2 + 1) * 64 * 4096; const int nlo = tl >= 8 ? tl - 8 : 0;
        KV_PIPELINE_PRE(nlo, (cur + 1 <= tl ? cur + 1 : -1), kp + (size_t)id * 4096, vp + (size_t)id * 4096,
            { if (id < tl && id >= tl - 7) attn_block_full(qf, o0, o1, m, l, ksb, vtb, r, hh, -slope * (float)(tq - 64 * id - 4 * hh), slope);
              else { const SfWin sf{tq, 64 * id, slope}; attn_block<0>(qf, o0, o1, m, l, ksb, vtb, r, hh, sf, 0.f, 0.f, nullptr, 0, dummy); } });
        const float sc = gl[2] / l;
#pragma unroll
        for (int i = 0; i < 16; ++i) { of0[i] = park[i * 64] + sc * o0[i]; of1[i] = park[(16 + i) * 64] + sc * o1[i]; }
    }
    {
        float ss = 0.f;
#pragma unroll
        for (int i = 0; i < 16; ++i) ss += of0[i] * of0[i] + of1[i] * of1[i];
        ss = sum32(ss);
        const float rs = rsqrtf(ss * (1.f / 64.f) + EPS); const float* go = A.g_out + head * 64; bf16_t* dst = A.groups + token * DM + head * 64;
#pragma unroll
        for (int g = 0; g < 4; ++g) { const int d0 = 8 * g + 4 * hh;
            u32x2 wa; wa.x = cvtpk(of0[4 * g] * rs * go[d0], of0[4 * g + 1] * rs * go[d0 + 1]); wa.y = cvtpk(of0[4 * g + 2] * rs * go[d0 + 2], of0[4 * g + 3] * rs * go[d0 + 3]);
            *(u32x2*)(dst + d0) = wa;
            u32x2 wb; wb.x = cvtpk(of1[4 * g] * rs * go[32 + d0], of1[4 * g + 1] * rs * go[32 + d0 + 1]); wb.y = cvtpk(of1[4 * g + 2] * rs * go[32 + d0 + 2], of1[4 * g + 3] * rs * go[32 + d0 + 3]);
            *(u32x2*)(dst + 32 + d0) = wb; }
    }
    __syncthreads();
}

struct SfDil { int iq, key0; float sl; __device__ __forceinline__ float operator()(float s, int kl) const { const int df = iq - key0 - kl; return (df >= 0 && df <= 128) ? s - sl * (float)df : -INFINITY; } };
struct DilArgs { const bf16_t* proj; bf16_t* po; float* plse; const float *g_q, *g_k; };
__device__ __forceinline__ void dil_item(const DilArgs& A, int item, LAS unsigned char* lds, int tid) {
    asm volatile("" : "+v"(tid));
    const int cfg = item >> 9, rem = item & 511, b = rem >> 6, head = (rem >> 4) & 3, sub = rem & 15;
    const int dil = cfg == 0 ? 1 : (cfg == 1 ? 4 : 16), nq = 16 / dil, c = sub / nq, qt = sub % nq, i0 = 256 * qt, L = SEQ / dil;
    const int lane = tid & 63, w = __builtin_amdgcn_readfirstlane(tid >> 6), r = lane & 31, hh = lane >> 5;
    const int iq = i0 + 32 * w + r, tq = c + dil * iq; const size_t token = (size_t)b * SEQ + tq;
    const bf16_t* base = A.proj + (size_t)b * SEQ * NP;
    const float slope = exp2f(-(float)(2 * head + 2)) * (float)dil * LOG2E;
    bf16x8 qf[4]; load_qfrag<true>(qf, base + (size_t)tq * NP + C_QD + head * 64, A.g_q, nullptr, 0.125f * LOG2E, hh);
    const bf16_t* kp = base + (size_t)c * NP + C_KD + head * 64; const bf16_t* vp = base + (size_t)c * NP + C_VD + head * 64;
    const int kb_lo = (i0 >> 6) >= 2 ? (i0 >> 6) - 2 : 0, kb_hi = (i0 >> 6) + 3, q_lo = i0 + 32 * w;
    f32x16 o0, o1;
#pragma unroll
    for (int i = 0; i < 16; ++i) { o0[i] = 0.f; o1[i] = 0.f; }
    float m = -INFINITY, l = 0.f, dummy = 0.f;
    KV_PIPELINE(kb_lo, (cur + 1 <= kb_hi ? cur + 1 : -1), (KVSrc{kp, vp, (long)dil * NP, 64 * id, 0, L}), true, A.g_k,
        { if (64 * id + 63 >= q_lo - 128 && 64 * id <= q_lo + 31) { const SfDil sf{iq, 64 * id, slope}; attn_block<0>(qf, o0, o1, m, l, ksb, vtb, r, hh, sf, 0.f, 0.f, nullptr, 0, dummy); } });
    const float inv = 1.f / l;
    bf16_t* dst = A.po + ((size_t)cfg * M + token) * 256 + head * 64;
#pragma unroll
    for (int g = 0; g < 4; ++g) { const int d0 = 8 * g + 4 * hh;
        u32x2 wa; wa.x = cvtpk(o0[4 * g] * inv, o0[4 * g + 1] * inv); wa.y = cvtpk(o0[4 * g + 2] * inv, o0[4 * g + 3] * inv); *(u32x2*)(dst + d0) = wa;
        u32x2 wb; wb.x = cvtpk(o1[4 * g] * inv, o1[4 * g + 1] * inv); wb.y = cvtpk(o1[4 * g + 2] * inv, o1[4 * g + 3] * inv); *(u32x2*)(dst + 32 + d0) = wb; }
    if (hh == 0) A.plse[((size_t)cfg * M + token) * 4 + head] = m + __log2f(l);
    __syncthreads();
}
template <int NI> __device__ __forceinline__ void dil_merge_items(const bf16_t* po, const float* plse, bf16_t* groups, const float* g_out, int item0, int stride, int lane) {
    const int pair = lane >> 3, ch = lane & 7, head = pair & 3;
    u32x4 pv[NI][3]; float ls[NI][3];
#pragma unroll
    for (int n = 0; n < NI; ++n) { const size_t token = (size_t)(item0 + n * stride) * 2 + (pair >> 2);
#pragma unroll
        for (int i = 0; i < 3; ++i) { ls[n][i] = plse[((size_t)i * M + token) * 4 + head]; pv[n][i] = *(const u32x4*)(po + ((size_t)i * M + token) * 256 + head * 64 + 8 * ch); } }
    const float* go = g_out + 768 + head * 64 + 8 * ch;
#pragma unroll
    for (int n = 0; n < NI; ++n) { const size_t token = (size_t)(item0 + n * stride) * 2 + (pair >> 2);
        const float mx = fmaxf(ls[n][0], fmaxf(ls[n][1], ls[n][2]));
        const float w0 = EXP2(ls[n][0] - mx), w1 = EXP2(ls[n][1] - mx), w2 = EXP2(ls[n][2] - mx), winv = 1.f / (w0 + w1 + w2);
        float o[8];
#pragma unroll
        for (int j = 0; j < 8; ++j) o[j] = 0.f;
#pragma unroll
        for (int i = 0; i < 3; ++i) { UNPACK8(pv[n][i], k); const float wi = (i == 0 ? w0 : (i == 1 ? w1 : w2)) * winv;
            o[0] += wi * k0; o[1] += wi * k1; o[2] += wi * k2; o[3] += wi * k3; o[4] += wi * k4; o[5] += wi * k5; o[6] += wi * k6; o[7] += wi * k7; }
        float ss = 0.f;
#pragma unroll
        for (int j = 0; j < 8; ++j) ss += o[j] * o[j];
        ss += swz_f<1>(ss); ss += swz_f<2>(ss); ss += swz_f<4>(ss);
        const float rs = rsqrtf(ss * (1.f / 64.f) + EPS);
        u32x4 wv; wv.x = cvtpk(o[0] * rs * go[0], o[1] * rs * go[1]); wv.y = cvtpk(o[2] * rs * go[2], o[3] * rs * go[3]); wv.z = cvtpk(o[4] * rs * go[4], o[5] * rs * go[5]); wv.w = cvtpk(o[6] * rs * go[6], o[7] * rs * go[7]);
        *(u32x4*)(groups + token * DM + 768 + head * 64 + 8 * ch) = wv; }
}

__device__ __forceinline__ void stick_block(const bf16x8 (&qf)[4], f32x16& o0, f32x16& o1, float& carry, LAS const unsigned char* ksb, LAS const unsigned char* vtb, int r, int hh, int tq, int key0) {
    f32x16 s0, s1;
#pragma unroll
    for (int i = 0; i < 16; ++i) { s0[i] = 0.f; s1[i] = 0.f; }
    bf16x8 ka[4], kb2[4];
#pragma unroll
    for (int s = 0; s < 4; ++s) { ka[s] = *(LAS const bf16x8*)(ksb + r * KSB + (16 * s + 8 * hh) * 2); kb2[s] = *(LAS const bf16x8*)(ksb + (32 + r) * KSB + (16 * s + 8 * hh) * 2); }
    __builtin_amdgcn_s_setprio(1);
#pragma unroll
    for (int s = 0; s < 4; ++s) { s0 = MFMA32(ka[s], qf[s], s0); s1 = MFMA32(kb2[s], qf[s], s1); }
    __builtin_amdgcn_s_setprio(0);
    __builtin_amdgcn_sched_barrier(0);
    float acc = carry;
#pragma unroll
    for (int kti = 0; kti < 2; ++kti) { const int kt = 1 - kti; float spm[16], G[4], R[4];
#pragma unroll
        for (int i = 0; i < 16; ++i) { const float z = kt ? s1[i] : s0[i]; const bool act = key0 + 32 * kt + crow(i, hh) < tq;
            const float sp = fmaxf(z, 0.f) + __logf(1.f + __expf(-fabsf(z)));
            spm[i] = act ? sp : 0.f; const float lw = act ? z - sp : -INFINITY; if (kt) s1[i] = lw; else s0[i] = lw; }
#pragma unroll
        for (int g = 0; g < 4; ++g) { G[g] = (spm[4 * g] + spm[4 * g + 1]) + (spm[4 * g + 2] + spm[4 * g + 3]); R[g] = partner32(G[g], hh); }
#pragma unroll
        for (int gi = 0; gi < 4; ++gi) { const int g = 3 - gi; float run = acc + (hh ? 0.f : R[g]);
#pragma unroll
            for (int ki = 0; ki < 4; ++ki) { const int i = 4 * g + 3 - ki; const float lw = kt ? s1[i] : s0[i]; const float wv = __expf(lw - run); if (kt) s1[i] = wv; else s0[i] = wv; run += spm[i]; }
            acc += G[g] + R[g]; } }
    carry = acc;
    __builtin_amdgcn_sched_barrier(0);
    pv_accum(s0, s1, o0, o1, vtb, r, hh);
}
struct StickArgs { const bf16_t* proj; bf16_t* groups; const float* g_out; };
__device__ __forceinline__ void stick_item(const StickArgs& A, int item, LAS unsigned char* lds, int tid) {
    asm volatile("" : "+v"(tid));
    const int b = item >> 6, head = (item >> 4) & 3, qt = item & 15, T0 = 256 * qt;
    const int lane = tid & 63, w = __builtin_amdgcn_readfirstlane(tid >> 6), r = lane & 31, hh = lane >> 5, tq = T0 + 32 * w + r;
    const size_t token = (size_t)b * SEQ + tq;
    const bf16_t* base = A.proj + (size_t)b * SEQ * NP;
    bf16x8 qf[4]; load_qfrag<false>(qf, base + (size_t)tq * NP + C_QC + head * 64, nullptr, nullptr, 0.125f, hh);
    LAS unsigned* flags = (LAS unsigned*)(lds + NSA_SLAB);
    if (tid < 16) flags[tid] = 0u;
    f32x16 o0, o1;
#pragma unroll
    for (int i = 0; i < 16; ++i) { o0[i] = 0.f; o1[i] = 0.f; }
    float carry = 0.f; bool done = false;
    const bf16_t* kp = base + C_KC + head * 64; const bf16_t* vp = base + C_VC + head * 64;
#define STK_NEXT(c) ({ const LAS unsigned* f_ = flags + (par_ ^ 1) * 8; const unsigned ad_ = (f_[0] & f_[1]) & (f_[2] & f_[3]) & (f_[4] & f_[5]) & (f_[6] & f_[7]); ((c) > 0 && !ad_) ? (c) - 1 : -1; })
    KV_PIPELINE((T0 >> 6) + 3, STK_NEXT(cur), (KVSrc{kp, vp, NP, 64 * id, 0, SEQ}), false, nullptr,
        { if (!done && 64 * id <= T0 + 32 * w + 30) { stick_block(qf, o0, o1, carry, ksb, vtb, r, hh, tq, 64 * id); done = __all(carry > 104.f); }
          if (lane == 0) flags[par_ * 8 + w] = done ? 1u : 0u; });
    float ss = 0.f;
#pragma unroll
    for (int i = 0; i < 16; ++i) ss += o0[i] * o0[i] + o1[i] * o1[i];
    ss = sum32(ss);
    const float rs = rsqrtf(ss * (1.f / 64.f) + EPS); const float* go = A.g_out + 512 + head * 64; bf16_t* dst = A.groups + token * DM + 512 + head * 64;
#pragma unroll
    for (int g = 0; g < 4; ++g) { const int d0 = 8 * g + 4 * hh;
        u32x2 wa; wa.x = cvtpk(o0[4 * g] * rs * go[d0], o0[4 * g + 1] * rs * go[d0 + 1]); wa.y = cvtpk(o0[4 * g + 2] * rs * go[d0 + 2], o0[4 * g + 3] * rs * go[d0 + 3]); *(u32x2*)(dst + d0) = wa;
        u32x2 wb; wb.x = cvtpk(o1[4 * g] * rs * go[32 + d0], o1[4 * g + 1] * rs * go[32 + d0 + 1]); wb.y = cvtpk(o1[4 * g + 2] * rs * go[32 + d0 + 2], o1[4 * g + 3] * rs * go[32 + d0 + 3]); *(u32x2*)(dst + 32 + d0) = wb; }
    __syncthreads();
}

struct CmpArgs { const bf16_t* proj; const bf16_t* w1t; const bf16_t* w2t; const float* cb; const float* g_kc; bf16_t* kcn; bf16_t* vcc; };
constexpr int HIDB = 528;
__device__ __forceinline__ void compress_item(const CmpArgs& A, int item, LAS unsigned char* lds, int tid) {
    asm volatile("" : "+v"(tid));
    const int kv = item >> 6, rt = item & 63, b = rt >> 3, j0 = (rt & 7) * 32;
    const int lane = tid & 63, w = __builtin_amdgcn_readfirstlane(tid >> 6), r = lane & 31, hh = lane >> 5;
    { const bf16_t* xsrc = A.proj + (size_t)b * SEQ * NP + (kv ? C_VCA : C_KCA);
      u32x4 stg[9];
#pragma unroll
      for (int q = 0; q < 9; ++q) { const int e2 = tid + 512 * q, t = e2 >> 3, c = e2 & 7; int tk = 16 * j0 + t; tk = tk < SEQ ? tk : SEQ - 1;
          if (e2 < 528 * 8) stg[q] = *(const u32x4*)(xsrc + (size_t)tk * NP + 8 * c); }
#pragma unroll
      for (int q = 0; q < 9; ++q) { const int e2 = tid + 512 * q, t = e2 >> 3, c = e2 & 7;
          if (e2 < 528 * 8) *(LAS u32x4*)(lds + (t ^ ((t >> 7) & 1)) * 128 + ((c ^ ((t >> 4) & 7)) * 16)) = stg[q]; } }
    __syncthreads();
    const bf16_t* wf = A.w1t + (size_t)kv * 256 * 2048 + ((size_t)w * 128 * 64 + lane) * 8;
    f32x16 acc;
#pragma unroll
    for (int i = 0; i < 16; ++i) acc[i] = 0.f;
#pragma unroll 8
    for (int pos = 0; pos < 32; ++pos) { const int t = 16 * r + pos; LAS const unsigned char* arow = lds + (t ^ ((t >> 7) & 1)) * 128; const int sw = (t >> 4) & 7;
#pragma unroll
        for (int q = 0; q < 4; ++q) { const bf16x8 af = *(LAS const bf16x8*)(arow + (((2 * q + hh) ^ sw) * 16)), bfr = *(const bf16x8*)(wf + (size_t)(4 * pos + q) * 512); acc = MFMA32(af, bfr, acc); } }
    __syncthreads();
    { const float bias = A.cb[kv * 256 + 32 * w + r];
#pragma unroll
      for (int i = 0; i < 16; ++i) { const float x = acc[i] + bias; const float hv = 0.5f * x * (1.f + tanhf(0.7978845608028654f * (x + 0.044715f * x * x * x)));
          *(LAS unsigned short*)(lds + crow(i, hh) * HIDB + (32 * w + r) * 2) = (unsigned short)(cvtpk(hv, hv) & 0xffffu); } }
    __syncthreads();
    if (w == 0) {
        f32x16 c0, c1;
#pragma unroll
        for (int i = 0; i < 16; ++i) { c0[i] = 0.f; c1[i] = 0.f; }
        const bf16_t* w2a = A.w2t + ((size_t)kv * 64 + r) * 256 + 8 * hh; const bf16_t* w2b = w2a + 32 * 256;
#pragma unroll
        for (int s = 0; s < 16; ++s) { const bf16x8 af = *(LAS const bf16x8*)(lds + r * HIDB + (16 * s + 8 * hh) * 2);
            c0 = MFMA32(af, *(const bf16x8*)(w2a + 16 * s), c0); c1 = MFMA32(af, *(const bf16x8*)(w2b + 16 * s), c1); }
        const float g0 = A.g_kc[r], g1 = A.g_kc[32 + r]; bf16_t* dst = (kv ? A.vcc : A.kcn) + ((size_t)b * 256 + j0) * 64;
#pragma unroll
        for (int i = 0; i < 16; ++i) { float v0 = c0[i], v1 = c1[i];
            if (!kv) { float ss = v0 * v0 + v1 * v1; ss += swz_f<1>(ss); ss += swz_f<2>(ss); ss += swz_f<4>(ss); ss += swz_f<8>(ss); ss += swz_f<16>(ss);
                const float rs = rsqrtf(ss * (1.f / 64.f) + EPS); v0 *= rs * g0; v1 *= rs * g1; }
            const int row = crow(i, hh);
            if (!kv) { dst[row * 64 + r] = (bf16_t)(cvtpk(v0, v0) & 0xffffu); dst[row * 64 + 32 + r] = (bf16_t)(cvtpk(v1, v1) & 0xffffu); }
            else { const int j = j0 + row; bf16_t* vt = A.vcc + ((size_t)b * 4 + (j >> 6)) * 4096 + (j & 63);
                vt[(size_t)r * 64] = (bf16_t)(cvtpk(v0, v0) & 0xffffu); vt[(size_t)(32 + r) * 64] = (bf16_t)(cvtpk(v1, v1) & 0xffffu); } }
    }
    __syncthreads();
}
#define RLX_AGENT __ATOMIC_RELAXED, __HIP_MEMORY_SCOPE_AGENT
#define XB_TMO      128
#define XB_XCNT(j)  (256  + 64 * (j))
#define XB_XSUB(j)  (1280 + 64 * (j))
#define XB_XGEN(j)  (2304 + 64 * (j))
#define XB_TOP      3328
#define XB_TOPGEN   3392
#define XCD_BAR_WORDS 3456
#define XB_SPIN_CAP (1u << 18)

__device__ __forceinline__ unsigned xb_ld(unsigned* p)              { return __hip_atomic_load(p, __ATOMIC_RELAXED, __HIP_MEMORY_SCOPE_AGENT); }
__device__ __forceinline__ unsigned xb_add(unsigned* p, unsigned v) { return __hip_atomic_fetch_add(p, v, __ATOMIC_RELAXED, __HIP_MEMORY_SCOPE_AGENT); }
__device__ __forceinline__ unsigned xb_xcc_id() { return (unsigned)__builtin_amdgcn_s_getreg((3 << 11) | 20) & 0xFu; }
#define XB_SPIN(cond, bar) do { unsigned _sp = 0; while (cond) { __builtin_amdgcn_s_sleep(1); \
    if ((++_sp & 255u) == 0u) { if (xb_ld(&(bar)[XB_TMO])) break; if (_sp > XB_SPIN_CAP) { atomicAdd(&(bar)[XB_TMO], 1u); break; } } } } while (0)

struct XcdBarrier {
    unsigned* bar; unsigned x;
    volatile LAS unsigned* st;
};

__device__ __forceinline__ XcdBarrier xcd_barrier_post(unsigned* bar, volatile LAS unsigned* st) {
    XcdBarrier b; b.bar = bar; b.x = xb_xcc_id(); b.st = st;
    if (threadIdx.x == 0) (void)xb_add(&bar[XB_XCNT(b.x)], 1u);
    return b;
}
__device__ __forceinline__ void xcd_barrier_complete(unsigned* bar, unsigned x, unsigned& nloc, unsigned& nx) {
    const unsigned G = gridDim.x * gridDim.y * gridDim.z;
    unsigned sum, cnt, mine, sp = 0u;
    for (;;) {
        sum = 0u; cnt = 0u; mine = 0u;
#pragma unroll
        for (unsigned j = 0; j < 16; ++j) { const unsigned c = xb_ld(&bar[XB_XCNT(j)]); sum += c; cnt += (c > 0u) ? 1u : 0u; mine = (j == x) ? c : mine; }
        if (sum == G) break;
        __builtin_amdgcn_s_sleep(1);
        if ((++sp & 255u) == 0u) { if (xb_ld(&bar[XB_TMO])) break; if (sp > XB_SPIN_CAP) { atomicAdd(&bar[XB_TMO], 1u); break; } }
    }
    nloc = mine > 0u ? mine : 1u; nx = cnt > 0u ? cnt : 1u;
}

__device__ __forceinline__ void xcd_barrier(const XcdBarrier& b) {
    asm volatile("s_waitcnt vmcnt(0)" ::: "memory");
    __syncthreads();
    if (threadIdx.x == 0) {
        unsigned* bar = b.bar;
        __builtin_amdgcn_s_waitcnt(0);
        unsigned nloc = b.st[0], nx = b.st[1];
        if (nloc == 0u) { xcd_barrier_complete(bar, b.x, nloc, nx); b.st[0] = nloc; b.st[1] = nx; }
        const unsigned old = xb_add(&bar[XB_XSUB(b.x)], 1u);
        const unsigned gen = old / nloc;
        if (old + 1u == (gen + 1u) * nloc) {
            __builtin_amdgcn_fence(__ATOMIC_RELEASE, "agent");
            asm volatile("s_waitcnt vmcnt(0)" ::: "memory");
            const unsigned og = xb_add(&bar[XB_TOP], 1u);
            const unsigned tg = og / nx;
            if (og + 1u == (tg + 1u) * nx) xb_add(&bar[XB_TOPGEN], 1u);
            else XB_SPIN(xb_ld(&bar[XB_TOPGEN]) == tg, bar);
            __builtin_amdgcn_fence(__ATOMIC_ACQUIRE, "agent");
            xb_add(&bar[XB_XGEN(b.x)], 1u);
            asm volatile("s_waitcnt vmcnt(0)" ::: "memory");
        } else {
            XB_SPIN(xb_ld(&bar[XB_XGEN(b.x)]) == gen, bar);
            __builtin_amdgcn_fence(__ATOMIC_ACQUIRE, "agent");
            asm volatile("s_waitcnt vmcnt(0)" ::: "memory");
        }
    }
    __syncthreads();
}

#ifndef REP_CMP
#define REP_CMP 1
#endif
#ifndef REP_STK
#define REP_STK 1
#endif
#ifndef REP_DIL
#define REP_DIL 1
#endif
#ifndef REP_NSA
#define REP_NSA 1
#endif
#ifndef REP_G1
#define REP_G1 1
#endif
#ifndef REP_G3
#define REP_G3 1
#endif
#ifndef REP_PRO
#define REP_PRO 1
#endif
#ifndef REP_PREP
#define REP_PREP 1
#endif
#ifndef RESID_BF16
#define RESID_BF16 1
#endif
#ifndef REP_CONV
#define REP_CONV 1
#endif
#ifndef REP_G2
#define REP_G2 1
#endif
#ifndef XSYNC
#define XSYNC 0
#endif
__global__ void __launch_bounds__(512, 2) fwd_kernel(Params p) {
    extern __shared__ __attribute__((aligned(16))) unsigned char lds_raw[];
    cg::grid_group grid = cg::this_grid();
    LAS unsigned char* lds = (LAS unsigned char*)lds_raw;
#define TID_SETUP() int tid = threadIdx.x; asm volatile("" : "+v"(tid)); const int lane = tid & 63, wave = __builtin_amdgcn_readfirstlane(tid >> 6), gw = blockIdx.x * 8 + wave; (void)lane; (void)gw
    const int G = gridDim.x, NGW = G * 8;
    unsigned char* ws = p.ws;
    volatile LAS unsigned* misc = (volatile LAS unsigned*)(lds + LDS_BYTES - 64);
    unsigned* barw = (unsigned*)(ws + WS_BAR);
    { int t0 = threadIdx.x; if (t0 < 2) misc[t0] = 0u;
      if (blockIdx.x == 0) for (int i = t0; i < XCD_BAR_WORDS; i += 512) barw[i] = 0u;
      __syncthreads(); }
    float* ss = (float*)(ws + WS_SS); bf16_t* kcn = (bf16_t*)(ws + WS_KCN); bf16_t* vcc = (bf16_t*)(ws + WS_VCC);
    bf16_t* xb = (bf16_t*)(ws + WS_XB); bf16_t* groups = (bf16_t*)(ws + WS_GR); bf16_t* proj = (bf16_t*)(ws + WS_PROJ); bf16_t* hbuf = proj;
    float* x1 = (float*)(ws + WS_X1); bf16_t* nkn = (bf16_t*)(ws + WS_X1); bf16_t* nvt = (bf16_t*)(ws + WS_X1 + 8 * MiB);
    bf16_t* dpo = (bf16_t*)((unsigned char*)p.out + DO_PO); float* dlse = (float*)((unsigned char*)p.out + DO_LSE);

#ifndef SKIP_PRO
    for (int rep_ = 0; rep_ < REP_PRO; ++rep_) { TID_SETUP(); prologue(p, lds, gw, NGW, wave, lane); }
#endif
    grid.sync();
    const XcdBarrier xbar = xcd_barrier_post(barw, misc);
    for (int xs_ = 0; xs_ < XSYNC; ++xs_) xcd_barrier(xbar);

    for (int l = 0; l < 2; ++l) {
        unsigned char* wl = ws + WS_W + (size_t)l * W_LAYER;
#ifndef SKIP_G1
        for (int rep_ = 0; rep_ < REP_G1; ++rep_)
        { pg8::Gemm g{xb, (const bf16_t*)(wl + W_IN), M, NP, DM}; pg8::StaticOrder S; S.init(M, NP, G, (int)blockIdx.x);
          EpiProj E{proj, ss + (size_t)(2 * l) * M};
          pg8::gemm_phase<EpiProj, pg8::StaticOrder, true, true>(lds, g, S, E); }
#endif
        xcd_barrier(xbar);
        {
            TID_SETUP();
            const float* g_out = p.in[17] + l * DM;
            {
              const CmpArgs CA{proj, (const bf16_t*)(ws + WS_W1T) + (size_t)l * 2 * 256 * 2048, (const bf16_t*)(ws + WS_W2T) + (size_t)l * 2 * 64 * 256, (const float*)(ws + WS_CB) + l * 512, p.in[5] + l * 64, kcn, vcc};
              const StickArgs SA{proj, groups, g_out}; const DilArgs DA{proj, dpo, dlse, p.in[15] + l * 64, p.in[16] + l * 64};
              volatile LAS int* slot = (volatile LAS int*)(lds + LDS_BYTES - 32);
              for (;;) { __syncthreads(); if (tid == 0) *slot = (int)atomicAdd(barw + 32 + 64 * l, 1u); __syncthreads(); const int it = *slot; if (it >= 128 + 512 + 1536) break;
                  if (it < 128) compress_item(CA, it, lds, tid); else if (it < 640) stick_item(SA, it - 128, lds, tid); else dil_item(DA, it - 640, lds, tid); } }
            for (int it = gw; it < 1024; it += NGW) nsa_prep_item(proj, nkn, nvt, p.in[6] + l * 64, p.in[7] + l * 64, it, lds + wave * 9216, lane);
            if (G == 256) { for (int it = gw; it < M / 2; it += 4 * NGW) conv_items<4>(proj, groups, p.in[14] + l * 768, g_out, it, NGW, lane); }
            else for (int it = gw; it < M / 2; it += NGW) conv_items<1>(proj, groups, p.in[14] + l * 768, g_out, it, 0, lane);
        }
        xcd_barrier(xbar);
#ifndef SKIP_NSA
#ifndef SKIP_DIL
#endif
        for (int rep_ = 0; rep_ < REP_NSA; ++rep_)
        { TID_SETUP(); NsaArgs A{proj, groups, kcn, vcc, p.in[3] + l * 12, p.in[4] + l * 64, p.in[6] + l * 64, p.in[7] + l * 64, p.in[17] + l * DM, nkn, nvt};
          volatile LAS int* slot = (volatile LAS int*)(lds + LDS_BYTES - 32);
          for (;;) { __syncthreads(); if (tid == 0) *slot = (int)atomicAdd(barw + 64 * l, 1u); __syncthreads(); const int it = *slot; if (it >= 512 + 256) break;
              if (it < 512) nsa_item(A, it & 7, 63 - (it >> 3), lds, tid);
              else { const int i0 = (it - 512) * 64 + wave; dil_merge_items<4>(dpo, dlse, groups, p.in[17] + l * DM, i0, 8, lane); dil_merge_items<4>(dpo, dlse, groups, p.in[17] + l * DM, i0 + 32, 8, lane); } } }
#endif
        xcd_barrier(xbar);
#ifndef SKIP_G2
        { pg8::Gemm g{groups, (const bf16_t*)(wl + W_OUT), M, DM, DM}; pg8::StaticOrder S; S.init(M, DM, G, (int)blockIdx.x);
#if RESID_BF16
          EpiResid E{l == 0 ? p.in[0] : nullptr, xb, nullptr, xb, ss + (size_t)(2 * l + 1) * M};
#else
          EpiResid E{l == 0 ? p.in[0] : x1, nullptr, l == 0 ? x1 : p.out, xb, ss + (size_t)(2 * l + 1) * M};
#endif
          pg8::gemm_phase<EpiResid, pg8::StaticOrder, true, true>(lds, g, S, E);
          for (int rep_ = 1; rep_ < REP_G2; ++rep_) { E.ss = nullptr; pg8::gemm_phase<EpiResid, pg8::StaticOrder, true, true>(lds, g, S, E); } }
#endif
        xcd_barrier(xbar);
#ifndef SKIP_G3
        for (int rep_ = 0; rep_ < REP_G3; ++rep_)
        { pg8::Gemm g{xb, (const bf16_t*)(wl + W_GU), M, NGU, DM}; pg8::StaticOrder S; S.init(M, NGU, G, (int)blockIdx.x);
          EpiSwiGLU E{hbuf, ss + (size_t)(2 * l + 1) * M};
          pg8::gemm_phase<EpiSwiGLU, pg8::StaticOrder, true, true>(lds, g, S, E); }
#endif
        xcd_barrier(xbar);
#ifndef SKIP_G4
        { pg8::Gemm g{hbuf, (const bf16_t*)(wl + W_DN), M, DM, FF}; pg8::StaticOrder S; S.init(M, DM, G, (int)blockIdx.x);
          float* xio = l == 0 ? x1 : p.out;
#if RESID_BF16
          EpiResid E{nullptr, xb, l == 0 ? nullptr : p.out, l == 0 ? xb : nullptr, l == 0 ? ss + (size_t)2 * M : nullptr}; (void)xio;
#else
          EpiResid E{xio, nullptr, xio, l == 0 ? xb : nullptr, l == 0 ? ss + (size_t)2 * M : nullptr};
#endif
          pg8::gemm_phase<EpiResid, pg8::StaticOrder, true, true>(lds, g, S, E); }
#endif
        if (l == 0) xcd_barrier(xbar);
    }
}

extern "C" void kernel_launch(void* const* d_in, const int* in_sizes, int n_in, void* d_out, int out_size, void* d_ws, size_t ws_size, hipStream_t stream) {
    static int grid = 0;
    if (grid == 0) {
        if (n_in != 23 || out_size != M * DM || ws_size < WS_END) { fprintf(stderr, "kernel_launch: unexpected shapes (n_in %d, out %d, ws %zu)\n", n_in, out_size, ws_size); grid = -1; return; }
        int dev = 0, cus = 0, per_cu = 0;
        (void)hipGetDevice(&dev); (void)hipDeviceGetAttribute(&cus, hipDeviceAttributeMultiprocessorCount, dev);
        if (hipFuncSetAttribute((const void*)fwd_kernel, hipFuncAttributeMaxDynamicSharedMemorySize, LDS_BYTES) != hipSuccess) { fprintf(stderr, "kernel_launch: hipFuncSetAttribute failed\n"); grid = -1; return; }
        if (hipOccupancyMaxActiveBlocksPerMultiprocessor(&per_cu, (const void*)fwd_kernel, 512, LDS_BYTES) != hipSuccess || per_cu < 1) per_cu = 1;
        (void)hipGetLastError();
        grid = cus * 1;
        (void)per_cu;
    }
    if (grid < 0) return;
    Params p{};
    for (int i = 0; i < 23; ++i) p.in[i] = (const float*)d_in[i];
    p.out = (float*)d_out; p.ws = (unsigned char*)d_ws;
    void* args[] = {&p};
    hipError_t e = hipLaunchCooperativeKernel((const void*)fwd_kernel, dim3(grid), dim3(512), args, LDS_BYTES, stream);
    if (e != hipSuccess) fprintf(stderr, "cooperative launch failed: %s (grid %d)\n", hipGetErrorString(e), grid);
}
```

```cpp
#include <hip/hip_runtime.h>
#include <hip/hip_cooperative_groups.h>
#include <cstdio>
#include <cstdint>
namespace cg = cooperative_groups;
namespace pg8 {
#define PG8_LAS __attribute__((address_space(3)))
typedef unsigned short bf16_t;
typedef short bf16x8 __attribute__((ext_vector_type(8)));
typedef float f32x4 __attribute__((ext_vector_type(4)));
typedef unsigned u32x4 __attribute__((ext_vector_type(4)));
constexpr int BM = 256, BK = 64, HALF = 128, HTB = HALF * BK * 2  , STAGE_BYTES = 8 * HTB, NXCD = 8, WGM = 8;

__host__ __device__ __forceinline__ int lds_byte(int r, int c) { const int st = (r >> 4) * 2 + (c >> 5), rr = r & 15, cc = c & 31, ob = rr * 64 + cc * 2; return st * 1024 + (ob ^ (((ob >> 9) & 1) << 5)); }
__host__ __device__ __forceinline__ void stage_rc(int b, int& R, int& C) { const int st = b / 1024, sb = b % 1024, swz = sb ^ (((sb >> 9) & 1) << 5); R = (st >> 1) * 16 + swz / 64; C = (st & 1) * 32 + (swz % 64) / 2; }
__host__ __device__ __forceinline__ int perm32(int rho) { const int n = rho >> 4, i = rho & 15; return 8 * (i >> 2) + 4 * n + (i & 3); }

struct Unit { int pm, pn; };
struct Gemm { const bf16_t* A; const bf16_t* Bt; int M, N, K; };

struct StaticOrder {
    int nM, nN, nwg, G, c;
    __host__ __device__ void init(int M, int N, int G_, int c_) { nM = M / BM; nN = N / BM; nwg = nM * nN; G = G_; c = c_; }
    __host__ __device__ bool next(int i, Unit& u) const {
        const long L = (long)i * G + c; if (L >= nwg) return false;
        int wgid = (int)L; { const int q = nwg / NXCD, r = nwg % NXCD, xcd = wgid % NXCD, off = wgid / NXCD; wgid = (xcd < r ? xcd * (q + 1) : r * (q + 1) + (xcd - r) * q) + off; }
        const int nig = WGM * nN, gid = wgid / nig, fm = gid * WGM, gsz = (nM - fm) < WGM ? (nM - fm) : WGM;
        u.pm = fm + ((wgid % nig) % gsz); u.pn = (wgid % nig) / gsz; return true;
    }
    __device__ __forceinline__ void a_ready(const Unit&) const {}
    __device__ __forceinline__ void done(const Unit&) const {}
};

__device__ __forceinline__ unsigned cvt_pk_bf16(float lo, float hi) { unsigned r; asm volatile("v_cvt_pk_bf16_f32 %0, %1, %2" : "=v"(r) : "v"(lo), "v"(hi)); return r; }
template <class Epi, class Sched, bool ALIGN_EPI = false, bool SP2 = false>
__device__ __forceinline__ void gemm_phase(PG8_LAS unsigned char* lds, const Gemm g, const Sched& S, const Epi& E) {
    int tid_l = threadIdx.x; asm volatile("" : "+v"(tid_l));
    const int tid = tid_l, wid = __builtin_amdgcn_readfirstlane(tid >> 6), lane = tid & 63, wr = wid >> 2, wc = wid & 3, fr = lane & 15, fq = lane >> 4;
    const int K = g.K, nt = K / BK;
    unsigned voffA[2], voffB[2];
#pragma unroll
    for (int i = 0; i < 2; ++i) { int R, C; stage_rc(tid * 16 + i * 8192, R, C); const int Rb = Epi::PERM ? ((R & ~31) + perm32(R & 31)) : R;
        voffA[i] = (unsigned)(R * K + C) * 2u; voffB[i] = (unsigned)(Rb * K + C) * 2u; }
    const size_t kstep = (size_t)(BK * 2);
    const size_t hstep = (size_t)HALF * K * 2;
    const size_t tstep = 2 * hstep;
    const unsigned ldsw = (unsigned)wid * 1024u;
    const int aoff = lds_byte(wr * 64 + fr, fq * 8), boff = lds_byte(wc * 32 + fr, fq * 8);
#define PG8_SA(b, h) (((b) * 2 + (h)) * HTB)
#define PG8_SB(b, h) ((4 + (b) * 2 + (h)) * HTB)
#define PG8_STAGE(bufoff, gbase, voff) do { _Pragma("unroll") for (int _i = 0; _i < 2; ++_i) \
        __builtin_amdgcn_global_load_lds((const unsigned*)((const char*)(gbase) + (voff)[_i]), (PG8_LAS unsigned*)(lds + (bufoff) + ldsw + _i * 8192), 16, 0, 0); } while (0)
#define PG8_LDA(dst, b, h) do { _Pragma("unroll") for (int m = 0; m < 4; ++m) _Pragma("unroll") for (int k = 0; k < 2; ++k) dst[m][k] = *(const PG8_LAS bf16x8*)(lds + PG8_SA(b, h) + aoff + m * 2048 + k * 1024); } while (0)
#define PG8_LDB(dst, b, h) do { _Pragma("unroll") for (int n = 0; n < 2; ++n) _Pragma("unroll") for (int k = 0; k < 2; ++k) dst[n][k] = *(const PG8_LAS bf16x8*)(lds + PG8_SB(b, h) + boff + n * 2048 + k * 1024); } while (0)
#define PG8_MMA(ai, bj, At, Bt) do { __builtin_amdgcn_s_setprio(1); _Pragma("unroll") for (int m = 0; m < 4; ++m) _Pragma("unroll") for (int n = 0; n < 2; ++n) _Pragma("unroll") for (int k = 0; k < 2; ++k) \
        acc[ai][bj][m][n] = __builtin_amdgcn_mfma_f32_16x16x32_bf16(Bt[n][k], At[m][k], acc[ai][bj][m][n], 0, 0, 0); __builtin_amdgcn_s_setprio(0); } while (0)
#define PG8_WAIT_V(n) asm volatile("s_waitcnt vmcnt(" #n ")" ::: "memory")
#define PG8_WAIT_L(n) asm volatile("s_waitcnt lgkmcnt(" #n ")" ::: "memory")
#define PG8_BAR __builtin_amdgcn_s_barrier()
#define PG8_SCHED __builtin_amdgcn_sched_barrier(0)
    Unit cur, nxt; int ui = 0;
    if (!S.next(0, cur)) return;
    f32x4 acc[2][2][4][2];
#pragma unroll
    for (int a = 0; a < 2; ++a)
#pragma unroll
        for (int b = 0; b < 2; ++b)
#pragma unroll
            for (int m = 0; m < 4; ++m)
#pragma unroll
                for (int n = 0; n < 2; ++n) acc[a][b][m][n] = (f32x4){0.f, 0.f, 0.f, 0.f};
    bf16x8 At[4][2], B0[2][2], B1[2][2];
    const char* cA = (const char*)g.A + (size_t)cur.pm * tstep; const char* cB = (const char*)g.Bt + (size_t)cur.pn * tstep;
    S.a_ready(cur);
    if constexpr (SP2) {
        PG8_STAGE(PG8_SB(0, 0), cB, voffB); PG8_STAGE(PG8_SB(0, 1), cB + hstep, voffB); PG8_STAGE(PG8_SA(0, 0), cA, voffA); PG8_STAGE(PG8_SA(0, 1), cA + hstep, voffA);
        if (wr == 1) PG8_BAR;
        PG8_WAIT_V(2); PG8_BAR;
        PG8_STAGE(PG8_SB(1, 0), cB + kstep, voffB); PG8_STAGE(PG8_SA(1, 0), cA + kstep, voffA); PG8_STAGE(PG8_SB(1, 1), cB + hstep + kstep, voffB);
        PG8_WAIT_V(6); PG8_BAR;
    } else {
        PG8_STAGE(PG8_SB(0, 0), cB, voffB); PG8_STAGE(PG8_SA(0, 0), cA, voffA); PG8_STAGE(PG8_SB(0, 1), cB + hstep, voffB); PG8_STAGE(PG8_SA(0, 1), cA + hstep, voffA);
        if (wr == 1) PG8_BAR;
        PG8_WAIT_V(4); PG8_BAR;
        PG8_STAGE(PG8_SB(1, 0), cB + kstep, voffB); PG8_STAGE(PG8_SA(1, 0), cA + kstep, voffA); PG8_STAGE(PG8_SB(1, 1), cB + hstep + kstep, voffB);
        PG8_WAIT_V(6); PG8_BAR;
    }
    for (;;) {
        const bool has_next = S.next(ui + 1, nxt);
        const char* nA = has_next ? (const char*)g.A + (size_t)nxt.pm * tstep : cA; const char* nB = has_next ? (const char*)g.Bt + (size_t)nxt.pn * tstep : cB;
        for (int t = 0; t < nt; t += 2) {
            const bool last = (t == nt - 2);
            const char* a1 = cA + (size_t)(t + 1) * kstep;
            const char* a2 = last ? nA : cA + (size_t)(t + 2) * kstep; const char* b2 = last ? nB : cB + (size_t)(t + 2) * kstep;
            const char* a3 = a2 + kstep; const char* b3 = b2 + kstep;
            if (last && has_next) S.a_ready(nxt);
            if constexpr (SP2) {
            PG8_LDB(B0, 0, 0); PG8_LDB(B1, 0, 1); PG8_SCHED; PG8_LDA(At, 0, 0); PG8_STAGE(PG8_SA(1, 1), a1 + hstep, voffA);
            PG8_WAIT_V(8); PG8_WAIT_L(0); PG8_BAR; PG8_MMA(0, 0, At, B0); PG8_MMA(0, 1, At, B1); PG8_BAR; PG8_SCHED;
            PG8_LDA(At, 0, 1); PG8_STAGE(PG8_SB(0, 0), b2, voffB); PG8_STAGE(PG8_SB(0, 1), b2 + hstep, voffB); PG8_STAGE(PG8_SA(0, 0), a2, voffA);
            PG8_WAIT_V(8); PG8_WAIT_L(0); PG8_BAR; PG8_MMA(1, 0, At, B0); PG8_MMA(1, 1, At, B1); PG8_BAR; PG8_SCHED;
            PG8_LDB(B0, 1, 0); PG8_LDB(B1, 1, 1); PG8_SCHED; PG8_LDA(At, 1, 0); PG8_STAGE(PG8_SA(0, 1), a2 + hstep, voffA);
            PG8_WAIT_V(8); PG8_WAIT_L(0); PG8_BAR; PG8_MMA(0, 0, At, B0); PG8_MMA(0, 1, At, B1); PG8_BAR; PG8_SCHED;
            PG8_LDA(At, 1, 1); PG8_STAGE(PG8_SB(1, 0), b3, voffB); PG8_STAGE(PG8_SB(1, 1), b3 + hstep, voffB); PG8_STAGE(PG8_SA(1, 0), a3, voffA);
            PG8_WAIT_V(8); PG8_WAIT_L(0); PG8_BAR; PG8_MMA(1, 0, At, B0); PG8_MMA(1, 1, At, B1); PG8_BAR; PG8_SCHED;
            } else {
            PG8_LDB(B0, 0, 0); PG8_SCHED; PG8_LDA(At, 0, 0); PG8_STAGE(PG8_SA(1, 1), a1 + hstep, voffA);
            PG8_WAIT_L(8); PG8_BAR; PG8_WAIT_L(0); PG8_MMA(0, 0, At, B0); PG8_BAR; PG8_SCHED;
            PG8_LDB(B1, 0, 1); PG8_STAGE(PG8_SB(0, 0), b2, voffB);
            PG8_BAR; PG8_WAIT_L(0); PG8_MMA(0, 1, At, B1); PG8_BAR;
            PG8_LDA(At, 0, 1); PG8_STAGE(PG8_SA(0, 0), a2, voffA);
            PG8_BAR; PG8_WAIT_L(0); PG8_MMA(1, 0, At, B0); PG8_BAR; PG8_SCHED;
            PG8_STAGE(PG8_SB(0, 1), b2 + hstep, voffB);
            PG8_WAIT_V(6); PG8_BAR; PG8_MMA(1, 1, At, B1); PG8_BAR;
            PG8_LDB(B0, 1, 0); PG8_SCHED; PG8_LDA(At, 1, 0); PG8_STAGE(PG8_SA(0, 1), a2 + hstep, voffA);
            PG8_WAIT_L(8); PG8_BAR; PG8_WAIT_L(0); PG8_MMA(0, 0, At, B0); PG8_BAR; PG8_SCHED;
            PG8_LDB(B1, 1, 1); PG8_STAGE(PG8_SB(1, 0), b3, voffB);
            PG8_BAR; PG8_WAIT_L(0); PG8_MMA(0, 1, At, B1); PG8_BAR;
            PG8_LDA(At, 1, 1); PG8_STAGE(PG8_SA(1, 0), a3, voffA);
            PG8_BAR; PG8_WAIT_L(0); PG8_MMA(1, 0, At, B0); PG8_BAR; PG8_SCHED;
            PG8_STAGE(PG8_SB(1, 1), b3 + hstep, voffB);
            PG8_WAIT_V(6); PG8_BAR; PG8_MMA(1, 1, At, B1); PG8_BAR;
            }
        }
        if constexpr (ALIGN_EPI) { if (wr == 0) PG8_BAR; }
        if constexpr (!Epi::AFTER_DRAIN) { E(acc, cur, wr, wc, fr, fq); S.done(cur); }
        if (!has_next) break;
#pragma unroll
        for (int a = 0; a < 2; ++a)
#pragma unroll
            for (int b = 0; b < 2; ++b)
#pragma unroll
                for (int m = 0; m < 4; ++m)
#pragma unroll
                    for (int n = 0; n < 2; ++n) acc[a][b][m][n] = (f32x4){0.f, 0.f, 0.f, 0.f};
        cur = nxt; cA = nA; cB = nB; ++ui;
        if constexpr (ALIGN_EPI) { if (wr == 1) PG8_BAR; }
    }
    PG8_WAIT_V(0);
    if constexpr (!ALIGN_EPI) { if (wr == 0) PG8_BAR; }
    PG8_BAR;
    if constexpr (Epi::AFTER_DRAIN) { E.fused(acc, cur, wr, wc, fr, fq, lds, wid, lane); S.done(cur); }
#undef PG8_SA
#undef PG8_SB
#undef PG8_STAGE
#undef PG8_LDA
#undef PG8_LDB
#undef PG8_MMA
#undef PG8_WAIT_V
#undef PG8_WAIT_L
#undef PG8_BAR
#undef PG8_SCHED
}
}

typedef unsigned short bf16_t;
typedef unsigned u32x4 __attribute__((ext_vector_type(4)));
typedef unsigned u32x2 __attribute__((ext_vector_type(2)));
typedef float f32x4 __attribute__((ext_vector_type(4)));
#define LAS __attribute__((address_space(3)))

constexpr int NB = 8, SEQ = 4096, M = NB * SEQ, DM = 1024, NP = 3072, FF = 2816, NGU = 2 * FF, INC = 2956;
constexpr int C_QA = 0, C_KCA = 256, C_VCA = 320, C_KSA = 384, C_VSA = 448, C_KWA = 512, C_VWA = 576, C_CVB = 640, C_CVC = 896, C_CVU = 1152,
              C_QC = 1408, C_KC = 1664, C_VC = 1920, C_QD = 2176, C_KD = 2432, C_VD = 2688, C_GT = 2944;
constexpr float EPS = 1e-6f;
constexpr size_t MiB = 1u << 20;
constexpr size_t WS_SS = 0, WS_KCN = 1 * MiB, WS_VCC = 1 * MiB + 512 * 1024, WS_W = 2 * MiB;
constexpr size_t W_IN = 0, W_OUT = 6 * MiB, W_GU = 8 * MiB, W_DN = 19 * MiB, W_LAYER = 24 * MiB + 512 * 1024;
constexpr size_t WS_XB = 52 * MiB, WS_GR = 116 * MiB, WS_PROJ = 180 * MiB, WS_X1 = 372 * MiB, WS_W1T = 500 * MiB, WS_W2T = 504 * MiB, WS_CB = 504 * MiB + 256 * 1024, WS_BAR = 504 * MiB + 512 * 1024, WS_END = 505 * MiB;
constexpr size_t DO_PO = 0, DO_LSE = 48 * MiB;
constexpr int LDS_BYTES = 143360;

struct Params { const float* in[23]; float* out; unsigned char* ws; };

__device__ __forceinline__ float blo(unsigned u) { return __uint_as_float(u << 16); }
__device__ __forceinline__ float bhi(unsigned u) { return __uint_as_float(u & 0xffff0000u); }
__device__ __forceinline__ float bf2f(bf16_t h) { return __uint_as_float((unsigned)h << 16); }
__device__ __forceinline__ unsigned pk2(float lo, float hi) { return pg8::cvt_pk_bf16(lo, hi); }
template <int K> __device__ __forceinline__ unsigned swz_u(unsigned v) { return (unsigned)__builtin_amdgcn_ds_swizzle((int)v, (K << 10) | 0x1f); }
template <int K> __device__ __forceinline__ float swz_f(float v) { return __uint_as_float(swz_u<K>(__float_as_uint(v))); }
__device__ __forceinline__ float sum32(float v) { auto rr = __builtin_amdgcn_permlane32_swap(__float_as_uint(v), __float_as_uint(v), false, false); return __uint_as_float(rr[0]) + __uint_as_float(rr[1]); }
__device__ __forceinline__ float max32(float v) { auto rr = __builtin_amdgcn_permlane32_swap(__float_as_uint(v), __float_as_uint(v), false, false); return fmaxf(__uint_as_float(rr[0]), __uint_as_float(rr[1])); }
__device__ __forceinline__ unsigned or32(unsigned v) { auto rr = __builtin_amdgcn_permlane32_swap(v, v, false, false); return rr[0] | rr[1]; }
__device__ __forceinline__ float partner32(float v, int hh) { auto rr = __builtin_amdgcn_permlane32_swap(__float_as_uint(v), __float_as_uint(v), false, false); return __uint_as_float(hh ? rr[0] : rr[1]); }
__device__ __forceinline__ float wave_sum(float v) {
    v += swz_f<1>(v); v += swz_f<2>(v); v += swz_f<4>(v); v += swz_f<8>(v); v += swz_f<16>(v); return sum32(v);
}
#define LDS_WAIT() asm volatile("s_waitcnt lgkmcnt(0)" ::: "memory")
#define CFENCE() asm volatile("" ::: "memory")

struct EpiProj {
    static constexpr bool PERM = true, AFTER_DRAIN = false;
    bf16_t* O; const float* ss;
    __device__ __forceinline__ void operator()(const pg8::f32x4 (&acc)[2][2][4][2], const pg8::Unit& u, int wr, int wc, int fr, int fq) const {
        const int row0 = u.pm * 256 + wr * 64 + fr, col0 = u.pn * 256 + wc * 32 + 8 * fq;
#pragma unroll
        for (int ai = 0; ai < 2; ++ai)
#pragma unroll
            for (int m = 0; m < 4; ++m) {
                const int row = row0 + ai * 128 + m * 16; const float rs = rsqrtf(ss[row] * (1.f / DM) + EPS);
                bf16_t* rowp = O + (size_t)row * NP + col0;
#pragma unroll
                for (int bj = 0; bj < 2; ++bj) { const pg8::f32x4 v0 = acc[ai][bj][m][0] * rs, v1 = acc[ai][bj][m][1] * rs;
                    u32x4 w; w.x = pk2(v0[0], v0[1]); w.y = pk2(v0[2], v0[3]); w.z = pk2(v1[0], v1[1]); w.w = pk2(v1[2], v1[3]);
                    *(u32x4*)(rowp + bj * 128) = w; }
            }
    }
};
struct EpiSwiGLU {
    static constexpr bool PERM = true, AFTER_DRAIN = false;
    bf16_t* H; const float* ss;
    __device__ __forceinline__ void operator()(const pg8::f32x4 (&acc)[2][2][4][2], const pg8::Unit& u, int wr, int wc, int fr, int fq) const {
        const int row0 = u.pm * 256 + wr * 64 + fr, col0 = u.pn * 128 + wc * 32 + 8 * fq;
#pragma unroll
        for (int ai = 0; ai < 2; ++ai)
#pragma unroll
            for (int m = 0; m < 4; ++m) {
                const int row = row0 + ai * 128 + m * 16; const float rs = rsqrtf(ss[row] * (1.f / DM) + EPS);
                float hv[8];
#pragma unroll
                for (int n = 0; n < 2; ++n)
#pragma unroll
                    for (int j = 0; j < 4; ++j) { const float g = acc[ai][0][m][n][j] * rs, up = acc[ai][1][m][n][j] * rs;
                        hv[4 * n + j] = g * up / (1.f + __expf(-g)); }
                u32x4 w; w.x = pk2(hv[0], hv[1]); w.y = pk2(hv[2], hv[3]); w.z = pk2(hv[4], hv[5]); w.w = pk2(hv[6], hv[7]);
                *(u32x4*)(H + (size_t)row * FF + col0) = w;
            }
    }
};
struct EpiResid {
    static constexpr bool PERM = false, AFTER_DRAIN = false;
    const float* xin; const bf16_t* xin_b; float* xout; bf16_t* xb; float* ss;
    __device__ __forceinline__ void operator()(const pg8::f32x4 (&acc)[2][2][4][2], const pg8::Unit& u, int wr, int wc, int fr, int fq) const {
        const int row0 = u.pm * 256 + wr * 64 + fr, col0 = u.pn * 256 + wc * 32 + 4 * fq;
#pragma unroll
        for (int ai = 0; ai < 2; ++ai)
#pragma unroll
            for (int m = 0; m < 4; ++m) {
                const int row = row0 + ai * 128 + m * 16; const size_t off = (size_t)row * DM + col0; float sq = 0.f;
#pragma unroll
                for (int bj = 0; bj < 2; ++bj)
#pragma unroll
                    for (int n = 0; n < 2; ++n) { const size_t o = off + bj * 128 + n * 16; f32x4 xi;
                        if (xin) xi = *(const f32x4*)(xin + o);
                        else { const u32x2 r2 = *(const u32x2*)(xin_b + o); xi[0] = blo(r2.x); xi[1] = bhi(r2.x); xi[2] = blo(r2.y); xi[3] = bhi(r2.y); }
                        f32x4 v;
                        v[0] = xi[0] + acc[ai][bj][m][n][0]; v[1] = xi[1] + acc[ai][bj][m][n][1]; v[2] = xi[2] + acc[ai][bj][m][n][2]; v[3] = xi[3] + acc[ai][bj][m][n][3];
                        if (xout) *(f32x4*)(xout + o) = v;
                        if (xb) { u32x2 w; w.x = pk2(v[0], v[1]); w.y = pk2(v[2], v[3]); *(u32x2*)(xb + o) = w; }
                        sq += (v[0] * v[0] + v[1] * v[1]) + (v[2] * v[2] + v[3] * v[3]); }
                if (ss) { sq += swz_f<16>(sq); sq = sum32(sq); if (fq == 0) atomicAdd(ss + row, sq); }
            }
    }
};

#ifndef REP_PW
#define REP_PW 1
#endif
#ifndef REP_PC
#define REP_PC 1
#endif
#ifndef REP_PX
#define REP_PX 1
#endif
template <int MAP> __device__ __forceinline__ int dst_row(int c) {
    if (MAP == 0) return c < 640 ? c : (c < 652 ? 2944 + (c - 640) : c - 12);
    if (MAP == 1) return c;
    if (MAP == 2) return 256 * (c >> 7) + (c & 127);
    return 256 * (c >> 7) + 128 + (c & 127);
}
template <int MAP> __device__ __forceinline__ void transpose_item(const float* W, int K, int N, const float* gk, bf16_t* WT, LAS float* scr, int item, int lane) {
    const int nblk = (N + 63) / 64, kb = item / nblk, nb = item % nblk, k0 = 64 * kb, n0 = 64 * nb;
    const int nn = n0 + lane; const bool okn = nn < N;
#pragma unroll
    for (int i = 0; i < 64; ++i) { float v = okn ? W[(size_t)(k0 + i) * N + nn] : 0.f; if (gk) v *= gk[k0 + i]; scr[i * 65 + lane] = v; }
    LDS_WAIT();
    const int c = lane & 7;
#pragma unroll
    for (int j = 0; j < 8; ++j) { const int n = (lane >> 3) + 8 * j; const LAS float* s = scr + (8 * c) * 65 + n;
        if (n0 + n < N) { u32x4 o; o.x = pk2(s[0 * 65], s[1 * 65]); o.y = pk2(s[2 * 65], s[3 * 65]); o.z = pk2(s[4 * 65], s[5 * 65]); o.w = pk2(s[6 * 65], s[7 * 65]);
            if (MAP == 4) { const int nn2 = n0 + n, kk2 = k0 + 8 * c; *(u32x4*)(WT + ((size_t)(((nn2 >> 5) * (K >> 4) + (kk2 >> 4)) * 64 + ((kk2 >> 3) & 1) * 32 + (nn2 & 31)) * 8)) = o; }
            else *(u32x4*)(WT + (size_t)dst_row<MAP>(n0 + n) * K + k0 + 8 * c) = o; } }
    LDS_WAIT();
}
__device__ __forceinline__ void prologue(const Params& p, LAS unsigned char* lds, int gw, int NGW, int wave, int lane) {
    LAS float* scr = (LAS float*)(lds + wave * 16640);
    constexpr int I_IN = 16 * 47, I_OUT = 16 * 16, I_G = 16 * 44, I_DN = 44 * 16, I_L = I_IN + I_OUT + 2 * I_G + I_DN, I_Z = 116;
    for (int rw_ = 0; rw_ < REP_PW; ++rw_)
    for (int it = gw; it < 2 * (I_L + I_Z); it += NGW) {
        const int l = it / (I_L + I_Z); int r = it % (I_L + I_Z);
        unsigned char* wl = p.ws + WS_W + (size_t)l * W_LAYER;
        if (r < I_IN) { transpose_item<0>(p.in[2] + (size_t)l * DM * INC, DM, INC, p.in[1] + l * DM, (bf16_t*)(wl + W_IN), scr, r, lane); continue; } r -= I_IN;
        if (r < I_OUT) { transpose_item<1>(p.in[18] + (size_t)l * DM * DM, DM, DM, nullptr, (bf16_t*)(wl + W_OUT), scr, r, lane); continue; } r -= I_OUT;
        if (r < I_G) { transpose_item<2>(p.in[20] + (size_t)l * DM * FF, DM, FF, p.in[19] + l * DM, (bf16_t*)(wl + W_GU), scr, r, lane); continue; } r -= I_G;
        if (r < I_G) { transpose_item<3>(p.in[21] + (size_t)l * DM * FF, DM, FF, p.in[19] + l * DM, (bf16_t*)(wl + W_GU), scr, r, lane); continue; } r -= I_G;
        if (r < I_DN) { transpose_item<1>(p.in[22] + (size_t)l * FF * DM, FF, DM, nullptr, (bf16_t*)(wl + W_DN), scr, r, lane); continue; } r -= I_DN;
        { u32x4 z = {0u, 0u, 0u, 0u}; u32x4* d = (u32x4*)((bf16_t*)(wl + W_IN) + (size_t)(INC + r) * DM) + lane * 2; d[0] = z; d[1] = z; }
    }
    for (int rc_ = 0; rc_ < REP_PC; ++rc_)
    for (int it = gw; it < 4 * (128 + 4 + 32); it += NGW) {
        const int mi = it / 164, r = it % 164, l = mi >> 1, kv = mi & 1;
        const float* w1 = p.in[kv ? 12 : 10] + (size_t)l * 2048 * 256; const float* w2 = p.in[kv ? 13 : 11] + (size_t)l * 256 * 64; const float* pe = p.in[kv ? 9 : 8] + l * 2048;
        if (r < 128) transpose_item<4>(w1, 2048, 256, nullptr, (bf16_t*)(p.ws + WS_W1T) + (size_t)mi * 256 * 2048, scr, r, lane);
        else if (r < 132) transpose_item<1>(w2, 256, 64, nullptr, (bf16_t*)(p.ws + WS_W2T) + (size_t)mi * 64 * 256, scr, r - 128, lane);
        else { const int c = (r - 132) * 8 + (lane & 7), rg = lane >> 3; float acc = 0.f;
#pragma unroll 32
            for (int i = rg * 256; i < rg * 256 + 256; ++i) acc += pe[i] * w1[(size_t)i * 256 + c];
            acc += swz_f<8>(acc); acc += swz_f<16>(acc); acc = sum32(acc);
            if (rg == 0) ((float*)(p.ws + WS_CB))[mi * 256 + c] = acc; }
    }
    float* ss = (float*)(p.ws + WS_SS); bf16_t* xb = (bf16_t*)(p.ws + WS_XB);
    for (int rx_ = 0; rx_ < REP_PX; ++rx_)
    for (int m0 = gw; m0 < M; m0 += 4 * NGW) {
        f32x4 v[4][4];
#pragma unroll
        for (int rr = 0; rr < 4; ++rr) { const int m = m0 + rr * NGW; const f32x4* xr = (const f32x4*)(p.in[0] + (size_t)(m < M ? m : 0) * DM) + lane;
#pragma unroll
            for (int j = 0; j < 4; ++j) v[rr][j] = xr[64 * j]; }
#pragma unroll
        for (int rr = 0; rr < 4; ++rr) { const int m = m0 + rr * NGW; if (m < M) { u32x2* o8 = (u32x2*)(xb + (size_t)m * DM) + lane; float s = 0.f;
#pragma unroll
            for (int j = 0; j < 4; ++j) { const f32x4 t = v[rr][j]; s += (t[0] * t[0] + t[1] * t[1]) + (t[2] * t[2] + t[3] * t[3]); u32x2 w; w.x = pk2(t[0], t[1]); w.y = pk2(t[2], t[3]); o8[64 * j] = w; }
            s = wave_sum(s);
            if (lane == 0) { ss[m] = s; ss[M + m] = 0.f; ss[2 * M + m] = 0.f; ss[3 * M + m] = 0.f; } } }
    }
}

#define UNPACK8(v, k) const float k##0 = blo(v.x), k##1 = bhi(v.x), k##2 = blo(v.y), k##3 = bhi(v.y), k##4 = blo(v.z), k##5 = bhi(v.z), k##6 = blo(v.w), k##7 = bhi(v.w)
__device__ __forceinline__ void load_row64(float (&q)[64], const bf16_t* p) {
#pragma unroll
    for (int c = 0; c < 8; ++c) { const u32x4 v = *(const u32x4*)(p + 8 * c); UNPACK8(v, k);
        q[8 * c] = k0; q[8 * c + 1] = k1; q[8 * c + 2] = k2; q[8 * c + 3] = k3; q[8 * c + 4] = k4; q[8 * c + 5] = k5; q[8 * c + 6] = k6; q[8 * c + 7] = k7; }
}
template <bool SS> __device__ __forceinline__ float dot_row(const float (&q)[64], const bf16_t* p, float& kss) {
    float z = 0.f, s = 0.f;
#pragma unroll
    for (int c = 0; c < 8; ++c) { const u32x4 v = *(const u32x4*)(p + 8 * c); UNPACK8(v, k);
        z += (q[8 * c] * k0 + q[8 * c + 1] * k1) + (q[8 * c + 2] * k2 + q[8 * c + 3] * k3) + (q[8 * c + 4] * k4 + q[8 * c + 5] * k5) + (q[8 * c + 6] * k6 + q[8 * c + 7] * k7);
        if (SS) s += (k0 * k0 + k1 * k1) + (k2 * k2 + k3 * k3) + (k4 * k4 + k5 * k5) + (k6 * k6 + k7 * k7);
        if (c == 3) CFENCE(); }
    kss = s; return z;
}
__device__ __forceinline__ void axpy_row(float (&o)[64], float w, const bf16_t* p) {
#pragma unroll
    for (int c = 0; c < 8; ++c) { const u32x4 v = *(const u32x4*)(p + 8 * c); UNPACK8(v, k);
        o[8 * c] += w * k0; o[8 * c + 1] += w * k1; o[8 * c + 2] += w * k2; o[8 * c + 3] += w * k3; o[8 * c + 4] += w * k4; o[8 * c + 5] += w * k5; o[8 * c + 6] += w * k6; o[8 * c + 7] += w * k7;
        if (c == 3) CFENCE(); }
}
__device__ __forceinline__ float dot_row_f32(const float (&q)[64], const float* p) {
    float z = 0.f;
#pragma unroll
    for (int c = 0; c < 16; ++c) { const f32x4 v = *(const f32x4*)(p + 4 * c); z += (q[4 * c] * v[0] + q[4 * c + 1] * v[1]) + (q[4 * c + 2] * v[2] + q[4 * c + 3] * v[3]); if (c == 7) CFENCE(); }
    return z;
}
__device__ __forceinline__ void axpy_row_f32(float (&o)[64], float w, const float* p) {
#pragma unroll
    for (int c = 0; c < 16; ++c) { const f32x4 v = *(const f32x4*)(p + 4 * c); o[4 * c] += w * v[0]; o[4 * c + 1] += w * v[1]; o[4 * c + 2] += w * v[2]; o[4 * c + 3] += w * v[3]; if (c == 7) CFENCE(); }
}
__device__ __forceinline__ void store_group(const float (&o)[64], const float* g, bf16_t* dst) {
    float ss = 0.f;
#pragma unroll
    for (int d = 0; d < 64; ++d) ss += o[d] * o[d];
    const float rs = rsqrtf(ss * (1.f / 64.f) + EPS);
#pragma unroll
    for (int c = 0; c < 8; ++c) { u32x4 w;
        w.x = pk2(o[8 * c] * rs * g[8 * c], o[8 * c + 1] * rs * g[8 * c + 1]); w.y = pk2(o[8 * c + 2] * rs * g[8 * c + 2], o[8 * c + 3] * rs * g[8 * c + 3]);
        w.z = pk2(o[8 * c + 4] * rs * g[8 * c + 4], o[8 * c + 5] * rs * g[8 * c + 5]); w.w = pk2(o[8 * c + 6] * rs * g[8 * c + 6], o[8 * c + 7] * rs * g[8 * c + 7]);
        *(u32x4*)(dst + 8 * c) = w; }
}
__device__ __forceinline__ void load_q_norm(float (&q)[64], const bf16_t* p, const float* gq, const float* gx) {
    load_row64(q, p); float ss = 0.f;
#pragma unroll
    for (int d = 0; d < 64; ++d) ss += q[d] * q[d];
    const float rs = rsqrtf(ss * (1.f / 64.f) + EPS) * 0.125f;
#pragma unroll
    for (int d = 0; d < 64; ++d) q[d] = q[d] * rs * gq[d] * (gx ? gx[d] : 1.f);
}

__device__ __forceinline__ void stick_naive(const bf16_t* proj, bf16_t* groups, const float* g_out, int item, int lane) {
    const int tile = item & 63, h = (item >> 6) & 3, b = item >> 8, t = tile * 64 + lane;
    const bf16_t* base = proj + (size_t)b * SEQ * NP;
    float q[64]; load_row64(q, base + (size_t)t * NP + C_QC + h * 64);
#pragma unroll
    for (int d = 0; d < 64; ++d) q[d] *= 0.125f;
    float o[64];
#pragma unroll
    for (int d = 0; d < 64; ++d) o[d] = 0.f;
    float between = 0.f;
    for (int s = tile * 64 + 62; s >= 0; --s) {
        const bf16_t* kr = base + (size_t)s * NP + C_KC + h * 64; float dummy;
        const float z = dot_row<false>(q, kr, dummy); CFENCE();
        const bool act = s < t;
        const float sp = fmaxf(z, 0.f) + __logf(1.f + __expf(-fabsf(z)));
        const float w = act ? __expf((z - sp) - between) : 0.f;
        axpy_row(o, w, base + (size_t)s * NP + C_VC + h * 64); CFENCE();
        between += act ? sp : 0.f;
        if (s < tile * 64 && __all(between > 104.f)) break;
    }
    store_group(o, g_out + 512 + h * 64, groups + (size_t)(b * SEQ + t) * DM + 512 + h * 64);
}

__device__ __forceinline__ void dil_naive(const bf16_t* proj, bf16_t* groups, const float* gq, const float* gk, const float* g_out, int item, int lane) {
    const int tile = item & 63, h = (item >> 6) & 3, b = item >> 8, t = tile * 64 + lane;
    const bf16_t* base = proj + (size_t)b * SEQ * NP;
    float q[64]; load_q_norm(q, base + (size_t)t * NP + C_QD + h * 64, gq, gk);
    const float slope = exp2f(-(float)(2 * h + 2));
    float o[64];
#pragma unroll
    for (int d = 0; d < 64; ++d) o[d] = 0.f;
    float mx = -1e30f, l = 0.f;
    for (int cfg = 0; cfg < 3; ++cfg) {
        const int dil = cfg == 0 ? 1 : (cfg == 1 ? 4 : 16);
        for (int j = 0; j <= 128; ++j) {
            const int s = t - j * dil; const bool act = s >= 0;
            if (!__any(act)) break;
            if (act) {
                float kss; const float z = dot_row<true>(q, base + (size_t)s * NP + C_KD + h * 64, kss); CFENCE();
                const float sc = z * rsqrtf(kss * (1.f / 64.f) + EPS) - slope * (float)(j * dil);
                if (sc > mx) { const float corr = __expf(mx - sc); l *= corr;
#pragma unroll
                    for (int d = 0; d < 64; ++d) o[d] *= corr;
                    mx = sc; }
                const float pw = __expf(sc - mx); l += pw;
                axpy_row(o, pw, base + (size_t)s * NP + C_VD + h * 64); CFENCE();
            }
        }
    }
    const float inv = 1.f / l;
#pragma unroll
    for (int d = 0; d < 64; ++d) o[d] *= inv;
    store_group(o, g_out + 768 + h * 64, groups + (size_t)(b * SEQ + t) * DM + 768 + h * 64);
}

template <int NI> __device__ __forceinline__ void conv_items(const bf16_t* proj, bf16_t* groups, const float* cw, const float* g_out, int item0, int stride, int lane) {
    const int ch = (lane & 31) * 8;
    u32x4 cv[NI][3], uv[NI][3], bv[NI];
#pragma unroll
    for (int n = 0; n < NI; ++n) { const int token = (item0 + n * stride) * 2 + (lane >> 5), tpos = token & (SEQ - 1); const bf16_t* row = proj + (size_t)token * NP;
#pragma unroll
        for (int k = 0; k < 3; ++k) { const int back = 2 - k;
            if (tpos >= back) { cv[n][k] = *(const u32x4*)(row - (size_t)back * NP + C_CVC + ch); uv[n][k] = *(const u32x4*)(row - (size_t)back * NP + C_CVU + ch); }
            else { cv[n][k] = (u32x4){0u, 0u, 0u, 0u}; uv[n][k] = cv[n][k]; } }
        bv[n] = *(const u32x4*)(row + C_CVB + ch); }
    float wk[3][8];
#pragma unroll
    for (int k = 0; k < 3; ++k)
#pragma unroll
        for (int i = 0; i < 8; ++i) wk[k][i] = cw[k * 256 + ch + i];
    const float* go = g_out + 256 + ch;
#pragma unroll
    for (int n = 0; n < NI; ++n) { const int token = (item0 + n * stride) * 2 + (lane >> 5);
        float acc[8];
#pragma unroll
        for (int i = 0; i < 8; ++i) acc[i] = 0.f;
#pragma unroll
        for (int k = 0; k < 3; ++k) { UNPACK8(cv[n][k], c); UNPACK8(uv[n][k], u);
            acc[0] += wk[k][0] * (c0 * u0); acc[1] += wk[k][1] * (c1 * u1); acc[2] += wk[k][2] * (c2 * u2); acc[3] += wk[k][3] * (c3 * u3);
            acc[4] += wk[k][4] * (c4 * u4); acc[5] += wk[k][5] * (c5 * u5); acc[6] += wk[k][6] * (c6 * u6); acc[7] += wk[k][7] * (c7 * u7); }
        UNPACK8(bv[n], g);
        float y[8] = {g0 * acc[0], g1 * acc[1], g2 * acc[2], g3 * acc[3], g4 * acc[4], g5 * acc[5], g6 * acc[6], g7 * acc[7]};
        float ss = 0.f;
#pragma unroll
        for (int i = 0; i < 8; ++i) ss += y[i] * y[i];
        ss += swz_f<1>(ss); ss += swz_f<2>(ss); ss += swz_f<4>(ss);
        const float rs = rsqrtf(ss * (1.f / 64.f) + EPS);
        u32x4 w; w.x = pk2(y[0] * rs * go[0], y[1] * rs * go[1]); w.y = pk2(y[2] * rs * go[2], y[3] * rs * go[3]);
        w.z = pk2(y[4] * rs * go[4], y[5] * rs * go[5]); w.w = pk2(y[6] * rs * go[6], y[7] * rs * go[7]);
        *(u32x4*)(groups + (size_t)token * DM + 256 + ch) = w; }
}

typedef short bf16x8 __attribute__((ext_vector_type(8)));
typedef short s16x4 __attribute__((ext_vector_type(4)));
typedef float f32x16 __attribute__((ext_vector_type(16)));
typedef float f32x2_t __attribute__((ext_vector_type(2)));
typedef __bf16 bf16x2_t __attribute__((ext_vector_type(2)));
__device__ __forceinline__ unsigned cvtpk(float lo, float hi) { f32x2_t v = {lo, hi}; bf16x2_t b = __builtin_convertvector(v, bf16x2_t); return __builtin_bit_cast(unsigned, b); }
#define MFMA32(a, b, c) __builtin_amdgcn_mfma_f32_32x32x16_bf16((a), (b), (c), 0, 0, 0)
#define EXP2(x) __builtin_amdgcn_exp2f(x)
constexpr float LOG2E = 1.4426950408889634f;
constexpr int KSB = 144, VTB = 136, KS_BYTES = 64 * KSB, VT_BYTES = 64 * VTB;
__device__ __forceinline__ int crow(int i, int h) { return (i & 3) + 8 * (i >> 2) + 4 * h; }

struct KVSrc { const bf16_t* k; const bf16_t* v; long pitch; int first, lo, hi; };
__device__ __forceinline__ void kv_fetch(const KVSrc& s, int tid, u32x4& kc, u32x4& vc) {
    const int kl = tid >> 3, ch = tid & 7, i = s.first + kl;
    if (i >= s.lo && i < s.hi) { kc = *(const u32x4*)(s.k + (long)i * s.pitch + 8 * ch); vc = *(const u32x4*)(s.v + (long)i * s.pitch + 8 * ch); }
    else { kc = (u32x4){0u, 0u, 0u, 0u}; vc = kc; }
}
template <bool NORM> __device__ __forceinline__ void kv_store(u32x4 kc, u32x4 vc, const float (&g)[8], LAS unsigned char* ksb, LAS unsigned char* vtb, int tid) {
    const int kl = tid >> 3, ch = tid & 7;
    if (NORM) { UNPACK8(kc, k); float ss = (k0 * k0 + k1 * k1) + (k2 * k2 + k3 * k3) + (k4 * k4 + k5 * k5) + (k6 * k6 + k7 * k7);
        ss += swz_f<1>(ss); ss += swz_f<2>(ss); ss += swz_f<4>(ss);
        const float rs = rsqrtf(ss * (1.f / 64.f) + EPS);
        kc.x = cvtpk(k0 * rs * g[0], k1 * rs * g[1]); kc.y = cvtpk(k2 * rs * g[2], k3 * rs * g[3]); kc.z = cvtpk(k4 * rs * g[4], k5 * rs * g[5]); kc.w = cvtpk(k6 * rs * g[6], k7 * rs * g[7]); }
    *(LAS u32x4*)(ksb + kl * KSB + ch * 16) = kc;
    LAS unsigned short* vp = (LAS unsigned short*)(vtb + (8 * ch) * VTB + kl * 2);
    vp[0 * (VTB / 2)] = (unsigned short)(vc.x & 0xffffu); vp[1 * (VTB / 2)] = (unsigned short)(vc.x >> 16);
    vp[2 * (VTB / 2)] = (unsigned short)(vc.y & 0xffffu); vp[3 * (VTB / 2)] = (unsigned short)(vc.y >> 16);
    vp[4 * (VTB / 2)] = (unsigned short)(vc.z & 0xffffu); vp[5 * (VTB / 2)] = (unsigned short)(vc.z >> 16);
    vp[6 * (VTB / 2)] = (unsigned short)(vc.w & 0xffffu); vp[7 * (VTB / 2)] = (unsigned short)(vc.w >> 16);
}
template <bool NORM> __device__ __forceinline__ void load_qfrag(bf16x8 (&qf)[4], const bf16_t* qrow, const float* g1, const float* g2, float sc, int hh) {
    float f[32];
#pragma unroll
    for (int s = 0; s < 4; ++s) { const u32x4 v = *(const u32x4*)(qrow + 16 * s + 8 * hh); UNPACK8(v, k);
        f[8 * s] = k0; f[8 * s + 1] = k1; f[8 * s + 2] = k2; f[8 * s + 3] = k3; f[8 * s + 4] = k4; f[8 * s + 5] = k5; f[8 * s + 6] = k6; f[8 * s + 7] = k7; }
    if (NORM) { float ss = 0.f;
#pragma unroll
        for (int i = 0; i < 32; ++i) ss += f[i] * f[i];
        ss = sum32(ss); sc *= rsqrtf(ss * (1.f / 64.f) + EPS); }
#pragma unroll
    for (int s = 0; s < 4; ++s) { float v[8];
#pragma unroll
        for (int j = 0; j < 8; ++j) { const int d = 16 * s + 8 * hh + j; v[j] = f[8 * s + j] * sc * (g1 ? g1[d] : 1.f) * (g2 ? g2[d] : 1.f); }
        u32x4 w; w.x = cvtpk(v[0], v[1]); w.y = cvtpk(v[2], v[3]); w.z = cvtpk(v[4], v[5]); w.w = cvtpk(v[6], v[7]);
        qf[s] = __builtin_bit_cast(bf16x8, w); }
}

struct SfCmp { int tq, nvis, j0; float slope; __device__ __forceinline__ float operator()(float s, int kl) const { const int j = j0 + kl; return j < nvis ? s - slope * (float)(tq - 16 * j - 31) : -INFINITY; } };
struct SfSlc { int tq, key0; float slope; bool sel; __device__ __forceinline__ float operator()(float s, int kl) const { const int key = key0 + kl; return (sel && key <= tq) ? s - slope * (float)(tq - key) : -INFINITY; } };
struct SfWin { int tq, key0; float slope; __device__ __forceinline__ float operator()(float s, int kl) const { const int key = key0 + kl; return (key <= tq && tq - key <= 511) ? s - slope * (float)(tq - key) : -INFINITY; } };

__device__ __forceinline__ void pv_accum(const f32x16& s0, const f32x16& s1, f32x16& o0, f32x16& o1, LAS const unsigned char* vtb, int r, int hh) {
    __builtin_amdgcn_s_setprio(1);
#pragma unroll
    for (int kt = 0; kt < 2; ++kt)
#pragma unroll
        for (int sp = 0; sp < 2; ++sp) { u32x4 w;
            if (kt == 0) { w.x = cvtpk(s0[8 * sp], s0[8 * sp + 1]); w.y = cvtpk(s0[8 * sp + 2], s0[8 * sp + 3]); w.z = cvtpk(s0[8 * sp + 4], s0[8 * sp + 5]); w.w = cvtpk(s0[8 * sp + 6], s0[8 * sp + 7]); }
            else         { w.x = cvtpk(s1[8 * sp], s1[8 * sp + 1]); w.y = cvtpk(s1[8 * sp + 2], s1[8 * sp + 3]); w.z = cvtpk(s1[8 * sp + 4], s1[8 * sp + 5]); w.w = cvtpk(s1[8 * sp + 6], s1[8 * sp + 7]); }
            const bf16x8 pb = __builtin_bit_cast(bf16x8, w); const int ko = 32 * kt + 16 * sp + 4 * hh;
            { const s16x4 lo = *(LAS const s16x4*)(vtb + r * VTB + ko * 2), hi = *(LAS const s16x4*)(vtb + r * VTB + (ko + 8) * 2);
              o0 = MFMA32(__builtin_shufflevector(lo, hi, 0, 1, 2, 3, 4, 5, 6, 7), pb, o0); }
            { const s16x4 lo = *(LAS const s16x4*)(vtb + (32 + r) * VTB + ko * 2), hi = *(LAS const s16x4*)(vtb + (32 + r) * VTB + (ko + 8) * 2);
              o1 = MFMA32(__builtin_shufflevector(lo, hi, 0, 1, 2, 3, 4, 5, 6, 7), pb, o1); } }
    __builtin_amdgcn_s_setprio(0);
}
template <int MODE, class SF>
__device__ __forceinline__ void attn_block(const bf16x8 (&qf)[4], f32x16& o0, f32x16& o1, float& m, float& l, LAS const unsigned char* ksb, LAS const unsigned char* vtb, int r, int hh, const SF sf,
                                           float msafe_f, float inv_f, LAS float* imprw, int nbase, float& carry) {
    f32x16 s0, s1;
#pragma unroll
    for (int i = 0; i < 16; ++i) { s0[i] = 0.f; s1[i] = 0.f; }
    bf16x8 ka[4], kb2[4];
#pragma unroll
    for (int s = 0; s < 4; ++s) { ka[s] = *(LAS const bf16x8*)(ksb + r * KSB + (16 * s + 8 * hh) * 2); kb2[s] = *(LAS const bf16x8*)(ksb + (32 + r) * KSB + (16 * s + 8 * hh) * 2); }
    __builtin_amdgcn_s_setprio(1);
#pragma unroll
    for (int s = 0; s < 4; ++s) { s0 = MFMA32(ka[s], qf[s], s0); s1 = MFMA32(kb2[s], qf[s], s1); }
    __builtin_amdgcn_s_setprio(0);
    __builtin_amdgcn_sched_barrier(0);
#pragma unroll
    for (int i = 0; i < 16; ++i) { s0[i] = sf(s0[i], crow(i, hh)); s1[i] = sf(s1[i], 32 + crow(i, hh)); }
    if (MODE != 2) {
        float mloc = fmaxf(s0[0], s1[0]);
#pragma unroll
        for (int i = 1; i < 16; ++i) mloc = fmaxf(mloc, fmaxf(s0[i], s1[i]));
        mloc = max32(mloc);
        const float mnew = fmaxf(m, mloc), msafe = mnew == -INFINITY ? 0.f : mnew, corr = EXP2(m - msafe);
        float psum = 0.f;
#pragma unroll
        for (int i = 0; i < 16; ++i) { s0[i] = EXP2(s0[i] - msafe); s1[i] = EXP2(s1[i] - msafe); psum += s0[i] + s1[i]; }
        psum = sum32(psum);
        l = l * corr + psum; m = mnew;
        if (MODE == 0 && !__all(corr == 1.f)) {
#pragma unroll
            for (int i = 0; i < 16; ++i) { o0[i] *= corr; o1[i] *= corr; } }
    } else {
#pragma unroll
        for (int i = 0; i < 16; ++i) { s0[i] = EXP2(s0[i] - msafe_f) * inv_f; s1[i] = EXP2(s1[i] - msafe_f) * inv_f; }
#pragma unroll
        for (int kt = 0; kt < 2; ++kt) { float A[4], T[4], R[4];
#pragma unroll
            for (int g = 0; g < 4; ++g) { const float p0 = kt ? s1[4 * g] : s0[4 * g], p1 = kt ? s1[4 * g + 1] : s0[4 * g + 1], p2 = kt ? s1[4 * g + 2] : s0[4 * g + 2], p3 = kt ? s1[4 * g + 3] : s0[4 * g + 3];
                A[g] = 2.f * ((p0 + p1) + p2) + p3; T[g] = p3; R[g] = partner32(p3, hh); }
#pragma unroll
            for (int g = 0; g < 4; ++g) { const float prev = hh ? R[g] : (g ? R[g - 1] : carry);
                imprw[nbase + 8 * kt + 2 * g + hh] = A[g] + prev; }
            carry = R[3]; (void)T; }
    }
    __builtin_amdgcn_sched_barrier(0);
    if (MODE != 1) pv_accum(s0, s1, o0, o1, vtb, r, hh);
}


__device__ __forceinline__ void attn_block_full(const bf16x8 (&qf)[4], f32x16& o0, f32x16& o1, float& m, float& l, LAS const unsigned char* ksb, LAS const unsigned char* vtb, int r, int hh, float b0, float sl) {
    f32x16 s0, s1;
#pragma unroll
    for (int i = 0; i < 16; ++i) { s0[i] = 0.f; s1[i] = 0.f; }
    bf16x8 ka[4], kb2[4];
#pragma unroll
    for (int s = 0; s < 4; ++s) { ka[s] = *(LAS const bf16x8*)(ksb + r * KSB + (16 * s + 8 * hh) * 2); kb2[s] = *(LAS const bf16x8*)(ksb + (32 + r) * KSB + (16 * s + 8 * hh) * 2); }
    __builtin_amdgcn_s_setprio(1);
#pragma unroll
    for (int s = 0; s < 4; ++s) { s0 = MFMA32(ka[s], qf[s], s0); s1 = MFMA32(kb2[s], qf[s], s1); }
    __builtin_amdgcn_s_setprio(0);
    __builtin_amdgcn_sched_barrier(0);
#pragma unroll
    for (int i = 0; i < 16; ++i) { const float c = (float)((i & 3) + 8 * (i >> 2)); s0[i] = fmaf(sl, c, s0[i]); s1[i] = fmaf(sl, c + 32.f, s1[i]); }
    float mloc = fmaxf(s0[0], s1[0]);
#pragma unroll
    for (int i = 1; i < 16; ++i) mloc = fmaxf(mloc, fmaxf(s0[i], s1[i]));
    mloc = max32(mloc + b0);
    const float mnew = fmaxf(m, mloc), msafe = mnew == -INFINITY ? 0.f : mnew, corr = EXP2(m - msafe), c0 = b0 - msafe;
    float psum = 0.f;
#pragma unroll
    for (int i = 0; i < 16; ++i) { s0[i] = EXP2(s0[i] + c0); s1[i] = EXP2(s1[i] + c0); psum += s0[i] + s1[i]; }
    psum = sum32(psum);
    l = l * corr + psum; m = mnew;
#pragma unroll
    for (int i = 0; i < 16; ++i) { o0[i] *= corr; o1[i] *= corr; }
    __builtin_amdgcn_sched_barrier(0);
    pv_accum(s0, s1, o0, o1, vtb, r, hh);
}

#define KV_PIPELINE(FIRST, NEXT, SRC, NORM, GAIN, ...) do { \
    __syncthreads(); \
    int nxt_ = (FIRST), par_ = 0; u32x4 kc_, vc_; float g8_[8]; \
    { const float* gp_ = (GAIN); _Pragma("unroll") for (int j_ = 0; j_ < 8; ++j_) g8_[j_] = gp_ ? gp_[8 * (tid & 7) + j_] : 1.f; } \
    if (nxt_ >= 0) { const int id = nxt_; const KVSrc src_ = SRC; kv_fetch(src_, tid, kc_, vc_); } \
    while (nxt_ >= 0) { const int cur_ = nxt_; \
        LAS unsigned char* ksb = lds + par_ * KS_BYTES; LAS unsigned char* vtb = lds + 2 * KS_BYTES + par_ * VT_BYTES; \
        kv_store<NORM>(kc_, vc_, g8_, ksb, vtb, tid); \
        __syncthreads(); \
        { const int cur = cur_; nxt_ = (NEXT); } \
        if (nxt_ >= 0) { const int id = nxt_; const KVSrc src_ = SRC; kv_fetch(src_, tid, kc_, vc_); } \
        { const int id = cur_; __VA_ARGS__; } \
        par_ ^= 1; } } while (0)


__device__ __forceinline__ void kv_store_pre(u32x4 kc, u32x4 vc, LAS unsigned char* ksb, LAS unsigned char* vtb, int tid) {
    *(LAS u32x4*)(ksb + (tid >> 3) * KSB + (tid & 7) * 16) = kc;
    LAS u32x2* vp = (LAS u32x2*)(vtb + (tid >> 3) * VTB + (tid & 7) * 16); u32x2 a = {vc.x, vc.y}, b2 = {vc.z, vc.w}; vp[0] = a; vp[1] = b2;
}
#define KV_PIPELINE_PRE(FIRST, NEXT, KTILE, VTILE, ...) do { \
    __syncthreads(); \
    int nxt_ = (FIRST), par_ = 0; u32x4 kc_, vc_; \
    if (nxt_ >= 0) { const int id = nxt_; kc_ = *(const u32x4*)((KTILE) + tid * 8); vc_ = *(const u32x4*)((VTILE) + tid * 8); } \
    while (nxt_ >= 0) { const int cur_ = nxt_; \
        LAS unsigned char* ksb = lds + par_ * KS_BYTES; LAS unsigned char* vtb = lds + 2 * KS_BYTES + par_ * VT_BYTES; \
        kv_store_pre(kc_, vc_, ksb, vtb, tid); \
        __syncthreads(); \
        { const int cur = cur_; nxt_ = (NEXT); } \
        if (nxt_ >= 0) { const int id = nxt_; kc_ = *(const u32x4*)((KTILE) + tid * 8); vc_ = *(const u32x4*)((VTILE) + tid * 8); } \
        { const int id = cur_; __VA_ARGS__; } \
        par_ ^= 1; } } while (0)

__device__ __forceinline__ void nsa_prep_item(const bf16_t* proj, bf16_t* kn, bf16_t* vtn, const float* g_ks, const float* g_kw, int item, LAS unsigned char* scr, int lane) {
    const int b = item >> 7, which = (item >> 6) & 1, n = item & 63, ch = lane & 7, row0 = lane >> 3;
    const bf16_t* src = proj + ((size_t)b * SEQ + 64 * n) * NP + (which ? C_KWA : C_KSA) + 8 * ch;
    const float* g = (which ? g_kw : g_ks) + 8 * ch;
    float gg[8];
#pragma unroll
    for (int i = 0; i < 8; ++i) gg[i] = g[i];
    u32x4 kc[8], vc[8];
#pragma unroll
    for (int j = 0; j < 8; ++j) { const bf16_t* rp = src + (size_t)(row0 + 8 * j) * NP; kc[j] = *(const u32x4*)rp; vc[j] = *(const u32x4*)(rp + 64); }
    bf16_t* kdst = kn + (((size_t)b * 2 + which) * SEQ + 64 * n) * 64 + 8 * ch;
#pragma unroll
    for (int j = 0; j < 8; ++j) { const int row = row0 + 8 * j; UNPACK8(kc[j], k);
        float ss = (k0 * k0 + k1 * k1) + (k2 * k2 + k3 * k3) + (k4 * k4 + k5 * k5) + (k6 * k6 + k7 * k7);
        ss += swz_f<1>(ss); ss += swz_f<2>(ss); ss += swz_f<4>(ss);
        const float rs = rsqrtf(ss * (1.f / 64.f) + EPS); u32x4 o;
        o.x = cvtpk(k0 * rs * gg[0], k1 * rs * gg[1]); o.y = cvtpk(k2 * rs * gg[2], k3 * rs * gg[3]); o.z = cvtpk(k4 * rs * gg[4], k5 * rs * gg[5]); o.w = cvtpk(k6 * rs * gg[6], k7 * rs * gg[7]);
        *(u32x4*)(kdst + (size_t)row * 64) = o;
        LAS unsigned short* vp = (LAS unsigned short*)(scr + (8 * ch) * 144 + row * 2); const u32x4 v = vc[j];
        vp[0 * 72] = (unsigned short)(v.x & 0xffffu); vp[1 * 72] = (unsigned short)(v.x >> 16); vp[2 * 72] = (unsigned short)(v.y & 0xffffu); vp[3 * 72] = (unsigned short)(v.y >> 16);
        vp[4 * 72] = (unsigned short)(v.z & 0xffffu); vp[5 * 72] = (unsigned short)(v.z >> 16); vp[6 * 72] = (unsigned short)(v.w & 0xffffu); vp[7 * 72] = (unsigned short)(v.w >> 16); }
    LDS_WAIT();
    bf16_t* vdst = vtn + ((((size_t)b * 2 + which) * 64 + n) * 64 + lane) * 64;
#pragma unroll
    for (int c = 0; c < 8; ++c) *(u32x4*)(vdst + 8 * c) = *(LAS const u32x4*)(scr + lane * 144 + 16 * c);
    LDS_WAIT();
}

struct NsaArgs { const bf16_t* proj; bf16_t* groups; const bf16_t *kcn, *vcc; const float *b_gate, *g_q, *g_ks, *g_kw, *g_out; const bf16_t *kn, *vtn; };
constexpr int NSA_SLAB = 2 * KS_BYTES + 2 * VT_BYTES, NSA_ISUM = NSA_SLAB + 4 * 64 * 65 * 4, NSA_MASK = NSA_ISUM + 64 * 65 * 4, NSA_UMASK = NSA_MASK + 512;
__device__ __forceinline__ void nsa_item(const NsaArgs& A, int b, int tl, LAS unsigned char* lds, int tid) {
    asm volatile("" : "+v"(tid));
    const int lane = tid & 63, w = __builtin_amdgcn_readfirstlane(tid >> 6), head = w & 3, half = w >> 2, r = lane & 31, hh = lane >> 5;
    const int tq = tl * 64 + 32 * half + r, tokl = 32 * half + r; const size_t token = (size_t)b * SEQ + tq;
    const bf16_t* base = A.proj + (size_t)b * SEQ * NP;
    LAS float* slab = (LAS float*)(lds + NSA_SLAB); LAS float* isum = (LAS float*)(lds + NSA_ISUM);
    LAS unsigned* masks = (LAS unsigned*)(lds + NSA_MASK); LAS unsigned* umask = (LAS unsigned*)(lds + NSA_UMASK);
    const float slope = exp2f(-(float)(2 * head + 1)) * LOG2E;
    bf16x8 qf[4]; load_qfrag<true>(qf, base + (size_t)tq * NP + C_QA + head * 64, A.g_q, nullptr, 0.125f * LOG2E, hh);
    float gl[3];
#pragma unroll
    for (int br = 0; br < 3; ++br) { const float x = bf2f(base[(size_t)tq * NP + C_GT + head * 3 + br]) + A.b_gate[head * 3 + br]; gl[br] = 1.f / (1.f + __expf(-x)); }
    f32x16 of0, of1, o0, o1;
#pragma unroll
    for (int i = 0; i < 16; ++i) { of0[i] = 0.f; of1[i] = 0.f; }
    float dummy = 0.f;
    {
        const int nbc = (tl >> 4) + 1, nvis = tq >= 31 ? ((tq - 31) >> 4) + 1 : 0;
        const bf16_t* kc = A.kcn + (size_t)b * 256 * 64; const bf16_t* vc = A.vcc + (size_t)b * 256 * 64;
        float m = -INFINITY, l = 0.f;
        KV_PIPELINE_PRE(0, (cur + 1 < nbc ? cur + 1 : -1), kc + (size_t)id * 4096, vc + (size_t)id * 4096,
            { const SfCmp sf{tq, nvis, 64 * id, slope}; attn_block<1>(qf, o0, o1, m, l, ksb, vtb, r, hh, sf, 0.f, 0.f, nullptr, 0, dummy); });
        const float inv = l > 0.f ? 1.f / l : 0.f, msafe = m == -INFINITY ? 0.f : m; float carry = 0.f;
#pragma unroll
        for (int i = 0; i < 16; ++i) { o0[i] = 0.f; o1[i] = 0.f; }
        LAS float* imprw = slab + (head * 64 + tokl) * 65;
        KV_PIPELINE_PRE(0, (cur + 1 < nbc ? cur + 1 : -1), kc + (size_t)id * 4096, vc + (size_t)id * 4096,
            { const SfCmp sf{tq, nvis, 64 * id, slope}; attn_block<2>(qf, o0, o1, m, l, ksb, vtb, r, hh, sf, msafe, inv, imprw, 16 * id, carry); });
#pragma unroll
        for (int i = 0; i < 16; ++i) { of0[i] += gl[0] * o0[i]; of1[i] += gl[0] * o1[i]; }
    }
    __syncthreads();
    if (tl > 15) {
        for (int e = tid; e < 64 * 64; e += 512) { const int tk = e >> 6, n = e & 63, o = tk * 65 + n; isum[o] = ((slab[o] + slab[64 * 65 + o]) + slab[2 * 64 * 65 + o]) + slab[3 * 64 * 65 + o]; }
        __syncthreads();
        const int tk = tid >> 3, sub = tid & 7; float v[8]; int cnt[8];
#pragma unroll
        for (int k = 0; k < 8; ++k) { v[k] = isum[tk * 65 + 8 * sub + k]; cnt[k] = 0; }
        for (int mm = 1; mm <= tl - 2; ++mm) { const float vm = isum[tk * 65 + mm];
#pragma unroll
            for (int k = 0; k < 8; ++k) cnt[k] += (vm > v[k] || (vm == v[k] && mm < 8 * sub + k)) ? 1 : 0; }
        unsigned bits = 0u;
#pragma unroll
        for (int k = 0; k < 8; ++k) { const int n = 8 * sub + k; if (n >= 1 && n <= tl - 2 && cnt[k] < 13) bits |= 1u << k; }
        unsigned lo = sub < 4 ? bits << (8 * sub) : 0u, hi = sub >= 4 ? bits << (8 * (sub - 4)) : 0u;
        lo |= swz_u<1>(lo); hi |= swz_u<1>(hi); lo |= swz_u<2>(lo); hi |= swz_u<2>(hi); lo |= swz_u<4>(lo); hi |= swz_u<4>(hi);
        const unsigned long long mk = ((unsigned long long)hi << 32 | lo) | 1ull | (3ull << (tl - 1));
        if (sub == 0) { masks[2 * tk] = (unsigned)mk; masks[2 * tk + 1] = (unsigned)(mk >> 32); }
    } else if (tid < 64) { const unsigned long long mk = (2ull << tl) - 1ull; masks[2 * tid] = (unsigned)mk; masks[2 * tid + 1] = (unsigned)(mk >> 32); }
    __syncthreads();
    if (tid < 64) { unsigned lo = masks[2 * tid], hi = masks[2 * tid + 1];
        lo |= swz_u<1>(lo); hi |= swz_u<1>(hi); lo |= swz_u<2>(lo); hi |= swz_u<2>(hi); lo |= swz_u<4>(lo); hi |= swz_u<4>(hi);
        lo |= swz_u<8>(lo); hi |= swz_u<8>(hi); lo |= swz_u<16>(lo); hi |= swz_u<16>(hi); lo = or32(lo); hi = or32(hi);
        if (tid == 0) { umask[0] = lo; umask[1] = hi; } }
    __syncthreads();
    const unsigned long long um = (unsigned long long)umask[1] << 32 | umask[0];
    const unsigned long long mymask = (unsigned long long)masks[2 * tokl + 1] << 32 | masks[2 * tokl];
    LAS float* park = slab + w * 2048 + lane;
#pragma unroll
    for (int i = 0; i < 16; ++i) { park[i * 64] = of0[i]; park[(16 + i) * 64] = of1[i]; }
    {
        float m = -INFINITY, l = 0.f;
#pragma unroll
        for (int i = 0; i < 16; ++i) { o0[i] = 0.f; o1[i] = 0.f; }
        const bf16_t* kp = A.kn + (size_t)(b * 2) * SEQ * 64; const bf16_t* vp = A.vtn + (size_t)(b * 2) * 64 * 4096;
#define NSA_NEXTBIT(c) ({ const unsigned long long rem_ = ((c) >= 63) ? 0ull : (um & ~((2ull << (c)) - 1ull)); rem_ ? (int)__builtin_ctzll(rem_) : -1; })
        KV_PIPELINE_PRE((int)__builtin_ctzll(um), NSA_NEXTBIT(cur), kp + (size_t)id * 4096, vp + (size_t)id * 4096,
            { const bool sel = (mymask >> id) & 1ull;
              if (__any(sel)) {
                  if (id < tl) attn_block_full(qf, o0, o1, m, l, ksb, vtb, r, hh, sel ? -slope * (float)(tq - 64 * id - 4 * hh) : -INFINITY, slope);
                  else { const SfSlc sf{tq, 64 * id, slope, sel}; attn_block<0>(qf, o0, o1, m, l, ksb, vtb, r, hh, sf, 0.f, 0.f, nullptr, 0, dummy); } } });
        const float sc = gl[1] / l;
#pragma unroll
        for (int i = 0; i < 16; ++i) { park[i * 64] += sc * o0[i]; park[(16 + i) * 64] += sc * o1[i]; }
    }
    {
        float m = -INFINITY, l = 0.f;
#pragma unroll
        for (int i = 0; i < 16; ++i) { o0[i] = 0.f; o1[i] = 0.f; }
        const bf16_t* kp = A.kn + (size_t)(b * 2 + 1) * SEQ * 64; const bf16_t* vp = A.vtn + (size_t)(b * 2 + 1) * 64 * 4096; const int nlo = tl >= 8 ? tl - 8 : 0;
        KV_PIPELINE_PRE(nlo, (cur + 1 <= tl ? cur + 1 : -1), kp + (size_t)id * 4096, vp + (size_t)id * 4096,
            { if (id < tl && id >= tl - 7) attn_block_full(qf, o0, o1, m, l, ksb, vtb, r, hh, -slope * (float)(tq - 64 * id - 4 * hh), slope);
              else { const SfWin sf{tq, 64 * id, slope}; attn_block<0>(qf, o0, o1, m, l, ksb, vtb, r, hh, sf, 0.f, 0.f, nullptr, 0, dummy); } });
        const float sc = gl[2] / l;
#pragma unroll
        for (int i = 0; i < 16; ++i) { of0[i] = park[i * 64] + sc * o0[i]; of1[i] = park[(16 + i) * 64] + sc * o1[i]; }
    }
    {
        float ss = 0.f;
#pragma unroll
        for (int i = 0; i < 16; ++i) ss += of0[i] * of0[i] + of1[i] * of1[i];
        ss = sum32(ss);
        const float rs = rsqrtf(ss * (1.f / 64.f) + EPS); const float* go = A.g_out + head * 64; bf16_t* dst = A.groups + token * DM + head * 64;
#pragma unroll
        for (int g = 0; g < 4; ++g) { const int d0 = 8 * g + 4 * hh;
            u32x2 wa; wa.x = cvtpk(of0[4 * g] * rs * go[d0], of0[4 * g + 1] * rs * go[d0 + 1]); wa.y = cvtpk(of0[4 * g + 2] * rs * go[d0 + 2], of0[4 * g + 3] * rs * go[d0 + 3]);
            *(u32x2*)(dst + d0) = wa;
            u32x2 wb; wb.x = cvtpk(of1[4 * g] * rs * go[32 + d0], of1[4 * g + 1] * rs * go[32 + d0 + 1]); wb.y = cvtpk(of1[4 * g + 2] * rs * go[32 + d0 + 2], of1[4 * g + 3] * rs * go[32 + d0 + 3]);
            *(u32x2*)(dst + 32 + d0) = wb; }
    }
    __syncthreads();
}

struct SfDil { int iq, key0; float sl; __device__ __forceinline__ float operator()(float s, int kl) const { const int df = iq - key0 - kl; return (df >= 0 && df <= 128) ? s - sl * (float)df : -INFINITY; } };
struct DilArgs { const bf16_t* proj; bf16_t* po; float* plse; const float *g_q, *g_k; };
__device__ __forceinline__ void dil_item(const DilArgs& A, int item, LAS unsigned char* lds, int tid) {
    asm volatile("" : "+v"(tid));
    const int cfg = item >> 9, rem = item & 511, b = rem >> 6, head = (rem >> 4) & 3, sub = rem & 15;
    const int dil = cfg == 0 ? 1 : (cfg == 1 ? 4 : 16), nq = 16 / dil, c = sub / nq, qt = sub % nq, i0 = 256 * qt, L = SEQ / dil;
    const int lane = tid & 63, w = __builtin_amdgcn_readfirstlane(tid >> 6), r = lane & 31, hh = lane >> 5;
    const int iq = i0 + 32 * w + r, tq = c + dil * iq; const size_t token = (size_t)b * SEQ + tq;
    const bf16_t* base = A.proj + (size_t)b * SEQ * NP;
    const float slope = exp2f(-(float)(2 * head + 2)) * (float)dil * LOG2E;
    bf16x8 qf[4]; load_qfrag<true>(qf, base + (size_t)tq * NP + C_QD + head * 64, A.g_q, nullptr, 0.125f * LOG2E, hh);
    const bf16_t* kp = base + (size_t)c * NP + C_KD + head * 64; const bf16_t* vp = base + (size_t)c * NP + C_VD + head * 64;
    const int kb_lo = (i0 >> 6) >= 2 ? (i0 >> 6) - 2 : 0, kb_hi = (i0 >> 6) + 3, q_lo = i0 + 32 * w;
    f32x16 o0, o1;
#pragma unroll
    for (int i = 0; i < 16; ++i) { o0[i] = 0.f; o1[i] = 0.f; }
    float m = -INFINITY, l = 0.f, dummy = 0.f;
    KV_PIPELINE(kb_lo, (cur + 1 <= kb_hi ? cur + 1 : -1), (KVSrc{kp, vp, (long)dil * NP, 64 * id, 0, L}), true, A.g_k,
        { if (64 * id + 63 >= q_lo - 128 && 64 * id <= q_lo + 31) { const SfDil sf{iq, 64 * id, slope}; attn_block<0>(qf, o0, o1, m, l, ksb, vtb, r, hh, sf, 0.f, 0.f, nullptr, 0, dummy); } });
    const float inv = 1.f / l;
    bf16_t* dst = A.po + ((size_t)cfg * M + token) * 256 + head * 64;
#pragma unroll
    for (int g = 0; g < 4; ++g) { const int d0 = 8 * g + 4 * hh;
        u32x2 wa; wa.x = cvtpk(o0[4 * g] * inv, o0[4 * g + 1] * inv); wa.y = cvtpk(o0[4 * g + 2] * inv, o0[4 * g + 3] * inv); *(u32x2*)(dst + d0) = wa;
        u32x2 wb; wb.x = cvtpk(o1[4 * g] * inv, o1[4 * g + 1] * inv); wb.y = cvtpk(o1[4 * g + 2] * inv, o1[4 * g + 3] * inv); *(u32x2*)(dst + 32 + d0) = wb; }
    if (hh == 0) A.plse[((size_t)cfg * M + token) * 4 + head] = m + __log2f(l);
    __syncthreads();
}
template <int NI> __device__ __forceinline__ void dil_merge_items(const bf16_t* po, const float* plse, bf16_t* groups, const float* g_out, int item0, int stride, int lane) {
    const int pair = lane >> 3, ch = lane & 7, head = pair & 3;
    u32x4 pv[NI][3]; float ls[NI][3];
#pragma unroll
    for (int n = 0; n < NI; ++n) { const size_t token = (size_t)(item0 + n * stride) * 2 + (pair >> 2);
#pragma unroll
        for (int i = 0; i < 3; ++i) { ls[n][i] = plse[((size_t)i * M + token) * 4 + head]; pv[n][i] = *(const u32x4*)(po + ((size_t)i * M + token) * 256 + head * 64 + 8 * ch); } }
    const float* go = g_out + 768 + head * 64 + 8 * ch;
#pragma unroll
    for (int n = 0; n < NI; ++n) { const size_t token = (size_t)(item0 + n * stride) * 2 + (pair >> 2);
        const float mx = fmaxf(ls[n][0], fmaxf(ls[n][1], ls[n][2]));
        const float w0 = EXP2(ls[n][0] - mx), w1 = EXP2(ls[n][1] - mx), w2 = EXP2(ls[n][2] - mx), winv = 1.f / (w0 + w1 + w2);
        float o[8];
#pragma unroll
        for (int j = 0; j < 8; ++j) o[j] = 0.f;
#pragma unroll
        for (int i = 0; i < 3; ++i) { UNPACK8(pv[n][i], k); const float wi = (i == 0 ? w0 : (i == 1 ? w1 : w2)) * winv;
            o[0] += wi * k0; o[1] += wi * k1; o[2] += wi * k2; o[3] += wi * k3; o[4] += wi * k4; o[5] += wi * k5; o[6] += wi * k6; o[7] += wi * k7; }
        float ss = 0.f;
#pragma unroll
        for (int j = 0; j < 8; ++j) ss += o[j] * o[j];
        ss += swz_f<1>(ss); ss += swz_f<2>(ss); ss += swz_f<4>(ss);
        const float rs = rsqrtf(ss * (1.f / 64.f) + EPS);
        u32x4 wv; wv.x = cvtpk(o[0] * rs * go[0], o[1] * rs * go[1]); wv.y = cvtpk(o[2] * rs * go[2], o[3] * rs * go[3]); wv.z = cvtpk(o[4] * rs * go[4], o[5] * rs * go[5]); wv.w = cvtpk(o[6] * rs * go[6], o[7] * rs * go[7]);
        *(u32x4*)(groups + token * DM + 768 + head * 64 + 8 * ch) = wv; }
}

__device__ __forceinline__ void stick_block(const bf16x8 (&qf)[4], f32x16& o0, f32x16& o1, float& carry, LAS const unsigned char* ksb, LAS const unsigned char* vtb, int r, int hh, int tq, int key0) {
    f32x16 s0, s1;
#pragma unroll
    for (int i = 0; i < 16; ++i) { s0[i] = 0.f; s1[i] = 0.f; }
    bf16x8 ka[4], kb2[4];
#pragma unroll
    for (int s = 0; s < 4; ++s) { ka[s] = *(LAS const bf16x8*)(ksb + r * KSB + (16 * s + 8 * hh) * 2); kb2[s] = *(LAS const bf16x8*)(ksb + (32 + r) * KSB + (16 * s + 8 * hh) * 2); }
    __builtin_amdgcn_s_setprio(1);
#pragma unroll
    for (int s = 0; s < 4; ++s) { s0 = MFMA32(ka[s], qf[s], s0); s1 = MFMA32(kb2[s], qf[s], s1); }
    __builtin_amdgcn_s_setprio(0);
    __builtin_amdgcn_sched_barrier(0);
    float acc = carry;
#pragma unroll
    for (int kti = 0; kti < 2; ++kti) { const int kt = 1 - kti; float spm[16], G[4], R[4];
#pragma unroll
        for (int i = 0; i < 16; ++i) { const float z = kt ? s1[i] : s0[i]; const bool act = key0 + 32 * kt + crow(i, hh) < tq;
            const float sp = fmaxf(z, 0.f) + __logf(1.f + __expf(-fabsf(z)));
            spm[i] = act ? sp : 0.f; const float lw = act ? z - sp : -INFINITY; if (kt) s1[i] = lw; else s0[i] = lw; }
#pragma unroll
        for (int g = 0; g < 4; ++g) { G[g] = (spm[4 * g] + spm[4 * g + 1]) + (spm[4 * g + 2] + spm[4 * g + 3]); R[g] = partner32(G[g], hh); }
#pragma unroll
        for (int gi = 0; gi < 4; ++gi) { const int g = 3 - gi; float run = acc + (hh ? 0.f : R[g]);
#pragma unroll
            for (int ki = 0; ki < 4; ++ki) { const int i = 4 * g + 3 - ki; const float lw = kt ? s1[i] : s0[i]; const float wv = __expf(lw - run); if (kt) s1[i] = wv; else s0[i] = wv; run += spm[i]; }
            acc += G[g] + R[g]; } }
    carry = acc;
    __builtin_amdgcn_sched_barrier(0);
    pv_accum(s0, s1, o0, o1, vtb, r, hh);
}
struct StickArgs { const bf16_t* proj; bf16_t* groups; const float* g_out; };
__device__ __forceinline__ void stick_item(const StickArgs& A, int item, LAS unsigned char* lds, int tid) {
    asm volatile("" : "+v"(tid));
    const int b = item >> 6, head = (item >> 4) & 3, qt = item & 15, T0 = 256 * qt;
    const int lane = tid & 63, w = __builtin_amdgcn_readfirstlane(tid >> 6), r = lane & 31, hh = lane >> 5, tq = T0 + 32 * w + r;
    const size_t token = (size_t)b * SEQ + tq;
    const bf16_t* base = A.proj + (size_t)b * SEQ * NP;
    bf16x8 qf[4]; load_qfrag<false>(qf, base + (size_t)tq * NP + C_QC + head * 64, nullptr, nullptr, 0.125f, hh);
    LAS unsigned* flags = (LAS unsigned*)(lds + NSA_SLAB);
    if (tid < 16) flags[tid] = 0u;
    f32x16 o0, o1;
#pragma unroll
    for (int i = 0; i < 16; ++i) { o0[i] = 0.f; o1[i] = 0.f; }
    float carry = 0.f; bool done = false;
    const bf16_t* kp = base + C_KC + head * 64; const bf16_t* vp = base + C_VC + head * 64;
#define STK_NEXT(c) ({ const LAS unsigned* f_ = flags + (par_ ^ 1) * 8; const unsigned ad_ = (f_[0] & f_[1]) & (f_[2] & f_[3]) & (f_[4] & f_[5]) & (f_[6] & f_[7]); ((c) > 0 && !ad_) ? (c) - 1 : -1; })
    KV_PIPELINE((T0 >> 6) + 3, STK_NEXT(cur), (KVSrc{kp, vp, NP, 64 * id, 0, SEQ}), false, nullptr,
        { if (!done && 64 * id <= T0 + 32 * w + 30) { stick_block(qf, o0, o1, carry, ksb, vtb, r, hh, tq, 64 * id); done = __all(carry > 104.f); }
          if (lane == 0) flags[par_ * 8 + w] = done ? 1u : 0u; });
    float ss = 0.f;
#pragma unroll
    for (int i = 0; i < 16; ++i) ss += o0[i] * o0[i] + o1[i] * o1[i];
    ss = sum32(ss);
    const float rs = rsqrtf(ss * (1.f / 64.f) + EPS); const float* go = A.g_out + 512 + head * 64; bf16_t* dst = A.groups + token * DM + 512 + head * 64;
#pragma unroll
    for (int g = 0; g < 4; ++g) { const int d0 = 8 * g + 4 * hh;
        u32x2 wa; wa.x = cvtpk(o0[4 * g] * rs * go[d0], o0[4 * g + 1] * rs * go[d0 + 1]); wa.y = cvtpk(o0[4 * g + 2] * rs * go[d0 + 2], o0[4 * g + 3] * rs * go[d0 + 3]); *(u32x2*)(dst + d0) = wa;
        u32x2 wb; wb.x = cvtpk(o1[4 * g] * rs * go[32 + d0], o1[4 * g + 1] * rs * go[32 + d0 + 1]); wb.y = cvtpk(o1[4 * g + 2] * rs * go[32 + d0 + 2], o1[4 * g + 3] * rs * go[32 + d0 + 3]); *(u32x2*)(dst + 32 + d0) = wb; }
    __syncthreads();
}

struct CmpArgs { const bf16_t* proj; const bf16_t* w1t; const bf16_t* w2t; const float* cb; const float* g_kc; bf16_t* kcn; bf16_t* vcc; };
constexpr int HIDB = 528;
__device__ __forceinline__ void compress_item(const CmpArgs& A, int item, LAS unsigned char* lds, int tid) {
    asm volatile("" : "+v"(tid));
    const int kv = item >> 6, rt = item & 63, b = rt >> 3, j0 = (rt & 7) * 32;
    const int lane = tid & 63, w = __builtin_amdgcn_readfirstlane(tid >> 6), r = lane & 31, hh = lane >> 5;
    { const bf16_t* xsrc = A.proj + (size_t)b * SEQ * NP + (kv ? C_VCA : C_KCA);
      u32x4 stg[9];
#pragma unroll
      for (int q = 0; q < 9; ++q) { const int e2 = tid + 512 * q, t = e2 >> 3, c = e2 & 7; int tk = 16 * j0 + t; tk = tk < SEQ ? tk : SEQ - 1;
          if (e2 < 528 * 8) stg[q] = *(const u32x4*)(xsrc + (size_t)tk * NP + 8 * c); }
#pragma unroll
      for (int q = 0; q < 9; ++q) { const int e2 = tid + 512 * q, t = e2 >> 3, c = e2 & 7;
          if (e2 < 528 * 8) *(LAS u32x4*)(lds + (t ^ ((t >> 7) & 1)) * 128 + ((c ^ ((t >> 4) & 7)) * 16)) = stg[q]; } }
    __syncthreads();
    const bf16_t* wf = A.w1t + (size_t)kv * 256 * 2048 + ((size_t)w * 128 * 64 + lane) * 8;
    f32x16 acc;
#pragma unroll
    for (int i = 0; i < 16; ++i) acc[i] = 0.f;
#pragma unroll 8
    for (int pos = 0; pos < 32; ++pos) { const int t = 16 * r + pos; LAS const unsigned char* arow = lds + (t ^ ((t >> 7) & 1)) * 128; const int sw = (t >> 4) & 7;
#pragma unroll
        for (int q = 0; q < 4; ++q) { const bf16x8 af = *(LAS const bf16x8*)(arow + (((2 * q + hh) ^ sw) * 16)), bfr = *(const bf16x8*)(wf + (size_t)(4 * pos + q) * 512); acc = MFMA32(af, bfr, acc); } }
    __syncthreads();
    { const float bias = A.cb[kv * 256 + 32 * w + r];
#pragma unroll
      for (int i = 0; i < 16; ++i) { const float x = acc[i] + bias; const float hv = 0.5f * x * (1.f + tanhf(0.7978845608028654f * (x + 0.044715f * x * x * x)));
          *(LAS unsigned short*)(lds + crow(i, hh) * HIDB + (32 * w + r) * 2) = (unsigned short)(cvtpk(hv, hv) & 0xffffu); } }
    __syncthreads();
    if (w == 0) {
        f32x16 c0, c1;
#pragma unroll
        for (int i = 0; i < 16; ++i) { c0[i] = 0.f; c1[i] = 0.f; }
        const bf16_t* w2a = A.w2t + ((size_t)kv * 64 + r) * 256 + 8 * hh; const bf16_t* w2b = w2a + 32 * 256;
#pragma unroll
        for (int s = 0; s < 16; ++s) { const bf16x8 af = *(LAS const bf16x8*)(lds + r * HIDB + (16 * s + 8 * hh) * 2);
            c0 = MFMA32(af, *(const bf16x8*)(w2a + 16 * s), c0); c1 = MFMA32(af, *(const bf16x8*)(w2b + 16 * s), c1); }
        const float g0 = A.g_kc[r], g1 = A.g_kc[32 + r]; bf16_t* dst = (kv ? A.vcc : A.kcn) + ((size_t)b * 256 + j0) * 64;
#pragma unroll
        for (int i = 0; i < 16; ++i) { float v0 = c0[i], v1 = c1[i];
            if (!kv) { float ss = v0 * v0 + v1 * v1; ss += swz_f<1>(ss); ss += swz_f<2>(ss); ss += swz_f<4>(ss); ss += swz_f<8>(ss); ss += swz_f<16>(ss);
                const float rs = rsqrtf(ss * (1.f / 64.f) + EPS); v0 *= rs * g0; v1 *= rs * g1; }
            const int row = crow(i, hh);
            if (!kv) { dst[row * 64 + r] = (bf16_t)(cvtpk(v0, v0) & 0xffffu); dst[row * 64 + 32 + r] = (bf16_t)(cvtpk(v1, v1) & 0xffffu); }
            else { const int j = j0 + row; bf16_t* vt = A.vcc + ((size_t)b * 4 + (j >> 6)) * 4096 + (j & 63);
                vt[(size_t)r * 64] = (bf16_t)(cvtpk(v0, v0) & 0xffffu); vt[(size_t)(32 + r) * 64] = (bf16_t)(cvtpk(v1, v1) & 0xffffu); } }
    }
    __syncthreads();
}
#define RLX_AGENT __ATOMIC_RELAXED, __HIP_MEMORY_SCOPE_AGENT
#define XB_TMO      128
#define XB_XCNT(j)  (256  + 64 * (j))
#define XB_XSUB(j)  (1280 + 64 * (j))
#define XB_XGEN(j)  (2304 + 64 * (j))
#define XB_TOP      3328
#define XB_TOPGEN   3392
#define XCD_BAR_WORDS 3456
#define XB_SPIN_CAP (1u << 18)

__device__ __forceinline__ unsigned xb_ld(unsigned* p)              { return __hip_atomic_load(p, __ATOMIC_RELAXED, __HIP_MEMORY_SCOPE_AGENT); }
__device__ __forceinline__ unsigned xb_add(unsigned* p, unsigned v) { return __hip_atomic_fetch_add(p, v, __ATOMIC_RELAXED, __HIP_MEMORY_SCOPE_AGENT); }
__device__ __forceinline__ unsigned xb_xcc_id() { return (unsigned)__builtin_amdgcn_s_getreg((3 << 11) | 20) & 0xFu; }
#define XB_SPIN(cond, bar) do { unsigned _sp = 0; while (cond) { __builtin_amdgcn_s_sleep(1); \
    if ((++_sp & 255u) == 0u) { if (xb_ld(&(bar)[XB_TMO])) break; if (_sp > XB_SPIN_CAP) { atomicAdd(&(bar)[XB_TMO], 1u); break; } } } } while (0)

struct XcdBarrier {
    unsigned* bar; unsigned x;
    volatile LAS unsigned* st;
};

__device__ __forceinline__ XcdBarrier xcd_barrier_post(unsigned* bar, volatile LAS unsigned* st) {
    XcdBarrier b; b.bar = bar; b.x = xb_xcc_id(); b.st = st;
    if (threadIdx.x == 0) (void)xb_add(&bar[XB_XCNT(b.x)], 1u);
    return b;
}
__device__ __forceinline__ void xcd_barrier_complete(unsigned* bar, unsigned x, unsigned& nloc, unsigned& nx) {
    const unsigned G = gridDim.x * gridDim.y * gridDim.z;
    unsigned sum, cnt, mine, sp = 0u;
    for (;;) {
        sum = 0u; cnt = 0u; mine = 0u;
#pragma unroll
        for (unsigned j = 0; j < 16; ++j) { const unsigned c = xb_ld(&bar[XB_XCNT(j)]); sum += c; cnt += (c > 0u) ? 1u : 0u; mine = (j == x) ? c : mine; }
        if (sum == G) break;
        __builtin_amdgcn_s_sleep(1);
        if ((++sp & 255u) == 0u) { if (xb_ld(&bar[XB_TMO])) break; if (sp > XB_SPIN_CAP) { atomicAdd(&bar[XB_TMO], 1u); break; } }
    }
    nloc = mine > 0u ? mine : 1u; nx = cnt > 0u ? cnt : 1u;
}

__device__ __forceinline__ void xcd_barrier(const XcdBarrier& b) {
    asm volatile("s_waitcnt vmcnt(0)" ::: "memory");
    __syncthreads();
    if (threadIdx.x == 0) {
        unsigned* bar = b.bar;
        __builtin_amdgcn_s_waitcnt(0);
        unsigned nloc = b.st[0], nx = b.st[1];
        if (nloc == 0u) { xcd_barrier_complete(bar, b.x, nloc, nx); b.st[0] = nloc; b.st[1] = nx; }
        const unsigned old = xb_add(&bar[XB_XSUB(b.x)], 1u);
        const unsigned gen = old / nloc;
        if (old + 1u == (gen + 1u) * nloc) {
            __builtin_amdgcn_fence(__ATOMIC_RELEASE, "agent");
            asm volatile("s_waitcnt vmcnt(0)" ::: "memory");
            const unsigned og = xb_add(&bar[XB_TOP], 1u);
            const unsigned tg = og / nx;
            if (og + 1u == (tg + 1u) * nx) xb_add(&bar[XB_TOPGEN], 1u);
            else XB_SPIN(xb_ld(&bar[XB_TOPGEN]) == tg, bar);
            __builtin_amdgcn_fence(__ATOMIC_ACQUIRE, "agent");
            xb_add(&bar[XB_XGEN(b.x)], 1u);
            asm volatile("s_waitcnt vmcnt(0)" ::: "memory");
        } else {
            XB_SPIN(xb_ld(&bar[XB_XGEN(b.x)]) == gen, bar);
            __builtin_amdgcn_fence(__ATOMIC_ACQUIRE, "agent");
            asm volatile("s_waitcnt vmcnt(0)" ::: "memory");
        }
    }
    __syncthreads();
}

#ifndef REP_CMP
#define REP_CMP 1
#endif
#ifndef REP_STK
#define REP_STK 1
#endif
#ifndef REP_DIL
#define REP_DIL 1
#endif
#ifndef REP_NSA
#define REP_NSA 1
#endif
#ifndef REP_G1
#define REP_G1 1
#endif
#ifndef REP_G3
#define REP_G3 1
#endif
#ifndef REP_PRO
#define REP_PRO 1
#endif
#ifndef REP_PREP
#define REP_PREP 1
#endif
#ifndef RESID_BF16
#define RESID_BF16 1
#endif
#ifndef REP_CONV
#define REP_CONV 1
#endif
#ifndef REP_G2
#define REP_G2 1
#endif
#ifndef XSYNC
#define XSYNC 0
#endif
__global__ void __launch_bounds__(512, 2) fwd_kernel(Params p) {
    extern __shared__ __attribute__((aligned(16))) unsigned char lds_raw[];
    cg::grid_group grid = cg::this_grid();
    LAS unsigned char* lds = (LAS unsigned char*)lds_raw;
#define TID_SETUP() int tid = threadIdx.x; asm volatile("" : "+v"(tid)); const int lane = tid & 63, wave = __builtin_amdgcn_readfirstlane(tid >> 6), gw = blockIdx.x * 8 + wave; (void)lane; (void)gw
    const int G = gridDim.x, NGW = G * 8;
    unsigned char* ws = p.ws;
    volatile LAS unsigned* misc = (volatile LAS unsigned*)(lds + LDS_BYTES - 64);
    unsigned* barw = (unsigned*)(ws + WS_BAR);
    { int t0 = threadIdx.x; if (t0 < 2) misc[t0] = 0u;
      if (blockIdx.x == 0) for (int i = t0; i < XCD_BAR_WORDS; i += 512) barw[i] = 0u;
      __syncthreads(); }
    float* ss = (float*)(ws + WS_SS); bf16_t* kcn = (bf16_t*)(ws + WS_KCN); bf16_t* vcc = (bf16_t*)(ws + WS_VCC);
    bf16_t* xb = (bf16_t*)(ws + WS_XB); bf16_t* groups = (bf16_t*)(ws + WS_GR); bf16_t* proj = (bf16_t*)(ws + WS_PROJ); bf16_t* hbuf = proj;
    float* x1 = (float*)(ws + WS_X1); bf16_t* nkn = (bf16_t*)(ws + WS_X1); bf16_t* nvt = (bf16_t*)(ws + WS_X1 + 8 * MiB);
    bf16_t* dpo = (bf16_t*)((unsigned char*)p.out + DO_PO); float* dlse = (float*)((unsigned char*)p.out + DO_LSE);

#ifndef SKIP_PRO
    for (int rep_ = 0; rep_ < REP_PRO; ++rep_) { TID_SETUP(); prologue(p, lds, gw, NGW, wave, lane); }
#endif
    grid.sync();
    const XcdBarrier xbar = xcd_barrier_post(barw, misc);
    for (int xs_ = 0; xs_ < XSYNC; ++xs_) xcd_barrier(xbar);

    for (int l = 0; l < 2; ++l) {
        unsigned char* wl = ws + WS_W + (size_t)l * W_LAYER;
#ifndef SKIP_G1
        for (int rep_ = 0; rep_ < REP_G1; ++rep_)
        { pg8::Gemm g{xb, (const bf16_t*)(wl + W_IN), M, NP, DM}; pg8::StaticOrder S; S.init(M, NP, G, (int)blockIdx.x);
          EpiProj E{proj, ss + (size_t)(2 * l) * M};
          pg8::gemm_phase<EpiProj, pg8::StaticOrder, true, true>(lds, g, S, E); }
#endif
        xcd_barrier(xbar);
        {
            TID_SETUP();
            const float* g_out = p.in[17] + l * DM;
            {
              const CmpArgs CA{proj, (const bf16_t*)(ws + WS_W1T) + (size_t)l * 2 * 256 * 2048, (const bf16_t*)(ws + WS_W2T) + (size_t)l * 2 * 64 * 256, (const float*)(ws + WS_CB) + l * 512, p.in[5] + l * 64, kcn, vcc};
              const StickArgs SA{proj, groups, g_out}; const DilArgs DA{proj, dpo, dlse, p.in[15] + l * 64, p.in[16] + l * 64};
              volatile LAS int* slot = (volatile LAS int*)(lds + LDS_BYTES - 32);
              for (;;) { __syncthreads(); if (tid == 0) *slot = (int)atomicAdd(barw + 32 + 64 * l, 1u); __syncthreads(); const int it = *slot; if (it >= 128 + 512 + 1536 + 256 + 128) break;
                  if (it < 128) compress_item(CA, it, lds, tid); else if (it < 640) stick_item(SA, it - 128, lds, tid); else if (it < 2176) dil_item(DA, it - 640, lds, tid);
                  else if (it < 2432) { const int i0 = (it - 2176) * 64 + wave; conv_items<4>(proj, groups, p.in[14] + l * 768, g_out, i0, 8, lane); conv_items<4>(proj, groups, p.in[14] + l * 768, g_out, i0 + 32, 8, lane); }
                  else nsa_prep_item(proj, nkn, nvt, p.in[6] + l * 64, p.in[7] + l * 64, (it - 2432) * 8 + wave, lds + wave * 9216, lane); } }
        }
        xcd_barrier(xbar);
#ifndef SKIP_NSA
#ifndef SKIP_DIL
#endif
        for (int rep_ = 0; rep_ < REP_NSA; ++rep_)
        { TID_SETUP(); NsaArgs A{proj, groups, kcn, vcc, p.in[3] + l * 12, p.in[4] + l * 64, p.in[6] + l * 64, p.in[7] + l * 64, p.in[17] + l * DM, nkn, nvt};
          volatile LAS int* slot = (volatile LAS int*)(lds + LDS_BYTES - 32);
          for (;;) { __syncthreads(); if (tid == 0) *slot = (int)atomicAdd(barw + 64 * l, 1u); __syncthreads(); const int it = *slot; if (it >= 512 + 256) break;
              if (it < 512) nsa_item(A, it & 7, 63 - (it >> 3), lds, tid);
              else { const int i0 = (it - 512) * 64 + wave; dil_merge_items<4>(dpo, dlse, groups, p.in[17] + l * DM, i0, 8, lane); dil_merge_items<4>(dpo, dlse, groups, p.in[17] + l * DM, i0 + 32, 8, lane); } } }
#endif
        xcd_barrier(xbar);
#ifndef SKIP_G2
        { pg8::Gemm g{groups, (const bf16_t*)(wl + W_OUT), M, DM, DM}; pg8::StaticOrder S; S.init(M, DM, G, (int)blockIdx.x);
#if RESID_BF16
          EpiResid E{l == 0 ? p.in[0] : nullptr, xb, nullptr, xb, ss + (size_t)(2 * l + 1) * M};
#else
          EpiResid E{l == 0 ? p.in[0] : x1, nullptr, l == 0 ? x1 : p.out, xb, ss + (size_t)(2 * l + 1) * M};
#endif
          pg8::gemm_phase<EpiResid, pg8::StaticOrder, true, true>(lds, g, S, E);
          for (int rep_ = 1; rep_ < REP_G2; ++rep_) { E.ss = nullptr; pg8::gemm_phase<EpiResid, pg8::StaticOrder, true, true>(lds, g, S, E); } }
#endif
        xcd_barrier(xbar);
#ifndef SKIP_G3
        for (int rep_ = 0; rep_ < REP_G3; ++rep_)
        { pg8::Gemm g{xb, (const bf16_t*)(wl + W_GU), M, NGU, DM}; pg8::StaticOrder S; S.init(M, NGU, G, (int)blockIdx.x);
          EpiSwiGLU E{hbuf, ss + (size_t)(2 * l + 1) * M};
          pg8::gemm_phase<EpiSwiGLU, pg8::StaticOrder, true, true>(lds, g, S, E); }
#endif
        xcd_barrier(xbar);
#ifndef SKIP_G4
        { pg8::Gemm g{hbuf, (const bf16_t*)(wl + W_DN), M, DM, FF}; pg8::StaticOrder S; S.init(M, DM, G, (int)blockIdx.x);
          float* xio = l == 0 ? x1 : p.out;
#if RESID_BF16
          EpiResid E{nullptr, xb, l == 0 ? nullptr : p.out, l == 0 ? xb : nullptr, l == 0 ? ss + (size_t)2 * M : nullptr}; (void)xio;
#else
          EpiResid E{xio, nullptr, xio, l == 0 ? xb : nullptr, l == 0 ? ss + (size_t)2 * M : nullptr};
#endif
          pg8::gemm_phase<EpiResid, pg8::StaticOrder, true, true>(lds, g, S, E); }
#endif
        if (l == 0) xcd_barrier(xbar);
    }
}

extern "C" void kernel_launch(void* const* d_in, const int* in_sizes, int n_in, void* d_out, int out_size, void* d_ws, size_t ws_size, hipStream_t stream) {
    static int grid = 0;
    if (grid == 0) {
        if (n_in != 23 || out_size != M * DM || ws_size < WS_END) { fprintf(stderr, "kernel_launch: unexpected shapes (n_in %d, out %d, ws %zu)\n", n_in, out_size, ws_size); grid = -1; return; }
        int dev = 0, cus = 0, per_cu = 0;
        (void)hipGetDevice(&dev); (void)hipDeviceGetAttribute(&cus, hipDeviceAttributeMultiprocessorCount, dev);
        if (hipFuncSetAttribute((const void*)fwd_kernel, hipFuncAttributeMaxDynamicSharedMemorySize, LDS_BYTES) != hipSuccess) { fprintf(stderr, "kernel_launch: hipFuncSetAttribute failed\n"); grid = -1; return; }
        if (hipOccupancyMaxActiveBlocksPerMultiprocessor(&per_cu, (const void*)fwd_kernel, 512, LDS_BYTES) != hipSuccess || per_cu < 1) per_cu = 1;
        (void)hipGetLastError();
        grid = cus * 1;
        (void)per_cu;
    }
    if (grid < 0) return;
    Params p{};
    for (int i = 0; i < 23; ++i) p.in[i] = (const float*)d_in[i];
    p.out = (float*)d_out; p.ws = (unsigned char*)d_ws;
    void* args[] = {&p};
    hipError_t e = hipLaunchCooperativeKernel((const void*)fwd_kernel, dim3(grid), dim3(512), args, LDS_BYTES, stream);
    if (e != hipSuccess) fprintf(stderr, "cooperative launch failed: %s (grid %d)\n", hipGetErrorString(e), grid);
}
```

```cpp
#include <hip/hip_runtime.h>
#include <hip/hip_cooperative_groups.h>
#include <cstdio>
#include <cstdint>
namespace cg = cooperative_groups;
namespace pg8 {
#define PG8_LAS __attribute__((address_space(3)))
typedef unsigned short bf16_t;
typedef short bf16x8 __attribute__((ext_vector_type(8)));
typedef float f32x4 __attribute__((ext_vector_type(4)));
typedef unsigned u32x4 __attribute__((ext_vector_type(4)));
constexpr int BM = 256, BK = 64, HALF = 128, HTB = HALF * BK * 2  , STAGE_BYTES = 8 * HTB, NXCD = 8, WGM = 8;

__host__ __device__ __forceinline__ int lds_byte(int r, int c) { const int st = (r >> 4) * 2 + (c >> 5), rr = r & 15, cc = c & 31, ob = rr * 64 + cc * 2; return st * 1024 + (ob ^ (((ob >> 9) & 1) << 5)); }
__host__ __device__ __forceinline__ void stage_rc(int b, int& R, int& C) { const int st = b / 1024, sb = b % 1024, swz = sb ^ (((sb >> 9) & 1) << 5); R = (st >> 1) * 16 + swz / 64; C = (st & 1) * 32 + (swz % 64) / 2; }
__host__ __device__ __forceinline__ int perm32(int rho) { const int n = rho >> 4, i = rho & 15; return 8 * (i >> 2) + 4 * n + (i & 3); }

struct Unit { int pm, pn; };
struct Gemm { const bf16_t* A; const bf16_t* Bt; int M, N, K; };

struct StaticOrder {
    int nM, nN, nwg, G, c;
    __host__ __device__ void init(int M, int N, int G_, int c_) { nM = M / BM; nN = N / BM; nwg = nM * nN; G = G_; c = c_; }
    __host__ __device__ bool next(int i, Unit& u) const {
        const long L = (long)i * G + c; if (L >= nwg) return false;
        int wgid = (int)L; { const int q = nwg / NXCD, r = nwg % NXCD, xcd = wgid % NXCD, off = wgid / NXCD; wgid = (xcd < r ? xcd * (q + 1) : r * (q + 1) + (xcd - r) * q) + off; }
        const int nig = WGM * nN, gid = wgid / nig, fm = gid * WGM, gsz = (nM - fm) < WGM ? (nM - fm) : WGM;
        u.pm = fm + ((wgid % nig) % gsz); u.pn = (wgid % nig) / gsz; return true;
    }
    __device__ __forceinline__ void a_ready(const Unit&) const {}
    __device__ __forceinline__ void done(const Unit&) const {}
};

__device__ __forceinline__ unsigned cvt_pk_bf16(float lo, float hi) { unsigned r; asm volatile("v_cvt_pk_bf16_f32 %0, %1, %2" : "=v"(r) : "v"(lo), "v"(hi)); return r; }
template <class Epi, class Sched, bool ALIGN_EPI = false, bool SP2 = false>
__device__ __forceinline__ void gemm_phase(PG8_LAS unsigned char* lds, const Gemm g, const Sched& S, const Epi& E) {
    int tid_l = threadIdx.x; asm volatile("" : "+v"(tid_l));
    const int tid = tid_l, wid = __builtin_amdgcn_readfirstlane(tid >> 6), lane = tid & 63, wr = wid >> 2, wc = wid & 3, fr = lane & 15, fq = lane >> 4;
    const int K = g.K, nt = K / BK;
    unsigned voffA[2], voffB[2];
#pragma unroll
    for (int i = 0; i < 2; ++i) { int R, C; stage_rc(tid * 16 + i * 8192, R, C); const int Rb = Epi::PERM ? ((R & ~31) + perm32(R & 31)) : R;
        voffA[i] = (unsigned)(R * K + C) * 2u; voffB[i] = (unsigned)(Rb * K + C) * 2u; }
    const size_t kstep = (size_t)(BK * 2);
    const size_t hstep = (size_t)HALF * K * 2;
    const size_t tstep = 2 * hstep;
    const unsigned ldsw = (unsigned)wid * 1024u;
    const int aoff = lds_byte(wr * 64 + fr, fq * 8), boff = lds_byte(wc * 32 + fr, fq * 8);
#define PG8_SA(b, h) (((b) * 2 + (h)) * HTB)
#define PG8_SB(b, h) ((4 + (b) * 2 + (h)) * HTB)
#define PG8_STAGE(bufoff, gbase, voff) do { _Pragma("unroll") for (int _i = 0; _i < 2; ++_i) \
        __builtin_amdgcn_global_load_lds((const unsigned*)((const char*)(gbase) + (voff)[_i]), (PG8_LAS unsigned*)(lds + (bufoff) + ldsw + _i * 8192), 16, 0, 0); } while (0)
#define PG8_LDA(dst, b, h) do { _Pragma("unroll") for (int m = 0; m < 4; ++m) _Pragma("unroll") for (int k = 0; k < 2; ++k) dst[m][k] = *(const PG8_LAS bf16x8*)(lds + PG8_SA(b, h) + aoff + m * 2048 + k * 1024); } while (0)
#define PG8_LDB(dst, b, h) do { _Pragma("unroll") for (int n = 0; n < 2; ++n) _Pragma("unroll") for (int k = 0; k < 2; ++k) dst[n][k] = *(const PG8_LAS bf16x8*)(lds + PG8_SB(b, h) + boff + n * 2048 + k * 1024); } while (0)
#define PG8_MMA(ai, bj, At, Bt) do { __builtin_amdgcn_s_setprio(1); _Pragma("unroll") for (int m = 0; m < 4; ++m) _Pragma("unroll") for (int n = 0; n < 2; ++n) _Pragma("unroll") for (int k = 0; k < 2; ++k) \
        acc[ai][bj][m][n] = __builtin_amdgcn_mfma_f32_16x16x32_bf16(Bt[n][k], At[m][k], acc[ai][bj][m][n], 0, 0, 0); __builtin_amdgcn_s_setprio(0); } while (0)
#define PG8_WAIT_V(n) asm volatile("s_waitcnt vmcnt(" #n ")" ::: "memory")
#define PG8_WAIT_L(n) asm volatile("s_waitcnt lgkmcnt(" #n ")" ::: "memory")
#define PG8_BAR __builtin_amdgcn_s_barrier()
#define PG8_SCHED __builtin_amdgcn_sched_barrier(0)
    Unit cur, nxt; int ui = 0;
    if (!S.next(0, cur)) return;
    f32x4 acc[2][2][4][2];
#pragma unroll
    for (int a = 0; a < 2; ++a)
#pragma unroll
        for (int b = 0; b < 2; ++b)
#pragma unroll
            for (int m = 0; m < 4; ++m)
#pragma unroll
                for (int n = 0; n < 2; ++n) acc[a][b][m][n] = (f32x4){0.f, 0.f, 0.f, 0.f};
    bf16x8 At[4][2], B0[2][2], B1[2][2];
    const char* cA = (const char*)g.A + (size_t)cur.pm * tstep; const char* cB = (const char*)g.Bt + (size_t)cur.pn * tstep;
    S.a_ready(cur);
    if constexpr (SP2) {
        PG8_STAGE(PG8_SB(0, 0), cB, voffB); PG8_STAGE(PG8_SB(0, 1), cB + hstep, voffB); PG8_STAGE(PG8_SA(0, 0), cA, voffA); PG8_STAGE(PG8_SA(0, 1), cA + hstep, voffA);
        if (wr == 1) PG8_BAR;
        PG8_WAIT_V(2); PG8_BAR;
        PG8_STAGE(PG8_SB(1, 0), cB + kstep, voffB); PG8_STAGE(PG8_SA(1, 0), cA + kstep, voffA); PG8_STAGE(PG8_SB(1, 1), cB + hstep + kstep, voffB);
        PG8_WAIT_V(6); PG8_BAR;
    } else {
        PG8_STAGE(PG8_SB(0, 0), cB, voffB); PG8_STAGE(PG8_SA(0, 0), cA, voffA); PG8_STAGE(PG8_SB(0, 1), cB + hstep, voffB); PG8_STAGE(PG8_SA(0, 1), cA + hstep, voffA);
        if (wr == 1) PG8_BAR;
        PG8_WAIT_V(4); PG8_BAR;
        PG8_STAGE(PG8_SB(1, 0), cB + kstep, voffB); PG8_STAGE(PG8_SA(1, 0), cA + kstep, voffA); PG8_STAGE(PG8_SB(1, 1), cB + hstep + kstep, voffB);
        PG8_WAIT_V(6); PG8_BAR;
    }
    for (;;) {
        const bool has_next = S.next(ui + 1, nxt);
        const char* nA = has_next ? (const char*)g.A + (size_t)nxt.pm * tstep : cA; const char* nB = has_next ? (const char*)g.Bt + (size_t)nxt.pn * tstep : cB;
        for (int t = 0; t < nt; t += 2) {
            const bool last = (t == nt - 2);
            const char* a1 = cA + (size_t)(t + 1) * kstep;
            const char* a2 = last ? nA : cA + (size_t)(t + 2) * kstep; const char* b2 = last ? nB : cB + (size_t)(t + 2) * kstep;
            const char* a3 = a2 + kstep; const char* b3 = b2 + kstep;
            if (last && has_next) S.a_ready(nxt);
            if constexpr (SP2) {
            PG8_LDB(B0, 0, 0); PG8_LDB(B1, 0, 1); PG8_SCHED; PG8_LDA(At, 0, 0); PG8_STAGE(PG8_SA(1, 1), a1 + hstep, voffA);
            PG8_WAIT_V(8); PG8_WAIT_L(0); PG8_BAR; PG8_MMA(0, 0, At, B0); PG8_MMA(0, 1, At, B1); PG8_BAR; PG8_SCHED;
            PG8_LDA(At, 0, 1); PG8_STAGE(PG8_SB(0, 0), b2, voffB); PG8_STAGE(PG8_SB(0, 1), b2 + hstep, voffB); PG8_STAGE(PG8_SA(0, 0), a2, voffA);
            PG8_WAIT_V(8); PG8_WAIT_L(0); PG8_BAR; PG8_MMA(1, 0, At, B0); PG8_MMA(1, 1, At, B1); PG8_BAR; PG8_SCHED;
            PG8_LDB(B0, 1, 0); PG8_LDB(B1, 1, 1); PG8_SCHED; PG8_LDA(At, 1, 0); PG8_STAGE(PG8_SA(0, 1), a2 + hstep, voffA);
            PG8_WAIT_V(8); PG8_WAIT_L(0); PG8_BAR; PG8_MMA(0, 0, At, B0); PG8_MMA(0, 1, At, B1); PG8_BAR; PG8_SCHED;
            PG8_LDA(At, 1, 1); PG8_STAGE(PG8_SB(1, 0), b3, voffB); PG8_STAGE(PG8_SB(1, 1), b3 + hstep, voffB); PG8_STAGE(PG8_SA(1, 0), a3, voffA);
            PG8_WAIT_V(8); PG8_WAIT_L(0); PG8_BAR; PG8_MMA(1, 0, At, B0); PG8_MMA(1, 1, At, B1); PG8_BAR; PG8_SCHED;
            } else {
            PG8_LDB(B0, 0, 0); PG8_SCHED; PG8_LDA(At, 0, 0); PG8_STAGE(PG8_SA(1, 1), a1 + hstep, voffA);
            PG8_WAIT_L(8); PG8_BAR; PG8_WAIT_L(0); PG8_MMA(0, 0, At, B0); PG8_BAR; PG8_SCHED;
            PG8_LDB(B1, 0, 1); PG8_STAGE(PG8_SB(0, 0), b2, voffB);
            PG8_BAR; PG8_WAIT_L(0); PG8_MMA(0, 1, At, B1); PG8_BAR;
            PG8_LDA(At, 0, 1); PG8_STAGE(PG8_SA(0, 0), a2, voffA);
            PG8_BAR; PG8_WAIT_L(0); PG8_MMA(1, 0, At, B0); PG8_BAR; PG8_SCHED;
            PG8_STAGE(PG8_SB(0, 1), b2 + hstep, voffB);
            PG8_WAIT_V(6); PG8_BAR; PG8_MMA(1, 1, At, B1); PG8_BAR;
            PG8_LDB(B0, 1, 0); PG8_SCHED; PG8_LDA(At, 1, 0); PG8_STAGE(PG8_SA(0, 1), a2 + hstep, voffA);
            PG8_WAIT_L(8); PG8_BAR; PG8_WAIT_L(0); PG8_MMA(0, 0, At, B0); PG8_BAR; PG8_SCHED;
            PG8_LDB(B1, 1, 1); PG8_STAGE(PG8_SB(1, 0), b3, voffB);
            PG8_BAR; PG8_WAIT_L(0); PG8_MMA(0, 1, At, B1); PG8_BAR;
            PG8_LDA(At, 1, 1); PG8_STAGE(PG8_SA(1, 0), a3, voffA);
            PG8_BAR; PG8_WAIT_L(0); PG8_MMA(1, 0, At, B0); PG8_BAR; PG8_SCHED;
            PG8_STAGE(PG8_SB(1, 1), b3 + hstep, voffB);
            PG8_WAIT_V(6); PG8_BAR; PG8_MMA(1, 1, At, B1); PG8_BAR;
            }
        }
        if constexpr (ALIGN_EPI) { if (wr == 0) PG8_BAR; }
        if constexpr (!Epi::AFTER_DRAIN) { E(acc, cur, wr, wc, fr, fq); S.done(cur); }
        if (!has_next) break;
#pragma unroll
        for (int a = 0; a < 2; ++a)
#pragma unroll
            for (int b = 0; b < 2; ++b)
#pragma unroll
                for (int m = 0; m < 4; ++m)
#pragma unroll
                    for (int n = 0; n < 2; ++n) acc[a][b][m][n] = (f32x4){0.f, 0.f, 0.f, 0.f};
        cur = nxt; cA = nA; cB = nB; ++ui;
        if constexpr (ALIGN_EPI) { if (wr == 1) PG8_BAR; }
    }
    PG8_WAIT_V(0);
    if constexpr (!ALIGN_EPI) { if (wr == 0) PG8_BAR; }
    PG8_BAR;
    if constexpr (Epi::AFTER_DRAIN) { E.fused(acc, cur, wr, wc, fr, fq, lds, wid, lane); S.done(cur); }
#undef PG8_SA
#undef PG8_SB
#undef PG8_STAGE
#undef PG8_LDA
#undef PG8_LDB
#undef PG8_MMA
#undef PG8_WAIT_V
#undef PG8_WAIT_L
#undef PG8_BAR
#undef PG8_SCHED
}
}

typedef unsigned short bf16_t;
typedef unsigned u32x4 __attribute__((ext_vector_type(4)));
typedef unsigned u32x2 __attribute__((ext_vector_type(2)));
typedef float f32x4 __attribute__((ext_vector_type(4)));
#define LAS __attribute__((address_space(3)))

constexpr int NB = 8, SEQ = 4096, M = NB * SEQ, DM = 1024, NP = 3072, FF = 2816, NGU = 2 * FF, INC = 2956;
constexpr int C_QA = 0, C_KCA = 256, C_VCA = 320, C_KSA = 384, C_VSA = 448, C_KWA = 512, C_VWA = 576, C_CVB = 640, C_CVC = 896, C_CVU = 1152,
              C_QC = 1408, C_KC = 1664, C_VC = 1920, C_QD = 2176, C_KD = 2432, C_VD = 2688, C_GT = 2944;
constexpr float EPS = 1e-6f;
constexpr size_t MiB = 1u << 20;
constexpr size_t WS_SS = 0, WS_KCN = 1 * MiB, WS_VCC = 1 * MiB + 512 * 1024, WS_W = 2 * MiB;
constexpr size_t W_IN = 0, W_OUT = 6 * MiB, W_GU = 8 * MiB, W_DN = 19 * MiB, W_LAYER = 24 * MiB + 512 * 1024;
constexpr size_t WS_XB = 52 * MiB, WS_GR = 116 * MiB, WS_PROJ = 180 * MiB, WS_X1 = 372 * MiB, WS_W1T = 500 * MiB, WS_W2T = 504 * MiB, WS_CB = 504 * MiB + 256 * 1024, WS_BAR = 504 * MiB + 512 * 1024, WS_END = 505 * MiB;
constexpr size_t DO_PO = 0, DO_LSE = 48 * MiB;
constexpr int LDS_BYTES = 143360;

struct Params { const float* in[23]; float* out; unsigned char* ws; };

__device__ __forceinline__ float blo(unsigned u) { return __uint_as_float(u << 16); }
__device__ __forceinline__ float bhi(unsigned u) { return __uint_as_float(u & 0xffff0000u); }
__device__ __forceinline__ float bf2f(bf16_t h) { return __uint_as_float((unsigned)h << 16); }
__device__ __forceinline__ unsigned pk2(float lo, float hi) { return pg8::cvt_pk_bf16(lo, hi); }
template <int K> __device__ __forceinline__ unsigned swz_u(unsigned v) { return (unsigned)__builtin_amdgcn_ds_swizzle((int)v, (K << 10) | 0x1f); }
template <int K> __device__ __forceinline__ float swz_f(float v) { return __uint_as_float(swz_u<K>(__float_as_uint(v))); }
__device__ __forceinline__ float sum32(float v) { auto rr = __builtin_amdgcn_permlane32_swap(__float_as_uint(v), __float_as_uint(v), false, false); return __uint_as_float(rr[0]) + __uint_as_float(rr[1]); }
__device__ __forceinline__ float max32(float v) { auto rr = __builtin_amdgcn_permlane32_swap(__float_as_uint(v), __float_as_uint(v), false, false); return fmaxf(__uint_as_float(rr[0]), __uint_as_float(rr[1])); }
__device__ __forceinline__ unsigned or32(unsigned v) { auto rr = __builtin_amdgcn_permlane32_swap(v, v, false, false); return rr[0] | rr[1]; }
__device__ __forceinline__ float partner32(float v, int hh) { auto rr = __builtin_amdgcn_permlane32_swap(__float_as_uint(v), __float_as_uint(v), false, false); return __uint_as_float(hh ? rr[0] : rr[1]); }
__device__ __forceinline__ float wave_sum(float v) {
    v += swz_f<1>(v); v += swz_f<2>(v); v += swz_f<4>(v); v += swz_f<8>(v); v += swz_f<16>(v); return sum32(v);
}
#define LDS_WAIT() asm volatile("s_waitcnt lgkmcnt(0)" ::: "memory")
#define CFENCE() asm volatile("" ::: "memory")

struct EpiProj {
    static constexpr bool PERM = true, AFTER_DRAIN = false;
    bf16_t* O; const float* ss;
    __device__ __forceinline__ void operator()(const pg8::f32x4 (&acc)[2][2][4][2], const pg8::Unit& u, int wr, int wc, int fr, int fq) const {
        const int row0 = u.pm * 256 + wr * 64 + fr, col0 = u.pn * 256 + wc * 32 + 8 * fq;
#pragma unroll
        for (int ai = 0; ai < 2; ++ai)
#pragma unroll
            for (int m = 0; m < 4; ++m) {
                const int row = row0 + ai * 128 + m * 16; const float rs = rsqrtf(ss[row] * (1.f / DM) + EPS);
                bf16_t* rowp = O + (size_t)row * NP + col0;
#pragma unroll
                for (int bj = 0; bj < 2; ++bj) { const pg8::f32x4 v0 = acc[ai][bj][m][0] * rs, v1 = acc[ai][bj][m][1] * rs;
                    u32x4 w; w.x = pk2(v0[0], v0[1]); w.y = pk2(v0[2], v0[3]); w.z = pk2(v1[0], v1[1]); w.w = pk2(v1[2], v1[3]);
                    *(u32x4*)(rowp + bj * 128) = w; }
            }
    }
};
struct EpiSwiGLU {
    static constexpr bool PERM = true, AFTER_DRAIN = false;
    bf16_t* H; const float* ss;
    __device__ __forceinline__ void operator()(const pg8::f32x4 (&acc)[2][2][4][2], const pg8::Unit& u, int wr, int wc, int fr, int fq) const {
        const int row0 = u.pm * 256 + wr * 64 + fr, col0 = u.pn * 128 + wc * 32 + 8 * fq;
#pragma unroll
        for (int ai = 0; ai < 2; ++ai)
#pragma unroll
            for (int m = 0; m < 4; ++m) {
                const int row = row0 + ai * 128 + m * 16; const float rs = rsqrtf(ss[row] * (1.f / DM) + EPS);
                float hv[8];
#pragma unroll
                for (int n = 0; n < 2; ++n)
#pragma unroll
                    for (int j = 0; j < 4; ++j) { const float g = acc[ai][0][m][n][j] * rs, up = acc[ai][1][m][n][j] * rs;
                        hv[4 * n + j] = g * up / (1.f + __expf(-g)); }
                u32x4 w; w.x = pk2(hv[0], hv[1]); w.y = pk2(hv[2], hv[3]); w.z = pk2(hv[4], hv[5]); w.w = pk2(hv[6], hv[7]);
                *(u32x4*)(H + (size_t)row * FF + col0) = w;
            }
    }
};
struct EpiResid {
    static constexpr bool PERM = true, AFTER_DRAIN = false;
    const float* xin; const bf16_t* xin_b; float* xout; bf16_t* xb; float* ss;
    __device__ __forceinline__ void operator()(const pg8::f32x4 (&acc)[2][2][4][2], const pg8::Unit& u, int wr, int wc, int fr, int fq) const {
        const int row0 = u.pm * 256 + wr * 64 + fr, col0 = u.pn * 256 + wc * 32 + 8 * fq;
#pragma unroll
        for (int ai = 0; ai < 2; ++ai)
#pragma unroll
            for (int m = 0; m < 4; ++m) {
                const int row = row0 + ai * 128 + m * 16; const size_t off = (size_t)row * DM + col0; float sq = 0.f;
#pragma unroll
                for (int bj = 0; bj < 2; ++bj) { const size_t o = off + bj * 128; f32x4 xa, xc;
                    if (xin) { xa = *(const f32x4*)(xin + o); xc = *(const f32x4*)(xin + o + 4); }
                    else { const u32x4 r4 = *(const u32x4*)(xin_b + o); xa[0] = blo(r4.x); xa[1] = bhi(r4.x); xa[2] = blo(r4.y); xa[3] = bhi(r4.y); xc[0] = blo(r4.z); xc[1] = bhi(r4.z); xc[2] = blo(r4.w); xc[3] = bhi(r4.w); }
                    f32x4 va, vc;
                    va[0] = xa[0] + acc[ai][bj][m][0][0]; va[1] = xa[1] + acc[ai][bj][m][0][1]; va[2] = xa[2] + acc[ai][bj][m][0][2]; va[3] = xa[3] + acc[ai][bj][m][0][3];
                    vc[0] = xc[0] + acc[ai][bj][m][1][0]; vc[1] = xc[1] + acc[ai][bj][m][1][1]; vc[2] = xc[2] + acc[ai][bj][m][1][2]; vc[3] = xc[3] + acc[ai][bj][m][1][3];
                    if (xout) { *(f32x4*)(xout + o) = va; *(f32x4*)(xout + o + 4) = vc; }
                    if (xb) { u32x4 w; w.x = pk2(va[0], va[1]); w.y = pk2(va[2], va[3]); w.z = pk2(vc[0], vc[1]); w.w = pk2(vc[2], vc[3]); *(u32x4*)(xb + o) = w; }
                    sq += ((va[0] * va[0] + va[1] * va[1]) + (va[2] * va[2] + va[3] * va[3])) + ((vc[0] * vc[0] + vc[1] * vc[1]) + (vc[2] * vc[2] + vc[3] * vc[3])); }
                if (ss) { sq += swz_f<16>(sq); sq = sum32(sq); if (fq == 0) atomicAdd(ss + row, sq); }
            }
    }
};

#ifndef REP_PW
#define REP_PW 1
#endif
#ifndef REP_PC
#define REP_PC 1
#endif
#ifndef REP_PX
#define REP_PX 1
#endif
template <int MAP> __device__ __forceinline__ int dst_row(int c) {
    if (MAP == 0) return c < 640 ? c : (c < 652 ? 2944 + (c - 640) : c - 12);
    if (MAP == 1) return c;
    if (MAP == 2) return 256 * (c >> 7) + (c & 127);
    return 256 * (c >> 7) + 128 + (c & 127);
}
template <int MAP> __device__ __forceinline__ void transpose_item(const float* W, int K, int N, const float* gk, bf16_t* WT, LAS float* scr, int item, int lane) {
    const int nblk = (N + 63) / 64, kb = item / nblk, nb = item % nblk, k0 = 64 * kb, n0 = 64 * nb;
    const int nn = n0 + lane; const bool okn = nn < N;
#pragma unroll
    for (int i = 0; i < 64; ++i) { float v = okn ? W[(size_t)(k0 + i) * N + nn] : 0.f; if (gk) v *= gk[k0 + i]; scr[i * 65 + lane] = v; }
    LDS_WAIT();
    const int c = lane & 7;
#pragma unroll
    for (int j = 0; j < 8; ++j) { const int n = (lane >> 3) + 8 * j; const LAS float* s = scr + (8 * c) * 65 + n;
        if (n0 + n < N) { u32x4 o; o.x = pk2(s[0 * 65], s[1 * 65]); o.y = pk2(s[2 * 65], s[3 * 65]); o.z = pk2(s[4 * 65], s[5 * 65]); o.w = pk2(s[6 * 65], s[7 * 65]);
            if (MAP == 4) { const int nn2 = n0 + n, kk2 = k0 + 8 * c; *(u32x4*)(WT + ((size_t)(((nn2 >> 5) * (K >> 4) + (kk2 >> 4)) * 64 + ((kk2 >> 3) & 1) * 32 + (nn2 & 31)) * 8)) = o; }
            else *(u32x4*)(WT + (size_t)dst_row<MAP>(n0 + n) * K + k0 + 8 * c) = o; } }
    LDS_WAIT();
}
__device__ __forceinline__ void prologue(const Params& p, LAS unsigned char* lds, int gw, int NGW, int wave, int lane) {
    LAS float* scr = (LAS float*)(lds + wave * 16640);
    constexpr int I_IN = 16 * 47, I_OUT = 16 * 16, I_G = 16 * 44, I_DN = 44 * 16, I_L = I_IN + I_OUT + 2 * I_G + I_DN, I_Z = 116;
    for (int rw_ = 0; rw_ < REP_PW; ++rw_)
    for (int it = gw; it < 2 * (I_L + I_Z); it += NGW) {
        const int l = it / (I_L + I_Z); int r = it % (I_L + I_Z);
        unsigned char* wl = p.ws + WS_W + (size_t)l * W_LAYER;
        if (r < I_IN) { transpose_item<0>(p.in[2] + (size_t)l * DM * INC, DM, INC, p.in[1] + l * DM, (bf16_t*)(wl + W_IN), scr, r, lane); continue; } r -= I_IN;
        if (r < I_OUT) { transpose_item<1>(p.in[18] + (size_t)l * DM * DM, DM, DM, nullptr, (bf16_t*)(wl + W_OUT), scr, r, lane); continue; } r -= I_OUT;
        if (r < I_G) { transpose_item<2>(p.in[20] + (size_t)l * DM * FF, DM, FF, p.in[19] + l * DM, (bf16_t*)(wl + W_GU), scr, r, lane); continue; } r -= I_G;
        if (r < I_G) { transpose_item<3>(p.in[21] + (size_t)l * DM * FF, DM, FF, p.in[19] + l * DM, (bf16_t*)(wl + W_GU), scr, r, lane); continue; } r -= I_G;
        if (r < I_DN) { transpose_item<1>(p.in[22] + (size_t)l * FF * DM, FF, DM, nullptr, (bf16_t*)(wl + W_DN), scr, r, lane); continue; } r -= I_DN;
        { u32x4 z = {0u, 0u, 0u, 0u}; u32x4* d = (u32x4*)((bf16_t*)(wl + W_IN) + (size_t)(INC + r) * DM) + lane * 2; d[0] = z; d[1] = z; }
    }
    for (int rc_ = 0; rc_ < REP_PC; ++rc_)
    for (int it = gw; it < 4 * (128 + 4 + 32); it += NGW) {
        const int mi = it / 164, r = it % 164, l = mi >> 1, kv = mi & 1;
        const float* w1 = p.in[kv ? 12 : 10] + (size_t)l * 2048 * 256; const float* w2 = p.in[kv ? 13 : 11] + (size_t)l * 256 * 64; const float* pe = p.in[kv ? 9 : 8] + l * 2048;
        if (r < 128) transpose_item<4>(w1, 2048, 256, nullptr, (bf16_t*)(p.ws + WS_W1T) + (size_t)mi * 256 * 2048, scr, r, lane);
        else if (r < 132) transpose_item<1>(w2, 256, 64, nullptr, (bf16_t*)(p.ws + WS_W2T) + (size_t)mi * 64 * 256, scr, r - 128, lane);
        else { const int c = (r - 132) * 8 + (lane & 7), rg = lane >> 3; float acc = 0.f;
#pragma unroll 32
            for (int i = rg * 256; i < rg * 256 + 256; ++i) acc += pe[i] * w1[(size_t)i * 256 + c];
            acc += swz_f<8>(acc); acc += swz_f<16>(acc); acc = sum32(acc);
            if (rg == 0) ((float*)(p.ws + WS_CB))[mi * 256 + c] = acc; }
    }
    float* ss = (float*)(p.ws + WS_SS); bf16_t* xb = (bf16_t*)(p.ws + WS_XB);
    for (int rx_ = 0; rx_ < REP_PX; ++rx_)
    for (int m0 = gw; m0 < M; m0 += 4 * NGW) {
        f32x4 v[4][4];
#pragma unroll
        for (int rr = 0; rr < 4; ++rr) { const int m = m0 + rr * NGW; const f32x4* xr = (const f32x4*)(p.in[0] + (size_t)(m < M ? m : 0) * DM) + lane;
#pragma unroll
            for (int j = 0; j < 4; ++j) v[rr][j] = xr[64 * j]; }
#pragma unroll
        for (int rr = 0; rr < 4; ++rr) { const int m = m0 + rr * NGW; if (m < M) { u32x2* o8 = (u32x2*)(xb + (size_t)m * DM) + lane; float s = 0.f;
#pragma unroll
            for (int j = 0; j < 4; ++j) { const f32x4 t = v[rr][j]; s += (t[0] * t[0] + t[1] * t[1]) + (t[2] * t[2] + t[3] * t[3]); u32x2 w; w.x = pk2(t[0], t[1]); w.y = pk2(t[2], t[3]); o8[64 * j] = w; }
            s = wave_sum(s);
            if (lane == 0) { ss[m] = s; ss[M + m] = 0.f; ss[2 * M + m] = 0.f; ss[3 * M + m] = 0.f; } } }
    }
}

#define UNPACK8(v, k) const float k##0 = blo(v.x), k##1 = bhi(v.x), k##2 = blo(v.y), k##3 = bhi(v.y), k##4 = blo(v.z), k##5 = bhi(v.z), k##6 = blo(v.w), k##7 = bhi(v.w)
__device__ __forceinline__ void load_row64(float (&q)[64], const bf16_t* p) {
#pragma unroll
    for (int c = 0; c < 8; ++c) { const u32x4 v = *(const u32x4*)(p + 8 * c); UNPACK8(v, k);
        q[8 * c] = k0; q[8 * c + 1] = k1; q[8 * c + 2] = k2; q[8 * c + 3] = k3; q[8 * c + 4] = k4; q[8 * c + 5] = k5; q[8 * c + 6] = k6; q[8 * c + 7] = k7; }
}
template <bool SS> __device__ __forceinline__ float dot_row(const float (&q)[64], const bf16_t* p, float& kss) {
    float z = 0.f, s = 0.f;
#pragma unroll
    for (int c = 0; c < 8; ++c) { const u32x4 v = *(const u32x4*)(p + 8 * c); UNPACK8(v, k);
        z += (q[8 * c] * k0 + q[8 * c + 1] * k1) + (q[8 * c + 2] * k2 + q[8 * c + 3] * k3) + (q[8 * c + 4] * k4 + q[8 * c + 5] * k5) + (q[8 * c + 6] * k6 + q[8 * c + 7] * k7);
        if (SS) s += (k0 * k0 + k1 * k1) + (k2 * k2 + k3 * k3) + (k4 * k4 + k5 * k5) + (k6 * k6 + k7 * k7);
        if (c == 3) CFENCE(); }
    kss = s; return z;
}
__device__ __forceinline__ void axpy_row(float (&o)[64], float w, const bf16_t* p) {
#pragma unroll
    for (int c = 0; c < 8; ++c) { const u32x4 v = *(const u32x4*)(p + 8 * c); UNPACK8(v, k);
        o[8 * c] += w * k0; o[8 * c + 1] += w * k1; o[8 * c + 2] += w * k2; o[8 * c + 3] += w * k3; o[8 * c + 4] += w * k4; o[8 * c + 5] += w * k5; o[8 * c + 6] += w * k6; o[8 * c + 7] += w * k7;
        if (c == 3) CFENCE(); }
}
__device__ __forceinline__ float dot_row_f32(const float (&q)[64], const float* p) {
    float z = 0.f;
#pragma unroll
    for (int c = 0; c < 16; ++c) { const f32x4 v = *(const f32x4*)(p + 4 * c); z += (q[4 * c] * v[0] + q[4 * c + 1] * v[1]) + (q[4 * c + 2] * v[2] + q[4 * c + 3] * v[3]); if (c == 7) CFENCE(); }
    return z;
}
__device__ __forceinline__ void axpy_row_f32(float (&o)[64], float w, const float* p) {
#pragma unroll
    for (int c = 0; c < 16; ++c) { const f32x4 v = *(const f32x4*)(p + 4 * c); o[4 * c] += w * v[0]; o[4 * c + 1] += w * v[1]; o[4 * c + 2] += w * v[2]; o[4 * c + 3] += w * v[3]; if (c == 7) CFENCE(); }
}
__device__ __forceinline__ void store_group(const float (&o)[64], const float* g, bf16_t* dst) {
    float ss = 0.f;
#pragma unroll
    for (int d = 0; d < 64; ++d) ss += o[d] * o[d];
    const float rs = rsqrtf(ss * (1.f / 64.f) + EPS);
#pragma unroll
    for (int c = 0; c < 8; ++c) { u32x4 w;
        w.x = pk2(o[8 * c] * rs * g[8 * c], o[8 * c + 1] * rs * g[8 * c + 1]); w.y = pk2(o[8 * c + 2] * rs * g[8 * c + 2], o[8 * c + 3] * rs * g[8 * c + 3]);
        w.z = pk2(o[8 * c + 4] * rs * g[8 * c + 4], o[8 * c + 5] * rs * g[8 * c + 5]); w.w = pk2(o[8 * c + 6] * rs * g[8 * c + 6], o[8 * c + 7] * rs * g[8 * c + 7]);
        *(u32x4*)(dst + 8 * c) = w; }
}
__device__ __forceinline__ void load_q_norm(float (&q)[64], const bf16_t* p, const float* gq, const float* gx) {
    load_row64(q, p); float ss = 0.f;
#pragma unroll
    for (int d = 0; d < 64; ++d) ss += q[d] * q[d];
    const float rs = rsqrtf(ss * (1.f / 64.f) + EPS) * 0.125f;
#pragma unroll
    for (int d = 0; d < 64; ++d) q[d] = q[d] * rs * gq[d] * (gx ? gx[d] : 1.f);
}

__device__ __forceinline__ void stick_naive(const bf16_t* proj, bf16_t* groups, const float* g_out, int item, int lane) {
    const int tile = item & 63, h = (item >> 6) & 3, b = item >> 8, t = tile * 64 + lane;
    const bf16_t* base = proj + (size_t)b * SEQ * NP;
    float q[64]; load_row64(q, base + (size_t)t * NP + C_QC + h * 64);
#pragma unroll
    for (int d = 0; d < 64; ++d) q[d] *= 0.125f;
    float o[64];
#pragma unroll
    for (int d = 0; d < 64; ++d) o[d] = 0.f;
    float between = 0.f;
    for (int s = tile * 64 + 62; s >= 0; --s) {
        const bf16_t* kr = base + (size_t)s * NP + C_KC + h * 64; float dummy;
        const float z = dot_row<false>(q, kr, dummy); CFENCE();
        const bool act = s < t;
        const float sp = fmaxf(z, 0.f) + __logf(1.f + __expf(-fabsf(z)));
        const float w = act ? __expf((z - sp) - between) : 0.f;
        axpy_row(o, w, base + (size_t)s * NP + C_VC + h * 64); CFENCE();
        between += act ? sp : 0.f;
        if (s < tile * 64 && __all(between > 104.f)) break;
    }
    store_group(o, g_out + 512 + h * 64, groups + (size_t)(b * SEQ + t) * DM + 512 + h * 64);
}

__device__ __forceinline__ void dil_naive(const bf16_t* proj, bf16_t* groups, const float* gq, const float* gk, const float* g_out, int item, int lane) {
    const int tile = item & 63, h = (item >> 6) & 3, b = item >> 8, t = tile * 64 + lane;
    const bf16_t* base = proj + (size_t)b * SEQ * NP;
    float q[64]; load_q_norm(q, base + (size_t)t * NP + C_QD + h * 64, gq, gk);
    const float slope = exp2f(-(float)(2 * h + 2));
    float o[64];
#pragma unroll
    for (int d = 0; d < 64; ++d) o[d] = 0.f;
    float mx = -1e30f, l = 0.f;
    for (int cfg = 0; cfg < 3; ++cfg) {
        const int dil = cfg == 0 ? 1 : (cfg == 1 ? 4 : 16);
        for (int j = 0; j <= 128; ++j) {
            const int s = t - j * dil; const bool act = s >= 0;
            if (!__any(act)) break;
            if (act) {
                float kss; const float z = dot_row<true>(q, base + (size_t)s * NP + C_KD + h * 64, kss); CFENCE();
                const float sc = z * rsqrtf(kss * (1.f / 64.f) + EPS) - slope * (float)(j * dil);
                if (sc > mx) { const float corr = __expf(mx - sc); l *= corr;
#pragma unroll
                    for (int d = 0; d < 64; ++d) o[d] *= corr;
                    mx = sc; }
                const float pw = __expf(sc - mx); l += pw;
                axpy_row(o, pw, base + (size_t)s * NP + C_VD + h * 64); CFENCE();
            }
        }
    }
    const float inv = 1.f / l;
#pragma unroll
    for (int d = 0; d < 64; ++d) o[d] *= inv;
    store_group(o, g_out + 768 + h * 64, groups + (size_t)(b * SEQ + t) * DM + 768 + h * 64);
}

template <int NI> __device__ __forceinline__ void conv_items(const bf16_t* proj, bf16_t* groups, const float* cw, const float* g_out, int item0, int stride, int lane) {
    const int ch = (lane & 31) * 8;
    u32x4 cv[NI][3], uv[NI][3], bv[NI];
#pragma unroll
    for (int n = 0; n < NI; ++n) { const int token = (item0 + n * stride) * 2 + (lane >> 5), tpos = token & (SEQ - 1); const bf16_t* row = proj + (size_t)token * NP;
#pragma unroll
        for (int k = 0; k < 3; ++k) { const int back = 2 - k;
            if (tpos >= back) { cv[n][k] = *(const u32x4*)(row - (size_t)back * NP + C_CVC + ch); uv[n][k] = *(const u32x4*)(row - (size_t)back * NP + C_CVU + ch); }
            else { cv[n][k] = (u32x4){0u, 0u, 0u, 0u}; uv[n][k] = cv[n][k]; } }
        bv[n] = *(const u32x4*)(row + C_CVB + ch); }
    float wk[3][8];
#pragma unroll
    for (int k = 0; k < 3; ++k)
#pragma unroll
        for (int i = 0; i < 8; ++i) wk[k][i] = cw[k * 256 + ch + i];
    const float* go = g_out + 256 + ch;
#pragma unroll
    for (int n = 0; n < NI; ++n) { const int token = (item0 + n * stride) * 2 + (lane >> 5);
        float acc[8];
#pragma unroll
        for (int i = 0; i < 8; ++i) acc[i] = 0.f;
#pragma unroll
        for (int k = 0; k < 3; ++k) { UNPACK8(cv[n][k], c); UNPACK8(uv[n][k], u);
            acc[0] += wk[k][0] * (c0 * u0); acc[1] += wk[k][1] * (c1 * u1); acc[2] += wk[k][2] * (c2 * u2); acc[3] += wk[k][3] * (c3 * u3);
            acc[4] += wk[k][4] * (c4 * u4); acc[5] += wk[k][5] * (c5 * u5); acc[6] += wk[k][6] * (c6 * u6); acc[7] += wk[k][7] * (c7 * u7); }
        UNPACK8(bv[n], g);
        float y[8] = {g0 * acc[0], g1 * acc[1], g2 * acc[2], g3 * acc[3], g4 * acc[4], g5 * acc[5], g6 * acc[6], g7 * acc[7]};
        float ss = 0.f;
#pragma unroll
        for (int i = 0; i < 8; ++i) ss += y[i] * y[i];
        ss += swz_f<1>(ss); ss += swz_f<2>(ss); ss += swz_f<4>(ss);
        const float rs = rsqrtf(ss * (1.f / 64.f) + EPS);
        u32x4 w; w.x = pk2(y[0] * rs * go[0], y[1] * rs * go[1]); w.y = pk2(y[2] * rs * go[2], y[3] * rs * go[3]);
        w.z = pk2(y[4] * rs * go[4], y[5] * rs * go[5]); w.w = pk2(y[6] * rs * go[6], y[7] * rs * go[7]);
        *(u32x4*)(groups + (size_t)token * DM + 256 + ch) = w; }
}

typedef short bf16x8 __attribute__((ext_vector_type(8)));
typedef short s16x4 __attribute__((ext_vector_type(4)));
typedef float f32x16 __attribute__((ext_vector_type(16)));
typedef float f32x2_t __attribute__((ext_vector_type(2)));
typedef __bf16 bf16x2_t __attribute__((ext_vector_type(2)));
__device__ __forceinline__ unsigned cvtpk(float lo, float hi) { f32x2_t v = {lo, hi}; bf16x2_t b = __builtin_convertvector(v, bf16x2_t); return __builtin_bit_cast(unsigned, b); }
#define MFMA32(a, b, c) __builtin_amdgcn_mfma_f32_32x32x16_bf16((a), (b), (c), 0, 0, 0)
#define EXP2(x) __builtin_amdgcn_exp2f(x)
constexpr float LOG2E = 1.4426950408889634f;
constexpr int KSB = 144, VTB = 136, KS_BYTES = 64 * KSB, VT_BYTES = 64 * VTB;
__device__ __forceinline__ int crow(int i, int h) { return (i & 3) + 8 * (i >> 2) + 4 * h; }

struct KVSrc { const bf16_t* k; const bf16_t* v; long pitch; int first, lo, hi; };
__device__ __forceinline__ void kv_fetch(const KVSrc& s, int tid, u32x4& kc, u32x4& vc) {
    const int kl = tid >> 3, ch = tid & 7, i = s.first + kl;
    if (i >= s.lo && i < s.hi) { kc = *(const u32x4*)(s.k + (long)i * s.pitch + 8 * ch); vc = *(const u32x4*)(s.v + (long)i * s.pitch + 8 * ch); }
    else { kc = (u32x4){0u, 0u, 0u, 0u}; vc = kc; }
}
template <bool NORM> __device__ __forceinline__ void kv_store(u32x4 kc, u32x4 vc, const float (&g)[8], LAS unsigned char* ksb, LAS unsigned char* vtb, int tid) {
    const int kl = tid >> 3, ch = tid & 7;
    if (NORM) { UNPACK8(kc, k); float ss = (k0 * k0 + k1 * k1) + (k2 * k2 + k3 * k3) + (k4 * k4 + k5 * k5) + (k6 * k6 + k7 * k7);
        ss += swz_f<1>(ss); ss += swz_f<2>(ss); ss += swz_f<4>(ss);
        const float rs = rsqrtf(ss * (1.f / 64.f) + EPS);
        kc.x = cvtpk(k0 * rs * g[0], k1 * rs * g[1]); kc.y = cvtpk(k2 * rs * g[2], k3 * rs * g[3]); kc.z = cvtpk(k4 * rs * g[4], k5 * rs * g[5]); kc.w = cvtpk(k6 * rs * g[6], k7 * rs * g[7]); }
    *(LAS u32x4*)(ksb + kl * KSB + ch * 16) = kc;
    LAS unsigned short* vp = (LAS unsigned short*)(vtb + (8 * ch) * VTB + kl * 2);
    vp[0 * (VTB / 2)] = (unsigned short)(vc.x & 0xffffu); vp[1 * (VTB / 2)] = (unsigned short)(vc.x >> 16);
    vp[2 * (VTB / 2)] = (unsigned short)(vc.y & 0xffffu); vp[3 * (VTB / 2)] = (unsigned short)(vc.y >> 16);
    vp[4 * (VTB / 2)] = (unsigned short)(vc.z & 0xffffu); vp[5 * (VTB / 2)] = (unsigned short)(vc.z >> 16);
    vp[6 * (VTB / 2)] = (unsigned short)(vc.w & 0xffffu); vp[7 * (VTB / 2)] = (unsigned short)(vc.w >> 16);
}
template <bool NORM> __device__ __forceinline__ void load_qfrag(bf16x8 (&qf)[4], const bf16_t* qrow, const float* g1, const float* g2, float sc, int hh) {
    float f[32];
#pragma unroll
    for (int s = 0; s < 4; ++s) { const u32x4 v = *(const u32x4*)(qrow + 16 * s + 8 * hh); UNPACK8(v, k);
        f[8 * s] = k0; f[8 * s + 1] = k1; f[8 * s + 2] = k2; f[8 * s + 3] = k3; f[8 * s + 4] = k4; f[8 * s + 5] = k5; f[8 * s + 6] = k6; f[8 * s + 7] = k7; }
    if (NORM) { float ss = 0.f;
#pragma unroll
        for (int i = 0; i < 32; ++i) ss += f[i] * f[i];
        ss = sum32(ss); sc *= rsqrtf(ss * (1.f / 64.f) + EPS); }
#pragma unroll
    for (int s = 0; s < 4; ++s) { float v[8];
#pragma unroll
        for (int j = 0; j < 8; ++j) { const int d = 16 * s + 8 * hh + j; v[j] = f[8 * s + j] * sc * (g1 ? g1[d] : 1.f) * (g2 ? g2[d] : 1.f); }
        u32x4 w; w.x = cvtpk(v[0], v[1]); w.y = cvtpk(v[2], v[3]); w.z = cvtpk(v[4], v[5]); w.w = cvtpk(v[6], v[7]);
        qf[s] = __builtin_bit_cast(bf16x8, w); }
}

struct SfCmp { int tq, nvis, j0; float slope; __device__ __forceinline__ float operator()(float s, int kl) const { const int j = j0 + kl; return j < nvis ? s - slope * (float)(tq - 16 * j - 31) : -INFINITY; } };
struct SfSlc { int tq, key0; float slope; bool sel; __device__ __forceinline__ float operator()(float s, int kl) const { const int key = key0 + kl; return (sel && key <= tq) ? s - slope * (float)(tq - key) : -INFINITY; } };
struct SfWin { int tq, key0; float slope; __device__ __forceinline__ float operator()(float s, int kl) const { const int key = key0 + kl; return (key <= tq && tq - key <= 511) ? s - slope * (float)(tq - key) : -INFINITY; } };

__device__ __forceinline__ void pv_accum(const f32x16& s0, const f32x16& s1, f32x16& o0, f32x16& o1, LAS const unsigned char* vtb, int r, int hh) {
    __builtin_amdgcn_s_setprio(1);
#pragma unroll
    for (int kt = 0; kt < 2; ++kt)
#pragma unroll
        for (int sp = 0; sp < 2; ++sp) { u32x4 w;
            if (kt == 0) { w.x = cvtpk(s0[8 * sp], s0[8 * sp + 1]); w.y = cvtpk(s0[8 * sp + 2], s0[8 * sp + 3]); w.z = cvtpk(s0[8 * sp + 4], s0[8 * sp + 5]); w.w = cvtpk(s0[8 * sp + 6], s0[8 * sp + 7]); }
            else         { w.x = cvtpk(s1[8 * sp], s1[8 * sp + 1]); w.y = cvtpk(s1[8 * sp + 2], s1[8 * sp + 3]); w.z = cvtpk(s1[8 * sp + 4], s1[8 * sp + 5]); w.w = cvtpk(s1[8 * sp + 6], s1[8 * sp + 7]); }
            const bf16x8 pb = __builtin_bit_cast(bf16x8, w); const int ko = 32 * kt + 16 * sp + 4 * hh;
            { const s16x4 lo = *(LAS const s16x4*)(vtb + r * VTB + ko * 2), hi = *(LAS const s16x4*)(vtb + r * VTB + (ko + 8) * 2);
              o0 = MFMA32(__builtin_shufflevector(lo, hi, 0, 1, 2, 3, 4, 5, 6, 7), pb, o0); }
            { const s16x4 lo = *(LAS const s16x4*)(vtb + (32 + r) * VTB + ko * 2), hi = *(LAS const s16x4*)(vtb + (32 + r) * VTB + (ko + 8) * 2);
              o1 = MFMA32(__builtin_shufflevector(lo, hi, 0, 1, 2, 3, 4, 5, 6, 7), pb, o1); } }
    __builtin_amdgcn_s_setprio(0);
}
template <int MODE, class SF>
__device__ __forceinline__ void attn_block(const bf16x8 (&qf)[4], f32x16& o0, f32x16& o1, float& m, float& l, LAS const unsigned char* ksb, LAS const unsigned char* vtb, int r, int hh, const SF sf,
                                           float msafe_f, float inv_f, LAS float* imprw, int nbase, float& carry) {
    f32x16 s0, s1;
#pragma unroll
    for (int i = 0; i < 16; ++i) { s0[i] = 0.f; s1[i] = 0.f; }
    bf16x8 ka[4], kb2[4];
#pragma unroll
    for (int s = 0; s < 4; ++s) { ka[s] = *(LAS const bf16x8*)(ksb + r * KSB + (16 * s + 8 * hh) * 2); kb2[s] = *(LAS const bf16x8*)(ksb + (32 + r) * KSB + (16 * s + 8 * hh) * 2); }
    __builtin_amdgcn_s_setprio(1);
#pragma unroll
    for (int s = 0; s < 4; ++s) { s0 = MFMA32(ka[s], qf[s], s0); s1 = MFMA32(kb2[s], qf[s], s1); }
    __builtin_amdgcn_s_setprio(0);
    __builtin_amdgcn_sched_barrier(0);
#pragma unroll
    for (int i = 0; i < 16; ++i) { s0[i] = sf(s0[i], crow(i, hh)); s1[i] = sf(s1[i], 32 + crow(i, hh)); }
    if (MODE != 2) {
        float mloc = fmaxf(s0[0], s1[0]);
#pragma unroll
        for (int i = 1; i < 16; ++i) mloc = fmaxf(mloc, fmaxf(s0[i], s1[i]));
        mloc = max32(mloc);
        const float mnew = fmaxf(m, mloc), msafe = mnew == -INFINITY ? 0.f : mnew, corr = EXP2(m - msafe);
        float psum = 0.f;
#pragma unroll
        for (int i = 0; i < 16; ++i) { s0[i] = EXP2(s0[i] - msafe); s1[i] = EXP2(s1[i] - msafe); psum += s0[i] + s1[i]; }
        psum = sum32(psum);
        l = l * corr + psum; m = mnew;
        if (MODE == 0 && !__all(corr == 1.f)) {
#pragma unroll
            for (int i = 0; i < 16; ++i) { o0[i] *= corr; o1[i] *= corr; } }
    } else {
#pragma unroll
        for (int i = 0; i < 16; ++i) { s0[i] = EXP2(s0[i] - msafe_f) * inv_f; s1[i] = EXP2(s1[i] - msafe_f) * inv_f; }
#pragma unroll
        for (int kt = 0; kt < 2; ++kt) { float A[4], T[4], R[4];
#pragma unroll
            for (int g = 0; g < 4; ++g) { const float p0 = kt ? s1[4 * g] : s0[4 * g], p1 = kt ? s1[4 * g + 1] : s0[4 * g + 1], p2 = kt ? s1[4 * g + 2] : s0[4 * g + 2], p3 = kt ? s1[4 * g + 3] : s0[4 * g + 3];
                A[g] = 2.f * ((p0 + p1) + p2) + p3; T[g] = p3; R[g] = partner32(p3, hh); }
#pragma unroll
            for (int g = 0; g < 4; ++g) { const float prev = hh ? R[g] : (g ? R[g - 1] : carry);
                imprw[nbase + 8 * kt + 2 * g + hh] = A[g] + prev; }
            carry = R[3]; (void)T; }
    }
    __builtin_amdgcn_sched_barrier(0);
    if (MODE != 1) pv_accum(s0, s1, o0, o1, vtb, r, hh);
}


__device__ __forceinline__ void attn_block_full(const bf16x8 (&qf)[4], f32x16& o0, f32x16& o1, float& m, float& l, LAS const unsigned char* ksb, LAS const unsigned char* vtb, int r, int hh, float b0, float sl) {
    f32x16 s0, s1;
#pragma unroll
    for (int i = 0; i < 16; ++i) { s0[i] = 0.f; s1[i] = 0.f; }
    bf16x8 ka[4], kb2[4];
#pragma unroll
    for (int s = 0; s < 4; ++s) { ka[s] = *(LAS const bf16x8*)(ksb + r * KSB + (16 * s + 8 * hh) * 2); kb2[s] = *(LAS const bf16x8*)(ksb + (32 + r) * KSB + (16 * s + 8 * hh) * 2); }
    __builtin_amdgcn_s_setprio(1);
#pragma unroll
    for (int s = 0; s < 4; ++s) { s0 = MFMA32(ka[s], qf[s], s0); s1 = MFMA32(kb2[s], qf[s], s1); }
    __builtin_amdgcn_s_setprio(0);
    __builtin_amdgcn_sched_barrier(0);
#pragma unroll
    for (int i = 0; i < 16; ++i) { const float c = (float)((i & 3) + 8 * (i >> 2)); s0[i] = fmaf(sl, c, s0[i]); s1[i] = fmaf(sl, c + 32.f, s1[i]); }
    float mloc = fmaxf(s0[0], s1[0]);
#pragma unroll
    for (int i = 1; i < 16; ++i) mloc = fmaxf(mloc, fmaxf(s0[i], s1[i]));
    mloc = max32(mloc + b0);
    const float mnew = fmaxf(m, mloc), msafe = mnew == -INFINITY ? 0.f : mnew, corr = EXP2(m - msafe), c0 = b0 - msafe;
    float psum = 0.f;
#pragma unroll
    for (int i = 0; i < 16; ++i) { s0[i] = EXP2(s0[i] + c0); s1[i] = EXP2(s1[i] + c0); psum += s0[i] + s1[i]; }
    psum = sum32(psum);
    l = l * corr + psum; m = mnew;
#pragma unroll
    for (int i = 0; i < 16; ++i) { o0[i] *= corr; o1[i] *= corr; }
    __builtin_amdgcn_sched_barrier(0);
    pv_accum(s0, s1, o0, o1, vtb, r, hh);
}

#define KV_PIPELINE(FIRST, NEXT, SRC, NORM, GAIN, ...) do { \
    __syncthreads(); \
    int nxt_ = (FIRST), par_ = 0; u32x4 kc_, vc_; float g8_[8]; \
    { const float* gp_ = (GAIN); _Pragma("unroll") for (int j_ = 0; j_ < 8; ++j_) g8_[j_] = gp_ ? gp_[8 * (tid & 7) + j_] : 1.f; } \
    if (nxt_ >= 0) { const int id = nxt_; const KVSrc src_ = SRC; kv_fetch(src_, tid, kc_, vc_); } \
    while (nxt_ >= 0) { const int cur_ = nxt_; \
        LAS unsigned char* ksb = lds + par_ * KS_BYTES; LAS unsigned char* vtb = lds + 2 * KS_BYTES + par_ * VT_BYTES; \
        kv_store<NORM>(kc_, vc_, g8_, ksb, vtb, tid); \
        __syncthreads(); \
        { const int cur = cur_; nxt_ = (NEXT); } \
        if (nxt_ >= 0) { const int id = nxt_; const KVSrc src_ = SRC; kv_fetch(src_, tid, kc_, vc_); } \
        { const int id = cur_; __VA_ARGS__; } \
        par_ ^= 1; } } while (0)


__device__ __forceinline__ void kv_store_pre(u32x4 kc, u32x4 vc, LAS unsigned char* ksb, LAS unsigned char* vtb, int tid) {
    *(LAS u32x4*)(ksb + (tid >> 3) * KSB + (tid & 7) * 16) = kc;
    LAS u32x2* vp = (LAS u32x2*)(vtb + (tid >> 3) * VTB + (tid & 7) * 16); u32x2 a = {vc.x, vc.y}, b2 = {vc.z, vc.w}; vp[0] = a; vp[1] = b2;
}
#define KV_PIPELINE_PRE(FIRST, NEXT, KTILE, VTILE, ...) do { \
    __syncthreads(); \
    int nxt_ = (FIRST), par_ = 0; u32x4 kc_, vc_; \
    if (nxt_ >= 0) { const int id = nxt_; kc_ = *(const u32x4*)((KTILE) + tid * 8); vc_ = *(const u32x4*)((VTILE) + tid * 8); } \
    while (nxt_ >= 0) { const int cur_ = nxt_; \
        LAS unsigned char* ksb = lds + par_ * KS_BYTES; LAS unsigned char* vtb = lds + 2 * KS_BYTES + par_ * VT_BYTES; \
        kv_store_pre(kc_, vc_, ksb, vtb, tid); \
        __syncthreads(); \
        { const int cur = cur_; nxt_ = (NEXT); } \
        if (nxt_ >= 0) { const int id = nxt_; kc_ = *(const u32x4*)((KTILE) + tid * 8); vc_ = *(const u32x4*)((VTILE) + tid * 8); } \
        { const int id = cur_; __VA_ARGS__; } \
        par_ ^= 1; } } while (0)

__device__ __forceinline__ void nsa_prep_item(const bf16_t* proj, bf16_t* kn, bf16_t* vtn, const float* g_ks, const float* g_kw, int item, LAS unsigned char* scr, int lane) {
    const int b = item >> 7, which = (item >> 6) & 1, n = item & 63, ch = lane & 7, row0 = lane >> 3;
    const bf16_t* src = proj + ((size_t)b * SEQ + 64 * n) * NP + (which ? C_KWA : C_KSA) + 8 * ch;
    const float* g = (which ? g_kw : g_ks) + 8 * ch;
    float gg[8];
#pragma unroll
    for (int i = 0; i < 8; ++i) gg[i] = g[i];
    u32x4 kc[8], vc[8];
#pragma unroll
    for (int j = 0; j < 8; ++j) { const bf16_t* rp = src + (size_t)(row0 + 8 * j) * NP; kc[j] = *(const u32x4*)rp; vc[j] = *(const u32x4*)(rp + 64); }
    bf16_t* kdst = kn + (((size_t)b * 2 + which) * SEQ + 64 * n) * 64 + 8 * ch;
#pragma unroll
    for (int j = 0; j < 8; ++j) { const int row = row0 + 8 * j; UNPACK8(kc[j], k);
        float ss = (k0 * k0 + k1 * k1) + (k2 * k2 + k3 * k3) + (k4 * k4 + k5 * k5) + (k6 * k6 + k7 * k7);
        ss += swz_f<1>(ss); ss += swz_f<2>(ss); ss += swz_f<4>(ss);
        const float rs = rsqrtf(ss * (1.f / 64.f) + EPS); u32x4 o;
        o.x = cvtpk(k0 * rs * gg[0], k1 * rs * gg[1]); o.y = cvtpk(k2 * rs * gg[2], k3 * rs * gg[3]); o.z = cvtpk(k4 * rs * gg[4], k5 * rs * gg[5]); o.w = cvtpk(k6 * rs * gg[6], k7 * rs * gg[7]);
        *(u32x4*)(kdst + (size_t)row * 64) = o;
        LAS unsigned short* vp = (LAS unsigned short*)(scr + (8 * ch) * 144 + row * 2); const u32x4 v = vc[j];
        vp[0 * 72] = (unsigned short)(v.x & 0xffffu); vp[1 * 72] = (unsigned short)(v.x >> 16); vp[2 * 72] = (unsigned short)(v.y & 0xffffu); vp[3 * 72] = (unsigned short)(v.y >> 16);
        vp[4 * 72] = (unsigned short)(v.z & 0xffffu); vp[5 * 72] = (unsigned short)(v.z >> 16); vp[6 * 72] = (unsigned short)(v.w & 0xffffu); vp[7 * 72] = (unsigned short)(v.w >> 16); }
    LDS_WAIT();
    bf16_t* vdst = vtn + ((((size_t)b * 2 + which) * 64 + n) * 64 + lane) * 64;
#pragma unroll
    for (int c = 0; c < 8; ++c) *(u32x4*)(vdst + 8 * c) = *(LAS const u32x4*)(scr + lane * 144 + 16 * c);
    LDS_WAIT();
}

struct NsaArgs { const bf16_t* proj; bf16_t* groups; const bf16_t *kcn, *vcc; const float *b_gate, *g_q, *g_ks, *g_kw, *g_out; const bf16_t *kn, *vtn; };
constexpr int NSA_SLAB = 2 * KS_BYTES + 2 * VT_BYTES, NSA_ISUM = NSA_SLAB + 4 * 64 * 65 * 4, NSA_MASK = NSA_ISUM + 64 * 65 * 4, NSA_UMASK = NSA_MASK + 512;
__device__ __forceinline__ void nsa_item(const NsaArgs& A, int b, int tl, LAS unsigned char* lds, int tid) {
    asm volatile("" : "+v"(tid));
    const int lane = tid & 63, w = __builtin_amdgcn_readfirstlane(tid >> 6), head = w & 3, half = w >> 2, r = lane & 31, hh = lane >> 5;
    const int tq = tl * 64 + 32 * half + r, tokl = 32 * half + r; const size_t token = (size_t)b * SEQ + tq;
    const bf16_t* base = A.proj + (size_t)b * SEQ * NP;
    LAS float* slab = (LAS float*)(lds + NSA_SLAB); LAS float* isum = (LAS float*)(lds + NSA_ISUM);
    LAS unsigned* masks = (LAS unsigned*)(lds + NSA_MASK); LAS unsigned* umask = (LAS unsigned*)(lds + NSA_UMASK);
    const float slope = exp2f(-(float)(2 * head + 1)) * LOG2E;
    bf16x8 qf[4]; load_qfrag<true>(qf, base + (size_t)tq * NP + C_QA + head * 64, A.g_q, nullptr, 0.125f * LOG2E, hh);
    float gl[3];
#pragma unroll
    for (int br = 0; br < 3; ++br) { const float x = bf2f(base[(size_t)tq * NP + C_GT + head * 3 + br]) + A.b_gate[head * 3 + br]; gl[br] = 1.f / (1.f + __expf(-x)); }
    f32x16 of0, of1, o0, o1;
#pragma unroll
    for (int i = 0; i < 16; ++i) { of0[i] = 0.f; of1[i] = 0.f; }
    float dummy = 0.f;
    {
        const int nbc = (tl >> 4) + 1, nvis = tq >= 31 ? ((tq - 31) >> 4) + 1 : 0;
        const bf16_t* kc = A.kcn + (size_t)b * 256 * 64; const bf16_t* vc = A.vcc + (size_t)b * 256 * 64;
        float m = -INFINITY, l = 0.f;
        KV_PIPELINE_PRE(0, (cur + 1 < nbc ? cur + 1 : -1), kc + (size_t)id * 4096, vc + (size_t)id * 4096,
            { const SfCmp sf{tq, nvis, 64 * id, slope}; attn_block<1>(qf, o0, o1, m, l, ksb, vtb, r, hh, sf, 0.f, 0.f, nullptr, 0, dummy); });
        const float inv = l > 0.f ? 1.f / l : 0.f, msafe = m == -INFINITY ? 0.f : m; float carry = 0.f;
#pragma unroll
        for (int i = 0; i < 16; ++i) { o0[i] = 0.f; o1[i] = 0.f; }
        LAS float* imprw = slab + (head * 64 + tokl) * 65;
        KV_PIPELINE_PRE(0, (cur + 1 < nbc ? cur + 1 : -1), kc + (size_t)id * 4096, vc + (size_t)id * 4096,
            { const SfCmp sf{tq, nvis, 64 * id, slope}; attn_block<2>(qf, o0, o1, m, l, ksb, vtb, r, hh, sf, msafe, inv, imprw, 16 * id, carry); });
#pragma unroll
        for (int i = 0; i < 16; ++i) { of0[i] += gl[0] * o0[i]; of1[i] += gl[0] * o1[i]; }
    }
    __syncthreads();
    if (tl > 15) {
        for (int e = tid; e < 64 * 64; e += 512) { const int tk = e >> 6, n = e & 63, o = tk * 65 + n; isum[o] = ((slab[o] + slab[64 * 65 + o]) + slab[2 * 64 * 65 + o]) + slab[3 * 64 * 65 + o]; }
        __syncthreads();
        const int tk = tid >> 3, sub = tid & 7; float v[8]; int cnt[8];
#pragma unroll
        for (int k = 0; k < 8; ++k) { v[k] = isum[tk * 65 + 8 * sub + k]; cnt[k] = 0; }
        for (int mm = 1; mm <= tl - 2; ++mm) { const float vm = isum[tk * 65 + mm];
#pragma unroll
            for (int k = 0; k < 8; ++k) cnt[k] += (vm > v[k] || (vm == v[k] && mm < 8 * sub + k)) ? 1 : 0; }
        unsigned bits = 0u;
#pragma unroll
        for (int k = 0; k < 8; ++k) { const int n = 8 * sub + k; if (n >= 1 && n <= tl - 2 && cnt[k] < 13) bits |= 1u << k; }
        unsigned lo = sub < 4 ? bits << (8 * sub) : 0u, hi = sub >= 4 ? bits << (8 * (sub - 4)) : 0u;
        lo |= swz_u<1>(lo); hi |= swz_u<1>(hi); lo |= swz_u<2>(lo); hi |= swz_u<2>(hi); lo |= swz_u<4>(lo); hi |= swz_u<4>(hi);
        const unsigned long long mk = ((unsigned long long)hi << 32 | lo) | 1ull | (3ull << (tl - 1));
        if (sub == 0) { masks[2 * tk] = (unsigned)mk; masks[2 * tk + 1] = (unsigned)(mk >> 32); }
    } else if (tid < 64) { const unsigned long long mk = (2ull << tl) - 1ull; masks[2 * tid] = (unsigned)mk; masks[2 * tid + 1] = (unsigned)(mk >> 32); }
    __syncthreads();
    if (tid < 64) { unsigned lo = masks[2 * tid], hi = masks[2 * tid + 1];
        lo |= swz_u<1>(lo); hi |= swz_u<1>(hi); lo |= swz_u<2>(lo); hi |= swz_u<2>(hi); lo |= swz_u<4>(lo); hi |= swz_u<4>(hi);
        lo |= swz_u<8>(lo); hi |= swz_u<8>(hi); lo |= swz_u<16>(lo); hi |= swz_u<16>(hi); lo = or32(lo); hi = or32(hi);
        if (tid == 0) { umask[0] = lo; umask[1] = hi; } }
    __syncthreads();
    const unsigned long long um = (unsigned long long)umask[1] << 32 | umask[0];
    const unsigned long long mymask = (unsigned long long)masks[2 * tokl + 1] << 32 | masks[2 * tokl];
    LAS float* park = slab + w * 2048 + lane;
#pragma unroll
    for (int i = 0; i < 16; ++i) { park[i * 64] = of0[i]; park[(16 + i) * 64] = of1[i]; }
    {
        float m = -INFINITY, l = 0.f;
#pragma unroll
        for (int i = 0; i < 16; ++i) { o0[i] = 0.f; o1[i] = 0.f; }
        const bf16_t* kp = A.kn + (size_t)(b * 2) * SEQ * 64; const bf16_t* vp = A.vtn + (size_t)(b * 2) * 64 * 4096;
#define NSA_NEXTBIT(c) ({ const unsigned long long rem_ = ((c) >= 63) ? 0ull : (um & ~((2ull << (c)) - 1ull)); rem_ ? (int)__builtin_ctzll(rem_) : -1; })
        KV_PIPELINE_PRE((int)__builtin_ctzll(um), NSA_NEXTBIT(cur), kp + (size_t)id * 4096, vp + (size_t)id * 4096,
            { const bool sel = (mymask >> id) & 1ull;
              if (__any(sel)) {
                  if (id < tl) attn_block_full(qf, o0, o1, m, l, ksb, vtb, r, hh, sel ? -slope * (float)(tq - 64 * id - 4 * hh) : -INFINITY, slope);
                  else { const SfSlc sf{tq, 64 * id, slope, sel}; attn_block<0>(qf, o0, o1, m, l, ksb, vtb, r, hh, sf, 0.f, 0.f, nullptr, 0, dummy); } } });
        const float sc = gl[1] / l;
#pragma unroll
        for (int i = 0; i < 16; ++i) { park[i * 64] += sc * o0[i]; park[(16 + i) * 64] += sc * o1[i]; }
    }
    {
        float m = -INFINITY, l = 0.f;
#pragma unroll
        for (int i = 0; i < 16; ++i) { o0[i] = 0.f; o1[i] = 0.f; }
        const bf16_t* kp = A.kn + (size_t)(b * 2 + 1) * SEQ * 64; const bf16_t* vp = A.vtn + (size_t)(b * 2 + 1) * 64 * 4096; const int nlo = tl >= 8 ? tl - 8 : 0;
        KV_PIPELINE_PRE(nlo, (cur + 1 <= tl ? cur + 1 : -1), kp + (size_t)id * 4096, vp + (size_t)id * 4096,
            { if (id < tl && id >= tl - 7) attn_block_full(qf, o0, o1, m, l, ksb, vtb, r, hh, -slope * (float)(tq - 64 * id - 4 * hh), slope);
              else { const SfWin sf{tq, 64 * id, slope}; attn_block<0>(qf, o0, o1, m, l, ksb, vtb, r, hh, sf, 0.f, 0.f, nullptr, 0, dummy); } });
        const float sc = gl[2] / l;
#pragma unroll
        for (int i = 0; i < 16; ++i) { of0[i] = park[i * 64] + sc * o0[i]; of1[i] = park[(16 + i) * 64] + sc * o1[i]; }
    }
    {
        float ss = 0.f;
#pragma unroll
        for (int i = 0; i < 16; ++i) ss += of0[i] * of0[i] + of1[i] * of1[i];
        ss = sum32(ss);
        const float rs = rsqrtf(ss * (1.f / 64.f) + EPS); const float* go = A.g_out + head * 64; bf16_t* dst = A.groups + token * DM + head * 64;
#pragma unroll
        for (int g = 0; g < 4; ++g) { const int d0 = 8 * g + 4 * hh;
            u32x2 wa; wa.x = cvtpk(of0[4 * g] * rs * go[d0], of0[4 * g + 1] * rs * go[d0 + 1]); wa.y = cvtpk(of0[4 * g + 2] * rs * go[d0 + 2], of0[4 * g + 3] * rs * go[d0 + 3]);
            *(u32x2*)(dst + d0) = wa;
            u32x2 wb; wb.x = cvtpk(of1[4 * g] * rs * go[32 + d0], of1[4 * g + 1] * rs * go[32 + d0 + 1]); wb.y = cvtpk(of1[4 * g + 2] * rs * go[32 + d0 + 2], of1[4 * g + 3] * rs * go[32 + d0 + 3]);
            *(u32x2*)(dst + 32 + d0) = wb; }
    }
    __syncthreads();
}

struct SfDil { int iq, key0; float sl; __device__ __forceinline__ float operator()(float s, int kl) const { const int df = iq - key0 - kl; return (df >= 0 && df <= 128) ? s - sl * (float)df : -INFINITY; } };
struct DilArgs { const bf16_t* proj; bf16_t* po; float* plse; const float *g_q, *g_k; };
__device__ __forceinline__ void dil_item(const DilArgs& A, int item, LAS unsigned char* lds, int tid) {
    asm volatile("" : "+v"(tid));
    const int cfg = item >> 9, rem = item & 511, b = rem >> 6, head = (rem >> 4) & 3, sub = rem & 15;
    const int dil = cfg == 0 ? 1 : (cfg == 1 ? 4 : 16), nq = 16 / dil, c = sub / nq, qt = sub % nq, i0 = 256 * qt, L = SEQ / dil;
    const int lane = tid & 63, w = __builtin_amdgcn_readfirstlane(tid >> 6), r = lane & 31, hh = lane >> 5;
    const int iq = i0 + 32 * w + r, tq = c + dil * iq; const size_t token = (size_t)b * SEQ + tq;
    const bf16_t* base = A.proj + (size_t)b * SEQ * NP;
    const float slope = exp2f(-(float)(2 * head + 2)) * (float)dil * LOG2E;
    bf16x8 qf[4]; load_qfrag<true>(qf, base + (size_t)tq * NP + C_QD + head * 64, A.g_q, nullptr, 0.125f * LOG2E, hh);
    const bf16_t* kp = base + (size_t)c * NP + C_KD + head * 64; const bf16_t* vp = base + (size_t)c * NP + C_VD + head * 64;
    const int kb_lo = (i0 >> 6) >= 2 ? (i0 >> 6) - 2 : 0, kb_hi = (i0 >> 6) + 3, q_lo = i0 + 32 * w;
    f32x16 o0, o1;
#pragma unroll
    for (int i = 0; i < 16; ++i) { o0[i] = 0.f; o1[i] = 0.f; }
    float m = -INFINITY, l = 0.f, dummy = 0.f;
    KV_PIPELINE(kb_lo, (cur + 1 <= kb_hi ? cur + 1 : -1), (KVSrc{kp, vp, (long)dil * NP, 64 * id, 0, L}), true, A.g_k,
        { if (64 * id + 63 >= q_lo - 128 && 64 * id <= q_lo + 31) { const SfDil sf{iq, 64 * id, slope}; attn_block<0>(qf, o0, o1, m, l, ksb, vtb, r, hh, sf, 0.f, 0.f, nullptr, 0, dummy); } });
    const float inv = 1.f / l;
    bf16_t* dst = A.po + ((size_t)cfg * M + token) * 256 + head * 64;
#pragma unroll
    for (int g = 0; g < 4; ++g) { const int d0 = 8 * g + 4 * hh;
        u32x2 wa; wa.x = cvtpk(o0[4 * g] * inv, o0[4 * g + 1] * inv); wa.y = cvtpk(o0[4 * g + 2] * inv, o0[4 * g + 3] * inv); *(u32x2*)(dst + d0) = wa;
        u32x2 wb; wb.x = cvtpk(o1[4 * g] * inv, o1[4 * g + 1] * inv); wb.y = cvtpk(o1[4 * g + 2] * inv, o1[4 * g + 3] * inv); *(u32x2*)(dst + 32 + d0) = wb; }
    if (hh == 0) A.plse[((size_t)cfg * M + token) * 4 + head] = m + __log2f(l);
    __syncthreads();
}
template <int NI> __device__ __forceinline__ void dil_merge_items(const bf16_t* po, const float* plse, bf16_t* groups, const float* g_out, int item0, int stride, int lane) {
    const int pair = lane >> 3, ch = lane & 7, head = pair & 3;
    u32x4 pv[NI][3]; float ls[NI][3];
#pragma unroll
    for (int n = 0; n < NI; ++n) { const size_t token = (size_t)(item0 + n * stride) * 2 + (pair >> 2);
#pragma unroll
        for (int i = 0; i < 3; ++i) { ls[n][i] = plse[((size_t)i * M + token) * 4 + head]; pv[n][i] = *(const u32x4*)(po + ((size_t)i * M + token) * 256 + head * 64 + 8 * ch); } }
    const float* go = g_out + 768 + head * 64 + 8 * ch;
#pragma unroll
    for (int n = 0; n < NI; ++n) { const size_t token = (size_t)(item0 + n * stride) * 2 + (pair >> 2);
        const float mx = fmaxf(ls[n][0], fmaxf(ls[n][1], ls[n][2]));
        const float w0 = EXP2(ls[n][0] - mx), w1 = EXP2(ls[n][1] - mx), w2 = EXP2(ls[n][2] - mx), winv = 1.f / (w0 + w1 + w2);
        float o[8];
#pragma unroll
        for (int j = 0; j < 8; ++j) o[j] = 0.f;
#pragma unroll
        for (int i = 0; i < 3; ++i) { UNPACK8(pv[n][i], k); const float wi = (i == 0 ? w0 : (i == 1 ? w1 : w2)) * winv;
            o[0] += wi * k0; o[1] += wi * k1; o[2] += wi * k2; o[3] += wi * k3; o[4] += wi * k4; o[5] += wi * k5; o[6] += wi * k6; o[7] += wi * k7; }
        float ss = 0.f;
#pragma unroll
        for (int j = 0; j < 8; ++j) ss += o[j] * o[j];
        ss += swz_f<1>(ss); ss += swz_f<2>(ss); ss += swz_f<4>(ss);
        const float rs = rsqrtf(ss * (1.f / 64.f) + EPS);
        u32x4 wv; wv.x = cvtpk(o[0] * rs * go[0], o[1] * rs * go[1]); wv.y = cvtpk(o[2] * rs * go[2], o[3] * rs * go[3]); wv.z = cvtpk(o[4] * rs * go[4], o[5] * rs * go[5]); wv.w = cvtpk(o[6] * rs * go[6], o[7] * rs * go[7]);
        *(u32x4*)(groups + token * DM + 768 + head * 64 + 8 * ch) = wv; }
}

__device__ __forceinline__ void stick_block(const bf16x8 (&qf)[4], f32x16& o0, f32x16& o1, float& carry, LAS const unsigned char* ksb, LAS const unsigned char* vtb, int r, int hh, int tq, int key0) {
    f32x16 s0, s1;
#pragma unroll
    for (int i = 0; i < 16; ++i) { s0[i] = 0.f; s1[i] = 0.f; }
    bf16x8 ka[4], kb2[4];
#pragma unroll
    for (int s = 0; s < 4; ++s) { ka[s] = *(LAS const bf16x8*)(ksb + r * KSB + (16 * s + 8 * hh) * 2); kb2[s] = *(LAS const bf16x8*)(ksb + (32 + r) * KSB + (16 * s + 8 * hh) * 2); }
    __builtin_amdgcn_s_setprio(1);
#pragma unroll
    for (int s = 0; s < 4; ++s) { s0 = MFMA32(ka[s], qf[s], s0); s1 = MFMA32(kb2[s], qf[s], s1); }
    __builtin_amdgcn_s_setprio(0);
    __builtin_amdgcn_sched_barrier(0);
    float acc = carry;
#pragma unroll
    for (int kti = 0; kti < 2; ++kti) { const int kt = 1 - kti; float spm[16], G[4], R[4];
#pragma unroll
        for (int i = 0; i < 16; ++i) { const float z = kt ? s1[i] : s0[i]; const bool act = key0 + 32 * kt + crow(i, hh) < tq;
            const float sp = fmaxf(z, 0.f) + __logf(1.f + __expf(-fabsf(z)));
            spm[i] = act ? sp : 0.f; const float lw = act ? z - sp : -INFINITY; if (kt) s1[i] = lw; else s0[i] = lw; }
#pragma unroll
        for (int g = 0; g < 4; ++g) { G[g] = (spm[4 * g] + spm[4 * g + 1]) + (spm[4 * g + 2] + spm[4 * g + 3]); R[g] = partner32(G[g], hh); }
#pragma unroll
        for (int gi = 0; gi < 4; ++gi) { const int g = 3 - gi; float run = acc + (hh ? 0.f : R[g]);
#pragma unroll
            for (int ki = 0; ki < 4; ++ki) { const int i = 4 * g + 3 - ki; const float lw = kt ? s1[i] : s0[i]; const float wv = __expf(lw - run); if (kt) s1[i] = wv; else s0[i] = wv; run += spm[i]; }
            acc += G[g] + R[g]; } }
    carry = acc;
    __builtin_amdgcn_sched_barrier(0);
    pv_accum(s0, s1, o0, o1, vtb, r, hh);
}
struct StickArgs { const bf16_t* proj; bf16_t* groups; const float* g_out; };
__device__ __forceinline__ void stick_item(const StickArgs& A, int item, LAS unsigned char* lds, int tid) {
    asm volatile("" : "+v"(tid));
    const int b = item >> 6, head = (item >> 4) & 3, qt = item & 15, T0 = 256 * qt;
    const int lane = tid & 63, w = __builtin_amdgcn_readfirstlane(tid >> 6), r = lane & 31, hh = lane >> 5, tq = T0 + 32 * w + r;
    const size_t token = (size_t)b * SEQ + tq;
    const bf16_t* base = A.proj + (size_t)b * SEQ * NP;
    bf16x8 qf[4]; load_qfrag<false>(qf, base + (size_t)tq * NP + C_QC + head * 64, nullptr, nullptr, 0.125f, hh);
    LAS unsigned* flags = (LAS unsigned*)(lds + NSA_SLAB);
    if (tid < 16) flags[tid] = 0u;
    f32x16 o0, o1;
#pragma unroll
    for (int i = 0; i < 16; ++i) { o0[i] = 0.f; o1[i] = 0.f; }
    float carry = 0.f; bool done = false;
    const bf16_t* kp = base + C_KC + head * 64; const bf16_t* vp = base + C_VC + head * 64;
#define STK_NEXT(c) ({ const LAS unsigned* f_ = flags + (par_ ^ 1) * 8; const unsigned ad_ = (f_[0] & f_[1]) & (f_[2] & f_[3]) & (f_[4] & f_[5]) & (f_[6] & f_[7]); ((c) > 0 && !ad_) ? (c) - 1 : -1; })
    KV_PIPELINE((T0 >> 6) + 3, STK_NEXT(cur), (KVSrc{kp, vp, NP, 64 * id, 0, SEQ}), false, nullptr,
        { if (!done && 64 * id <= T0 + 32 * w + 30) { stick_block(qf, o0, o1, carry, ksb, vtb, r, hh, tq, 64 * id); done = __all(carry > 104.f); }
          if (lane == 0) flags[par_ * 8 + w] = done ? 1u : 0u; });
    float ss = 0.f;
#pragma unroll
    for (int i = 0; i < 16; ++i) ss += o0[i] * o0[i] + o1[i] * o1[i];
    ss = sum32(ss);
    const float rs = rsqrtf(ss * (1.f / 64.f) + EPS); const float* go = A.g_out + 512 + head * 64; bf16_t* dst = A.groups + token * DM + 512 + head * 64;
#pragma unroll
    for (int g = 0; g < 4; ++g) { const int d0 = 8 * g + 4 * hh;
        u32x2 wa; wa.x = cvtpk(o0[4 * g] * rs * go[d0], o0[4 * g + 1] * rs * go[d0 + 1]); wa.y = cvtpk(o0[4 * g + 2] * rs * go[d0 + 2], o0[4 * g + 3] * rs * go[d0 + 3]); *(u32x2*)(dst + d0) = wa;
        u32x2 wb; wb.x = cvtpk(o1[4 * g] * rs * go[32 + d0], o1[4 * g + 1] * rs * go[32 + d0 + 1]); wb.y = cvtpk(o1[4 * g + 2] * rs * go[32 + d0 + 2], o1[4 * g + 3] * rs * go[32 + d0 + 3]); *(u32x2*)(dst + 32 + d0) = wb; }
    __syncthreads();
}

struct CmpArgs { const bf16_t* proj; const bf16_t* w1t; const bf16_t* w2t; const float* cb; const float* g_kc; bf16_t* kcn; bf16_t* vcc; };
constexpr int HIDB = 528;
__device__ __forceinline__ void compress_item(const CmpArgs& A, int item, LAS unsigned char* lds, int tid) {
    asm volatile("" : "+v"(tid));
    const int kv = item >> 6, rt = item & 63, b = rt >> 3, j0 = (rt & 7) * 32;
    const int lane = tid & 63, w = __builtin_amdgcn_readfirstlane(tid >> 6), r = lane & 31, hh = lane >> 5;
    { const bf16_t* xsrc = A.proj + (size_t)b * SEQ * NP + (kv ? C_VCA : C_KCA);
      u32x4 stg[9];
#pragma unroll
      for (int q = 0; q < 9; ++q) { const int e2 = tid + 512 * q, t = e2 >> 3, c = e2 & 7; int tk = 16 * j0 + t; tk = tk < SEQ ? tk : SEQ - 1;
          if (e2 < 528 * 8) stg[q] = *(const u32x4*)(xsrc + (size_t)tk * NP + 8 * c); }
#pragma unroll
      for (int q = 0; q < 9; ++q) { const int e2 = tid + 512 * q, t = e2 >> 3, c = e2 & 7;
          if (e2 < 528 * 8) *(LAS u32x4*)(lds + (t ^ ((t >> 7) & 1)) * 128 + ((c ^ ((t >> 4) & 7)) * 16)) = stg[q]; } }
    __syncthreads();
    const bf16_t* wf = A.w1t + (size_t)kv * 256 * 2048 + ((size_t)w * 128 * 64 + lane) * 8;
    f32x16 acc;
#pragma unroll
    for (int i = 0; i < 16; ++i) acc[i] = 0.f;
#pragma unroll 8
    for (int pos = 0; pos < 32; ++pos) { const int t = 16 * r + pos; LAS const unsigned char* arow = lds + (t ^ ((t >> 7) & 1)) * 128; const int sw = (t >> 4) & 7;
#pragma unroll
        for (int q = 0; q < 4; ++q) { const bf16x8 af = *(LAS const bf16x8*)(arow + (((2 * q + hh) ^ sw) * 16)), bfr = *(const bf16x8*)(wf + (size_t)(4 * pos + q) * 512); acc = MFMA32(af, bfr, acc); } }
    __syncthreads();
    { const float bias = A.cb[kv * 256 + 32 * w + r];
#pragma unroll
      for (int i = 0; i < 16; ++i) { const float x = acc[i] + bias; const float hv = 0.5f * x * (1.f + tanhf(0.7978845608028654f * (x + 0.044715f * x * x * x)));
          *(LAS unsigned short*)(lds + crow(i, hh) * HIDB + (32 * w + r) * 2) = (unsigned short)(cvtpk(hv, hv) & 0xffffu); } }
    __syncthreads();
    if (w == 0) {
        f32x16 c0, c1;
#pragma unroll
        for (int i = 0; i < 16; ++i) { c0[i] = 0.f; c1[i] = 0.f; }
        const bf16_t* w2a = A.w2t + ((size_t)kv * 64 + r) * 256 + 8 * hh; const bf16_t* w2b = w2a + 32 * 256;
#pragma unroll
        for (int s = 0; s < 16; ++s) { const bf16x8 af = *(LAS const bf16x8*)(lds + r * HIDB + (16 * s + 8 * hh) * 2);
            c0 = MFMA32(af, *(const bf16x8*)(w2a + 16 * s), c0); c1 = MFMA32(af, *(const bf16x8*)(w2b + 16 * s), c1); }
        const float g0 = A.g_kc[r], g1 = A.g_kc[32 + r]; bf16_t* dst = (kv ? A.vcc : A.kcn) + ((size_t)b * 256 + j0) * 64;
#pragma unroll
        for (int i = 0; i < 16; ++i) { float v0 = c0[i], v1 = c1[i];
            if (!kv) { float ss = v0 * v0 + v1 * v1; ss += swz_f<1>(ss); ss += swz_f<2>(ss); ss += swz_f<4>(ss); ss += swz_f<8>(ss); ss += swz_f<16>(ss);
                const float rs = rsqrtf(ss * (1.f / 64.f) + EPS); v0 *= rs * g0; v1 *= rs * g1; }
            const int row = crow(i, hh);
            if (!kv) { dst[row * 64 + r] = (bf16_t)(cvtpk(v0, v0) & 0xffffu); dst[row * 64 + 32 + r] = (bf16_t)(cvtpk(v1, v1) & 0xffffu); }
            else { const int j = j0 + row; bf16_t* vt = A.vcc + ((size_t)b * 4 + (j >> 6)) * 4096 + (j & 63);
                vt[(size_t)r * 64] = (bf16_t)(cvtpk(v0, v0) & 0xffffu); vt[(size_t)(32 + r) * 64] = (bf16_t)(cvtpk(v1, v1) & 0xffffu); } }
    }
    __syncthreads();
}
#define RLX_AGENT __ATOMIC_RELAXED, __HIP_MEMORY_SCOPE_AGENT
#define XB_TMO      128
#define XB_XCNT(j)  (256  + 64 * (j))
#define XB_XSUB(j)  (1280 + 64 * (j))
#define XB_XGEN(j)  (2304 + 64 * (j))
#define XB_TOP      3328
#define XB_TOPGEN   3392
#define XCD_BAR_WORDS 3456
#define XB_SPIN_CAP (1u << 18)

__device__ __forceinline__ unsigned xb_ld(unsigned* p)              { return __hip_atomic_load(p, __ATOMIC_RELAXED, __HIP_MEMORY_SCOPE_AGENT); }
__device__ __forceinline__ unsigned xb_add(unsigned* p, unsigned v) { return __hip_atomic_fetch_add(p, v, __ATOMIC_RELAXED, __HIP_MEMORY_SCOPE_AGENT); }
__device__ __forceinline__ unsigned xb_xcc_id() { return (unsigned)__builtin_amdgcn_s_getreg((3 << 11) | 20) & 0xFu; }
#define XB_SPIN(cond, bar) do { unsigned _sp = 0; while (cond) { __builtin_amdgcn_s_sleep(1); \
    if ((++_sp & 255u) == 0u) { if (xb_ld(&(bar)[XB_TMO])) break; if (_sp > XB_SPIN_CAP) { atomicAdd(&(bar)[XB_TMO], 1u); break; } } } } while (0)

struct XcdBarrier {
    unsigned* bar; unsigned x;
    volatile LAS unsigned* st;
};

__device__ __forceinline__ XcdBarrier xcd_barrier_post(unsigned* bar, volatile LAS unsigned* st) {
    XcdBarrier b; b.bar = bar; b.x = xb_xcc_id(); b.st = st;
    if (threadIdx.x == 0) (void)xb_add(&bar[XB_XCNT(b.x)], 1u);
    return b;
}
__device__ __forceinline__ void xcd_barrier_complete(unsigned* bar, unsigned x, unsigned& nloc, unsigned& nx) {
    const unsigned G = gridDim.x * gridDim.y * gridDim.z;
    unsigned sum, cnt, mine, sp = 0u;
    for (;;) {
        sum = 0u; cnt = 0u; mine = 0u;
#pragma unroll
        for (unsigned j = 0; j < 16; ++j) { const unsigned c = xb_ld(&bar[XB_XCNT(j)]); sum += c; cnt += (c > 0u) ? 1u : 0u; mine = (j == x) ? c : mine; }
        if (sum == G) break;
        __builtin_amdgcn_s_sleep(1);
        if ((++sp & 255u) == 0u) { if (xb_ld(&bar[XB_TMO])) break; if (sp > XB_SPIN_CAP) { atomicAdd(&bar[XB_TMO], 1u); break; } }
    }
    nloc = mine > 0u ? mine : 1u; nx = cnt > 0u ? cnt : 1u;
}

__device__ __forceinline__ void xcd_barrier(const XcdBarrier& b) {
    asm volatile("s_waitcnt vmcnt(0)" ::: "memory");
    __syncthreads();
    if (threadIdx.x == 0) {
        unsigned* bar = b.bar;
        __builtin_amdgcn_s_waitcnt(0);
        unsigned nloc = b.st[0], nx = b.st[1];
        if (nloc == 0u) { xcd_barrier_complete(bar, b.x, nloc, nx); b.st[0] = nloc; b.st[1] = nx; }
        const unsigned old = xb_add(&bar[XB_XSUB(b.x)], 1u);
        const unsigned gen = old / nloc;
        if (old + 1u == (gen + 1u) * nloc) {
            __builtin_amdgcn_fence(__ATOMIC_RELEASE, "agent");
            asm volatile("s_waitcnt vmcnt(0)" ::: "memory");
            const unsigned og = xb_add(&bar[XB_TOP], 1u);
            const unsigned tg = og / nx;
            if (og + 1u == (tg + 1u) * nx) xb_add(&bar[XB_TOPGEN], 1u);
            else XB_SPIN(xb_ld(&bar[XB_TOPGEN]) == tg, bar);
            __builtin_amdgcn_fence(__ATOMIC_ACQUIRE, "agent");
            xb_add(&bar[XB_XGEN(b.x)], 1u);
            asm volatile("s_waitcnt vmcnt(0)" ::: "memory");
        } else {
            XB_SPIN(xb_ld(&bar[XB_XGEN(b.x)]) == gen, bar);
            __builtin_amdgcn_fence(__ATOMIC_ACQUIRE, "agent");
            asm volatile("s_waitcnt vmcnt(0)" ::: "memory");
        }
    }
    __syncthreads();
}

#ifndef REP_CMP
#define REP_CMP 1
#endif
#ifndef REP_STK
#define REP_STK 1
#endif
#ifndef REP_DIL
#define REP_DIL 1
#endif
#ifndef REP_NSA
#define REP_NSA 1
#endif
#ifndef REP_G1
#define REP_G1 1
#endif
#ifndef REP_G3
#define REP_G3 1
#endif
#ifndef REP_PRO
#define REP_PRO 1
#endif
#ifndef REP_PREP
#define REP_PREP 1
#endif
#ifndef RESID_BF16
#define RESID_BF16 1
#endif
#ifndef REP_CONV
#define REP_CONV 1
#endif
#ifndef REP_G2
#define REP_G2 1
#endif
#ifndef XSYNC
#define XSYNC 0
#endif
__global__ void __launch_bounds__(512, 2) fwd_kernel(Params p) {
    extern __shared__ __attribute__((aligned(16))) unsigned char lds_raw[];
    cg::grid_group grid = cg::this_grid();
    LAS unsigned char* lds = (LAS unsigned char*)lds_raw;
#define TID_SETUP() int tid = threadIdx.x; asm volatile("" : "+v"(tid)); const int lane = tid & 63, wave = __builtin_amdgcn_readfirstlane(tid >> 6), gw = blockIdx.x * 8 + wave; (void)lane; (void)gw
    const int G = gridDim.x, NGW = G * 8;
    unsigned char* ws = p.ws;
    volatile LAS unsigned* misc = (volatile LAS unsigned*)(lds + LDS_BYTES - 64);
    unsigned* barw = (unsigned*)(ws + WS_BAR);
    { int t0 = threadIdx.x; if (t0 < 2) misc[t0] = 0u;
      if (blockIdx.x == 0) for (int i = t0; i < XCD_BAR_WORDS; i += 512) barw[i] = 0u;
      __syncthreads(); }
    float* ss = (float*)(ws + WS_SS); bf16_t* kcn = (bf16_t*)(ws + WS_KCN); bf16_t* vcc = (bf16_t*)(ws + WS_VCC);
    bf16_t* xb = (bf16_t*)(ws + WS_XB); bf16_t* groups = (bf16_t*)(ws + WS_GR); bf16_t* proj = (bf16_t*)(ws + WS_PROJ); bf16_t* hbuf = proj;
    float* x1 = (float*)(ws + WS_X1); bf16_t* nkn = (bf16_t*)(ws + WS_X1); bf16_t* nvt = (bf16_t*)(ws + WS_X1 + 8 * MiB);
    bf16_t* dpo = (bf16_t*)((unsigned char*)p.out + DO_PO); float* dlse = (float*)((unsigned char*)p.out + DO_LSE);

#ifndef SKIP_PRO
    for (int rep_ = 0; rep_ < REP_PRO; ++rep_) { TID_SETUP(); prologue(p, lds, gw, NGW, wave, lane); }
#endif
    grid.sync();
    const XcdBarrier xbar = xcd_barrier_post(barw, misc);
    for (int xs_ = 0; xs_ < XSYNC; ++xs_) xcd_barrier(xbar);

    for (int l = 0; l < 2; ++l) {
        unsigned char* wl = ws + WS_W + (size_t)l * W_LAYER;
#ifndef SKIP_G1
        for (int rep_ = 0; rep_ < REP_G1; ++rep_)
        { pg8::Gemm g{xb, (const bf16_t*)(wl + W_IN), M, NP, DM}; pg8::StaticOrder S; S.init(M, NP, G, (int)blockIdx.x);
          EpiProj E{proj, ss + (size_t)(2 * l) * M};
          pg8::gemm_phase<EpiProj, pg8::StaticOrder, true, true>(lds, g, S, E); }
#endif
        xcd_barrier(xbar);
        {
            TID_SETUP();
            const float* g_out = p.in[17] + l * DM;
            {
              const CmpArgs CA{proj, (const bf16_t*)(ws + WS_W1T) + (size_t)l * 2 * 256 * 2048, (const bf16_t*)(ws + WS_W2T) + (size_t)l * 2 * 64 * 256, (const float*)(ws + WS_CB) + l * 512, p.in[5] + l * 64, kcn, vcc};
              const StickArgs SA{proj, groups, g_out}; const DilArgs DA{proj, dpo, dlse, p.in[15] + l * 64, p.in[16] + l * 64};
              volatile LAS int* slot = (volatile LAS int*)(lds + LDS_BYTES - 32);
              for (;;) { __syncthreads(); if (tid == 0) *slot = (int)atomicAdd(barw + 32 + 64 * l, 1u); __syncthreads(); const int it = *slot; if (it >= 128 + 512 + 1536 + 256 + 128) break;
                  if (it < 128) compress_item(CA, it, lds, tid); else if (it < 640) stick_item(SA, it - 128, lds, tid); else if (it < 2176) dil_item(DA, it - 640, lds, tid);
                  else if (it < 2432) { const int i0 = (it - 2176) * 64 + wave; conv_items<4>(proj, groups, p.in[14] + l * 768, g_out, i0, 8, lane); conv_items<4>(proj, groups, p.in[14] + l * 768, g_out, i0 + 32, 8, lane); }
                  else nsa_prep_item(proj, nkn, nvt, p.in[6] + l * 64, p.in[7] + l * 64, (it - 2432) * 8 + wave, lds + wave * 9216, lane); } }
        }
        xcd_barrier(xbar);
#ifndef SKIP_NSA
#ifndef SKIP_DIL
#endif
        for (int rep_ = 0; rep_ < REP_NSA; ++rep_)
        { TID_SETUP(); NsaArgs A{proj, groups, kcn, vcc, p.in[3] + l * 12, p.in[4] + l * 64, p.in[6] + l * 64, p.in[7] + l * 64, p.in[17] + l * DM, nkn, nvt};
          volatile LAS int* slot = (volatile LAS int*)(lds + LDS_BYTES - 32);
          for (;;) { __syncthreads(); if (tid == 0) *slot = (int)atomicAdd(barw + 64 * l, 1u); __syncthreads(); const int it = *slot; if (it >= 512 + 256) break;
              if (it < 512) nsa_item(A, it & 7, 63 - (it >> 3), lds, tid);
              else { const int i0 = (it - 512) * 64 + wave; dil_merge_items<4>(dpo, dlse, groups, p.in[17] + l * DM, i0, 8, lane); dil_merge_items<4>(dpo, dlse, groups, p.in[17] + l * DM, i0 + 32, 8, lane); } } }
#endif
        xcd_barrier(xbar);
#ifndef SKIP_G2
        { pg8::Gemm g{groups, (const bf16_t*)(wl + W_OUT), M, DM, DM}; pg8::StaticOrder S; S.init(M, DM, G, (int)blockIdx.x);
#if RESID_BF16
          EpiResid E{l == 0 ? p.in[0] : nullptr, xb, nullptr, xb, ss + (size_t)(2 * l + 1) * M};
#else
          EpiResid E{l == 0 ? p.in[0] : x1, nullptr, l == 0 ? x1 : p.out, xb, ss + (size_t)(2 * l + 1) * M};
#endif
          pg8::gemm_phase<EpiResid, pg8::StaticOrder, true, true>(lds, g, S, E);
          for (int rep_ = 1; rep_ < REP_G2; ++rep_) { E.ss = nullptr; pg8::gemm_phase<EpiResid, pg8::StaticOrder, true, true>(lds, g, S, E); } }
#endif
        xcd_barrier(xbar);
#ifndef SKIP_G3
        for (int rep_ = 0; rep_ < REP_G3; ++rep_)
        { pg8::Gemm g{xb, (const bf16_t*)(wl + W_GU), M, NGU, DM}; pg8::StaticOrder S; S.init(M, NGU, G, (int)blockIdx.x);
          EpiSwiGLU E{hbuf, ss + (size_t)(2 * l + 1) * M};
          pg8::gemm_phase<EpiSwiGLU, pg8::StaticOrder, true, true>(lds, g, S, E); }
#endif
        xcd_barrier(xbar);
#ifndef SKIP_G4
        { pg8::Gemm g{hbuf, (const bf16_t*)(wl + W_DN), M, DM, FF}; pg8::StaticOrder S; S.init(M, DM, G, (int)blockIdx.x);
          float* xio = l == 0 ? x1 : p.out;
#if RESID_BF16
          EpiResid E{nullptr, xb, l == 0 ? nullptr : p.out, l == 0 ? xb : nullptr, l == 0 ? ss + (size_t)2 * M : nullptr}; (void)xio;
#else
          EpiResid E{xio, nullptr, xio, l == 0 ? xb : nullptr, l == 0 ? ss + (size_t)2 * M : nullptr};
#endif
          pg8::gemm_phase<EpiResid, pg8::StaticOrder, true, true>(lds, g, S, E); }
#endif
        if (l == 0) xcd_barrier(xbar);
    }
}

extern "C" void kernel_launch(void* const* d_in, const int* in_sizes, int n_in, void* d_out, int out_size, void* d_ws, size_t ws_size, hipStream_t stream) {
    static int grid = 0;
    if (grid == 0) {
        if (n_in != 23 || out_size != M * DM || ws_size < WS_END) { fprintf(stderr, "kernel_launch: unexpected shapes (n_in %d, out %d, ws %zu)\n", n_in, out_size, ws_size); grid = -1; return; }
        int dev = 0, cus = 0, per_cu = 0;
        (void)hipGetDevice(&dev); (void)hipDeviceGetAttribute(&cus, hipDeviceAttributeMultiprocessorCount, dev);
        if (hipFuncSetAttribute((const void*)fwd_kernel, hipFuncAttributeMaxDynamicSharedMemorySize, LDS_BYTES) != hipSuccess) { fprintf(stderr, "kernel_launch: hipFuncSetAttribute failed\n"); grid = -1; return; }
        if (hipOccupancyMaxActiveBlocksPerMultiprocessor(&per_cu, (const void*)fwd_kernel, 512, LDS_BYTES) != hipSuccess || per_cu < 1) per_cu = 1;
        (void)hipGetLastError();
        grid = cus * 1;
        (void)per_cu;
    }
    if (grid < 0) return;
    Params p{};
    for (int i = 0; i < 23; ++i) p.in[i] = (const float*)d_in[i];
    p.out = (float*)d_out; p.ws = (unsigned char*)d_ws;
    void* args[] = {&p};
    hipError_t e = hipLaunchCooperativeKernel((const void*)fwd_kernel, dim3(grid), dim3(512), args, LDS_BYTES, stream);
    if (e != hipSuccess) fprintf(stderr, "cooperative launch failed: %s (grid %d)\n", hipGetErrorString(e), grid);
}
```

```cpp
#include <hip/hip_runtime.h>
#include <hip/hip_cooperative_groups.h>
#include <cstdio>
#include <cstdint>
namespace cg = cooperative_groups;
namespace pg8 {
#define PG8_LAS __attribute__((address_space(3)))
typedef unsigned short bf16_t;
typedef short bf16x8 __attribute__((ext_vector_type(8)));
typedef float f32x4 __attribute__((ext_vector_type(4)));
typedef unsigned u32x4 __attribute__((ext_vector_type(4)));
constexpr int BM = 256, BK = 64, HALF = 128, HTB = HALF * BK * 2  , STAGE_BYTES = 8 * HTB, NXCD = 8, WGM = 8;

__host__ __device__ __forceinline__ int lds_byte(int r, int c) { const int st = (r >> 4) * 2 + (c >> 5), rr = r & 15, cc = c & 31, ob = rr * 64 + cc * 2; return st * 1024 + (ob ^ (((ob >> 9) & 1) << 5)); }
__host__ __device__ __forceinline__ void stage_rc(int b, int& R, int& C) { const int st = b / 1024, sb = b % 1024, swz = sb ^ (((sb >> 9) & 1) << 5); R = (st >> 1) * 16 + swz / 64; C = (st & 1) * 32 + (swz % 64) / 2; }
__host__ __device__ __forceinline__ int perm32(int rho) { const int n = rho >> 4, i = rho & 15; return 8 * (i >> 2) + 4 * n + (i & 3); }

struct Unit { int pm, pn; };
struct Gemm { const bf16_t* A; const bf16_t* Bt; int M, N, K; };

struct StaticOrder {
    int nM, nN, nwg, G, c;
    __host__ __device__ void init(int M, int N, int G_, int c_) { nM = M / BM; nN = N / BM; nwg = nM * nN; G = G_; c = c_; }
    __host__ __device__ bool next(int i, Unit& u) const {
        const long L = (long)i * G + c; if (L >= nwg) return false;
        int wgid = (int)L; { const int q = nwg / NXCD, r = nwg % NXCD, xcd = wgid % NXCD, off = wgid / NXCD; wgid = (xcd < r ? xcd * (q + 1) : r * (q + 1) + (xcd - r) * q) + off; }
        const int nig = WGM * nN, gid = wgid / nig, fm = gid * WGM, gsz = (nM - fm) < WGM ? (nM - fm) : WGM;
        u.pm = fm + ((wgid % nig) % gsz); u.pn = (wgid % nig) / gsz; return true;
    }
    __device__ __forceinline__ void a_ready(const Unit&) const {}
    __device__ __forceinline__ void done(const Unit&) const {}
};

__device__ __forceinline__ unsigned cvt_pk_bf16(float lo, float hi) { unsigned r; asm volatile("v_cvt_pk_bf16_f32 %0, %1, %2" : "=v"(r) : "v"(lo), "v"(hi)); return r; }
template <class Epi, class Sched, bool ALIGN_EPI = false, bool SP2 = false>
__device__ __forceinline__ void gemm_phase(PG8_LAS unsigned char* lds, const Gemm g, const Sched& S, const Epi& E) {
    int tid_l = threadIdx.x; asm volatile("" : "+v"(tid_l));
    const int tid = tid_l, wid = __builtin_amdgcn_readfirstlane(tid >> 6), lane = tid & 63, wr = wid >> 2, wc = wid & 3, fr = lane & 15, fq = lane >> 4;
    const int K = g.K, nt = K / BK;
    unsigned voffA[2], voffB[2];
#pragma unroll
    for (int i = 0; i < 2; ++i) { int R, C; stage_rc(tid * 16 + i * 8192, R, C); const int Rb = Epi::PERM ? ((R & ~31) + perm32(R & 31)) : R;
        voffA[i] = (unsigned)(R * K + C) * 2u; voffB[i] = (unsigned)(Rb * K + C) * 2u; }
    const size_t kstep = (size_t)(BK * 2);
    const size_t hstep = (size_t)HALF * K * 2;
    const size_t tstep = 2 * hstep;
    const unsigned ldsw = (unsigned)wid * 1024u;
    const int aoff = lds_byte(wr * 64 + fr, fq * 8), boff = lds_byte(wc * 32 + fr, fq * 8);
#define PG8_SA(b, h) (((b) * 2 + (h)) * HTB)
#define PG8_SB(b, h) ((4 + (b) * 2 + (h)) * HTB)
#define PG8_STAGE(bufoff, gbase, voff) do { _Pragma("unroll") for (int _i = 0; _i < 2; ++_i) \
        __builtin_amdgcn_global_load_lds((const unsigned*)((const char*)(gbase) + (voff)[_i]), (PG8_LAS unsigned*)(lds + (bufoff) + ldsw + _i * 8192), 16, 0, 0); } while (0)
#define PG8_LDA(dst, b, h) do { _Pragma("unroll") for (int m = 0; m < 4; ++m) _Pragma("unroll") for (int k = 0; k < 2; ++k) dst[m][k] = *(const PG8_LAS bf16x8*)(lds + PG8_SA(b, h) + aoff + m * 2048 + k * 1024); } while (0)
#define PG8_LDB(dst, b, h) do { _Pragma("unroll") for (int n = 0; n < 2; ++n) _Pragma("unroll") for (int k = 0; k < 2; ++k) dst[n][k] = *(const PG8_LAS bf16x8*)(lds + PG8_SB(b, h) + boff + n * 2048 + k * 1024); } while (0)
#define PG8_MMA(ai, bj, At, Bt) do { __builtin_amdgcn_s_setprio(1); _Pragma("unroll") for (int m = 0; m < 4; ++m) _Pragma("unroll") for (int n = 0; n < 2; ++n) _Pragma("unroll") for (int k = 0; k < 2; ++k) \
        acc[ai][bj][m][n] = __builtin_amdgcn_mfma_f32_16x16x32_bf16(Bt[n][k], At[m][k], acc[ai][bj][m][n], 0, 0, 0); __builtin_amdgcn_s_setprio(0); } while (0)
#define PG8_WAIT_V(n) asm volatile("s_waitcnt vmcnt(" #n ")" ::: "memory")
#define PG8_WAIT_L(n) asm volatile("s_waitcnt lgkmcnt(" #n ")" ::: "memory")
#define PG8_BAR __builtin_amdgcn_s_barrier()
#define PG8_SCHED __builtin_amdgcn_sched_barrier(0)
    Unit cur, nxt; int ui = 0;
    if (!S.next(0, cur)) return;
    f32x4 acc[2][2][4][2];
#pragma unroll
    for (int a = 0; a < 2; ++a)
#pragma unroll
        for (int b = 0; b < 2; ++b)
#pragma unroll
            for (int m = 0; m < 4; ++m)
#pragma unroll
                for (int n = 0; n < 2; ++n) acc[a][b][m][n] = (f32x4){0.f, 0.f, 0.f, 0.f};
    bf16x8 At[4][2], B0[2][2], B1[2][2];
    const char* cA = (const char*)g.A + (size_t)cur.pm * tstep; const char* cB = (const char*)g.Bt + (size_t)cur.pn * tstep;
    S.a_ready(cur);
    if constexpr (SP2) {
        PG8_STAGE(PG8_SB(0, 0), cB, voffB); PG8_STAGE(PG8_SB(0, 1), cB + hstep, voffB); PG8_STAGE(PG8_SA(0, 0), cA, voffA); PG8_STAGE(PG8_SA(0, 1), cA + hstep, voffA);
        if (wr == 1) PG8_BAR;
        PG8_WAIT_V(2); PG8_BAR;
        PG8_STAGE(PG8_SB(1, 0), cB + kstep, voffB); PG8_STAGE(PG8_SA(1, 0), cA + kstep, voffA); PG8_STAGE(PG8_SB(1, 1), cB + hstep + kstep, voffB);
        PG8_WAIT_V(6); PG8_BAR;
    } else {
        PG8_STAGE(PG8_SB(0, 0), cB, voffB); PG8_STAGE(PG8_SA(0, 0), cA, voffA); PG8_STAGE(PG8_SB(0, 1), cB + hstep, voffB); PG8_STAGE(PG8_SA(0, 1), cA + hstep, voffA);
        if (wr == 1) PG8_BAR;
        PG8_WAIT_V(4); PG8_BAR;
        PG8_STAGE(PG8_SB(1, 0), cB + kstep, voffB); PG8_STAGE(PG8_SA(1, 0), cA + kstep, voffA); PG8_STAGE(PG8_SB(1, 1), cB + hstep + kstep, voffB);
        PG8_WAIT_V(6); PG8_BAR;
    }
    for (;;) {
        const bool has_next = S.next(ui + 1, nxt);
        const char* nA = has_next ? (const char*)g.A + (size_t)nxt.pm * tstep : cA; const char* nB = has_next ? (const char*)g.Bt + (size_t)nxt.pn * tstep : cB;
        for (int t = 0; t < nt; t += 2) {
            const bool last = (t == nt - 2);
            const char* a1 = cA + (size_t)(t + 1) * kstep;
            const char* a2 = last ? nA : cA + (size_t)(t + 2) * kstep; const char* b2 = last ? nB : cB + (size_t)(t + 2) * kstep;
            const char* a3 = a2 + kstep; const char* b3 = b2 + kstep;
            if (last && has_next) S.a_ready(nxt);
            if constexpr (SP2) {
            PG8_LDB(B0, 0, 0); PG8_LDB(B1, 0, 1); PG8_SCHED; PG8_LDA(At, 0, 0); PG8_STAGE(PG8_SA(1, 1), a1 + hstep, voffA);
            PG8_WAIT_V(8); PG8_WAIT_L(0); PG8_BAR; PG8_MMA(0, 0, At, B0); PG8_MMA(0, 1, At, B1); PG8_BAR; PG8_SCHED;
            PG8_LDA(At, 0, 1); PG8_STAGE(PG8_SB(0, 0), b2, voffB); PG8_STAGE(PG8_SB(0, 1), b2 + hstep, voffB); PG8_STAGE(PG8_SA(0, 0), a2, voffA);
            PG8_WAIT_V(8); PG8_WAIT_L(0); PG8_BAR; PG8_MMA(1, 0, At, B0); PG8_MMA(1, 1, At, B1); PG8_BAR; PG8_SCHED;
            PG8_LDB(B0, 1, 0); PG8_LDB(B1, 1, 1); PG8_SCHED; PG8_LDA(At, 1, 0); PG8_STAGE(PG8_SA(0, 1), a2 + hstep, voffA);
            PG8_WAIT_V(8); PG8_WAIT_L(0); PG8_BAR; PG8_MMA(0, 0, At, B0); PG8_MMA(0, 1, At, B1); PG8_BAR; PG8_SCHED;
            PG8_LDA(At, 1, 1); PG8_STAGE(PG8_SB(1, 0), b3, voffB); PG8_STAGE(PG8_SB(1, 1), b3 + hstep, voffB); PG8_STAGE(PG8_SA(1, 0), a3, voffA);
            PG8_WAIT_V(8); PG8_WAIT_L(0); PG8_BAR; PG8_MMA(1, 0, At, B0); PG8_MMA(1, 1, At, B1); PG8_BAR; PG8_SCHED;
            } else {
            PG8_LDB(B0, 0, 0); PG8_SCHED; PG8_LDA(At, 0, 0); PG8_STAGE(PG8_SA(1, 1), a1 + hstep, voffA);
            PG8_WAIT_L(8); PG8_BAR; PG8_WAIT_L(0); PG8_MMA(0, 0, At, B0); PG8_BAR; PG8_SCHED;
            PG8_LDB(B1, 0, 1); PG8_STAGE(PG8_SB(0, 0), b2, voffB);
            PG8_BAR; PG8_WAIT_L(0); PG8_MMA(0, 1, At, B1); PG8_BAR;
            PG8_LDA(At, 0, 1); PG8_STAGE(PG8_SA(0, 0), a2, voffA);
            PG8_BAR; PG8_WAIT_L(0); PG8_MMA(1, 0, At, B0); PG8_BAR; PG8_SCHED;
            PG8_STAGE(PG8_SB(0, 1), b2 + hstep, voffB);
            PG8_WAIT_V(6); PG8_BAR; PG8_MMA(1, 1, At, B1); PG8_BAR;
            PG8_LDB(B0, 1, 0); PG8_SCHED; PG8_LDA(At, 1, 0); PG8_STAGE(PG8_SA(0, 1), a2 + hstep, voffA);
            PG8_WAIT_L(8); PG8_BAR; PG8_WAIT_L(0); PG8_MMA(0, 0, At, B0); PG8_BAR; PG8_SCHED;
            PG8_LDB(B1, 1, 1); PG8_STAGE(PG8_SB(1, 0), b3, voffB);
            PG8_BAR; PG8_WAIT_L(0); PG8_MMA(0, 1, At, B1); PG8_BAR;
            PG8_LDA(At, 1, 1); PG8_STAGE(PG8_SA(1, 0), a3, voffA);
            PG8_BAR; PG8_WAIT_L(0); PG8_MMA(1, 0, At, B0); PG8_BAR; PG8_SCHED;
            PG8_STAGE(PG8_SB(1, 1), b3 + hstep, voffB);
            PG8_WAIT_V(6); PG8_BAR; PG8_MMA(1, 1, At, B1); PG8_BAR;
            }
        }
        if constexpr (ALIGN_EPI) { if (wr == 0) PG8_BAR; }
        if constexpr (!Epi::AFTER_DRAIN) { E(acc, cur, wr, wc, fr, fq); S.done(cur); }
        if (!has_next) break;
#pragma unroll
        for (int a = 0; a < 2; ++a)
#pragma unroll
            for (int b = 0; b < 2; ++b)
#pragma unroll
                for (int m = 0; m < 4; ++m)
#pragma unroll
                    for (int n = 0; n < 2; ++n) acc[a][b][m][n] = (f32x4){0.f, 0.f, 0.f, 0.f};
        cur = nxt; cA = nA; cB = nB; ++ui;
        if constexpr (ALIGN_EPI) { if (wr == 1) PG8_BAR; }
    }
    PG8_WAIT_V(0);
    if constexpr (!ALIGN_EPI) { if (wr == 0) PG8_BAR; }
    PG8_BAR;
    if constexpr (Epi::AFTER_DRAIN) { E.fused(acc, cur, wr, wc, fr, fq, lds, wid, lane); S.done(cur); }
#undef PG8_SA
#undef PG8_SB
#undef PG8_STAGE
#undef PG8_LDA
#undef PG8_LDB
#undef PG8_MMA
#undef PG8_WAIT_V
#undef PG8_WAIT_L
#undef PG8_BAR
#undef PG8_SCHED
}
}

typedef unsigned short bf16_t;
typedef unsigned u32x4 __attribute__((ext_vector_type(4)));
typedef unsigned u32x2 __attribute__((ext_vector_type(2)));
typedef float f32x4 __attribute__((ext_vector_type(4)));
#define LAS __attribute__((address_space(3)))

constexpr int NB = 8, SEQ = 4096, M = NB * SEQ, DM = 1024, NP = 3072, FF = 2816, NGU = 2 * FF, INC = 2956;
constexpr int C_QA = 0, C_KCA = 256, C_VCA = 320, C_KSA = 384, C_VSA = 448, C_KWA = 512, C_VWA = 576, C_CVB = 640, C_CVC = 896, C_CVU = 1152,
              C_QC = 1408, C_KC = 1664, C_VC = 1920, C_QD = 2176, C_KD = 2432, C_VD = 2688, C_GT = 2944;
constexpr float EPS = 1e-6f;
constexpr size_t MiB = 1u << 20;
constexpr size_t WS_SS = 0, WS_KCN = 1 * MiB, WS_VCC = 1 * MiB + 512 * 1024, WS_W = 2 * MiB;
constexpr size_t W_IN = 0, W_OUT = 6 * MiB, W_GU = 8 * MiB, W_DN = 19 * MiB, W_LAYER = 24 * MiB + 512 * 1024;
constexpr size_t WS_XB = 52 * MiB, WS_GR = 116 * MiB, WS_PROJ = 180 * MiB, WS_X1 = 372 * MiB, WS_W1T = 500 * MiB, WS_W2T = 504 * MiB, WS_CB = 504 * MiB + 256 * 1024, WS_BAR = 504 * MiB + 512 * 1024, WS_END = 505 * MiB;
constexpr size_t DO_PO = 0, DO_LSE = 48 * MiB;
constexpr int LDS_BYTES = 143360;

struct Params { const float* in[23]; float* out; unsigned char* ws; };

__device__ __forceinline__ float blo(unsigned u) { return __uint_as_float(u << 16); }
__device__ __forceinline__ float bhi(unsigned u) { return __uint_as_float(u & 0xffff0000u); }
__device__ __forceinline__ float bf2f(bf16_t h) { return __uint_as_float((unsigned)h << 16); }
__device__ __forceinline__ unsigned pk2(float lo, float hi) { return pg8::cvt_pk_bf16(lo, hi); }
template <int K> __device__ __forceinline__ unsigned swz_u(unsigned v) { return (unsigned)__builtin_amdgcn_ds_swizzle((int)v, (K << 10) | 0x1f); }
template <int K> __device__ __forceinline__ float swz_f(float v) { return __uint_as_float(swz_u<K>(__float_as_uint(v))); }
__device__ __forceinline__ float sum32(float v) { auto rr = __builtin_amdgcn_permlane32_swap(__float_as_uint(v), __float_as_uint(v), false, false); return __uint_as_float(rr[0]) + __uint_as_float(rr[1]); }
__device__ __forceinline__ float max32(float v) { auto rr = __builtin_amdgcn_permlane32_swap(__float_as_uint(v), __float_as_uint(v), false, false); return fmaxf(__uint_as_float(rr[0]), __uint_as_float(rr[1])); }
__device__ __forceinline__ unsigned or32(unsigned v) { auto rr = __builtin_amdgcn_permlane32_swap(v, v, false, false); return rr[0] | rr[1]; }
__device__ __forceinline__ float partner32(float v, int hh) { auto rr = __builtin_amdgcn_permlane32_swap(__float_as_uint(v), __float_as_uint(v), false, false); return __uint_as_float(hh ? rr[0] : rr[1]); }
__device__ __forceinline__ float wave_sum(float v) {
    v += swz_f<1>(v); v += swz_f<2>(v); v += swz_f<4>(v); v += swz_f<8>(v); v += swz_f<16>(v); return sum32(v);
}
#define LDS_WAIT() asm volatile("s_waitcnt lgkmcnt(0)" ::: "memory")
#define CFENCE() asm volatile("" ::: "memory")

struct EpiProj {
    static constexpr bool PERM = true, AFTER_DRAIN = false;
    bf16_t* O; const float* ss;
    __device__ __forceinline__ void operator()(const pg8::f32x4 (&acc)[2][2][4][2], const pg8::Unit& u, int wr, int wc, int fr, int fq) const {
        const int row0 = u.pm * 256 + wr * 64 + fr, col0 = u.pn * 256 + wc * 32 + 8 * fq;
#pragma unroll
        for (int ai = 0; ai < 2; ++ai)
#pragma unroll
            for (int m = 0; m < 4; ++m) {
                const int row = row0 + ai * 128 + m * 16; const float rs = rsqrtf(ss[row] * (1.f / DM) + EPS);
                bf16_t* rowp = O + (size_t)row * NP + col0;
#pragma unroll
                for (int bj = 0; bj < 2; ++bj) { const pg8::f32x4 v0 = acc[ai][bj][m][0] * rs, v1 = acc[ai][bj][m][1] * rs;
                    u32x4 w; w.x = pk2(v0[0], v0[1]); w.y = pk2(v0[2], v0[3]); w.z = pk2(v1[0], v1[1]); w.w = pk2(v1[2], v1[3]);
                    *(u32x4*)(rowp + bj * 128) = w; }
            }
    }
};
struct EpiSwiGLU {
    static constexpr bool PERM = true, AFTER_DRAIN = false;
    bf16_t* H; const float* ss;
    __device__ __forceinline__ void operator()(const pg8::f32x4 (&acc)[2][2][4][2], const pg8::Unit& u, int wr, int wc, int fr, int fq) const {
        const int row0 = u.pm * 256 + wr * 64 + fr, col0 = u.pn * 128 + wc * 32 + 8 * fq;
#pragma unroll
        for (int ai = 0; ai < 2; ++ai)
#pragma unroll
            for (int m = 0; m < 4; ++m) {
                const int row = row0 + ai * 128 + m * 16; const float rs = rsqrtf(ss[row] * (1.f / DM) + EPS);
                float hv[8];
#pragma unroll
                for (int n = 0; n < 2; ++n)
#pragma unroll
                    for (int j = 0; j < 4; ++j) { const float g = acc[ai][0][m][n][j] * rs, up = acc[ai][1][m][n][j] * rs;
                        hv[4 * n + j] = g * up * __builtin_amdgcn_rcpf(1.f + __expf(-g)); }
                u32x4 w; w.x = pk2(hv[0], hv[1]); w.y = pk2(hv[2], hv[3]); w.z = pk2(hv[4], hv[5]); w.w = pk2(hv[6], hv[7]);
                *(u32x4*)(H + (size_t)row * FF + col0) = w;
            }
    }
};
struct EpiResid {
    static constexpr bool PERM = true, AFTER_DRAIN = false;
    const float* xin; const bf16_t* xin_b; float* xout; bf16_t* xb; float* ss;
    __device__ __forceinline__ void operator()(const pg8::f32x4 (&acc)[2][2][4][2], const pg8::Unit& u, int wr, int wc, int fr, int fq) const {
        const int row0 = u.pm * 256 + wr * 64 + fr, col0 = u.pn * 256 + wc * 32 + 8 * fq;
#pragma unroll
        for (int ai = 0; ai < 2; ++ai)
#pragma unroll
            for (int m = 0; m < 4; ++m) {
                const int row = row0 + ai * 128 + m * 16; const size_t off = (size_t)row * DM + col0; float sq = 0.f;
#pragma unroll
                for (int bj = 0; bj < 2; ++bj) { const size_t o = off + bj * 128; f32x4 xa, xc;
                    if (xin) { xa = *(const f32x4*)(xin + o); xc = *(const f32x4*)(xin + o + 4); }
                    else { const u32x4 r4 = *(const u32x4*)(xin_b + o); xa[0] = blo(r4.x); xa[1] = bhi(r4.x); xa[2] = blo(r4.y); xa[3] = bhi(r4.y); xc[0] = blo(r4.z); xc[1] = bhi(r4.z); xc[2] = blo(r4.w); xc[3] = bhi(r4.w); }
                    f32x4 va, vc;
                    va[0] = xa[0] + acc[ai][bj][m][0][0]; va[1] = xa[1] + acc[ai][bj][m][0][1]; va[2] = xa[2] + acc[ai][bj][m][0][2]; va[3] = xa[3] + acc[ai][bj][m][0][3];
                    vc[0] = xc[0] + acc[ai][bj][m][1][0]; vc[1] = xc[1] + acc[ai][bj][m][1][1]; vc[2] = xc[2] + acc[ai][bj][m][1][2]; vc[3] = xc[3] + acc[ai][bj][m][1][3];
                    if (xout) { *(f32x4*)(xout + o) = va; *(f32x4*)(xout + o + 4) = vc; }
                    if (xb) { u32x4 w; w.x = pk2(va[0], va[1]); w.y = pk2(va[2], va[3]); w.z = pk2(vc[0], vc[1]); w.w = pk2(vc[2], vc[3]); *(u32x4*)(xb + o) = w; }
                    sq += ((va[0] * va[0] + va[1] * va[1]) + (va[2] * va[2] + va[3] * va[3])) + ((vc[0] * vc[0] + vc[1] * vc[1]) + (vc[2] * vc[2] + vc[3] * vc[3])); }
                if (ss) { sq += swz_f<16>(sq); sq = sum32(sq); if (fq == 0) atomicAdd(ss + row, sq); }
            }
    }
};

#ifndef REP_PW
#define REP_PW 1
#endif
#ifndef REP_PC
#define REP_PC 1
#endif
#ifndef REP_PX
#define REP_PX 1
#endif
template <int MAP> __device__ __forceinline__ int dst_row(int c) {
    if (MAP == 0) return c < 640 ? c : (c < 652 ? 2944 + (c - 640) : c - 12);
    if (MAP == 1) return c;
    if (MAP == 2) return 256 * (c >> 7) + (c & 127);
    return 256 * (c >> 7) + 128 + (c & 127);
}
template <int MAP> __device__ __forceinline__ void transpose_item(const float* W, int K, int N, const float* gk, bf16_t* WT, LAS float* scr, int item, int lane) {
    const int nblk = (N + 63) / 64, kb = item / nblk, nb = item % nblk, k0 = 64 * kb, n0 = 64 * nb;
    const int nn = n0 + lane; const bool okn = nn < N;
#pragma unroll
    for (int i = 0; i < 64; ++i) { float v = okn ? W[(size_t)(k0 + i) * N + nn] : 0.f; if (gk) v *= gk[k0 + i]; scr[i * 65 + lane] = v; }
    LDS_WAIT();
    const int c = lane & 7;
#pragma unroll
    for (int j = 0; j < 8; ++j) { const int n = (lane >> 3) + 8 * j; const LAS float* s = scr + (8 * c) * 65 + n;
        if (n0 + n < N) { u32x4 o; o.x = pk2(s[0 * 65], s[1 * 65]); o.y = pk2(s[2 * 65], s[3 * 65]); o.z = pk2(s[4 * 65], s[5 * 65]); o.w = pk2(s[6 * 65], s[7 * 65]);
            if (MAP == 4) { const int nn2 = n0 + n, kk2 = k0 + 8 * c; *(u32x4*)(WT + ((size_t)(((nn2 >> 5) * (K >> 4) + (kk2 >> 4)) * 64 + ((kk2 >> 3) & 1) * 32 + (nn2 & 31)) * 8)) = o; }
            else *(u32x4*)(WT + (size_t)dst_row<MAP>(n0 + n) * K + k0 + 8 * c) = o; } }
    LDS_WAIT();
}
__device__ __forceinline__ void prologue(const Params& p, LAS unsigned char* lds, int gw, int NGW, int wave, int lane) {
    LAS float* scr = (LAS float*)(lds + wave * 16640);
    constexpr int I_IN = 16 * 47, I_OUT = 16 * 16, I_G = 16 * 44, I_DN = 44 * 16, I_L = I_IN + I_OUT + 2 * I_G + I_DN, I_Z = 116;
    for (int rw_ = 0; rw_ < REP_PW; ++rw_)
    for (int it = gw; it < 2 * (I_L + I_Z); it += NGW) {
        const int l = it / (I_L + I_Z); int r = it % (I_L + I_Z);
        unsigned char* wl = p.ws + WS_W + (size_t)l * W_LAYER;
        if (r < I_IN) { transpose_item<0>(p.in[2] + (size_t)l * DM * INC, DM, INC, p.in[1] + l * DM, (bf16_t*)(wl + W_IN), scr, r, lane); continue; } r -= I_IN;
        if (r < I_OUT) { transpose_item<1>(p.in[18] + (size_t)l * DM * DM, DM, DM, nullptr, (bf16_t*)(wl + W_OUT), scr, r, lane); continue; } r -= I_OUT;
        if (r < I_G) { transpose_item<2>(p.in[20] + (size_t)l * DM * FF, DM, FF, p.in[19] + l * DM, (bf16_t*)(wl + W_GU), scr, r, lane); continue; } r -= I_G;
        if (r < I_G) { transpose_item<3>(p.in[21] + (size_t)l * DM * FF, DM, FF, p.in[19] + l * DM, (bf16_t*)(wl + W_GU), scr, r, lane); continue; } r -= I_G;
        if (r < I_DN) { transpose_item<1>(p.in[22] + (size_t)l * FF * DM, FF, DM, nullptr, (bf16_t*)(wl + W_DN), scr, r, lane); continue; } r -= I_DN;
        { u32x4 z = {0u, 0u, 0u, 0u}; u32x4* d = (u32x4*)((bf16_t*)(wl + W_IN) + (size_t)(INC + r) * DM) + lane * 2; d[0] = z; d[1] = z; }
    }
    for (int rc_ = 0; rc_ < REP_PC; ++rc_)
    for (int it = gw; it < 4 * (128 + 4 + 32); it += NGW) {
        const int mi = it / 164, r = it % 164, l = mi >> 1, kv = mi & 1;
        const float* w1 = p.in[kv ? 12 : 10] + (size_t)l * 2048 * 256; const float* w2 = p.in[kv ? 13 : 11] + (size_t)l * 256 * 64; const float* pe = p.in[kv ? 9 : 8] + l * 2048;
        if (r < 128) transpose_item<4>(w1, 2048, 256, nullptr, (bf16_t*)(p.ws + WS_W1T) + (size_t)mi * 256 * 2048, scr, r, lane);
        else if (r < 132) transpose_item<1>(w2, 256, 64, nullptr, (bf16_t*)(p.ws + WS_W2T) + (size_t)mi * 64 * 256, scr, r - 128, lane);
        else { const int c = (r - 132) * 8 + (lane & 7), rg = lane >> 3; float acc = 0.f;
#pragma unroll 32
            for (int i = rg * 256; i < rg * 256 + 256; ++i) acc += pe[i] * w1[(size_t)i * 256 + c];
            acc += swz_f<8>(acc); acc += swz_f<16>(acc); acc = sum32(acc);
            if (rg == 0) ((float*)(p.ws + WS_CB))[mi * 256 + c] = acc; }
    }
    float* ss = (float*)(p.ws + WS_SS); bf16_t* xb = (bf16_t*)(p.ws + WS_XB);
    for (int rx_ = 0; rx_ < REP_PX; ++rx_)
    for (int m0 = gw; m0 < M; m0 += 4 * NGW) {
        f32x4 v[4][4];
#pragma unroll
        for (int rr = 0; rr < 4; ++rr) { const int m = m0 + rr * NGW; const f32x4* xr = (const f32x4*)(p.in[0] + (size_t)(m < M ? m : 0) * DM) + lane;
#pragma unroll
            for (int j = 0; j < 4; ++j) v[rr][j] = xr[64 * j]; }
#pragma unroll
        for (int rr = 0; rr < 4; ++rr) { const int m = m0 + rr * NGW; if (m < M) { u32x2* o8 = (u32x2*)(xb + (size_t)m * DM) + lane; float s = 0.f;
#pragma unroll
            for (int j = 0; j < 4; ++j) { const f32x4 t = v[rr][j]; s += (t[0] * t[0] + t[1] * t[1]) + (t[2] * t[2] + t[3] * t[3]); u32x2 w; w.x = pk2(t[0], t[1]); w.y = pk2(t[2], t[3]); o8[64 * j] = w; }
            s = wave_sum(s);
            if (lane == 0) { ss[m] = s; ss[M + m] = 0.f; ss[2 * M + m] = 0.f; ss[3 * M + m] = 0.f; } } }
    }
}

#define UNPACK8(v, k) const float k##0 = blo(v.x), k##1 = bhi(v.x), k##2 = blo(v.y), k##3 = bhi(v.y), k##4 = blo(v.z), k##5 = bhi(v.z), k##6 = blo(v.w), k##7 = bhi(v.w)
__device__ __forceinline__ void load_row64(float (&q)[64], const bf16_t* p) {
#pragma unroll
    for (int c = 0; c < 8; ++c) { const u32x4 v = *(const u32x4*)(p + 8 * c); UNPACK8(v, k);
        q[8 * c] = k0; q[8 * c + 1] = k1; q[8 * c + 2] = k2; q[8 * c + 3] = k3; q[8 * c + 4] = k4; q[8 * c + 5] = k5; q[8 * c + 6] = k6; q[8 * c + 7] = k7; }
}
template <bool SS> __device__ __forceinline__ float dot_row(const float (&q)[64], const bf16_t* p, float& kss) {
    float z = 0.f, s = 0.f;
#pragma unroll
    for (int c = 0; c < 8; ++c) { const u32x4 v = *(const u32x4*)(p + 8 * c); UNPACK8(v, k);
        z += (q[8 * c] * k0 + q[8 * c + 1] * k1) + (q[8 * c + 2] * k2 + q[8 * c + 3] * k3) + (q[8 * c + 4] * k4 + q[8 * c + 5] * k5) + (q[8 * c + 6] * k6 + q[8 * c + 7] * k7);
        if (SS) s += (k0 * k0 + k1 * k1) + (k2 * k2 + k3 * k3) + (k4 * k4 + k5 * k5) + (k6 * k6 + k7 * k7);
        if (c == 3) CFENCE(); }
    kss = s; return z;
}
__device__ __forceinline__ void axpy_row(float (&o)[64], float w, const bf16_t* p) {
#pragma unroll
    for (int c = 0; c < 8; ++c) { const u32x4 v = *(const u32x4*)(p + 8 * c); UNPACK8(v, k);
        o[8 * c] += w * k0; o[8 * c + 1] += w * k1; o[8 * c + 2] += w * k2; o[8 * c + 3] += w * k3; o[8 * c + 4] += w * k4; o[8 * c + 5] += w * k5; o[8 * c + 6] += w * k6; o[8 * c + 7] += w * k7;
        if (c == 3) CFENCE(); }
}
__device__ __forceinline__ float dot_row_f32(const float (&q)[64], const float* p) {
    float z = 0.f;
#pragma unroll
    for (int c = 0; c < 16; ++c) { const f32x4 v = *(const f32x4*)(p + 4 * c); z += (q[4 * c] * v[0] + q[4 * c + 1] * v[1]) + (q[4 * c + 2] * v[2] + q[4 * c + 3] * v[3]); if (c == 7) CFENCE(); }
    return z;
}
__device__ __forceinline__ void axpy_row_f32(float (&o)[64], float w, const float* p) {
#pragma unroll
    for (int c = 0; c < 16; ++c) { const f32x4 v = *(const f32x4*)(p + 4 * c); o[4 * c] += w * v[0]; o[4 * c + 1] += w * v[1]; o[4 * c + 2] += w * v[2]; o[4 * c + 3] += w * v[3]; if (c == 7) CFENCE(); }
}
__device__ __forceinline__ void store_group(const float (&o)[64], const float* g, bf16_t* dst) {
    float ss = 0.f;
#pragma unroll
    for (int d = 0; d < 64; ++d) ss += o[d] * o[d];
    const float rs = rsqrtf(ss * (1.f / 64.f) + EPS);
#pragma unroll
    for (int c = 0; c < 8; ++c) { u32x4 w;
        w.x = pk2(o[8 * c] * rs * g[8 * c], o[8 * c + 1] * rs * g[8 * c + 1]); w.y = pk2(o[8 * c + 2] * rs * g[8 * c + 2], o[8 * c + 3] * rs * g[8 * c + 3]);
        w.z = pk2(o[8 * c + 4] * rs * g[8 * c + 4], o[8 * c + 5] * rs * g[8 * c + 5]); w.w = pk2(o[8 * c + 6] * rs * g[8 * c + 6], o[8 * c + 7] * rs * g[8 * c + 7]);
        *(u32x4*)(dst + 8 * c) = w; }
}
__device__ __forceinline__ void load_q_norm(float (&q)[64], const bf16_t* p, const float* gq, const float* gx) {
    load_row64(q, p); float ss = 0.f;
#pragma unroll
    for (int d = 0; d < 64; ++d) ss += q[d] * q[d];
    const float rs = rsqrtf(ss * (1.f / 64.f) + EPS) * 0.125f;
#pragma unroll
    for (int d = 0; d < 64; ++d) q[d] = q[d] * rs * gq[d] * (gx ? gx[d] : 1.f);
}

__device__ __forceinline__ void stick_naive(const bf16_t* proj, bf16_t* groups, const float* g_out, int item, int lane) {
    const int tile = item & 63, h = (item >> 6) & 3, b = item >> 8, t = tile * 64 + lane;
    const bf16_t* base = proj + (size_t)b * SEQ * NP;
    float q[64]; load_row64(q, base + (size_t)t * NP + C_QC + h * 64);
#pragma unroll
    for (int d = 0; d < 64; ++d) q[d] *= 0.125f;
    float o[64];
#pragma unroll
    for (int d = 0; d < 64; ++d) o[d] = 0.f;
    float between = 0.f;
    for (int s = tile * 64 + 62; s >= 0; --s) {
        const bf16_t* kr = base + (size_t)s * NP + C_KC + h * 64; float dummy;
        const float z = dot_row<false>(q, kr, dummy); CFENCE();
        const bool act = s < t;
        const float sp = fmaxf(z, 0.f) + __logf(1.f + __expf(-fabsf(z)));
        const float w = act ? __expf((z - sp) - between) : 0.f;
        axpy_row(o, w, base + (size_t)s * NP + C_VC + h * 64); CFENCE();
        between += act ? sp : 0.f;
        if (s < tile * 64 && __all(between > 104.f)) break;
    }
    store_group(o, g_out + 512 + h * 64, groups + (size_t)(b * SEQ + t) * DM + 512 + h * 64);
}

__device__ __forceinline__ void dil_naive(const bf16_t* proj, bf16_t* groups, const float* gq, const float* gk, const float* g_out, int item, int lane) {
    const int tile = item & 63, h = (item >> 6) & 3, b = item >> 8, t = tile * 64 + lane;
    const bf16_t* base = proj + (size_t)b * SEQ * NP;
    float q[64]; load_q_norm(q, base + (size_t)t * NP + C_QD + h * 64, gq, gk);
    const float slope = exp2f(-(float)(2 * h + 2));
    float o[64];
#pragma unroll
    for (int d = 0; d < 64; ++d) o[d] = 0.f;
    float mx = -1e30f, l = 0.f;
    for (int cfg = 0; cfg < 3; ++cfg) {
        const int dil = cfg == 0 ? 1 : (cfg == 1 ? 4 : 16);
        for (int j = 0; j <= 128; ++j) {
            const int s = t - j * dil; const bool act = s >= 0;
            if (!__any(act)) break;
            if (act) {
                float kss; const float z = dot_row<true>(q, base + (size_t)s * NP + C_KD + h * 64, kss); CFENCE();
                const float sc = z * rsqrtf(kss * (1.f / 64.f) + EPS) - slope * (float)(j * dil);
                if (sc > mx) { const float corr = __expf(mx - sc); l *= corr;
#pragma unroll
                    for (int d = 0; d < 64; ++d) o[d] *= corr;
                    mx = sc; }
                const float pw = __expf(sc - mx); l += pw;
                axpy_row(o, pw, base + (size_t)s * NP + C_VD + h * 64); CFENCE();
            }
        }
    }
    const float inv = 1.f / l;
#pragma unroll
    for (int d = 0; d < 64; ++d) o[d] *= inv;
    store_group(o, g_out + 768 + h * 64, groups + (size_t)(b * SEQ + t) * DM + 768 + h * 64);
}

template <int NI> __device__ __forceinline__ void conv_items(const bf16_t* proj, bf16_t* groups, const float* cw, const float* g_out, int item0, int stride, int lane) {
    const int ch = (lane & 31) * 8;
    u32x4 cv[NI][3], uv[NI][3], bv[NI];
#pragma unroll
    for (int n = 0; n < NI; ++n) { const int token = (item0 + n * stride) * 2 + (lane >> 5), tpos = token & (SEQ - 1); const bf16_t* row = proj + (size_t)token * NP;
#pragma unroll
        for (int k = 0; k < 3; ++k) { const int back = 2 - k;
            if (tpos >= back) { cv[n][k] = *(const u32x4*)(row - (size_t)back * NP + C_CVC + ch); uv[n][k] = *(const u32x4*)(row - (size_t)back * NP + C_CVU + ch); }
            else { cv[n][k] = (u32x4){0u, 0u, 0u, 0u}; uv[n][k] = cv[n][k]; } }
        bv[n] = *(const u32x4*)(row + C_CVB + ch); }
    float wk[3][8];
#pragma unroll
    for (int k = 0; k < 3; ++k)
#pragma unroll
        for (int i = 0; i < 8; ++i) wk[k][i] = cw[k * 256 + ch + i];
    const float* go = g_out + 256 + ch;
#pragma unroll
    for (int n = 0; n < NI; ++n) { const int token = (item0 + n * stride) * 2 + (lane >> 5);
        float acc[8];
#pragma unroll
        for (int i = 0; i < 8; ++i) acc[i] = 0.f;
#pragma unroll
        for (int k = 0; k < 3; ++k) { UNPACK8(cv[n][k], c); UNPACK8(uv[n][k], u);
            acc[0] += wk[k][0] * (c0 * u0); acc[1] += wk[k][1] * (c1 * u1); acc[2] += wk[k][2] * (c2 * u2); acc[3] += wk[k][3] * (c3 * u3);
            acc[4] += wk[k][4] * (c4 * u4); acc[5] += wk[k][5] * (c5 * u5); acc[6] += wk[k][6] * (c6 * u6); acc[7] += wk[k][7] * (c7 * u7); }
        UNPACK8(bv[n], g);
        float y[8] = {g0 * acc[0], g1 * acc[1], g2 * acc[2], g3 * acc[3], g4 * acc[4], g5 * acc[5], g6 * acc[6], g7 * acc[7]};
        float ss = 0.f;
#pragma unroll
        for (int i = 0; i < 8; ++i) ss += y[i] * y[i];
        ss += swz_f<1>(ss); ss += swz_f<2>(ss); ss += swz_f<4>(ss);
        const float rs = rsqrtf(ss * (1.f / 64.f) + EPS);
        u32x4 w; w.x = pk2(y[0] * rs * go[0], y[1] * rs * go[1]); w.y = pk2(y[2] * rs * go[2], y[3] * rs * go[3]);
        w.z = pk2(y[4] * rs * go[4], y[5] * rs * go[5]); w.w = pk2(y[6] * rs * go[6], y[7] * rs * go[7]);
        *(u32x4*)(groups + (size_t)token * DM + 256 + ch) = w; }
}

typedef short bf16x8 __attribute__((ext_vector_type(8)));
typedef short s16x4 __attribute__((ext_vector_type(4)));
typedef float f32x16 __attribute__((ext_vector_type(16)));
typedef float f32x2_t __attribute__((ext_vector_type(2)));
typedef __bf16 bf16x2_t __attribute__((ext_vector_type(2)));
__device__ __forceinline__ unsigned cvtpk(float lo, float hi) { f32x2_t v = {lo, hi}; bf16x2_t b = __builtin_convertvector(v, bf16x2_t); return __builtin_bit_cast(unsigned, b); }
#define MFMA32(a, b, c) __builtin_amdgcn_mfma_f32_32x32x16_bf16((a), (b), (c), 0, 0, 0)
#define EXP2(x) __builtin_amdgcn_exp2f(x)
constexpr float LOG2E = 1.4426950408889634f;
constexpr int KSB = 144, VTB = 136, KS_BYTES = 64 * KSB, VT_BYTES = 64 * VTB;
__device__ __forceinline__ int crow(int i, int h) { return (i & 3) + 8 * (i >> 2) + 4 * h; }

struct KVSrc { const bf16_t* k; const bf16_t* v; long pitch; int first, lo, hi; };
__device__ __forceinline__ void kv_fetch(const KVSrc& s, int tid, u32x4& kc, u32x4& vc) {
    const int kl = tid >> 3, ch = tid & 7, i = s.first + kl;
    if (i >= s.lo && i < s.hi) { kc = *(const u32x4*)(s.k + (long)i * s.pitch + 8 * ch); vc = *(const u32x4*)(s.v + (long)i * s.pitch + 8 * ch); }
    else { kc = (u32x4){0u, 0u, 0u, 0u}; vc = kc; }
}
template <bool NORM> __device__ __forceinline__ void kv_store(u32x4 kc, u32x4 vc, const float (&g)[8], LAS unsigned char* ksb, LAS unsigned char* vtb, int tid) {
    const int kl = tid >> 3, ch = tid & 7;
    if (NORM) { UNPACK8(kc, k); float ss = (k0 * k0 + k1 * k1) + (k2 * k2 + k3 * k3) + (k4 * k4 + k5 * k5) + (k6 * k6 + k7 * k7);
        ss += swz_f<1>(ss); ss += swz_f<2>(ss); ss += swz_f<4>(ss);
        const float rs = rsqrtf(ss * (1.f / 64.f) + EPS);
        kc.x = cvtpk(k0 * rs * g[0], k1 * rs * g[1]); kc.y = cvtpk(k2 * rs * g[2], k3 * rs * g[3]); kc.z = cvtpk(k4 * rs * g[4], k5 * rs * g[5]); kc.w = cvtpk(k6 * rs * g[6], k7 * rs * g[7]); }
    *(LAS u32x4*)(ksb + kl * KSB + ch * 16) = kc;
    LAS unsigned short* vp = (LAS unsigned short*)(vtb + (8 * ch) * VTB + kl * 2);
    vp[0 * (VTB / 2)] = (unsigned short)(vc.x & 0xffffu); vp[1 * (VTB / 2)] = (unsigned short)(vc.x >> 16);
    vp[2 * (VTB / 2)] = (unsigned short)(vc.y & 0xffffu); vp[3 * (VTB / 2)] = (unsigned short)(vc.y >> 16);
    vp[4 * (VTB / 2)] = (unsigned short)(vc.z & 0xffffu); vp[5 * (VTB / 2)] = (unsigned short)(vc.z >> 16);
    vp[6 * (VTB / 2)] = (unsigned short)(vc.w & 0xffffu); vp[7 * (VTB / 2)] = (unsigned short)(vc.w >> 16);
}
template <bool NORM> __device__ __forceinline__ void load_qfrag(bf16x8 (&qf)[4], const bf16_t* qrow, const float* g1, const float* g2, float sc, int hh) {
    float f[32];
#pragma unroll
    for (int s = 0; s < 4; ++s) { const u32x4 v = *(const u32x4*)(qrow + 16 * s + 8 * hh); UNPACK8(v, k);
        f[8 * s] = k0; f[8 * s + 1] = k1; f[8 * s + 2] = k2; f[8 * s + 3] = k3; f[8 * s + 4] = k4; f[8 * s + 5] = k5; f[8 * s + 6] = k6; f[8 * s + 7] = k7; }
    if (NORM) { float ss = 0.f;
#pragma unroll
        for (int i = 0; i < 32; ++i) ss += f[i] * f[i];
        ss = sum32(ss); sc *= rsqrtf(ss * (1.f / 64.f) + EPS); }
#pragma unroll
    for (int s = 0; s < 4; ++s) { float v[8];
#pragma unroll
        for (int j = 0; j < 8; ++j) { const int d = 16 * s + 8 * hh + j; v[j] = f[8 * s + j] * sc * (g1 ? g1[d] : 1.f) * (g2 ? g2[d] : 1.f); }
        u32x4 w; w.x = cvtpk(v[0], v[1]); w.y = cvtpk(v[2], v[3]); w.z = cvtpk(v[4], v[5]); w.w = cvtpk(v[6], v[7]);
        qf[s] = __builtin_bit_cast(bf16x8, w); }
}

struct SfCmp { int tq, nvis, j0; float slope; __device__ __forceinline__ float operator()(float s, int kl) const { const int j = j0 + kl; return j < nvis ? s - slope * (float)(tq - 16 * j - 31) : -INFINITY; } };
struct SfSlc { int tq, key0; float slope; bool sel; __device__ __forceinline__ float operator()(float s, int kl) const { const int key = key0 + kl; return (sel && key <= tq) ? s - slope * (float)(tq - key) : -INFINITY; } };
struct SfWin { int tq, key0; float slope; __device__ __forceinline__ float operator()(float s, int kl) const { const int key = key0 + kl; return (key <= tq && tq - key <= 511) ? s - slope * (float)(tq - key) : -INFINITY; } };

__device__ __forceinline__ void pv_accum(const f32x16& s0, const f32x16& s1, f32x16& o0, f32x16& o1, LAS const unsigned char* vtb, int r, int hh) {
    __builtin_amdgcn_s_setprio(1);
#pragma unroll
    for (int kt = 0; kt < 2; ++kt)
#pragma unroll
        for (int sp = 0; sp < 2; ++sp) { u32x4 w;
            if (kt == 0) { w.x = cvtpk(s0[8 * sp], s0[8 * sp + 1]); w.y = cvtpk(s0[8 * sp + 2], s0[8 * sp + 3]); w.z = cvtpk(s0[8 * sp + 4], s0[8 * sp + 5]); w.w = cvtpk(s0[8 * sp + 6], s0[8 * sp + 7]); }
            else         { w.x = cvtpk(s1[8 * sp], s1[8 * sp + 1]); w.y = cvtpk(s1[8 * sp + 2], s1[8 * sp + 3]); w.z = cvtpk(s1[8 * sp + 4], s1[8 * sp + 5]); w.w = cvtpk(s1[8 * sp + 6], s1[8 * sp + 7]); }
            const bf16x8 pb = __builtin_bit_cast(bf16x8, w); const int ko = 32 * kt + 16 * sp + 4 * hh;
            { const s16x4 lo = *(LAS const s16x4*)(vtb + r * VTB + ko * 2), hi = *(LAS const s16x4*)(vtb + r * VTB + (ko + 8) * 2);
              o0 = MFMA32(__builtin_shufflevector(lo, hi, 0, 1, 2, 3, 4, 5, 6, 7), pb, o0); }
            { const s16x4 lo = *(LAS const s16x4*)(vtb + (32 + r) * VTB + ko * 2), hi = *(LAS const s16x4*)(vtb + (32 + r) * VTB + (ko + 8) * 2);
              o1 = MFMA32(__builtin_shufflevector(lo, hi, 0, 1, 2, 3, 4, 5, 6, 7), pb, o1); } }
    __builtin_amdgcn_s_setprio(0);
}
template <int MODE, class SF>
__device__ __forceinline__ void attn_block(const bf16x8 (&qf)[4], f32x16& o0, f32x16& o1, float& m, float& l, LAS const unsigned char* ksb, LAS const unsigned char* vtb, int r, int hh, const SF sf,
                                           float msafe_f, float inv_f, LAS float* imprw, int nbase, float& carry) {
    f32x16 s0, s1;
#pragma unroll
    for (int i = 0; i < 16; ++i) { s0[i] = 0.f; s1[i] = 0.f; }
    bf16x8 ka[4], kb2[4];
#pragma unroll
    for (int s = 0; s < 4; ++s) { ka[s] = *(LAS const bf16x8*)(ksb + r * KSB + (16 * s + 8 * hh) * 2); kb2[s] = *(LAS const bf16x8*)(ksb + (32 + r) * KSB + (16 * s + 8 * hh) * 2); }
    __builtin_amdgcn_s_setprio(1);
#pragma unroll
    for (int s = 0; s < 4; ++s) { s0 = MFMA32(ka[s], qf[s], s0); s1 = MFMA32(kb2[s], qf[s], s1); }
    __builtin_amdgcn_s_setprio(0);
    __builtin_amdgcn_sched_barrier(0);
#pragma unroll
    for (int i = 0; i < 16; ++i) { s0[i] = sf(s0[i], crow(i, hh)); s1[i] = sf(s1[i], 32 + crow(i, hh)); }
    if (MODE != 2) {
        float mloc = fmaxf(s0[0], s1[0]);
#pragma unroll
        for (int i = 1; i < 16; ++i) mloc = fmaxf(mloc, fmaxf(s0[i], s1[i]));
        mloc = max32(mloc);
        const float mnew = fmaxf(m, mloc), msafe = mnew == -INFINITY ? 0.f : mnew, corr = EXP2(m - msafe);
        float psum = 0.f;
#pragma unroll
        for (int i = 0; i < 16; ++i) { s0[i] = EXP2(s0[i] - msafe); s1[i] = EXP2(s1[i] - msafe); psum += s0[i] + s1[i]; }
        psum = sum32(psum);
        l = l * corr + psum; m = mnew;
        if (MODE == 0 && !__all(corr == 1.f)) {
#pragma unroll
            for (int i = 0; i < 16; ++i) { o0[i] *= corr; o1[i] *= corr; } }
    } else {
#pragma unroll
        for (int i = 0; i < 16; ++i) { s0[i] = EXP2(s0[i] - msafe_f) * inv_f; s1[i] = EXP2(s1[i] - msafe_f) * inv_f; }
#pragma unroll
        for (int kt = 0; kt < 2; ++kt) { float A[4], T[4], R[4];
#pragma unroll
            for (int g = 0; g < 4; ++g) { const float p0 = kt ? s1[4 * g] : s0[4 * g], p1 = kt ? s1[4 * g + 1] : s0[4 * g + 1], p2 = kt ? s1[4 * g + 2] : s0[4 * g + 2], p3 = kt ? s1[4 * g + 3] : s0[4 * g + 3];
                A[g] = 2.f * ((p0 + p1) + p2) + p3; T[g] = p3; R[g] = partner32(p3, hh); }
#pragma unroll
            for (int g = 0; g < 4; ++g) { const float prev = hh ? R[g] : (g ? R[g - 1] : carry);
                imprw[nbase + 8 * kt + 2 * g + hh] = A[g] + prev; }
            carry = R[3]; (void)T; }
    }
    __builtin_amdgcn_sched_barrier(0);
    if (MODE != 1) pv_accum(s0, s1, o0, o1, vtb, r, hh);
}


__device__ __forceinline__ void attn_block_full(const bf16x8 (&qf)[4], f32x16& o0, f32x16& o1, float& m, float& l, LAS const unsigned char* ksb, LAS const unsigned char* vtb, int r, int hh, float b0, float sl) {
    f32x16 s0, s1;
#pragma unroll
    for (int i = 0; i < 16; ++i) { s0[i] = 0.f; s1[i] = 0.f; }
    bf16x8 ka[4], kb2[4];
#pragma unroll
    for (int s = 0; s < 4; ++s) { ka[s] = *(LAS const bf16x8*)(ksb + r * KSB + (16 * s + 8 * hh) * 2); kb2[s] = *(LAS const bf16x8*)(ksb + (32 + r) * KSB + (16 * s + 8 * hh) * 2); }
    __builtin_amdgcn_s_setprio(1);
#pragma unroll
    for (int s = 0; s < 4; ++s) { s0 = MFMA32(ka[s], qf[s], s0); s1 = MFMA32(kb2[s], qf[s], s1); }
    __builtin_amdgcn_s_setprio(0);
    __builtin_amdgcn_sched_barrier(0);
#pragma unroll
    for (int i = 0; i < 16; ++i) { const float c = (float)((i & 3) + 8 * (i >> 2)); s0[i] = fmaf(sl, c, s0[i]); s1[i] = fmaf(sl, c + 32.f, s1[i]); }
    float mloc = fmaxf(s0[0], s1[0]);
#pragma unroll
    for (int i = 1; i < 16; ++i) mloc = fmaxf(mloc, fmaxf(s0[i], s1[i]));
    mloc = max32(mloc + b0);
    const float mnew = fmaxf(m, mloc), msafe = mnew == -INFINITY ? 0.f : mnew, corr = EXP2(m - msafe), c0 = b0 - msafe;
    float psum = 0.f;
#pragma unroll
    for (int i = 0; i < 16; ++i) { s0[i] = EXP2(s0[i] + c0); s1[i] = EXP2(s1[i] + c0); psum += s0[i] + s1[i]; }
    psum = sum32(psum);
    l = l * corr + psum; m = mnew;
#pragma unroll
    for (int i = 0; i < 16; ++i) { o0[i] *= corr; o1[i] *= corr; }
    __builtin_amdgcn_sched_barrier(0);
    pv_accum(s0, s1, o0, o1, vtb, r, hh);
}

#define KV_PIPELINE(FIRST, NEXT, SRC, NORM, GAIN, ...) do { \
    __syncthreads(); \
    int nxt_ = (FIRST), par_ = 0; u32x4 kc_, vc_; float g8_[8]; \
    { const float* gp_ = (GAIN); _Pragma("unroll") for (int j_ = 0; j_ < 8; ++j_) g8_[j_] = gp_ ? gp_[8 * (tid & 7) + j_] : 1.f; } \
    if (nxt_ >= 0) { const int id = nxt_; const KVSrc src_ = SRC; kv_fetch(src_, tid, kc_, vc_); } \
    while (nxt_ >= 0) { const int cur_ = nxt_; \
        LAS unsigned char* ksb = lds + par_ * KS_BYTES; LAS unsigned char* vtb = lds + 2 * KS_BYTES + par_ * VT_BYTES; \
        kv_store<NORM>(kc_, vc_, g8_, ksb, vtb, tid); \
        __syncthreads(); \
        { const int cur = cur_; nxt_ = (NEXT); } \
        if (nxt_ >= 0) { const int id = nxt_; const KVSrc src_ = SRC; kv_fetch(src_, tid, kc_, vc_); } \
        { const int id = cur_; __VA_ARGS__; } \
        par_ ^= 1; } } while (0)


__device__ __forceinline__ void kv_store_pre(u32x4 kc, u32x4 vc, LAS unsigned char* ksb, LAS unsigned char* vtb, int tid) {
    *(LAS u32x4*)(ksb + (tid >> 3) * KSB + (tid & 7) * 16) = kc;
    LAS u32x2* vp = (LAS u32x2*)(vtb + (tid >> 3) * VTB + (tid & 7) * 16); u32x2 a = {vc.x, vc.y}, b2 = {vc.z, vc.w}; vp[0] = a; vp[1] = b2;
}
#define KV_PIPELINE_PRE(FIRST, NEXT, KTILE, VTILE, ...) do { \
    __syncthreads(); \
    int nxt_ = (FIRST), par_ = 0; u32x4 kc_, vc_; \
    if (nxt_ >= 0) { const int id = nxt_; kc_ = *(const u32x4*)((KTILE) + tid * 8); vc_ = *(const u32x4*)((VTILE) + tid * 8); } \
    while (nxt_ >= 0) { const int cur_ = nxt_; \
        LAS unsigned char* ksb = lds + par_ * KS_BYTES; LAS unsigned char* vtb = lds + 2 * KS_BYTES + par_ * VT_BYTES; \
        kv_store_pre(kc_, vc_, ksb, vtb, tid); \
        __syncthreads(); \
        { const int cur = cur_; nxt_ = (NEXT); } \
        if (nxt_ >= 0) { const int id = nxt_; kc_ = *(const u32x4*)((KTILE) + tid * 8); vc_ = *(const u32x4*)((VTILE) + tid * 8); } \
        { const int id = cur_; __VA_ARGS__; } \
        par_ ^= 1; } } while (0)

__device__ __forceinline__ void nsa_prep_item(const bf16_t* proj, bf16_t* kn, bf16_t* vtn, const float* g_ks, const float* g_kw, int item, LAS unsigned char* scr, int lane) {
    const int b = item >> 7, which = (item >> 6) & 1, n = item & 63, ch = lane & 7, row0 = lane >> 3;
    const bf16_t* src = proj + ((size_t)b * SEQ + 64 * n) * NP + (which ? C_KWA : C_KSA) + 8 * ch;
    const float* g = (which ? g_kw : g_ks) + 8 * ch;
    float gg[8];
#pragma unroll
    for (int i = 0; i < 8; ++i) gg[i] = g[i];
    u32x4 kc[8], vc[8];
#pragma unroll
    for (int j = 0; j < 8; ++j) { const bf16_t* rp = src + (size_t)(row0 + 8 * j) * NP; kc[j] = *(const u32x4*)rp; vc[j] = *(const u32x4*)(rp + 64); }
    bf16_t* kdst = kn + (((size_t)b * 2 + which) * SEQ + 64 * n) * 64 + 8 * ch;
#pragma unroll
    for (int j = 0; j < 8; ++j) { const int row = row0 + 8 * j; UNPACK8(kc[j], k);
        float ss = (k0 * k0 + k1 * k1) + (k2 * k2 + k3 * k3) + (k4 * k4 + k5 * k5) + (k6 * k6 + k7 * k7);
        ss += swz_f<1>(ss); ss += swz_f<2>(ss); ss += swz_f<4>(ss);
        const float rs = rsqrtf(ss * (1.f / 64.f) + EPS); u32x4 o;
        o.x = cvtpk(k0 * rs * gg[0], k1 * rs * gg[1]); o.y = cvtpk(k2 * rs * gg[2], k3 * rs * gg[3]); o.z = cvtpk(k4 * rs * gg[4], k5 * rs * gg[5]); o.w = cvtpk(k6 * rs * gg[6], k7 * rs * gg[7]);
        *(u32x4*)(kdst + (size_t)row * 64) = o;
        LAS unsigned short* vp = (LAS unsigned short*)(scr + (8 * ch) * 144 + row * 2); const u32x4 v = vc[j];
        vp[0 * 72] = (unsigned short)(v.x & 0xffffu); vp[1 * 72] = (unsigned short)(v.x >> 16); vp[2 * 72] = (unsigned short)(v.y & 0xffffu); vp[3 * 72] = (unsigned short)(v.y >> 16);
        vp[4 * 72] = (unsigned short)(v.z & 0xffffu); vp[5 * 72] = (unsigned short)(v.z >> 16); vp[6 * 72] = (unsigned short)(v.w & 0xffffu); vp[7 * 72] = (unsigned short)(v.w >> 16); }
    LDS_WAIT();
    bf16_t* vdst = vtn + ((((size_t)b * 2 + which) * 64 + n) * 64 + lane) * 64;
#pragma unroll
    for (int c = 0; c < 8; ++c) *(u32x4*)(vdst + 8 * c) = *(LAS const u32x4*)(scr + lane * 144 + 16 * c);
    LDS_WAIT();
}

struct NsaArgs { const bf16_t* proj; bf16_t* groups; const bf16_t *kcn, *vcc; const float *b_gate, *g_q, *g_ks, *g_kw, *g_out; const bf16_t *kn, *vtn; };
constexpr int NSA_SLAB = 2 * KS_BYTES + 2 * VT_BYTES, NSA_ISUM = NSA_SLAB + 4 * 64 * 65 * 4, NSA_MASK = NSA_ISUM + 64 * 65 * 4, NSA_UMASK = NSA_MASK + 512;
__device__ __forceinline__ void nsa_item(const NsaArgs& A, int b, int tl, LAS unsigned char* lds, int tid) {
    asm volatile("" : "+v"(tid));
    const int lane = tid & 63, w = __builtin_amdgcn_readfirstlane(tid >> 6), head = w & 3, half = w >> 2, r = lane & 31, hh = lane >> 5;
    const int tq = tl * 64 + 32 * half + r, tokl = 32 * half + r; const size_t token = (size_t)b * SEQ + tq;
    const bf16_t* base = A.proj + (size_t)b * SEQ * NP;
    LAS float* slab = (LAS float*)(lds + NSA_SLAB); LAS float* isum = (LAS float*)(lds + NSA_ISUM);
    LAS unsigned* masks = (LAS unsigned*)(lds + NSA_MASK); LAS unsigned* umask = (LAS unsigned*)(lds + NSA_UMASK);
    const float slope = exp2f(-(float)(2 * head + 1)) * LOG2E;
    bf16x8 qf[4]; load_qfrag<true>(qf, base + (size_t)tq * NP + C_QA + head * 64, A.g_q, nullptr, 0.125f * LOG2E, hh);
    float gl[3];
#pragma unroll
    for (int br = 0; br < 3; ++br) { const float x = bf2f(base[(size_t)tq * NP + C_GT + head * 3 + br]) + A.b_gate[head * 3 + br]; gl[br] = 1.f / (1.f + __expf(-x)); }
    f32x16 of0, of1, o0, o1;
#pragma unroll
    for (int i = 0; i < 16; ++i) { of0[i] = 0.f; of1[i] = 0.f; }
    float dummy = 0.f;
    {
        const int nbc = (tl >> 4) + 1, nvis = tq >= 31 ? ((tq - 31) >> 4) + 1 : 0;
        const bf16_t* kc = A.kcn + (size_t)b * 256 * 64; const bf16_t* vc = A.vcc + (size_t)b * 256 * 64;
        float m = -INFINITY, l = 0.f;
        KV_PIPELINE_PRE(0, (cur + 1 < nbc ? cur + 1 : -1), kc + (size_t)id * 4096, vc + (size_t)id * 4096,
            { const SfCmp sf{tq, nvis, 64 * id, slope}; attn_block<1>(qf, o0, o1, m, l, ksb, vtb, r, hh, sf, 0.f, 0.f, nullptr, 0, dummy); });
        const float inv = l > 0.f ? 1.f / l : 0.f, msafe = m == -INFINITY ? 0.f : m; float carry = 0.f;
#pragma unroll
        for (int i = 0; i < 16; ++i) { o0[i] = 0.f; o1[i] = 0.f; }
        LAS float* imprw = slab + (head * 64 + tokl) * 65;
        KV_PIPELINE_PRE(0, (cur + 1 < nbc ? cur + 1 : -1), kc + (size_t)id * 4096, vc + (size_t)id * 4096,
            { const SfCmp sf{tq, nvis, 64 * id, slope}; attn_block<2>(qf, o0, o1, m, l, ksb, vtb, r, hh, sf, msafe, inv, imprw, 16 * id, carry); });
#pragma unroll
        for (int i = 0; i < 16; ++i) { of0[i] += gl[0] * o0[i]; of1[i] += gl[0] * o1[i]; }
    }
    __syncthreads();
    if (tl > 15) {
        for (int e = tid; e < 64 * 64; e += 512) { const int tk = e >> 6, n = e & 63, o = tk * 65 + n; isum[o] = ((slab[o] + slab[64 * 65 + o]) + slab[2 * 64 * 65 + o]) + slab[3 * 64 * 65 + o]; }
        __syncthreads();
        const int tk = tid >> 3, sub = tid & 7; float v[8]; int cnt[8];
#pragma unroll
        for (int k = 0; k < 8; ++k) { v[k] = isum[tk * 65 + 8 * sub + k]; cnt[k] = 0; }
        for (int mm = 1; mm <= tl - 2; ++mm) { const float vm = isum[tk * 65 + mm];
#pragma unroll
            for (int k = 0; k < 8; ++k) cnt[k] += (vm > v[k] || (vm == v[k] && mm < 8 * sub + k)) ? 1 : 0; }
        unsigned bits = 0u;
#pragma unroll
        for (int k = 0; k < 8; ++k) { const int n = 8 * sub + k; if (n >= 1 && n <= tl - 2 && cnt[k] < 13) bits |= 1u << k; }
        unsigned lo = sub < 4 ? bits << (8 * sub) : 0u, hi = sub >= 4 ? bits << (8 * (sub - 4)) : 0u;
        lo |= swz_u<1>(lo); hi |= swz_u<1>(hi); lo |= swz_u<2>(lo); hi |= swz_u<2>(hi); lo |= swz_u<4>(lo); hi |= swz_u<4>(hi);
        const unsigned long long mk = ((unsigned long long)hi << 32 | lo) | 1ull | (3ull << (tl - 1));
        if (sub == 0) { masks[2 * tk] = (unsigned)mk; masks[2 * tk + 1] = (unsigned)(mk >> 32); }
    } else if (tid < 64) { const unsigned long long mk = (2ull << tl) - 1ull; masks[2 * tid] = (unsigned)mk; masks[2 * tid + 1] = (unsigned)(mk >> 32); }
    __syncthreads();
    if (tid < 64) { unsigned lo = masks[2 * tid], hi = masks[2 * tid + 1];
        lo |= swz_u<1>(lo); hi |= swz_u<1>(hi); lo |= swz_u<2>(lo); hi |= swz_u<2>(hi); lo |= swz_u<4>(lo); hi |= swz_u<4>(hi);
        lo |= swz_u<8>(lo); hi |= swz_u<8>(hi); lo |= swz_u<16>(lo); hi |= swz_u<16>(hi); lo = or32(lo); hi = or32(hi);
        if (tid == 0) { umask[0] = lo; umask[1] = hi; } }
    __syncthreads();
    const unsigned long long um = (unsigned long long)umask[1] << 32 | umask[0];
    const unsigned long long mymask = (unsigned long long)masks[2 * tokl + 1] << 32 | masks[2 * tokl];
    LAS float* park = slab + w * 2048 + lane;
#pragma unroll
    for (int i = 0; i < 16; ++i) { park[i * 64] = of0[i]; park[(16 + i) * 64] = of1[i]; }
    {
        float m = -INFINITY, l = 0.f;
#pragma unroll
        for (int i = 0; i < 16; ++i) { o0[i] = 0.f; o1[i] = 0.f; }
        const bf16_t* kp = A.kn + (size_t)(b * 2) * SEQ * 64; const bf16_t* vp = A.vtn + (size_t)(b * 2) * 64 * 4096;
#define NSA_NEXTBIT(c) ({ const unsigned long long rem_ = ((c) >= 63) ? 0ull : (um & ~((2ull << (c)) - 1ull)); rem_ ? (int)__builtin_ctzll(rem_) : -1; })
        KV_PIPELINE_PRE((int)__builtin_ctzll(um), NSA_NEXTBIT(cur), kp + (size_t)id * 4096, vp + (size_t)id * 4096,
            { const bool sel = (mymask >> id) & 1ull;
              if (__any(sel)) {
                  if (id < tl) attn_block_full(qf, o0, o1, m, l, ksb, vtb, r, hh, sel ? -slope * (float)(tq - 64 * id - 4 * hh) : -INFINITY, slope);
                  else { const SfSlc sf{tq, 64 * id, slope, sel}; attn_block<0>(qf, o0, o1, m, l, ksb, vtb, r, hh, sf, 0.f, 0.f, nullptr, 0, dummy); } } });
        const float sc = gl[1] / l;
#pragma unroll
        for (int i = 0; i < 16; ++i) { park[i * 64] += sc * o0[i]; park[(16 + i) * 64] += sc * o1[i]; }
    }
    {
        float m = -INFINITY, l = 0.f;
#pragma unroll
        for (int i = 0; i < 16; ++i) { o0[i] = 0.f; o1[i] = 0.f; }
        const bf16_t* kp = A.kn + (size_t)(b * 2 + 1) * SEQ * 64; const bf16_t* vp = A.vtn + (size_t)(b * 2 + 1) * 64 * 4096; const int nlo = tl >= 8 ? tl - 8 : 0;
        KV_PIPELINE_PRE(nlo, (cur + 1 <= tl ? cur + 1 : -1), kp + (size_t)id * 4096, vp + (size_t)id * 4096,
            { if (id < tl && id >= tl - 7) attn_block_full(qf, o0, o1, m, l, ksb, vtb, r, hh, -slope * (float)(tq - 64 * id - 4 * hh), slope);
              else { const SfWin sf{tq, 64 * id, slope}; attn_block<0>(qf, o0, o1, m, l, ksb, vtb, r, hh, sf, 0.f, 0.f, nullptr, 0, dummy); } });
        const float sc = gl[2] / l;
#pragma unroll
        for (int i = 0; i < 16; ++i) { of0[i] = park[i * 64] + sc * o0[i]; of1[i] = park[(16 + i) * 64] + sc * o1[i]; }
    }
    {
        float ss = 0.f;
#pragma unroll
        for (int i = 0; i < 16; ++i) ss += of0[i] * of0[i] + of1[i] * of1[i];
        ss = sum32(ss);
        const float rs = rsqrtf(ss * (1.f / 64.f) + EPS); const float* go = A.g_out + head * 64; bf16_t* dst = A.groups + token * DM + head * 64;
#pragma unroll
        for (int g = 0; g < 4; ++g) { const int d0 = 8 * g + 4 * hh;
            u32x2 wa; wa.x = cvtpk(of0[4 * g] * rs * go[d0], of0[4 * g + 1] * rs * go[d0 + 1]); wa.y = cvtpk(of0[4 * g + 2] * rs * go[d0 + 2], of0[4 * g + 3] * rs * go[d0 + 3]);
            *(u32x2*)(dst + d0) = wa;
            u32x2 wb; wb.x = cvtpk(of1[4 * g] * rs * go[32 + d0], of1[4 * g + 1] * rs * go[32 + d0 + 1]); wb.y = cvtpk(of1[4 * g + 2] * rs * go[32 + d0 + 2], of1[4 * g + 3] * rs * go[32 + d0 + 3]);
            *(u32x2*)(dst + 32 + d0) = wb; }
    }
    __syncthreads();
}

struct SfDil { int iq, key0; float sl; __device__ __forceinline__ float operator()(float s, int kl) const { const int df = iq - key0 - kl; return (df >= 0 && df <= 128) ? s - sl * (float)df : -INFINITY; } };
struct DilArgs { const bf16_t* proj; bf16_t* po; float* plse; const float *g_q, *g_k; };
__device__ __forceinline__ void dil_item(const DilArgs& A, int item, LAS unsigned char* lds, int tid) {
    asm volatile("" : "+v"(tid));
    const int cfg = item >> 9, rem = item & 511, b = rem >> 6, head = (rem >> 4) & 3, sub = rem & 15;
    const int dil = cfg == 0 ? 1 : (cfg == 1 ? 4 : 16), nq = 16 / dil, c = sub / nq, qt = sub % nq, i0 = 256 * qt, L = SEQ / dil;
    const int lane = tid & 63, w = __builtin_amdgcn_readfirstlane(tid >> 6), r = lane & 31, hh = lane >> 5;
    const int iq = i0 + 32 * w + r, tq = c + dil * iq; const size_t token = (size_t)b * SEQ + tq;
    const bf16_t* base = A.proj + (size_t)b * SEQ * NP;
    const float slope = exp2f(-(float)(2 * head + 2)) * (float)dil * LOG2E;
    bf16x8 qf[4]; load_qfrag<true>(qf, base + (size_t)tq * NP + C_QD + head * 64, A.g_q, nullptr, 0.125f * LOG2E, hh);
    const bf16_t* kp = base + (size_t)c * NP + C_KD + head * 64; const bf16_t* vp = base + (size_t)c * NP + C_VD + head * 64;
    const int kb_lo = (i0 >> 6) >= 2 ? (i0 >> 6) - 2 : 0, kb_hi = (i0 >> 6) + 3, q_lo = i0 + 32 * w;
    f32x16 o0, o1;
#pragma unroll
    for (int i = 0; i < 16; ++i) { o0[i] = 0.f; o1[i] = 0.f; }
    float m = -INFINITY, l = 0.f, dummy = 0.f;
    KV_PIPELINE(kb_lo, (cur + 1 <= kb_hi ? cur + 1 : -1), (KVSrc{kp, vp, (long)dil * NP, 64 * id, 0, L}), true, A.g_k,
        { if (64 * id + 63 >= q_lo - 128 && 64 * id <= q_lo + 31) { const SfDil sf{iq, 64 * id, slope}; attn_block<0>(qf, o0, o1, m, l, ksb, vtb, r, hh, sf, 0.f, 0.f, nullptr, 0, dummy); } });
    const float inv = 1.f / l;
    bf16_t* dst = A.po + ((size_t)cfg * M + token) * 256 + head * 64;
#pragma unroll
    for (int g = 0; g < 4; ++g) { const int d0 = 8 * g + 4 * hh;
        u32x2 wa; wa.x = cvtpk(o0[4 * g] * inv, o0[4 * g + 1] * inv); wa.y = cvtpk(o0[4 * g + 2] * inv, o0[4 * g + 3] * inv); *(u32x2*)(dst + d0) = wa;
        u32x2 wb; wb.x = cvtpk(o1[4 * g] * inv, o1[4 * g + 1] * inv); wb.y = cvtpk(o1[4 * g + 2] * inv, o1[4 * g + 3] * inv); *(u32x2*)(dst + 32 + d0) = wb; }
    if (hh == 0) A.plse[((size_t)cfg * M + token) * 4 + head] = m + __log2f(l);
    __syncthreads();
}
template <int NI> __device__ __forceinline__ void dil_merge_items(const bf16_t* po, const float* plse, bf16_t* groups, const float* g_out, int item0, int stride, int lane) {
    const int pair = lane >> 3, ch = lane & 7, head = pair & 3;
    u32x4 pv[NI][3]; float ls[NI][3];
#pragma unroll
    for (int n = 0; n < NI; ++n) { const size_t token = (size_t)(item0 + n * stride) * 2 + (pair >> 2);
#pragma unroll
        for (int i = 0; i < 3; ++i) { ls[n][i] = plse[((size_t)i * M + token) * 4 + head]; pv[n][i] = *(const u32x4*)(po + ((size_t)i * M + token) * 256 + head * 64 + 8 * ch); } }
    const float* go = g_out + 768 + head * 64 + 8 * ch;
#pragma unroll
    for (int n = 0; n < NI; ++n) { const size_t token = (size_t)(item0 + n * stride) * 2 + (pair >> 2);
        const float mx = fmaxf(ls[n][0], fmaxf(ls[n][1], ls[n][2]));
        const float w0 = EXP2(ls[n][0] - mx), w1 = EXP2(ls[n][1] - mx), w2 = EXP2(ls[n][2] - mx), winv = 1.f / (w0 + w1 + w2);
        float o[8];
#pragma unroll
        for (int j = 0; j < 8; ++j) o[j] = 0.f;
#pragma unroll
        for (int i = 0; i < 3; ++i) { UNPACK8(pv[n][i], k); const float wi = (i == 0 ? w0 : (i == 1 ? w1 : w2)) * winv;
            o[0] += wi * k0; o[1] += wi * k1; o[2] += wi * k2; o[3] += wi * k3; o[4] += wi * k4; o[5] += wi * k5; o[6] += wi * k6; o[7] += wi * k7; }
        float ss = 0.f;
#pragma unroll
        for (int j = 0; j < 8; ++j) ss += o[j] * o[j];
        ss += swz_f<1>(ss); ss += swz_f<2>(ss); ss += swz_f<4>(ss);
        const float rs = rsqrtf(ss * (1.f / 64.f) + EPS);
        u32x4 wv; wv.x = cvtpk(o[0] * rs * go[0], o[1] * rs * go[1]); wv.y = cvtpk(o[2] * rs * go[2], o[3] * rs * go[3]); wv.z = cvtpk(o[4] * rs * go[4], o[5] * rs * go[5]); wv.w = cvtpk(o[6] * rs * go[6], o[7] * rs * go[7]);
        *(u32x4*)(groups + token * DM + 768 + head * 64 + 8 * ch) = wv; }
}

__device__ __forceinline__ void stick_block(const bf16x8 (&qf)[4], f32x16& o0, f32x16& o1, float& carry, LAS const unsigned char* ksb, LAS const unsigned char* vtb, int r, int hh, int tq, int key0) {
    f32x16 s0, s1;
#pragma unroll
    for (int i = 0; i < 16; ++i) { s0[i] = 0.f; s1[i] = 0.f; }
    bf16x8 ka[4], kb2[4];
#pragma unroll
    for (int s = 0; s < 4; ++s) { ka[s] = *(LAS const bf16x8*)(ksb + r * KSB + (16 * s + 8 * hh) * 2); kb2[s] = *(LAS const bf16x8*)(ksb + (32 + r) * KSB + (16 * s + 8 * hh) * 2); }
    __builtin_amdgcn_s_setprio(1);
#pragma unroll
    for (int s = 0; s < 4; ++s) { s0 = MFMA32(ka[s], qf[s], s0); s1 = MFMA32(kb2[s], qf[s], s1); }
    __builtin_amdgcn_s_setprio(0);
    __builtin_amdgcn_sched_barrier(0);
    float acc = carry;
#pragma unroll
    for (int kti = 0; kti < 2; ++kti) { const int kt = 1 - kti; float spm[16], G[4], R[4];
#pragma unroll
        for (int i = 0; i < 16; ++i) { const float z = kt ? s1[i] : s0[i]; const bool act = key0 + 32 * kt + crow(i, hh) < tq;
            const float sp = fmaxf(z, 0.f) + __logf(1.f + __expf(-fabsf(z)));
            spm[i] = act ? sp : 0.f; const float lw = act ? z - sp : -INFINITY; if (kt) s1[i] = lw; else s0[i] = lw; }
#pragma unroll
        for (int g = 0; g < 4; ++g) { G[g] = (spm[4 * g] + spm[4 * g + 1]) + (spm[4 * g + 2] + spm[4 * g + 3]); R[g] = partner32(G[g], hh); }
#pragma unroll
        for (int gi = 0; gi < 4; ++gi) { const int g = 3 - gi; float run = acc + (hh ? 0.f : R[g]);
#pragma unroll
            for (int ki = 0; ki < 4; ++ki) { const int i = 4 * g + 3 - ki; const float lw = kt ? s1[i] : s0[i]; const float wv = __expf(lw - run); if (kt) s1[i] = wv; else s0[i] = wv; run += spm[i]; }
            acc += G[g] + R[g]; } }
    carry = acc;
    __builtin_amdgcn_sched_barrier(0);
    pv_accum(s0, s1, o0, o1, vtb, r, hh);
}
struct StickArgs { const bf16_t* proj; bf16_t* groups; const float* g_out; };
__device__ __forceinline__ void stick_item(const StickArgs& A, int item, LAS unsigned char* lds, int tid) {
    asm volatile("" : "+v"(tid));
    const int b = item >> 6, head = (item >> 4) & 3, qt = item & 15, T0 = 256 * qt;
    const int lane = tid & 63, w = __builtin_amdgcn_readfirstlane(tid >> 6), r = lane & 31, hh = lane >> 5, tq = T0 + 32 * w + r;
    const size_t token = (size_t)b * SEQ + tq;
    const bf16_t* base = A.proj + (size_t)b * SEQ * NP;
    bf16x8 qf[4]; load_qfrag<false>(qf, base + (size_t)tq * NP + C_QC + head * 64, nullptr, nullptr, 0.125f, hh);
    LAS unsigned* flags = (LAS unsigned*)(lds + NSA_SLAB);
    if (tid < 16) flags[tid] = 0u;
    f32x16 o0, o1;
#pragma unroll
    for (int i = 0; i < 16; ++i) { o0[i] = 0.f; o1[i] = 0.f; }
    float carry = 0.f; bool done = false;
    const bf16_t* kp = base + C_KC + head * 64; const bf16_t* vp = base + C_VC + head * 64;
#define STK_NEXT(c) ({ const LAS unsigned* f_ = flags + (par_ ^ 1) * 8; const unsigned ad_ = (f_[0] & f_[1]) & (f_[2] & f_[3]) & (f_[4] & f_[5]) & (f_[6] & f_[7]); ((c) > 0 && !ad_) ? (c) - 1 : -1; })
    KV_PIPELINE((T0 >> 6) + 3, STK_NEXT(cur), (KVSrc{kp, vp, NP, 64 * id, 0, SEQ}), false, nullptr,
        { if (!done && 64 * id <= T0 + 32 * w + 30) { stick_block(qf, o0, o1, carry, ksb, vtb, r, hh, tq, 64 * id); done = __all(carry > 104.f); }
          if (lane == 0) flags[par_ * 8 + w] = done ? 1u : 0u; });
    float ss = 0.f;
#pragma unroll
    for (int i = 0; i < 16; ++i) ss += o0[i] * o0[i] + o1[i] * o1[i];
    ss = sum32(ss);
    const float rs = rsqrtf(ss * (1.f / 64.f) + EPS); const float* go = A.g_out + 512 + head * 64; bf16_t* dst = A.groups + token * DM + 512 + head * 64;
#pragma unroll
    for (int g = 0; g < 4; ++g) { const int d0 = 8 * g + 4 * hh;
        u32x2 wa; wa.x = cvtpk(o0[4 * g] * rs * go[d0], o0[4 * g + 1] * rs * go[d0 + 1]); wa.y = cvtpk(o0[4 * g + 2] * rs * go[d0 + 2], o0[4 * g + 3] * rs * go[d0 + 3]); *(u32x2*)(dst + d0) = wa;
        u32x2 wb; wb.x = cvtpk(o1[4 * g] * rs * go[32 + d0], o1[4 * g + 1] * rs * go[32 + d0 + 1]); wb.y = cvtpk(o1[4 * g + 2] * rs * go[32 + d0 + 2], o1[4 * g + 3] * rs * go[32 + d0 + 3]); *(u32x2*)(dst + 32 + d0) = wb; }
    __syncthreads();
}

struct CmpArgs { const bf16_t* proj; const bf16_t* w1t; const bf16_t* w2t; const float* cb; const float* g_kc; bf16_t* kcn; bf16_t* vcc; };
constexpr int HIDB = 528;
__device__ __forceinline__ void compress_item(const CmpArgs& A, int item, LAS unsigned char* lds, int tid) {
    asm volatile("" : "+v"(tid));
    const int kv = item >> 6, rt = item & 63, b = rt >> 3, j0 = (rt & 7) * 32;
    const int lane = tid & 63, w = __builtin_amdgcn_readfirstlane(tid >> 6), r = lane & 31, hh = lane >> 5;
    { const bf16_t* xsrc = A.proj + (size_t)b * SEQ * NP + (kv ? C_VCA : C_KCA);
      u32x4 stg[9];
#pragma unroll
      for (int q = 0; q < 9; ++q) { const int e2 = tid + 512 * q, t = e2 >> 3, c = e2 & 7; int tk = 16 * j0 + t; tk = tk < SEQ ? tk : SEQ - 1;
          if (e2 < 528 * 8) stg[q] = *(const u32x4*)(xsrc + (size_t)tk * NP + 8 * c); }
#pragma unroll
      for (int q = 0; q < 9; ++q) { const int e2 = tid + 512 * q, t = e2 >> 3, c = e2 & 7;
          if (e2 < 528 * 8) *(LAS u32x4*)(lds + (t ^ ((t >> 7) & 1)) * 128 + ((c ^ ((t >> 4) & 7)) * 16)) = stg[q]; } }
    __syncthreads();
    const bf16_t* wf = A.w1t + (size_t)kv * 256 * 2048 + ((size_t)w * 128 * 64 + lane) * 8;
    f32x16 acc;
#pragma unroll
    for (int i = 0; i < 16; ++i) acc[i] = 0.f;
#pragma unroll 8
    for (int pos = 0; pos < 32; ++pos) { const int t = 16 * r + pos; LAS const unsigned char* arow = lds + (t ^ ((t >> 7) & 1)) * 128; const int sw = (t >> 4) & 7;
#pragma unroll
        for (int q = 0; q < 4; ++q) { const bf16x8 af = *(LAS const bf16x8*)(arow + (((2 * q + hh) ^ sw) * 16)), bfr = *(const bf16x8*)(wf + (size_t)(4 * pos + q) * 512); acc = MFMA32(af, bfr, acc); } }
    __syncthreads();
    { const float bias = A.cb[kv * 256 + 32 * w + r];
#pragma unroll
      for (int i = 0; i < 16; ++i) { const float x = acc[i] + bias; const float hv = 0.5f * x * (1.f + tanhf(0.7978845608028654f * (x + 0.044715f * x * x * x)));
          *(LAS unsigned short*)(lds + crow(i, hh) * HIDB + (32 * w + r) * 2) = (unsigned short)(cvtpk(hv, hv) & 0xffffu); } }
    __syncthreads();
    if (w == 0) {
        f32x16 c0, c1;
#pragma unroll
        for (int i = 0; i < 16; ++i) { c0[i] = 0.f; c1[i] = 0.f; }
        const bf16_t* w2a = A.w2t + ((size_t)kv * 64 + r) * 256 + 8 * hh; const bf16_t* w2b = w2a + 32 * 256;
#pragma unroll
        for (int s = 0; s < 16; ++s) { const bf16x8 af = *(LAS const bf16x8*)(lds + r * HIDB + (16 * s + 8 * hh) * 2);
            c0 = MFMA32(af, *(const bf16x8*)(w2a + 16 * s), c0); c1 = MFMA32(af, *(const bf16x8*)(w2b + 16 * s), c1); }
        const float g0 = A.g_kc[r], g1 = A.g_kc[32 + r]; bf16_t* dst = (kv ? A.vcc : A.kcn) + ((size_t)b * 256 + j0) * 64;
#pragma unroll
        for (int i = 0; i < 16; ++i) { float v0 = c0[i], v1 = c1[i];
            if (!kv) { float ss = v0 * v0 + v1 * v1; ss += swz_f<1>(ss); ss += swz_f<2>(ss); ss += swz_f<4>(ss); ss += swz_f<8>(ss); ss += swz_f<16>(ss);
                const float rs = rsqrtf(ss * (1.f / 64.f) + EPS); v0 *= rs * g0; v1 *= rs * g1; }
            const int row = crow(i, hh);
            if (!kv) { dst[row * 64 + r] = (bf16_t)(cvtpk(v0, v0) & 0xffffu); dst[row * 64 + 32 + r] = (bf16_t)(cvtpk(v1, v1) & 0xffffu); }
            else { const int j = j0 + row; bf16_t* vt = A.vcc + ((size_t)b * 4 + (j >> 6)) * 4096 + (j & 63);
                vt[(size_t)r * 64] = (bf16_t)(cvtpk(v0, v0) & 0xffffu); vt[(size_t)(32 + r) * 64] = (bf16_t)(cvtpk(v1, v1) & 0xffffu); } }
    }
    __syncthreads();
}
#define RLX_AGENT __ATOMIC_RELAXED, __HIP_MEMORY_SCOPE_AGENT
#define XB_TMO      128
#define XB_XCNT(j)  (256  + 64 * (j))
#define XB_XSUB(j)  (1280 + 64 * (j))
#define XB_XGEN(j)  (2304 + 64 * (j))
#define XB_TOP      3328
#define XB_TOPGEN   3392
#define XCD_BAR_WORDS 3456
#define XB_SPIN_CAP (1u << 18)

__device__ __forceinline__ unsigned xb_ld(unsigned* p)              { return __hip_atomic_load(p, __ATOMIC_RELAXED, __HIP_MEMORY_SCOPE_AGENT); }
__device__ __forceinline__ unsigned xb_add(unsigned* p, unsigned v) { return __hip_atomic_fetch_add(p, v, __ATOMIC_RELAXED, __HIP_MEMORY_SCOPE_AGENT); }
__device__ __forceinline__ unsigned xb_xcc_id() { return (unsigned)__builtin_amdgcn_s_getreg((3 << 11) | 20) & 0xFu; }
#define XB_SPIN(cond, bar) do { unsigned _sp = 0; while (cond) { __builtin_amdgcn_s_sleep(1); \
    if ((++_sp & 255u) == 0u) { if (xb_ld(&(bar)[XB_TMO])) break; if (_sp > XB_SPIN_CAP) { atomicAdd(&(bar)[XB_TMO], 1u); break; } } } } while (0)

struct XcdBarrier {
    unsigned* bar; unsigned x;
    volatile LAS unsigned* st;
};

__device__ __forceinline__ XcdBarrier xcd_barrier_post(unsigned* bar, volatile LAS unsigned* st) {
    XcdBarrier b; b.bar = bar; b.x = xb_xcc_id(); b.st = st;
    if (threadIdx.x == 0) (void)xb_add(&bar[XB_XCNT(b.x)], 1u);
    return b;
}
__device__ __forceinline__ void xcd_barrier_complete(unsigned* bar, unsigned x, unsigned& nloc, unsigned& nx) {
    const unsigned G = gridDim.x * gridDim.y * gridDim.z;
    unsigned sum, cnt, mine, sp = 0u;
    for (;;) {
        sum = 0u; cnt = 0u; mine = 0u;
#pragma unroll
        for (unsigned j = 0; j < 16; ++j) { const unsigned c = xb_ld(&bar[XB_XCNT(j)]); sum += c; cnt += (c > 0u) ? 1u : 0u; mine = (j == x) ? c : mine; }
        if (sum == G) break;
        __builtin_amdgcn_s_sleep(1);
        if ((++sp & 255u) == 0u) { if (xb_ld(&bar[XB_TMO])) break; if (sp > XB_SPIN_CAP) { atomicAdd(&bar[XB_TMO], 1u); break; } }
    }
    nloc = mine > 0u ? mine : 1u; nx = cnt > 0u ? cnt : 1u;
}

__device__ __forceinline__ void xcd_barrier(const XcdBarrier& b) {
    asm volatile("s_waitcnt vmcnt(0)" ::: "memory");
    __syncthreads();
    if (threadIdx.x == 0) {
        unsigned* bar = b.bar;
        __builtin_amdgcn_s_waitcnt(0);
        unsigned nloc = b.st[0], nx = b.st[1];
        if (nloc == 0u) { xcd_barrier_complete(bar, b.x, nloc, nx); b.st[0] = nloc; b.st[1] = nx; }
        const unsigned old = xb_add(&bar[XB_XSUB(b.x)], 1u);
        const unsigned gen = old / nloc;
        if (old + 1u == (gen + 1u) * nloc) {
            __builtin_amdgcn_fence(__ATOMIC_RELEASE, "agent");
            asm volatile("s_waitcnt vmcnt(0)" ::: "memory");
            const unsigned og = xb_add(&bar[XB_TOP], 1u);
            const unsigned tg = og / nx;
            if (og + 1u == (tg + 1u) * nx) xb_add(&bar[XB_TOPGEN], 1u);
            else XB_SPIN(xb_ld(&bar[XB_TOPGEN]) == tg, bar);
            __builtin_amdgcn_fence(__ATOMIC_ACQUIRE, "agent");
            xb_add(&bar[XB_XGEN(b.x)], 1u);
            asm volatile("s_waitcnt vmcnt(0)" ::: "memory");
        } else {
            XB_SPIN(xb_ld(&bar[XB_XGEN(b.x)]) == gen, bar);
            __builtin_amdgcn_fence(__ATOMIC_ACQUIRE, "agent");
            asm volatile("s_waitcnt vmcnt(0)" ::: "memory");
        }
    }
    __syncthreads();
}

#ifndef REP_CMP
#define REP_CMP 1
#endif
#ifndef REP_STK
#define REP_STK 1
#endif
#ifndef REP_DIL
#define REP_DIL 1
#endif
#ifndef REP_NSA
#define REP_NSA 1
#endif
#ifndef REP_G1
#define REP_G1 1
#endif
#ifndef REP_G3
#define REP_G3 1
#endif
#ifndef REP_PRO
#define REP_PRO 1
#endif
#ifndef REP_PREP
#define REP_PREP 1
#endif
#ifndef RESID_BF16
#define RESID_BF16 1
#endif
#ifndef REP_CONV
#define REP_CONV 1
#endif
#ifndef REP_G2
#define REP_G2 1
#endif
#ifndef XSYNC
#define XSYNC 0
#endif
__global__ void __launch_bounds__(512, 2) fwd_kernel(Params p) {
    extern __shared__ __attribute__((aligned(16))) unsigned char lds_raw[];
    cg::grid_group grid = cg::this_grid();
    LAS unsigned char* lds = (LAS unsigned char*)lds_raw;
#define TID_SETUP() int tid = threadIdx.x; asm volatile("" : "+v"(tid)); const int lane = tid & 63, wave = __builtin_amdgcn_readfirstlane(tid >> 6), gw = blockIdx.x * 8 + wave; (void)lane; (void)gw
    const int G = gridDim.x, NGW = G * 8;
    unsigned char* ws = p.ws;
    volatile LAS unsigned* misc = (volatile LAS unsigned*)(lds + LDS_BYTES - 64);
    unsigned* barw = (unsigned*)(ws + WS_BAR);
    { int t0 = threadIdx.x; if (t0 < 2) misc[t0] = 0u;
      if (blockIdx.x == 0) for (int i = t0; i < XCD_BAR_WORDS; i += 512) barw[i] = 0u;
      __syncthreads(); }
    float* ss = (float*)(ws + WS_SS); bf16_t* kcn = (bf16_t*)(ws + WS_KCN); bf16_t* vcc = (bf16_t*)(ws + WS_VCC);
    bf16_t* xb = (bf16_t*)(ws + WS_XB); bf16_t* groups = (bf16_t*)(ws + WS_GR); bf16_t* proj = (bf16_t*)(ws + WS_PROJ); bf16_t* hbuf = proj;
    float* x1 = (float*)(ws + WS_X1); bf16_t* nkn = (bf16_t*)(ws + WS_X1); bf16_t* nvt = (bf16_t*)(ws + WS_X1 + 8 * MiB);
    bf16_t* dpo = (bf16_t*)((unsigned char*)p.out + DO_PO); float* dlse = (float*)((unsigned char*)p.out + DO_LSE);

#ifndef SKIP_PRO
    for (int rep_ = 0; rep_ < REP_PRO; ++rep_) { TID_SETUP(); prologue(p, lds, gw, NGW, wave, lane); }
#endif
    grid.sync();
    const XcdBarrier xbar = xcd_barrier_post(barw, misc);
    for (int xs_ = 0; xs_ < XSYNC; ++xs_) xcd_barrier(xbar);

    for (int l = 0; l < 2; ++l) {
        unsigned char* wl = ws + WS_W + (size_t)l * W_LAYER;
#ifndef SKIP_G1
        for (int rep_ = 0; rep_ < REP_G1; ++rep_)
        { pg8::Gemm g{xb, (const bf16_t*)(wl + W_IN), M, NP, DM}; pg8::StaticOrder S; S.init(M, NP, G, (int)blockIdx.x);
          EpiProj E{proj, ss + (size_t)(2 * l) * M};
          pg8::gemm_phase<EpiProj, pg8::StaticOrder, true, true>(lds, g, S, E); }
#endif
        xcd_barrier(xbar);
        {
            TID_SETUP();
            const float* g_out = p.in[17] + l * DM;
            {
              const CmpArgs CA{proj, (const bf16_t*)(ws + WS_W1T) + (size_t)l * 2 * 256 * 2048, (const bf16_t*)(ws + WS_W2T) + (size_t)l * 2 * 64 * 256, (const float*)(ws + WS_CB) + l * 512, p.in[5] + l * 64, kcn, vcc};
              const StickArgs SA{proj, groups, g_out}; const DilArgs DA{proj, dpo, dlse, p.in[15] + l * 64, p.in[16] + l * 64};
              volatile LAS int* slot = (volatile LAS int*)(lds + LDS_BYTES - 32);
              for (;;) { __syncthreads(); if (tid == 0) *slot = (int)atomicAdd(barw + 32 + 64 * l, 1u); __syncthreads(); const int it = *slot; if (it >= 128 + 512 + 1536 + 256 + 128) break;
                  if (it < 128) compress_item(CA, it, lds, tid); else if (it < 640) stick_item(SA, it - 128, lds, tid); else if (it < 2176) dil_item(DA, it - 640, lds, tid);
                  else if (it < 2432) { const int i0 = (it - 2176) * 64 + wave; conv_items<4>(proj, groups, p.in[14] + l * 768, g_out, i0, 8, lane); conv_items<4>(proj, groups, p.in[14] + l * 768, g_out, i0 + 32, 8, lane); }
                  else nsa_prep_item(proj, nkn, nvt, p.in[6] + l * 64, p.in[7] + l * 64, (it - 2432) * 8 + wave, lds + wave * 9216, lane); } }
        }
        xcd_barrier(xbar);
#ifndef SKIP_NSA
#ifndef SKIP_DIL
#endif
        for (int rep_ = 0; rep_ < REP_NSA; ++rep_)
        { TID_SETUP(); NsaArgs A{proj, groups, kcn, vcc, p.in[3] + l * 12, p.in[4] + l * 64, p.in[6] + l * 64, p.in[7] + l * 64, p.in[17] + l * DM, nkn, nvt};
          volatile LAS int* slot = (volatile LAS int*)(lds + LDS_BYTES - 32);
          for (;;) { __syncthreads(); if (tid == 0) *slot = (int)atomicAdd(barw + 64 * l, 1u); __syncthreads(); const int it = *slot; if (it >= 512 + 256) break;
              if (it < 512) nsa_item(A, it & 7, 63 - (it >> 3), lds, tid);
              else { const int i0 = (it - 512) * 64 + wave; dil_merge_items<4>(dpo, dlse, groups, p.in[17] + l * DM, i0, 8, lane); dil_merge_items<4>(dpo, dlse, groups, p.in[17] + l * DM, i0 + 32, 8, lane); } } }
#endif
        xcd_barrier(xbar);
#ifndef SKIP_G2
        { pg8::Gemm g{groups, (const bf16_t*)(wl + W_OUT), M, DM, DM}; pg8::StaticOrder S; S.init(M, DM, G, (int)blockIdx.x);
#if RESID_BF16
          EpiResid E{l == 0 ? p.in[0] : nullptr, xb, nullptr, xb, ss + (size_t)(2 * l + 1) * M};
#else
          EpiResid E{l == 0 ? p.in[0] : x1, nullptr, l == 0 ? x1 : p.out, xb, ss + (size_t)(2 * l + 1) * M};
#endif
          pg8::gemm_phase<EpiResid, pg8::StaticOrder, true, true>(lds, g, S, E);
          for (int rep_ = 1; rep_ < REP_G2; ++rep_) { E.ss = nullptr; pg8::gemm_phase<EpiResid, pg8::StaticOrder, true, true>(lds, g, S, E); } }
#endif
        xcd_barrier(xbar);
#ifndef SKIP_G3
        for (int rep_ = 0; rep_ < REP_G3; ++rep_)
        { pg8::Gemm g{xb, (const bf16_t*)(wl + W_GU), M, NGU, DM}; pg8::StaticOrder S; S.init(M, NGU, G, (int)blockIdx.x);
          EpiSwiGLU E{hbuf, ss + (size_t)(2 * l + 1) * M};
          pg8::gemm_phase<EpiSwiGLU, pg8::StaticOrder, true, true>(lds, g, S, E); }
#endif
        xcd_barrier(xbar);
#ifndef SKIP_G4
        { pg8::Gemm g{hbuf, (const bf16_t*)(wl + W_DN), M, DM, FF}; pg8::StaticOrder S; S.init(M, DM, G, (int)blockIdx.x);
          float* xio = l == 0 ? x1 : p.out;
#if RESID_BF16
          EpiResid E{nullptr, xb, l == 0 ? nullptr : p.out, l == 0 ? xb : nullptr, l == 0 ? ss + (size_t)2 * M : nullptr}; (void)xio;
#else
          EpiResid E{xio, nullptr, xio, l == 0 ? xb : nullptr, l == 0 ? ss + (size_t)2 * M : nullptr};
#endif
          pg8::gemm_phase<EpiResid, pg8::StaticOrder, true, true>(lds, g, S, E); }
#endif
        if (l == 0) xcd_barrier(xbar);
    }
}

extern "C" void kernel_launch(void* const* d_in, const int* in_sizes, int n_in, void* d_out, int out_size, void* d_ws, size_t ws_size, hipStream_t stream) {
    static int grid = 0;
    if (grid == 0) {
        if (n_in != 23 || out_size != M * DM || ws_size < WS_END) { fprintf(stderr, "kernel_launch: unexpected shapes (n_in %d, out %d, ws %zu)\n", n_in, out_size, ws_size); grid = -1; return; }
        int dev = 0, cus = 0, per_cu = 0;
        (void)hipGetDevice(&dev); (void)hipDeviceGetAttribute(&cus, hipDeviceAttributeMultiprocessorCount, dev);
        if (hipFuncSetAttribute((const void*)fwd_kernel, hipFuncAttributeMaxDynamicSharedMemorySize, LDS_BYTES) != hipSuccess) { fprintf(stderr, "kernel_launch: hipFuncSetAttribute failed\n"); grid = -1; return; }
        if (hipOccupancyMaxActiveBlocksPerMultiprocessor(&per_cu, (const void*)fwd_kernel, 512, LDS_BYTES) != hipSuccess || per_cu < 1) per_cu = 1;
        (void)hipGetLastError();
        grid = cus * 1;
        (void)per_cu;
    }
    if (grid < 0) return;
    Params p{};
    for (int i = 0; i < 23; ++i) p.in[i] = (const float*)d_in[i];
    p.out = (float*)d_out; p.ws = (unsigned char*)d_ws;
    void* args[] = {&p};
    hipError_t e = hipLaunchCooperativeKernel((const void*)fwd_kernel, dim3(grid), dim3(512), args, LDS_BYTES, stream);
    if (e != hipSuccess) fprintf(stderr, "cooperative launch failed: %s (grid %d)\n", hipGetErrorString(e), grid);
}
```

```cpp
#include <hip/hip_runtime.h>
#include <hip/hip_cooperative_groups.h>
#include <cstdio>
#include <cstdint>
namespace cg = cooperative_groups;
namespace pg8 {
#define PG8_LAS __attribute__((address_space(3)))
typedef unsigned short bf16_t;
typedef short bf16x8 __attribute__((ext_vector_type(8)));
typedef float f32x4 __attribute__((ext_vector_type(4)));
typedef unsigned u32x4 __attribute__((ext_vector_type(4)));
constexpr int BM = 256, BK = 64, HALF = 128, HTB = HALF * BK * 2  , STAGE_BYTES = 8 * HTB, NXCD = 8, WGM = 8;

__host__ __device__ __forceinline__ int lds_byte(int r, int c) { const int st = (r >> 4) * 2 + (c >> 5), rr = r & 15, cc = c & 31, ob = rr * 64 + cc * 2; return st * 1024 + (ob ^ (((ob >> 9) & 1) << 5)); }
__host__ __device__ __forceinline__ void stage_rc(int b, int& R, int& C) { const int st = b / 1024, sb = b % 1024, swz = sb ^ (((sb >> 9) & 1) << 5); R = (st >> 1) * 16 + swz / 64; C = (st & 1) * 32 + (swz % 64) / 2; }
__host__ __device__ __forceinline__ int perm32(int rho) { const int n = rho >> 4, i = rho & 15; return 8 * (i >> 2) + 4 * n + (i & 3); }

struct Unit { int pm, pn; };
struct Gemm { const bf16_t* A; const bf16_t* Bt; int M, N, K; };

struct StaticOrder {
    int nM, nN, nwg, G, c;
    __host__ __device__ void init(int M, int N, int G_, int c_) { nM = M / BM; nN = N / BM; nwg = nM * nN; G = G_; c = c_; }
    __host__ __device__ bool next(int i, Unit& u) const {
        const long L = (long)i * G + c; if (L >= nwg) return false;
        int wgid = (int)L; { const int q = nwg / NXCD, r = nwg % NXCD, xcd = wgid % NXCD, off = wgid / NXCD; wgid = (xcd < r ? xcd * (q + 1) : r * (q + 1) + (xcd - r) * q) + off; }
        const int nig = WGM * nN, gid = wgid / nig, fm = gid * WGM, gsz = (nM - fm) < WGM ? (nM - fm) : WGM;
        u.pm = fm + ((wgid % nig) % gsz); u.pn = (wgid % nig) / gsz; return true;
    }
    __device__ __forceinline__ void a_ready(const Unit&) const {}
    __device__ __forceinline__ void done(const Unit&) const {}
};

__device__ __forceinline__ unsigned cvt_pk_bf16(float lo, float hi) { unsigned r; asm volatile("v_cvt_pk_bf16_f32 %0, %1, %2" : "=v"(r) : "v"(lo), "v"(hi)); return r; }
template <class Epi, class Sched, bool ALIGN_EPI = false, bool SP2 = false>
__device__ __forceinline__ void gemm_phase(PG8_LAS unsigned char* lds, const Gemm g, const Sched& S, const Epi& E) {
    int tid_l = threadIdx.x; asm volatile("" : "+v"(tid_l));
    const int tid = tid_l, wid = __builtin_amdgcn_readfirstlane(tid >> 6), lane = tid & 63, wr = wid >> 2, wc = wid & 3, fr = lane & 15, fq = lane >> 4;
    const int K = g.K, nt = K / BK;
    unsigned voffA[2], voffB[2];
#pragma unroll
    for (int i = 0; i < 2; ++i) { int R, C; stage_rc(tid * 16 + i * 8192, R, C); const int Rb = Epi::PERM ? ((R & ~31) + perm32(R & 31)) : R;
        voffA[i] = (unsigned)(R * K + C) * 2u; voffB[i] = (unsigned)(Rb * K + C) * 2u; }
    const size_t kstep = (size_t)(BK * 2);
    const size_t hstep = (size_t)HALF * K * 2;
    const size_t tstep = 2 * hstep;
    const unsigned ldsw = (unsigned)wid * 1024u;
    const int aoff = lds_byte(wr * 64 + fr, fq * 8), boff = lds_byte(wc * 32 + fr, fq * 8);
#define PG8_SA(b, h) (((b) * 2 + (h)) * HTB)
#define PG8_SB(b, h) ((4 + (b) * 2 + (h)) * HTB)
#define PG8_STAGE(bufoff, gbase, voff) do { _Pragma("unroll") for (int _i = 0; _i < 2; ++_i) \
        __builtin_amdgcn_global_load_lds((const unsigned*)((const char*)(gbase) + (voff)[_i]), (PG8_LAS unsigned*)(lds + (bufoff) + ldsw + _i * 8192), 16, 0, 0); } while (0)
#define PG8_LDA(dst, b, h) do { _Pragma("unroll") for (int m = 0; m < 4; ++m) _Pragma("unroll") for (int k = 0; k < 2; ++k) dst[m][k] = *(const PG8_LAS bf16x8*)(lds + PG8_SA(b, h) + aoff + m * 2048 + k * 1024); } while (0)
#define PG8_LDB(dst, b, h) do { _Pragma("unroll") for (int n = 0; n < 2; ++n) _Pragma("unroll") for (int k = 0; k < 2; ++k) dst[n][k] = *(const PG8_LAS bf16x8*)(lds + PG8_SB(b, h) + boff + n * 2048 + k * 1024); } while (0)
#define PG8_MMA(ai, bj, At, Bt) do { __builtin_amdgcn_s_setprio(1); _Pragma("unroll") for (int m = 0; m < 4; ++m) _Pragma("unroll") for (int n = 0; n < 2; ++n) _Pragma("unroll") for (int k = 0; k < 2; ++k) \
        acc[ai][bj][m][n] = __builtin_amdgcn_mfma_f32_16x16x32_bf16(Bt[n][k], At[m][k], acc[ai][bj][m][n], 0, 0, 0); __builtin_amdgcn_s_setprio(0); } while (0)
#define PG8_WAIT_V(n) asm volatile("s_waitcnt vmcnt(" #n ")" ::: "memory")
#define PG8_WAIT_L(n) asm volatile("s_waitcnt lgkmcnt(" #n ")" ::: "memory")
#define PG8_BAR __builtin_amdgcn_s_barrier()
#define PG8_SCHED __builtin_amdgcn_sched_barrier(0)
    Unit cur, nxt; int ui = 0;
    if (!S.next(0, cur)) return;
    f32x4 acc[2][2][4][2];
#pragma unroll
    for (int a = 0; a < 2; ++a)
#pragma unroll
        for (int b = 0; b < 2; ++b)
#pragma unroll
            for (int m = 0; m < 4; ++m)
#pragma unroll
                for (int n = 0; n < 2; ++n) acc[a][b][m][n] = (f32x4){0.f, 0.f, 0.f, 0.f};
    bf16x8 At[4][2], B0[2][2], B1[2][2];
    const char* cA = (const char*)g.A + (size_t)cur.pm * tstep; const char* cB = (const char*)g.Bt + (size_t)cur.pn * tstep;
    S.a_ready(cur);
    if constexpr (SP2) {
        PG8_STAGE(PG8_SB(0, 0), cB, voffB); PG8_STAGE(PG8_SB(0, 1), cB + hstep, voffB); PG8_STAGE(PG8_SA(0, 0), cA, voffA); PG8_STAGE(PG8_SA(0, 1), cA + hstep, voffA);
        if (wr == 1) PG8_BAR;
        PG8_WAIT_V(2); PG8_BAR;
        PG8_STAGE(PG8_SB(1, 0), cB + kstep, voffB); PG8_STAGE(PG8_SA(1, 0), cA + kstep, voffA); PG8_STAGE(PG8_SB(1, 1), cB + hstep + kstep, voffB);
        PG8_WAIT_V(6); PG8_BAR;
    } else {
        PG8_STAGE(PG8_SB(0, 0), cB, voffB); PG8_STAGE(PG8_SA(0, 0), cA, voffA); PG8_STAGE(PG8_SB(0, 1), cB + hstep, voffB); PG8_STAGE(PG8_SA(0, 1), cA + hstep, voffA);
        if (wr == 1) PG8_BAR;
        PG8_WAIT_V(4); PG8_BAR;
        PG8_STAGE(PG8_SB(1, 0), cB + kstep, voffB); PG8_STAGE(PG8_SA(1, 0), cA + kstep, voffA); PG8_STAGE(PG8_SB(1, 1), cB + hstep + kstep, voffB);
        PG8_WAIT_V(6); PG8_BAR;
    }
    for (;;) {
        const bool has_next = S.next(ui + 1, nxt);
        const char* nA = has_next ? (const char*)g.A + (size_t)nxt.pm * tstep : cA; const char* nB = has_next ? (const char*)g.Bt + (size_t)nxt.pn * tstep : cB;
        for (int t = 0; t < nt; t += 2) {
            const bool last = (t == nt - 2);
            const char* a1 = cA + (size_t)(t + 1) * kstep;
            const char* a2 = last ? nA : cA + (size_t)(t + 2) * kstep; const char* b2 = last ? nB : cB + (size_t)(t + 2) * kstep;
            const char* a3 = a2 + kstep; const char* b3 = b2 + kstep;
            if (last && has_next) S.a_ready(nxt);
            if constexpr (SP2) {
            PG8_LDB(B0, 0, 0); PG8_LDB(B1, 0, 1); PG8_SCHED; PG8_LDA(At, 0, 0); PG8_STAGE(PG8_SA(1, 1), a1 + hstep, voffA);
            PG8_WAIT_V(8); PG8_WAIT_L(0); PG8_BAR; PG8_MMA(0, 0, At, B0); PG8_MMA(0, 1, At, B1); PG8_BAR; PG8_SCHED;
            PG8_LDA(At, 0, 1); PG8_STAGE(PG8_SB(0, 0), b2, voffB); PG8_STAGE(PG8_SB(0, 1), b2 + hstep, voffB); PG8_STAGE(PG8_SA(0, 0), a2, voffA);
            PG8_WAIT_V(8); PG8_WAIT_L(0); PG8_BAR; PG8_MMA(1, 0, At, B0); PG8_MMA(1, 1, At, B1); PG8_BAR; PG8_SCHED;
            PG8_LDB(B0, 1, 0); PG8_LDB(B1, 1, 1); PG8_SCHED; PG8_LDA(At, 1, 0); PG8_STAGE(PG8_SA(0, 1), a2 + hstep, voffA);
            PG8_WAIT_V(8); PG8_WAIT_L(0); PG8_BAR; PG8_MMA(0, 0, At, B0); PG8_MMA(0, 1, At, B1); PG8_BAR; PG8_SCHED;
            PG8_LDA(At, 1, 1); PG8_STAGE(PG8_SB(1, 0), b3, voffB); PG8_STAGE(PG8_SB(1, 1), b3 + hstep, voffB); PG8_STAGE(PG8_SA(1, 0), a3, voffA);
            PG8_WAIT_V(8); PG8_WAIT_L(0); PG8_BAR; PG8_MMA(1, 0, At, B0); PG8_MMA(1, 1, At, B1); PG8_BAR; PG8_SCHED;
            } else {
            PG8_LDB(B0, 0, 0); PG8_SCHED; PG8_LDA(At, 0, 0); PG8_STAGE(PG8_SA(1, 1), a1 + hstep, voffA);
            PG8_WAIT_L(8); PG8_BAR; PG8_WAIT_L(0); PG8_MMA(0, 0, At, B0); PG8_BAR; PG8_SCHED;
            PG8_LDB(B1, 0, 1); PG8_STAGE(PG8_SB(0, 0), b2, voffB);
            PG8_BAR; PG8_WAIT_L(0); PG8_MMA(0, 1, At, B1); PG8_BAR;
            PG8_LDA(At, 0, 1); PG8_STAGE(PG8_SA(0, 0), a2, voffA);
            PG8_BAR; PG8_WAIT_L(0); PG8_MMA(1, 0, At, B0); PG8_BAR; PG8_SCHED;
            PG8_STAGE(PG8_SB(0, 1), b2 + hstep, voffB);
            PG8_WAIT_V(6); PG8_BAR; PG8_MMA(1, 1, At, B1); PG8_BAR;
            PG8_LDB(B0, 1, 0); PG8_SCHED; PG8_LDA(At, 1, 0); PG8_STAGE(PG8_SA(0, 1), a2 + hstep, voffA);
            PG8_WAIT_L(8); PG8_BAR; PG8_WAIT_L(0); PG8_MMA(0, 0, At, B0); PG8_BAR; PG8_SCHED;
            PG8_LDB(B1, 1, 1); PG8_STAGE(PG8_SB(1, 0), b3, voffB);
            PG8_BAR; PG8_WAIT_L(0); PG8_MMA(0, 1, At, B1); PG8_BAR;
            PG8_LDA(At, 1, 1); PG8_STAGE(PG8_SA(1, 0), a3, voffA);
            PG8_BAR; PG8_WAIT_L(0); PG8_MMA(1, 0, At, B0); PG8_BAR; PG8_SCHED;
            PG8_STAGE(PG8_SB(1, 1), b3 + hstep, voffB);
            PG8_WAIT_V(6); PG8_BAR; PG8_MMA(1, 1, At, B1); PG8_BAR;
            }
        }
        if constexpr (ALIGN_EPI) { if (wr == 0) PG8_BAR; }
        if constexpr (!Epi::AFTER_DRAIN) { E(acc, cur, wr, wc, fr, fq); S.done(cur); }
        if (!has_next) break;
#pragma unroll
        for (int a = 0; a < 2; ++a)
#pragma unroll
            for (int b = 0; b < 2; ++b)
#pragma unroll
                for (int m = 0; m < 4; ++m)
#pragma unroll
                    for (int n = 0; n < 2; ++n) acc[a][b][m][n] = (f32x4){0.f, 0.f, 0.f, 0.f};
        cur = nxt; cA = nA; cB = nB; ++ui;
        if constexpr (ALIGN_EPI) { if (wr == 1) PG8_BAR; }
    }
    PG8_WAIT_V(0);
    if constexpr (!ALIGN_EPI) { if (wr == 0) PG8_BAR; }
    PG8_BAR;
    if constexpr (Epi::AFTER_DRAIN) { E.fused(acc, cur, wr, wc, fr, fq, lds, wid, lane); S.done(cur); }
#undef PG8_SA
#undef PG8_SB
#undef PG8_STAGE
#undef PG8_LDA
#undef PG8_LDB
#undef PG8_MMA
#undef PG8_WAIT_V
#undef PG8_WAIT_L
#undef PG8_BAR
#undef PG8_SCHED
}
}

typedef unsigned short bf16_t;
typedef unsigned u32x4 __attribute__((ext_vector_type(4)));
typedef unsigned u32x2 __attribute__((ext_vector_type(2)));
typedef float f32x4 __attribute__((ext_vector_type(4)));
#define LAS __attribute__((address_space(3)))

constexpr int NB = 8, SEQ = 4096, M = NB * SEQ, DM = 1024, NP = 3072, FF = 2816, NGU = 2 * FF, INC = 2956;
constexpr int C_QA = 0, C_KCA = 256, C_VCA = 320, C_KSA = 384, C_VSA = 448, C_KWA = 512, C_VWA = 576, C_CVB = 640, C_CVC = 896, C_CVU = 1152,
              C_QC = 1408, C_KC = 1664, C_VC = 1920, C_QD = 2176, C_KD = 2432, C_VD = 2688, C_GT = 2944;
constexpr float EPS = 1e-6f;
constexpr size_t MiB = 1u << 20;
constexpr size_t WS_SS = 0, WS_KCN = 1 * MiB, WS_VCC = 1 * MiB + 512 * 1024, WS_W = 2 * MiB;
constexpr size_t W_IN = 0, W_OUT = 6 * MiB, W_GU = 8 * MiB, W_DN = 19 * MiB, W_LAYER = 24 * MiB + 512 * 1024;
constexpr size_t WS_XB = 52 * MiB, WS_GR = 116 * MiB, WS_PROJ = 180 * MiB, WS_X1 = 372 * MiB, WS_W1T = 500 * MiB, WS_W2T = 504 * MiB, WS_CB = 504 * MiB + 256 * 1024, WS_BAR = 504 * MiB + 512 * 1024, WS_END = 505 * MiB;
constexpr size_t DO_PO = 0, DO_LSE = 48 * MiB;
constexpr int LDS_BYTES = 143360;

struct Params { const float* in[23]; float* out; unsigned char* ws; };

__device__ __forceinline__ float blo(unsigned u) { return __uint_as_float(u << 16); }
__device__ __forceinline__ float bhi(unsigned u) { return __uint_as_float(u & 0xffff0000u); }
__device__ __forceinline__ float bf2f(bf16_t h) { return __uint_as_float((unsigned)h << 16); }
__device__ __forceinline__ unsigned pk2(float lo, float hi) { return pg8::cvt_pk_bf16(lo, hi); }
template <int K> __device__ __forceinline__ unsigned swz_u(unsigned v) { return (unsigned)__builtin_amdgcn_ds_swizzle((int)v, (K << 10) | 0x1f); }
template <int K> __device__ __forceinline__ float swz_f(float v) { return __uint_as_float(swz_u<K>(__float_as_uint(v))); }
__device__ __forceinline__ float sum32(float v) { auto rr = __builtin_amdgcn_permlane32_swap(__float_as_uint(v), __float_as_uint(v), false, false); return __uint_as_float(rr[0]) + __uint_as_float(rr[1]); }
__device__ __forceinline__ float max32(float v) { auto rr = __builtin_amdgcn_permlane32_swap(__float_as_uint(v), __float_as_uint(v), false, false); return fmaxf(__uint_as_float(rr[0]), __uint_as_float(rr[1])); }
__device__ __forceinline__ unsigned or32(unsigned v) { auto rr = __builtin_amdgcn_permlane32_swap(v, v, false, false); return rr[0] | rr[1]; }
__device__ __forceinline__ float partner32(float v, int hh) { auto rr = __builtin_amdgcn_permlane32_swap(__float_as_uint(v), __float_as_uint(v), false, false); return __uint_as_float(hh ? rr[0] : rr[1]); }
__device__ __forceinline__ float wave_sum(float v) {
    v += swz_f<1>(v); v += swz_f<2>(v); v += swz_f<4>(v); v += swz_f<8>(v); v += swz_f<16>(v); return sum32(v);
}
#define LDS_WAIT() asm volatile("s_waitcnt lgkmcnt(0)" ::: "memory")
#define CFENCE() asm volatile("" ::: "memory")

struct EpiProj {
    static constexpr bool PERM = true, AFTER_DRAIN = false;
    bf16_t* O; const float* ss;
    __device__ __forceinline__ void operator()(const pg8::f32x4 (&acc)[2][2][4][2], const pg8::Unit& u, int wr, int wc, int fr, int fq) const {
        const int row0 = u.pm * 256 + wr * 64 + fr, col0 = u.pn * 256 + wc * 32 + 8 * fq;
#pragma unroll
        for (int ai = 0; ai < 2; ++ai)
#pragma unroll
            for (int m = 0; m < 4; ++m) {
                const int row = row0 + ai * 128 + m * 16; const float rs = rsqrtf(ss[row] * (1.f / DM) + EPS);
                bf16_t* rowp = O + (size_t)row * NP + col0;
#pragma unroll
                for (int bj = 0; bj < 2; ++bj) { const pg8::f32x4 v0 = acc[ai][bj][m][0] * rs, v1 = acc[ai][bj][m][1] * rs;
                    u32x4 w; w.x = pk2(v0[0], v0[1]); w.y = pk2(v0[2], v0[3]); w.z = pk2(v1[0], v1[1]); w.w = pk2(v1[2], v1[3]);
                    *(u32x4*)(rowp + bj * 128) = w; }
            }
    }
};
struct EpiSwiGLU {
    static constexpr bool PERM = true, AFTER_DRAIN = false;
    bf16_t* H; const float* ss;
    __device__ __forceinline__ void operator()(const pg8::f32x4 (&acc)[2][2][4][2], const pg8::Unit& u, int wr, int wc, int fr, int fq) const {
        const int row0 = u.pm * 256 + wr * 64 + fr, col0 = u.pn * 128 + wc * 32 + 8 * fq;
#pragma unroll
        for (int ai = 0; ai < 2; ++ai)
#pragma unroll
            for (int m = 0; m < 4; ++m) {
                const int row = row0 + ai * 128 + m * 16; const float rs = rsqrtf(ss[row] * (1.f / DM) + EPS), rs2 = rs * rs, nrs = rs * -1.4426950408889634f;
                float hv[8];
#pragma unroll
                for (int n = 0; n < 2; ++n)
#pragma unroll
                    for (int j = 0; j < 4; ++j) { const float ga = acc[ai][0][m][n][j], ua = acc[ai][1][m][n][j];
                        hv[4 * n + j] = (ga * ua) * (rs2 * __builtin_amdgcn_rcpf(1.f + __builtin_amdgcn_exp2f(ga * nrs))); }
                u32x4 w; w.x = pk2(hv[0], hv[1]); w.y = pk2(hv[2], hv[3]); w.z = pk2(hv[4], hv[5]); w.w = pk2(hv[6], hv[7]);
                *(u32x4*)(H + (size_t)row * FF + col0) = w;
            }
    }
};
struct EpiResid {
    static constexpr bool PERM = true, AFTER_DRAIN = false;
    const float* xin; const bf16_t* xin_b; float* xout; bf16_t* xb; float* ss;
    __device__ __forceinline__ void operator()(const pg8::f32x4 (&acc)[2][2][4][2], const pg8::Unit& u, int wr, int wc, int fr, int fq) const {
        const int row0 = u.pm * 256 + wr * 64 + fr, col0 = u.pn * 256 + wc * 32 + 8 * fq;
#pragma unroll
        for (int ai = 0; ai < 2; ++ai)
#pragma unroll
            for (int m = 0; m < 4; ++m) {
                const int row = row0 + ai * 128 + m * 16; const size_t off = (size_t)row * DM + col0; float sq = 0.f;
#pragma unroll
                for (int bj = 0; bj < 2; ++bj) { const size_t o = off + bj * 128; f32x4 xa, xc;
                    if (xin) { xa = *(const f32x4*)(xin + o); xc = *(const f32x4*)(xin + o + 4); }
                    else { const u32x4 r4 = *(const u32x4*)(xin_b + o); xa[0] = blo(r4.x); xa[1] = bhi(r4.x); xa[2] = blo(r4.y); xa[3] = bhi(r4.y); xc[0] = blo(r4.z); xc[1] = bhi(r4.z); xc[2] = blo(r4.w); xc[3] = bhi(r4.w); }
                    f32x4 va, vc;
                    va[0] = xa[0] + acc[ai][bj][m][0][0]; va[1] = xa[1] + acc[ai][bj][m][0][1]; va[2] = xa[2] + acc[ai][bj][m][0][2]; va[3] = xa[3] + acc[ai][bj][m][0][3];
                    vc[0] = xc[0] + acc[ai][bj][m][1][0]; vc[1] = xc[1] + acc[ai][bj][m][1][1]; vc[2] = xc[2] + acc[ai][bj][m][1][2]; vc[3] = xc[3] + acc[ai][bj][m][1][3];
                    if (xout) { *(f32x4*)(xout + o) = va; *(f32x4*)(xout + o + 4) = vc; }
                    if (xb) { u32x4 w; w.x = pk2(va[0], va[1]); w.y = pk2(va[2], va[3]); w.z = pk2(vc[0], vc[1]); w.w = pk2(vc[2], vc[3]); *(u32x4*)(xb + o) = w; }
                    sq += ((va[0] * va[0] + va[1] * va[1]) + (va[2] * va[2] + va[3] * va[3])) + ((vc[0] * vc[0] + vc[1] * vc[1]) + (vc[2] * vc[2] + vc[3] * vc[3])); }
                if (ss) { sq += swz_f<16>(sq); sq = sum32(sq); if (fq == 0) atomicAdd(ss + row, sq); }
            }
    }
};

#ifndef REP_PW
#define REP_PW 1
#endif
#ifndef REP_PC
#define REP_PC 1
#endif
#ifndef REP_PX
#define REP_PX 1
#endif
template <int MAP> __device__ __forceinline__ int dst_row(int c) {
    if (MAP == 0) return c < 640 ? c : (c < 652 ? 2944 + (c - 640) : c - 12);
    if (MAP == 1) return c;
    if (MAP == 2) return 256 * (c >> 7) + (c & 127);
    return 256 * (c >> 7) + 128 + (c & 127);
}
template <int MAP> __device__ __forceinline__ void transpose_item(const float* W, int K, int N, const float* gk, bf16_t* WT, LAS float* scr, int item, int lane) {
    const int nblk = (N + 63) / 64, kb = item / nblk, nb = item % nblk, k0 = 64 * kb, n0 = 64 * nb;
    const int nn = n0 + lane; const bool okn = nn < N;
#pragma unroll
    for (int i = 0; i < 64; ++i) { float v = okn ? W[(size_t)(k0 + i) * N + nn] : 0.f; if (gk) v *= gk[k0 + i]; scr[i * 65 + lane] = v; }
    LDS_WAIT();
    const int c = lane & 7;
#pragma unroll
    for (int j = 0; j < 8; ++j) { const int n = (lane >> 3) + 8 * j; const LAS float* s = scr + (8 * c) * 65 + n;
        if (n0 + n < N) { u32x4 o; o.x = pk2(s[0 * 65], s[1 * 65]); o.y = pk2(s[2 * 65], s[3 * 65]); o.z = pk2(s[4 * 65], s[5 * 65]); o.w = pk2(s[6 * 65], s[7 * 65]);
            if (MAP == 4) { const int nn2 = n0 + n, kk2 = k0 + 8 * c; *(u32x4*)(WT + ((size_t)(((nn2 >> 5) * (K >> 4) + (kk2 >> 4)) * 64 + ((kk2 >> 3) & 1) * 32 + (nn2 & 31)) * 8)) = o; }
            else *(u32x4*)(WT + (size_t)dst_row<MAP>(n0 + n) * K + k0 + 8 * c) = o; } }
    LDS_WAIT();
}
__device__ __forceinline__ void prologue(const Params& p, LAS unsigned char* lds, int gw, int NGW, int wave, int lane) {
    LAS float* scr = (LAS float*)(lds + wave * 16640);
    constexpr int I_IN = 16 * 47, I_OUT = 16 * 16, I_G = 16 * 44, I_DN = 44 * 16, I_L = I_IN + I_OUT + 2 * I_G + I_DN, I_Z = 116;
    for (int rw_ = 0; rw_ < REP_PW; ++rw_)
    for (int it = gw; it < 2 * (I_L + I_Z); it += NGW) {
        const int l = it / (I_L + I_Z); int r = it % (I_L + I_Z);
        unsigned char* wl = p.ws + WS_W + (size_t)l * W_LAYER;
        if (r < I_IN) { transpose_item<0>(p.in[2] + (size_t)l * DM * INC, DM, INC, p.in[1] + l * DM, (bf16_t*)(wl + W_IN), scr, r, lane); continue; } r -= I_IN;
        if (r < I_OUT) { transpose_item<1>(p.in[18] + (size_t)l * DM * DM, DM, DM, nullptr, (bf16_t*)(wl + W_OUT), scr, r, lane); continue; } r -= I_OUT;
        if (r < I_G) { transpose_item<2>(p.in[20] + (size_t)l * DM * FF, DM, FF, p.in[19] + l * DM, (bf16_t*)(wl + W_GU), scr, r, lane); continue; } r -= I_G;
        if (r < I_G) { transpose_item<3>(p.in[21] + (size_t)l * DM * FF, DM, FF, p.in[19] + l * DM, (bf16_t*)(wl + W_GU), scr, r, lane); continue; } r -= I_G;
        if (r < I_DN) { transpose_item<1>(p.in[22] + (size_t)l * FF * DM, FF, DM, nullptr, (bf16_t*)(wl + W_DN), scr, r, lane); continue; } r -= I_DN;
        { u32x4 z = {0u, 0u, 0u, 0u}; u32x4* d = (u32x4*)((bf16_t*)(wl + W_IN) + (size_t)(INC + r) * DM) + lane * 2; d[0] = z; d[1] = z; }
    }
    for (int rc_ = 0; rc_ < REP_PC; ++rc_)
    for (int it = gw; it < 4 * (128 + 4 + 32); it += NGW) {
        const int mi = it / 164, r = it % 164, l = mi >> 1, kv = mi & 1;
        const float* w1 = p.in[kv ? 12 : 10] + (size_t)l * 2048 * 256; const float* w2 = p.in[kv ? 13 : 11] + (size_t)l * 256 * 64; const float* pe = p.in[kv ? 9 : 8] + l * 2048;
        if (r < 128) transpose_item<4>(w1, 2048, 256, nullptr, (bf16_t*)(p.ws + WS_W1T) + (size_t)mi * 256 * 2048, scr, r, lane);
        else if (r < 132) transpose_item<1>(w2, 256, 64, nullptr, (bf16_t*)(p.ws + WS_W2T) + (size_t)mi * 64 * 256, scr, r - 128, lane);
        else { const int c = (r - 132) * 8 + (lane & 7), rg = lane >> 3; float acc = 0.f;
#pragma unroll 32
            for (int i = rg * 256; i < rg * 256 + 256; ++i) acc += pe[i] * w1[(size_t)i * 256 + c];
            acc += swz_f<8>(acc); acc += swz_f<16>(acc); acc = sum32(acc);
            if (rg == 0) ((float*)(p.ws + WS_CB))[mi * 256 + c] = acc; }
    }
    float* ss = (float*)(p.ws + WS_SS); bf16_t* xb = (bf16_t*)(p.ws + WS_XB);
    for (int rx_ = 0; rx_ < REP_PX; ++rx_)
    for (int m0 = gw; m0 < M; m0 += 4 * NGW) {
        f32x4 v[4][4];
#pragma unroll
        for (int rr = 0; rr < 4; ++rr) { const int m = m0 + rr * NGW; const f32x4* xr = (const f32x4*)(p.in[0] + (size_t)(m < M ? m : 0) * DM) + lane;
#pragma unroll
            for (int j = 0; j < 4; ++j) v[rr][j] = xr[64 * j]; }
#pragma unroll
        for (int rr = 0; rr < 4; ++rr) { const int m = m0 + rr * NGW; if (m < M) { u32x2* o8 = (u32x2*)(xb + (size_t)m * DM) + lane; float s = 0.f;
#pragma unroll
            for (int j = 0; j < 4; ++j) { const f32x4 t = v[rr][j]; s += (t[0] * t[0] + t[1] * t[1]) + (t[2] * t[2] + t[3] * t[3]); u32x2 w; w.x = pk2(t[0], t[1]); w.y = pk2(t[2], t[3]); o8[64 * j] = w; }
            s = wave_sum(s);
            if (lane == 0) { ss[m] = s; ss[M + m] = 0.f; ss[2 * M + m] = 0.f; ss[3 * M + m] = 0.f; } } }
    }
}

#define UNPACK8(v, k) const float k##0 = blo(v.x), k##1 = bhi(v.x), k##2 = blo(v.y), k##3 = bhi(v.y), k##4 = blo(v.z), k##5 = bhi(v.z), k##6 = blo(v.w), k##7 = bhi(v.w)
__device__ __forceinline__ void load_row64(float (&q)[64], const bf16_t* p) {
#pragma unroll
    for (int c = 0; c < 8; ++c) { const u32x4 v = *(const u32x4*)(p + 8 * c); UNPACK8(v, k);
        q[8 * c] = k0; q[8 * c + 1] = k1; q[8 * c + 2] = k2; q[8 * c + 3] = k3; q[8 * c + 4] = k4; q[8 * c + 5] = k5; q[8 * c + 6] = k6; q[8 * c + 7] = k7; }
}
template <bool SS> __device__ __forceinline__ float dot_row(const float (&q)[64], const bf16_t* p, float& kss) {
    float z = 0.f, s = 0.f;
#pragma unroll
    for (int c = 0; c < 8; ++c) { const u32x4 v = *(const u32x4*)(p + 8 * c); UNPACK8(v, k);
        z += (q[8 * c] * k0 + q[8 * c + 1] * k1) + (q[8 * c + 2] * k2 + q[8 * c + 3] * k3) + (q[8 * c + 4] * k4 + q[8 * c + 5] * k5) + (q[8 * c + 6] * k6 + q[8 * c + 7] * k7);
        if (SS) s += (k0 * k0 + k1 * k1) + (k2 * k2 + k3 * k3) + (k4 * k4 + k5 * k5) + (k6 * k6 + k7 * k7);
        if (c == 3) CFENCE(); }
    kss = s; return z;
}
__device__ __forceinline__ void axpy_row(float (&o)[64], float w, const bf16_t* p) {
#pragma unroll
    for (int c = 0; c < 8; ++c) { const u32x4 v = *(const u32x4*)(p + 8 * c); UNPACK8(v, k);
        o[8 * c] += w * k0; o[8 * c + 1] += w * k1; o[8 * c + 2] += w * k2; o[8 * c + 3] += w * k3; o[8 * c + 4] += w * k4; o[8 * c + 5] += w * k5; o[8 * c + 6] += w * k6; o[8 * c + 7] += w * k7;
        if (c == 3) CFENCE(); }
}
__device__ __forceinline__ float dot_row_f32(const float (&q)[64], const float* p) {
    float z = 0.f;
#pragma unroll
    for (int c = 0; c < 16; ++c) { const f32x4 v = *(const f32x4*)(p + 4 * c); z += (q[4 * c] * v[0] + q[4 * c + 1] * v[1]) + (q[4 * c + 2] * v[2] + q[4 * c + 3] * v[3]); if (c == 7) CFENCE(); }
    return z;
}
__device__ __forceinline__ void axpy_row_f32(float (&o)[64], float w, const float* p) {
#pragma unroll
    for (int c = 0; c < 16; ++c) { const f32x4 v = *(const f32x4*)(p + 4 * c); o[4 * c] += w * v[0]; o[4 * c + 1] += w * v[1]; o[4 * c + 2] += w * v[2]; o[4 * c + 3] += w * v[3]; if (c == 7) CFENCE(); }
}
__device__ __forceinline__ void store_group(const float (&o)[64], const float* g, bf16_t* dst) {
    float ss = 0.f;
#pragma unroll
    for (int d = 0; d < 64; ++d) ss += o[d] * o[d];
    const float rs = rsqrtf(ss * (1.f / 64.f) + EPS);
#pragma unroll
    for (int c = 0; c < 8; ++c) { u32x4 w;
        w.x = pk2(o[8 * c] * rs * g[8 * c], o[8 * c + 1] * rs * g[8 * c + 1]); w.y = pk2(o[8 * c + 2] * rs * g[8 * c + 2], o[8 * c + 3] * rs * g[8 * c + 3]);
        w.z = pk2(o[8 * c + 4] * rs * g[8 * c + 4], o[8 * c + 5] * rs * g[8 * c + 5]); w.w = pk2(o[8 * c + 6] * rs * g[8 * c + 6], o[8 * c + 7] * rs * g[8 * c + 7]);
        *(u32x4*)(dst + 8 * c) = w; }
}
__device__ __forceinline__ void load_q_norm(float (&q)[64], const bf16_t* p, const float* gq, const float* gx) {
    load_row64(q, p); float ss = 0.f;
#pragma unroll
    for (int d = 0; d < 64; ++d) ss += q[d] * q[d];
    const float rs = rsqrtf(ss * (1.f / 64.f) + EPS) * 0.125f;
#pragma unroll
    for (int d = 0; d < 64; ++d) q[d] = q[d] * rs * gq[d] * (gx ? gx[d] : 1.f);
}

__device__ __forceinline__ void stick_naive(const bf16_t* proj, bf16_t* groups, const float* g_out, int item, int lane) {
    const int tile = item & 63, h = (item >> 6) & 3, b = item >> 8, t = tile * 64 + lane;
    const bf16_t* base = proj + (size_t)b * SEQ * NP;
    float q[64]; load_row64(q, base + (size_t)t * NP + C_QC + h * 64);
#pragma unroll
    for (int d = 0; d < 64; ++d) q[d] *= 0.125f;
    float o[64];
#pragma unroll
    for (int d = 0; d < 64; ++d) o[d] = 0.f;
    float between = 0.f;
    for (int s = tile * 64 + 62; s >= 0; --s) {
        const bf16_t* kr = base + (size_t)s * NP + C_KC + h * 64; float dummy;
        const float z = dot_row<false>(q, kr, dummy); CFENCE();
        const bool act = s < t;
        const float sp = fmaxf(z, 0.f) + __logf(1.f + __expf(-fabsf(z)));
        const float w = act ? __expf((z - sp) - between) : 0.f;
        axpy_row(o, w, base + (size_t)s * NP + C_VC + h * 64); CFENCE();
        between += act ? sp : 0.f;
        if (s < tile * 64 && __all(between > 104.f)) break;
    }
    store_group(o, g_out + 512 + h * 64, groups + (size_t)(b * SEQ + t) * DM + 512 + h * 64);
}

__device__ __forceinline__ void dil_naive(const bf16_t* proj, bf16_t* groups, const float* gq, const float* gk, const float* g_out, int item, int lane) {
    const int tile = item & 63, h = (item >> 6) & 3, b = item >> 8, t = tile * 64 + lane;
    const bf16_t* base = proj + (size_t)b * SEQ * NP;
    float q[64]; load_q_norm(q, base + (size_t)t * NP + C_QD + h * 64, gq, gk);
    const float slope = exp2f(-(float)(2 * h + 2));
    float o[64];
#pragma unroll
    for (int d = 0; d < 64; ++d) o[d] = 0.f;
    float mx = -1e30f, l = 0.f;
    for (int cfg = 0; cfg < 3; ++cfg) {
        const int dil = cfg == 0 ? 1 : (cfg == 1 ? 4 : 16);
        for (int j = 0; j <= 128; ++j) {
            const int s = t - j * dil; const bool act = s >= 0;
            if (!__any(act)) break;
            if (act) {
                float kss; const float z = dot_row<true>(q, base + (size_t)s * NP + C_KD + h * 64, kss); CFENCE();
                const float sc = z * rsqrtf(kss * (1.f / 64.f) + EPS) - slope * (float)(j * dil);
                if (sc > mx) { const float corr = __expf(mx - sc); l *= corr;
#pragma unroll
                    for (int d = 0; d < 64; ++d) o[d] *= corr;
                    mx = sc; }
                const float pw = __expf(sc - mx); l += pw;
                axpy_row(o, pw, base + (size_t)s * NP + C_VD + h * 64); CFENCE();
            }
        }
    }
    const float inv = 1.f / l;
#pragma unroll
    for (int d = 0; d < 64; ++d) o[d] *= inv;
    store_group(o, g_out + 768 + h * 64, groups + (size_t)(b * SEQ + t) * DM + 768 + h * 64);
}

template <int NI> __device__ __forceinline__ void conv_items(const bf16_t* proj, bf16_t* groups, const float* cw, const float* g_out, int item0, int stride, int lane) {
    const int ch = (lane & 31) * 8;
    u32x4 cv[NI][3], uv[NI][3], bv[NI];
#pragma unroll
    for (int n = 0; n < NI; ++n) { const int token = (item0 + n * stride) * 2 + (lane >> 5), tpos = token & (SEQ - 1); const bf16_t* row = proj + (size_t)token * NP;
#pragma unroll
        for (int k = 0; k < 3; ++k) { const int back = 2 - k;
            if (tpos >= back) { cv[n][k] = *(const u32x4*)(row - (size_t)back * NP + C_CVC + ch); uv[n][k] = *(const u32x4*)(row - (size_t)back * NP + C_CVU + ch); }
            else { cv[n][k] = (u32x4){0u, 0u, 0u, 0u}; uv[n][k] = cv[n][k]; } }
        bv[n] = *(const u32x4*)(row + C_CVB + ch); }
    float wk[3][8];
#pragma unroll
    for (int k = 0; k < 3; ++k)
#pragma unroll
        for (int i = 0; i < 8; ++i) wk[k][i] = cw[k * 256 + ch + i];
    const float* go = g_out + 256 + ch;
#pragma unroll
    for (int n = 0; n < NI; ++n) { const int token = (item0 + n * stride) * 2 + (lane >> 5);
        float acc[8];
#pragma unroll
        for (int i = 0; i < 8; ++i) acc[i] = 0.f;
#pragma unroll
        for (int k = 0; k < 3; ++k) { UNPACK8(cv[n][k], c); UNPACK8(uv[n][k], u);
            acc[0] += wk[k][0] * (c0 * u0); acc[1] += wk[k][1] * (c1 * u1); acc[2] += wk[k][2] * (c2 * u2); acc[3] += wk[k][3] * (c3 * u3);
            acc[4] += wk[k][4] * (c4 * u4); acc[5] += wk[k][5] * (c5 * u5); acc[6] += wk[k][6] * (c6 * u6); acc[7] += wk[k][7] * (c7 * u7); }
        UNPACK8(bv[n], g);
        float y[8] = {g0 * acc[0], g1 * acc[1], g2 * acc[2], g3 * acc[3], g4 * acc[4], g5 * acc[5], g6 * acc[6], g7 * acc[7]};
        float ss = 0.f;
#pragma unroll
        for (int i = 0; i < 8; ++i) ss += y[i] * y[i];
        ss += swz_f<1>(ss); ss += swz_f<2>(ss); ss += swz_f<4>(ss);
        const float rs = rsqrtf(ss * (1.f / 64.f) + EPS);
        u32x4 w; w.x = pk2(y[0] * rs * go[0], y[1] * rs * go[1]); w.y = pk2(y[2] * rs * go[2], y[3] * rs * go[3]);
        w.z = pk2(y[4] * rs * go[4], y[5] * rs * go[5]); w.w = pk2(y[6] * rs * go[6], y[7] * rs * go[7]);
        *(u32x4*)(groups + (size_t)token * DM + 256 + ch) = w; }
}

typedef short bf16x8 __attribute__((ext_vector_type(8)));
typedef short s16x4 __attribute__((ext_vector_type(4)));
typedef float f32x16 __attribute__((ext_vector_type(16)));
typedef float f32x2_t __attribute__((ext_vector_type(2)));
typedef __bf16 bf16x2_t __attribute__((ext_vector_type(2)));
__device__ __forceinline__ unsigned cvtpk(float lo, float hi) { f32x2_t v = {lo, hi}; bf16x2_t b = __builtin_convertvector(v, bf16x2_t); return __builtin_bit_cast(unsigned, b); }
#define MFMA32(a, b, c) __builtin_amdgcn_mfma_f32_32x32x16_bf16((a), (b), (c), 0, 0, 0)
#define EXP2(x) __builtin_amdgcn_exp2f(x)
constexpr float LOG2E = 1.4426950408889634f;
constexpr int KSB = 144, VTB = 136, KS_BYTES = 64 * KSB, VT_BYTES = 64 * VTB;
__device__ __forceinline__ int crow(int i, int h) { return (i & 3) + 8 * (i >> 2) + 4 * h; }

struct KVSrc { const bf16_t* k; const bf16_t* v; long pitch; int first, lo, hi; };
__device__ __forceinline__ void kv_fetch(const KVSrc& s, int tid, u32x4& kc, u32x4& vc) {
    const int kl = tid >> 3, ch = tid & 7, i = s.first + kl;
    if (i >= s.lo && i < s.hi) { kc = *(const u32x4*)(s.k + (long)i * s.pitch + 8 * ch); vc = *(const u32x4*)(s.v + (long)i * s.pitch + 8 * ch); }
    else { kc = (u32x4){0u, 0u, 0u, 0u}; vc = kc; }
}
template <bool NORM> __device__ __forceinline__ void kv_store(u32x4 kc, u32x4 vc, const float (&g)[8], LAS unsigned char* ksb, LAS unsigned char* vtb, int tid) {
    const int kl = tid >> 3, ch = tid & 7;
    if (NORM) { UNPACK8(kc, k); float ss = (k0 * k0 + k1 * k1) + (k2 * k2 + k3 * k3) + (k4 * k4 + k5 * k5) + (k6 * k6 + k7 * k7);
        ss += swz_f<1>(ss); ss += swz_f<2>(ss); ss += swz_f<4>(ss);
        const float rs = rsqrtf(ss * (1.f / 64.f) + EPS);
        kc.x = cvtpk(k0 * rs * g[0], k1 * rs * g[1]); kc.y = cvtpk(k2 * rs * g[2], k3 * rs * g[3]); kc.z = cvtpk(k4 * rs * g[4], k5 * rs * g[5]); kc.w = cvtpk(k6 * rs * g[6], k7 * rs * g[7]); }
    *(LAS u32x4*)(ksb + kl * KSB + ch * 16) = kc;
    LAS unsigned short* vp = (LAS unsigned short*)(vtb + (8 * ch) * VTB + kl * 2);
    vp[0 * (VTB / 2)] = (unsigned short)(vc.x & 0xffffu); vp[1 * (VTB / 2)] = (unsigned short)(vc.x >> 16);
    vp[2 * (VTB / 2)] = (unsigned short)(vc.y & 0xffffu); vp[3 * (VTB / 2)] = (unsigned short)(vc.y >> 16);
    vp[4 * (VTB / 2)] = (unsigned short)(vc.z & 0xffffu); vp[5 * (VTB / 2)] = (unsigned short)(vc.z >> 16);
    vp[6 * (VTB / 2)] = (unsigned short)(vc.w & 0xffffu); vp[7 * (VTB / 2)] = (unsigned short)(vc.w >> 16);
}
template <bool NORM> __device__ __forceinline__ void load_qfrag(bf16x8 (&qf)[4], const bf16_t* qrow, const float* g1, const float* g2, float sc, int hh) {
    float f[32];
#pragma unroll
    for (int s = 0; s < 4; ++s) { const u32x4 v = *(const u32x4*)(qrow + 16 * s + 8 * hh); UNPACK8(v, k);
        f[8 * s] = k0; f[8 * s + 1] = k1; f[8 * s + 2] = k2; f[8 * s + 3] = k3; f[8 * s + 4] = k4; f[8 * s + 5] = k5; f[8 * s + 6] = k6; f[8 * s + 7] = k7; }
    if (NORM) { float ss = 0.f;
#pragma unroll
        for (int i = 0; i < 32; ++i) ss += f[i] * f[i];
        ss = sum32(ss); sc *= rsqrtf(ss * (1.f / 64.f) + EPS); }
#pragma unroll
    for (int s = 0; s < 4; ++s) { float v[8];
#pragma unroll
        for (int j = 0; j < 8; ++j) { const int d = 16 * s + 8 * hh + j; v[j] = f[8 * s + j] * sc * (g1 ? g1[d] : 1.f) * (g2 ? g2[d] : 1.f); }
        u32x4 w; w.x = cvtpk(v[0], v[1]); w.y = cvtpk(v[2], v[3]); w.z = cvtpk(v[4], v[5]); w.w = cvtpk(v[6], v[7]);
        qf[s] = __builtin_bit_cast(bf16x8, w); }
}

struct SfCmp { int tq, nvis, j0; float slope; __device__ __forceinline__ float operator()(float s, int kl) const { const int j = j0 + kl; return j < nvis ? s - slope * (float)(tq - 16 * j - 31) : -INFINITY; } };
struct SfSlc { int tq, key0; float slope; bool sel; __device__ __forceinline__ float operator()(float s, int kl) const { const int key = key0 + kl; return (sel && key <= tq) ? s - slope * (float)(tq - key) : -INFINITY; } };
struct SfWin { int tq, key0; float slope; __device__ __forceinline__ float operator()(float s, int kl) const { const int key = key0 + kl; return (key <= tq && tq - key <= 511) ? s - slope * (float)(tq - key) : -INFINITY; } };

__device__ __forceinline__ void pv_accum(const f32x16& s0, const f32x16& s1, f32x16& o0, f32x16& o1, LAS const unsigned char* vtb, int r, int hh) {
    __builtin_amdgcn_s_setprio(1);
#pragma unroll
    for (int kt = 0; kt < 2; ++kt)
#pragma unroll
        for (int sp = 0; sp < 2; ++sp) { u32x4 w;
            if (kt == 0) { w.x = cvtpk(s0[8 * sp], s0[8 * sp + 1]); w.y = cvtpk(s0[8 * sp + 2], s0[8 * sp + 3]); w.z = cvtpk(s0[8 * sp + 4], s0[8 * sp + 5]); w.w = cvtpk(s0[8 * sp + 6], s0[8 * sp + 7]); }
            else         { w.x = cvtpk(s1[8 * sp], s1[8 * sp + 1]); w.y = cvtpk(s1[8 * sp + 2], s1[8 * sp + 3]); w.z = cvtpk(s1[8 * sp + 4], s1[8 * sp + 5]); w.w = cvtpk(s1[8 * sp + 6], s1[8 * sp + 7]); }
            const bf16x8 pb = __builtin_bit_cast(bf16x8, w); const int ko = 32 * kt + 16 * sp + 4 * hh;
            { const s16x4 lo = *(LAS const s16x4*)(vtb + r * VTB + ko * 2), hi = *(LAS const s16x4*)(vtb + r * VTB + (ko + 8) * 2);
              o0 = MFMA32(__builtin_shufflevector(lo, hi, 0, 1, 2, 3, 4, 5, 6, 7), pb, o0); }
            { const s16x4 lo = *(LAS const s16x4*)(vtb + (32 + r) * VTB + ko * 2), hi = *(LAS const s16x4*)(vtb + (32 + r) * VTB + (ko + 8) * 2);
              o1 = MFMA32(__builtin_shufflevector(lo, hi, 0, 1, 2, 3, 4, 5, 6, 7), pb, o1); } }
    __builtin_amdgcn_s_setprio(0);
}
template <int MODE, class SF>
__device__ __forceinline__ void attn_block(const bf16x8 (&qf)[4], f32x16& o0, f32x16& o1, float& m, float& l, LAS const unsigned char* ksb, LAS const unsigned char* vtb, int r, int hh, const SF sf,
                                           float msafe_f, float inv_f, LAS float* imprw, int nbase, float& carry) {
    f32x16 s0, s1;
#pragma unroll
    for (int i = 0; i < 16; ++i) { s0[i] = 0.f; s1[i] = 0.f; }
    bf16x8 ka[4], kb2[4];
#pragma unroll
    for (int s = 0; s < 4; ++s) { ka[s] = *(LAS const bf16x8*)(ksb + r * KSB + (16 * s + 8 * hh) * 2); kb2[s] = *(LAS const bf16x8*)(ksb + (32 + r) * KSB + (16 * s + 8 * hh) * 2); }
    __builtin_amdgcn_s_setprio(1);
#pragma unroll
    for (int s = 0; s < 4; ++s) { s0 = MFMA32(ka[s], qf[s], s0); s1 = MFMA32(kb2[s], qf[s], s1); }
    __builtin_amdgcn_s_setprio(0);
    __builtin_amdgcn_sched_barrier(0);
#pragma unroll
    for (int i = 0; i < 16; ++i) { s0[i] = sf(s0[i], crow(i, hh)); s1[i] = sf(s1[i], 32 + crow(i, hh)); }
    if (MODE != 2) {
        float mloc = fmaxf(s0[0], s1[0]);
#pragma unroll
        for (int i = 1; i < 16; ++i) mloc = fmaxf(mloc, fmaxf(s0[i], s1[i]));
        mloc = max32(mloc);
        const float mnew = fmaxf(m, mloc), msafe = mnew == -INFINITY ? 0.f : mnew, corr = EXP2(m - msafe);
        float psum = 0.f;
#pragma unroll
        for (int i = 0; i < 16; ++i) { s0[i] = EXP2(s0[i] - msafe); s1[i] = EXP2(s1[i] - msafe); psum += s0[i] + s1[i]; }
        psum = sum32(psum);
        l = l * corr + psum; m = mnew;
        if (MODE == 0 && !__all(corr == 1.f)) {
#pragma unroll
            for (int i = 0; i < 16; ++i) { o0[i] *= corr; o1[i] *= corr; } }
    } else {
#pragma unroll
        for (int i = 0; i < 16; ++i) { s0[i] = EXP2(s0[i] - msafe_f) * inv_f; s1[i] = EXP2(s1[i] - msafe_f) * inv_f; }
#pragma unroll
        for (int kt = 0; kt < 2; ++kt) { float A[4], T[4], R[4];
#pragma unroll
            for (int g = 0; g < 4; ++g) { const float p0 = kt ? s1[4 * g] : s0[4 * g], p1 = kt ? s1[4 * g + 1] : s0[4 * g + 1], p2 = kt ? s1[4 * g + 2] : s0[4 * g + 2], p3 = kt ? s1[4 * g + 3] : s0[4 * g + 3];
                A[g] = 2.f * ((p0 + p1) + p2) + p3; T[g] = p3; R[g] = partner32(p3, hh); }
#pragma unroll
            for (int g = 0; g < 4; ++g) { const float prev = hh ? R[g] : (g ? R[g - 1] : carry);
                imprw[nbase + 8 * kt + 2 * g + hh] = A[g] + prev; }
            carry = R[3]; (void)T; }
    }
    __builtin_amdgcn_sched_barrier(0);
    if (MODE != 1) pv_accum(s0, s1, o0, o1, vtb, r, hh);
}


__device__ __forceinline__ void attn_block_full(const bf16x8 (&qf)[4], f32x16& o0, f32x16& o1, float& m, float& l, LAS const unsigned char* ksb, LAS const unsigned char* vtb, int r, int hh, float b0, float sl) {
    f32x16 s0, s1;
#pragma unroll
    for (int i = 0; i < 16; ++i) { s0[i] = 0.f; s1[i] = 0.f; }
    bf16x8 ka[4], kb2[4];
#pragma unroll
    for (int s = 0; s < 4; ++s) { ka[s] = *(LAS const bf16x8*)(ksb + r * KSB + (16 * s + 8 * hh) * 2); kb2[s] = *(LAS const bf16x8*)(ksb + (32 + r) * KSB + (16 * s + 8 * hh) * 2); }
    __builtin_amdgcn_s_setprio(1);
#pragma unroll
    for (int s = 0; s < 4; ++s) { s0 = MFMA32(ka[s], qf[s], s0); s1 = MFMA32(kb2[s], qf[s], s1); }
    __builtin_amdgcn_s_setprio(0);
    __builtin_amdgcn_sched_barrier(0);
#pragma unroll
    for (int i = 0; i < 16; ++i) { const float c = (float)((i & 3) + 8 * (i >> 2)); s0[i] = fmaf(sl, c, s0[i]); s1[i] = fmaf(sl, c + 32.f, s1[i]); }
    float mloc = fmaxf(s0[0], s1[0]);
#pragma unroll
    for (int i = 1; i < 16; ++i) mloc = fmaxf(mloc, fmaxf(s0[i], s1[i]));
    mloc = max32(mloc + b0);
    const float mnew = fmaxf(m, mloc), msafe = mnew == -INFINITY ? 0.f : mnew, corr = EXP2(m - msafe), c0 = b0 - msafe;
    float psum = 0.f;
#pragma unroll
    for (int i = 0; i < 16; ++i) { s0[i] = EXP2(s0[i] + c0); s1[i] = EXP2(s1[i] + c0); psum += s0[i] + s1[i]; }
    psum = sum32(psum);
    l = l * corr + psum; m = mnew;
#pragma unroll
    for (int i = 0; i < 16; ++i) { o0[i] *= corr; o1[i] *= corr; }
    __builtin_amdgcn_sched_barrier(0);
    pv_accum(s0, s1, o0, o1, vtb, r, hh);
}

#define KV_PIPELINE(FIRST, NEXT, SRC, NORM, GAIN, ...) do { \
    __syncthreads(); \
    int nxt_ = (FIRST), par_ = 0; u32x4 kc_, vc_; float g8_[8]; \
    { const float* gp_ = (GAIN); _Pragma("unroll") for (int j_ = 0; j_ < 8; ++j_) g8_[j_] = gp_ ? gp_[8 * (tid & 7) + j_] : 1.f; } \
    if (nxt_ >= 0) { const int id = nxt_; const KVSrc src_ = SRC; kv_fetch(src_, tid, kc_, vc_); } \
    while (nxt_ >= 0) { const int cur_ = nxt_; \
        LAS unsigned char* ksb = lds + par_ * KS_BYTES; LAS unsigned char* vtb = lds + 2 * KS_BYTES + par_ * VT_BYTES; \
        kv_store<NORM>(kc_, vc_, g8_, ksb, vtb, tid); \
        __syncthreads(); \
        { const int cur = cur_; nxt_ = (NEXT); } \
        if (nxt_ >= 0) { const int id = nxt_; const KVSrc src_ = SRC; kv_fetch(src_, tid, kc_, vc_); } \
        { const int id = cur_; __VA_ARGS__; } \
        par_ ^= 1; } } while (0)


__device__ __forceinline__ void kv_store_pre(u32x4 kc, u32x4 vc, LAS unsigned char* ksb, LAS unsigned char* vtb, int tid) {
    *(LAS u32x4*)(ksb + (tid >> 3) * KSB + (tid & 7) * 16) = kc;
    LAS u32x2* vp = (LAS u32x2*)(vtb + (tid >> 3) * VTB + (tid & 7) * 16); u32x2 a = {vc.x, vc.y}, b2 = {vc.z, vc.w}; vp[0] = a; vp[1] = b2;
}
#define KV_PIPELINE_PRE(FIRST, NEXT, KTILE, VTILE, ...) do { \
    __syncthreads(); \
    int nxt_ = (FIRST), par_ = 0; u32x4 kc_, vc_; \
    if (nxt_ >= 0) { const int id = nxt_; kc_ = *(const u32x4*)((KTILE) + tid * 8); vc_ = *(const u32x4*)((VTILE) + tid * 8); } \
    while (nxt_ >= 0) { const int cur_ = nxt_; \
        LAS unsigned char* ksb = lds + par_ * KS_BYTES; LAS unsigned char* vtb = lds + 2 * KS_BYTES + par_ * VT_BYTES; \
        kv_store_pre(kc_, vc_, ksb, vtb, tid); \
        __syncthreads(); \
        { const int cur = cur_; nxt_ = (NEXT); } \
        if (nxt_ >= 0) { const int id = nxt_; kc_ = *(const u32x4*)((KTILE) + tid * 8); vc_ = *(const u32x4*)((VTILE) + tid * 8); } \
        { const int id = cur_; __VA_ARGS__; } \
        par_ ^= 1; } } while (0)

__device__ __forceinline__ void nsa_prep_item(const bf16_t* proj, bf16_t* kn, bf16_t* vtn, const float* g_ks, const float* g_kw, int item, LAS unsigned char* scr, int lane) {
    const int b = item >> 7, which = (item >> 6) & 1, n = item & 63, ch = lane & 7, row0 = lane >> 3;
    const bf16_t* src = proj + ((size_t)b * SEQ + 64 * n) * NP + (which ? C_KWA : C_KSA) + 8 * ch;
    const float* g = (which ? g_kw : g_ks) + 8 * ch;
    float gg[8];
#pragma unroll
    for (int i = 0; i < 8; ++i) gg[i] = g[i];
    u32x4 kc[8], vc[8];
#pragma unroll
    for (int j = 0; j < 8; ++j) { const bf16_t* rp = src + (size_t)(row0 + 8 * j) * NP; kc[j] = *(const u32x4*)rp; vc[j] = *(const u32x4*)(rp + 64); }
    bf16_t* kdst = kn + (((size_t)b * 2 + which) * SEQ + 64 * n) * 64 + 8 * ch;
#pragma unroll
    for (int j = 0; j < 8; ++j) { const int row = row0 + 8 * j; UNPACK8(kc[j], k);
        float ss = (k0 * k0 + k1 * k1) + (k2 * k2 + k3 * k3) + (k4 * k4 + k5 * k5) + (k6 * k6 + k7 * k7);
        ss += swz_f<1>(ss); ss += swz_f<2>(ss); ss += swz_f<4>(ss);
        const float rs = rsqrtf(ss * (1.f / 64.f) + EPS); u32x4 o;
        o.x = cvtpk(k0 * rs * gg[0], k1 * rs * gg[1]); o.y = cvtpk(k2 * rs * gg[2], k3 * rs * gg[3]); o.z = cvtpk(k4 * rs * gg[4], k5 * rs * gg[5]); o.w = cvtpk(k6 * rs * gg[6], k7 * rs * gg[7]);
        *(u32x4*)(kdst + (size_t)row * 64) = o;
        LAS unsigned short* vp = (LAS unsigned short*)(scr + (8 * ch) * 144 + row * 2); const u32x4 v = vc[j];
        vp[0 * 72] = (unsigned short)(v.x & 0xffffu); vp[1 * 72] = (unsigned short)(v.x >> 16); vp[2 * 72] = (unsigned short)(v.y & 0xffffu); vp[3 * 72] = (unsigned short)(v.y >> 16);
        vp[4 * 72] = (unsigned short)(v.z & 0xffffu); vp[5 * 72] = (unsigned short)(v.z >> 16); vp[6 * 72] = (unsigned short)(v.w & 0xffffu); vp[7 * 72] = (unsigned short)(v.w >> 16); }
    LDS_WAIT();
    bf16_t* vdst = vtn + ((((size_t)b * 2 + which) * 64 + n) * 64 + lane) * 64;
#pragma unroll
    for (int c = 0; c < 8; ++c) *(u32x4*)(vdst + 8 * c) = *(LAS const u32x4*)(scr + lane * 144 + 16 * c);
    LDS_WAIT();
}

struct NsaArgs { const bf16_t* proj; bf16_t* groups; const bf16_t *kcn, *vcc; const float *b_gate, *g_q, *g_ks, *g_kw, *g_out; const bf16_t *kn, *vtn; };
constexpr int NSA_SLAB = 2 * KS_BYTES + 2 * VT_BYTES, NSA_ISUM = NSA_SLAB + 4 * 64 * 65 * 4, NSA_MASK = NSA_ISUM + 64 * 65 * 4, NSA_UMASK = NSA_MASK + 512;
__device__ __forceinline__ void nsa_item(const NsaArgs& A, int b, int tl, LAS unsigned char* lds, int tid) {
    asm volatile("" : "+v"(tid));
    const int lane = tid & 63, w = __builtin_amdgcn_readfirstlane(tid >> 6), head = w & 3, half = w >> 2, r = lane & 31, hh = lane >> 5;
    const int tq = tl * 64 + 32 * half + r, tokl = 32 * half + r; const size_t token = (size_t)b * SEQ + tq;
    const bf16_t* base = A.proj + (size_t)b * SEQ * NP;
    LAS float* slab = (LAS float*)(lds + NSA_SLAB); LAS float* isum = (LAS float*)(lds + NSA_ISUM);
    LAS unsigned* masks = (LAS unsigned*)(lds + NSA_MASK); LAS unsigned* umask = (LAS unsigned*)(lds + NSA_UMASK);
    const float slope = exp2f(-(float)(2 * head + 1)) * LOG2E;
    bf16x8 qf[4]; load_qfrag<true>(qf, base + (size_t)tq * NP + C_QA + head * 64, A.g_q, nullptr, 0.125f * LOG2E, hh);
    float gl[3];
#pragma unroll
    for (int br = 0; br < 3; ++br) { const float x = bf2f(base[(size_t)tq * NP + C_GT + head * 3 + br]) + A.b_gate[head * 3 + br]; gl[br] = 1.f / (1.f + __expf(-x)); }
    f32x16 of0, of1, o0, o1;
#pragma unroll
    for (int i = 0; i < 16; ++i) { of0[i] = 0.f; of1[i] = 0.f; }
    float dummy = 0.f;
    {
        const int nbc = (tl >> 4) + 1, nvis = tq >= 31 ? ((tq - 31) >> 4) + 1 : 0;
        const bf16_t* kc = A.kcn + (size_t)b * 256 * 64; const bf16_t* vc = A.vcc + (size_t)b * 256 * 64;
        float m = -INFINITY, l = 0.f;
        KV_PIPELINE_PRE(0, (cur + 1 < nbc ? cur + 1 : -1), kc + (size_t)id * 4096, vc + (size_t)id * 4096,
            { const SfCmp sf{tq, nvis, 64 * id, slope}; attn_block<1>(qf, o0, o1, m, l, ksb, vtb, r, hh, sf, 0.f, 0.f, nullptr, 0, dummy); });
        const float inv = l > 0.f ? 1.f / l : 0.f, msafe = m == -INFINITY ? 0.f : m; float carry = 0.f;
#pragma unroll
        for (int i = 0; i < 16; ++i) { o0[i] = 0.f; o1[i] = 0.f; }
        LAS float* imprw = slab + (head * 64 + tokl) * 65;
        KV_PIPELINE_PRE(0, (cur + 1 < nbc ? cur + 1 : -1), kc + (size_t)id * 4096, vc + (size_t)id * 4096,
            { const SfCmp sf{tq, nvis, 64 * id, slope}; attn_block<2>(qf, o0, o1, m, l, ksb, vtb, r, hh, sf, msafe, inv, imprw, 16 * id, carry); });
#pragma unroll
        for (int i = 0; i < 16; ++i) { of0[i] += gl[0] * o0[i]; of1[i] += gl[0] * o1[i]; }
    }
    __syncthreads();
    if (tl > 15) {
        for (int e = tid; e < 64 * 64; e += 512) { const int tk = e >> 6, n = e & 63, o = tk * 65 + n; isum[o] = ((slab[o] + slab[64 * 65 + o]) + slab[2 * 64 * 65 + o]) + slab[3 * 64 * 65 + o]; }
        __syncthreads();
        const int tk = tid >> 3, sub = tid & 7; float v[8]; int cnt[8];
#pragma unroll
        for (int k = 0; k < 8; ++k) { v[k] = isum[tk * 65 + 8 * sub + k]; cnt[k] = 0; }
        for (int mm = 1; mm <= tl - 2; ++mm) { const float vm = isum[tk * 65 + mm];
#pragma unroll
            for (int k = 0; k < 8; ++k) cnt[k] += (vm > v[k] || (vm == v[k] && mm < 8 * sub + k)) ? 1 : 0; }
        unsigned bits = 0u;
#pragma unroll
        for (int k = 0; k < 8; ++k) { const int n = 8 * sub + k; if (n >= 1 && n <= tl - 2 && cnt[k] < 13) bits |= 1u << k; }
        unsigned lo = sub < 4 ? bits << (8 * sub) : 0u, hi = sub >= 4 ? bits << (8 * (sub - 4)) : 0u;
        lo |= swz_u<1>(lo); hi |= swz_u<1>(hi); lo |= swz_u<2>(lo); hi |= swz_u<2>(hi); lo |= swz_u<4>(lo); hi |= swz_u<4>(hi);
        const unsigned long long mk = ((unsigned long long)hi << 32 | lo) | 1ull | (3ull << (tl - 1));
        if (sub == 0) { masks[2 * tk] = (unsigned)mk; masks[2 * tk + 1] = (unsigned)(mk >> 32); }
    } else if (tid < 64) { const unsigned long long mk = (2ull << tl) - 1ull; masks[2 * tid] = (unsigned)mk; masks[2 * tid + 1] = (unsigned)(mk >> 32); }
    __syncthreads();
    if (tid < 64) { unsigned lo = masks[2 * tid], hi = masks[2 * tid + 1];
        lo |= swz_u<1>(lo); hi |= swz_u<1>(hi); lo |= swz_u<2>(lo); hi |= swz_u<2>(hi); lo |= swz_u<4>(lo); hi |= swz_u<4>(hi);
        lo |= swz_u<8>(lo); hi |= swz_u<8>(hi); lo |= swz_u<16>(lo); hi |= swz_u<16>(hi); lo = or32(lo); hi = or32(hi);
        if (tid == 0) { umask[0] = lo; umask[1] = hi; } }
    __syncthreads();
    const unsigned long long um = (unsigned long long)umask[1] << 32 | umask[0];
    const unsigned long long mymask = (unsigned long long)masks[2 * tokl + 1] << 32 | masks[2 * tokl];
    LAS float* park = slab + w * 2048 + lane;
#pragma unroll
    for (int i = 0; i < 16; ++i) { park[i * 64] = of0[i]; park[(16 + i) * 64] = of1[i]; }
    {
        float m = -INFINITY, l = 0.f;
#pragma unroll
        for (int i = 0; i < 16; ++i) { o0[i] = 0.f; o1[i] = 0.f; }
        const bf16_t* kp = A.kn + (size_t)(b * 2) * SEQ * 64; const bf16_t* vp = A.vtn + (size_t)(b * 2) * 64 * 4096;
#define NSA_NEXTBIT(c) ({ const unsigned long long rem_ = ((c) >= 63) ? 0ull : (um & ~((2ull << (c)) - 1ull)); rem_ ? (int)__builtin_ctzll(rem_) : -1; })
        KV_PIPELINE_PRE((int)__builtin_ctzll(um), NSA_NEXTBIT(cur), kp + (size_t)id * 4096, vp + (size_t)id * 4096,
            { const bool sel = (mymask >> id) & 1ull;
              if (__any(sel)) {
                  if (id < tl) attn_block_full(qf, o0, o1, m, l, ksb, vtb, r, hh, sel ? -slope * (float)(tq - 64 * id - 4 * hh) : -INFINITY, slope);
                  else { const SfSlc sf{tq, 64 * id, slope, sel}; attn_block<0>(qf, o0, o1, m, l, ksb, vtb, r, hh, sf, 0.f, 0.f, nullptr, 0, dummy); } } });
        const float sc = gl[1] / l;
#pragma unroll
        for (int i = 0; i < 16; ++i) { park[i * 64] += sc * o0[i]; park[(16 + i) * 64] += sc * o1[i]; }
    }
    {
        float m = -INFINITY, l = 0.f;
#pragma unroll
        for (int i = 0; i < 16; ++i) { o0[i] = 0.f; o1[i] = 0.f; }
        const bf16_t* kp = A.kn + (size_t)(b * 2 + 1) * SEQ * 64; const bf16_t* vp = A.vtn + (size_t)(b * 2 + 1) * 64 * 4096; const int nlo = tl >= 8 ? tl - 8 : 0;
        KV_PIPELINE_PRE(nlo, (cur + 1 <= tl ? cur + 1 : -1), kp + (size_t)id * 4096, vp + (size_t)id * 4096,
            { if (id < tl && id >= tl - 7) attn_block_full(qf, o0, o1, m, l, ksb, vtb, r, hh, -slope * (float)(tq - 64 * id - 4 * hh), slope);
              else { const SfWin sf{tq, 64 * id, slope}; attn_block<0>(qf, o0, o1, m, l, ksb, vtb, r, hh, sf, 0.f, 0.f, nullptr, 0, dummy); } });
        const float sc = gl[2] / l;
#pragma unroll
        for (int i = 0; i < 16; ++i) { of0[i] = park[i * 64] + sc * o0[i]; of1[i] = park[(16 + i) * 64] + sc * o1[i]; }
    }
    {
        float ss = 0.f;
#pragma unroll
        for (int i = 0; i < 16; ++i) ss += of0[i] * of0[i] + of1[i] * of1[i];
        ss = sum32(ss);
        const float rs = rsqrtf(ss * (1.f / 64.f) + EPS); const float* go = A.g_out + head * 64; bf16_t* dst = A.groups + token * DM + head * 64;
#pragma unroll
        for (int g = 0; g < 4; ++g) { const int d0 = 8 * g + 4 * hh;
            u32x2 wa; wa.x = cvtpk(of0[4 * g] * rs * go[d0], of0[4 * g + 1] * rs * go[d0 + 1]); wa.y = cvtpk(of0[4 * g + 2] * rs * go[d0 + 2], of0[4 * g + 3] * rs * go[d0 + 3]);
            *(u32x2*)(dst + d0) = wa;
            u32x2 wb; wb.x = cvtpk(of1[4 * g] * rs * go[32 + d0], of1[4 * g + 1] * rs * go[32 + d0 + 1]); wb.y = cvtpk(of1[4 * g + 2] * rs * go[32 + d0 + 2], of1[4 * g + 3] * rs * go[32 + d0 + 3]);
            *(u32x2*)(dst + 32 + d0) = wb; }
    }
    __syncthreads();
}

struct SfDil { int iq, key0; float sl; __device__ __forceinline__ float operator()(float s, int kl) const { const int df = iq - key0 - kl; return (df >= 0 && df <= 128) ? s - sl * (float)df : -INFINITY; } };
struct DilArgs { const bf16_t* proj; bf16_t* po; float* plse; const float *g_q, *g_k; };
__device__ __forceinline__ void dil_item(const DilArgs& A, int item, LAS unsigned char* lds, int tid) {
    asm volatile("" : "+v"(tid));
    const int cfg = item >> 9, rem = item & 511, b = rem >> 6, head = (rem >> 4) & 3, sub = rem & 15;
    const int dil = cfg == 0 ? 1 : (cfg == 1 ? 4 : 16), nq = 16 / dil, c = sub / nq, qt = sub % nq, i0 = 256 * qt, L = SEQ / dil;
    const int lane = tid & 63, w = __builtin_amdgcn_readfirstlane(tid >> 6), r = lane & 31, hh = lane >> 5;
    const int iq = i0 + 32 * w + r, tq = c + dil * iq; const size_t token = (size_t)b * SEQ + tq;
    const bf16_t* base = A.proj + (size_t)b * SEQ * NP;
    const float slope = exp2f(-(float)(2 * head + 2)) * (float)dil * LOG2E;
    bf16x8 qf[4]; load_qfrag<true>(qf, base + (size_t)tq * NP + C_QD + head * 64, A.g_q, nullptr, 0.125f * LOG2E, hh);
    const bf16_t* kp = base + (size_t)c * NP + C_KD + head * 64; const bf16_t* vp = base + (size_t)c * NP + C_VD + head * 64;
    const int kb_lo = (i0 >> 6) >= 2 ? (i0 >> 6) - 2 : 0, kb_hi = (i0 >> 6) + 3, q_lo = i0 + 32 * w;
    f32x16 o0, o1;
#pragma unroll
    for (int i = 0; i < 16; ++i) { o0[i] = 0.f; o1[i] = 0.f; }
    float m = -INFINITY, l = 0.f, dummy = 0.f;
    KV_PIPELINE(kb_lo, (cur + 1 <= kb_hi ? cur + 1 : -1), (KVSrc{kp, vp, (long)dil * NP, 64 * id, 0, L}), true, A.g_k,
        { if (64 * id + 63 >= q_lo - 128 && 64 * id <= q_lo + 31) { const SfDil sf{iq, 64 * id, slope}; attn_block<0>(qf, o0, o1, m, l, ksb, vtb, r, hh, sf, 0.f, 0.f, nullptr, 0, dummy); } });
    const float inv = 1.f / l;
    bf16_t* dst = A.po + ((size_t)cfg * M + token) * 256 + head * 64;
#pragma unroll
    for (int g = 0; g < 4; ++g) { const int d0 = 8 * g + 4 * hh;
        u32x2 wa; wa.x = cvtpk(o0[4 * g] * inv, o0[4 * g + 1] * inv); wa.y = cvtpk(o0[4 * g + 2] * inv, o0[4 * g + 3] * inv); *(u32x2*)(dst + d0) = wa;
        u32x2 wb; wb.x = cvtpk(o1[4 * g] * inv, o1[4 * g + 1] * inv); wb.y = cvtpk(o1[4 * g + 2] * inv, o1[4 * g + 3] * inv); *(u32x2*)(dst + 32 + d0) = wb; }
    if (hh == 0) A.plse[((size_t)cfg * M + token) * 4 + head] = m + __log2f(l);
    __syncthreads();
}
template <int NI> __device__ __forceinline__ void dil_merge_items(const bf16_t* po, const float* plse, bf16_t* groups, const float* g_out, int item0, int stride, int lane) {
    const int pair = lane >> 3, ch = lane & 7, head = pair & 3;
    u32x4 pv[NI][3]; float ls[NI][3];
#pragma unroll
    for (int n = 0; n < NI; ++n) { const size_t token = (size_t)(item0 + n * stride) * 2 + (pair >> 2);
#pragma unroll
        for (int i = 0; i < 3; ++i) { ls[n][i] = plse[((size_t)i * M + token) * 4 + head]; pv[n][i] = *(const u32x4*)(po + ((size_t)i * M + token) * 256 + head * 64 + 8 * ch); } }
    const float* go = g_out + 768 + head * 64 + 8 * ch;
#pragma unroll
    for (int n = 0; n < NI; ++n) { const size_t token = (size_t)(item0 + n * stride) * 2 + (pair >> 2);
        const float mx = fmaxf(ls[n][0], fmaxf(ls[n][1], ls[n][2]));
        const float w0 = EXP2(ls[n][0] - mx), w1 = EXP2(ls[n][1] - mx), w2 = EXP2(ls[n][2] - mx), winv = 1.f / (w0 + w1 + w2);
        float o[8];
#pragma unroll
        for (int j = 0; j < 8; ++j) o[j] = 0.f;
#pragma unroll
        for (int i = 0; i < 3; ++i) { UNPACK8(pv[n][i], k); const float wi = (i == 0 ? w0 : (i == 1 ? w1 : w2)) * winv;
            o[0] += wi * k0; o[1] += wi * k1; o[2] += wi * k2; o[3] += wi * k3; o[4] += wi * k4; o[5] += wi * k5; o[6] += wi * k6; o[7] += wi * k7; }
        float ss = 0.f;
#pragma unroll
        for (int j = 0; j < 8; ++j) ss += o[j] * o[j];
        ss += swz_f<1>(ss); ss += swz_f<2>(ss); ss += swz_f<4>(ss);
        const float rs = rsqrtf(ss * (1.f / 64.f) + EPS);
        u32x4 wv; wv.x = cvtpk(o[0] * rs * go[0], o[1] * rs * go[1]); wv.y = cvtpk(o[2] * rs * go[2], o[3] * rs * go[3]); wv.z = cvtpk(o[4] * rs * go[4], o[5] * rs * go[5]); wv.w = cvtpk(o[6] * rs * go[6], o[7] * rs * go[7]);
        *(u32x4*)(groups + token * DM + 768 + head * 64 + 8 * ch) = wv; }
}

__device__ __forceinline__ void stick_block(const bf16x8 (&qf)[4], f32x16& o0, f32x16& o1, float& carry, LAS const unsigned char* ksb, LAS const unsigned char* vtb, int r, int hh, int tq, int key0) {
    f32x16 s0, s1;
#pragma unroll
    for (int i = 0; i < 16; ++i) { s0[i] = 0.f; s1[i] = 0.f; }
    bf16x8 ka[4], kb2[4];
#pragma unroll
    for (int s = 0; s < 4; ++s) { ka[s] = *(LAS const bf16x8*)(ksb + r * KSB + (16 * s + 8 * hh) * 2); kb2[s] = *(LAS const bf16x8*)(ksb + (32 + r) * KSB + (16 * s + 8 * hh) * 2); }
    __builtin_amdgcn_s_setprio(1);
#pragma unroll
    for (int s = 0; s < 4; ++s) { s0 = MFMA32(ka[s], qf[s], s0); s1 = MFMA32(kb2[s], qf[s], s1); }
    __builtin_amdgcn_s_setprio(0);
    __builtin_amdgcn_sched_barrier(0);
    float acc = carry;
#pragma unroll
    for (int kti = 0; kti < 2; ++kti) { const int kt = 1 - kti; float spm[16], G[4], R[4];
#pragma unroll
        for (int i = 0; i < 16; ++i) { const float z = kt ? s1[i] : s0[i]; const bool act = key0 + 32 * kt + crow(i, hh) < tq;
            const float sp = fmaxf(z, 0.f) + __logf(1.f + __expf(-fabsf(z)));
            spm[i] = act ? sp : 0.f; const float lw = act ? z - sp : -INFINITY; if (kt) s1[i] = lw; else s0[i] = lw; }
#pragma unroll
        for (int g = 0; g < 4; ++g) { G[g] = (spm[4 * g] + spm[4 * g + 1]) + (spm[4 * g + 2] + spm[4 * g + 3]); R[g] = partner32(G[g], hh); }
#pragma unroll
        for (int gi = 0; gi < 4; ++gi) { const int g = 3 - gi; float run = acc + (hh ? 0.f : R[g]);
#pragma unroll
            for (int ki = 0; ki < 4; ++ki) { const int i = 4 * g + 3 - ki; const float lw = kt ? s1[i] : s0[i]; const float wv = __expf(lw - run); if (kt) s1[i] = wv; else s0[i] = wv; run += spm[i]; }
            acc += G[g] + R[g]; } }
    carry = acc;
    __builtin_amdgcn_sched_barrier(0);
    pv_accum(s0, s1, o0, o1, vtb, r, hh);
}
struct StickArgs { const bf16_t* proj; bf16_t* groups; const float* g_out; };
__device__ __forceinline__ void stick_item(const StickArgs& A, int item, LAS unsigned char* lds, int tid) {
    asm volatile("" : "+v"(tid));
    const int b = item >> 6, head = (item >> 4) & 3, qt = item & 15, T0 = 256 * qt;
    const int lane = tid & 63, w = __builtin_amdgcn_readfirstlane(tid >> 6), r = lane & 31, hh = lane >> 5, tq = T0 + 32 * w + r;
    const size_t token = (size_t)b * SEQ + tq;
    const bf16_t* base = A.proj + (size_t)b * SEQ * NP;
    bf16x8 qf[4]; load_qfrag<false>(qf, base + (size_t)tq * NP + C_QC + head * 64, nullptr, nullptr, 0.125f, hh);
    LAS unsigned* flags = (LAS unsigned*)(lds + NSA_SLAB);
    if (tid < 16) flags[tid] = 0u;
    f32x16 o0, o1;
#pragma unroll
    for (int i = 0; i < 16; ++i) { o0[i] = 0.f; o1[i] = 0.f; }
    float carry = 0.f; bool done = false;
    const bf16_t* kp = base + C_KC + head * 64; const bf16_t* vp = base + C_VC + head * 64;
#define STK_NEXT(c) ({ const LAS unsigned* f_ = flags + (par_ ^ 1) * 8; const unsigned ad_ = (f_[0] & f_[1]) & (f_[2] & f_[3]) & (f_[4] & f_[5]) & (f_[6] & f_[7]); ((c) > 0 && !ad_) ? (c) - 1 : -1; })
    KV_PIPELINE((T0 >> 6) + 3, STK_NEXT(cur), (KVSrc{kp, vp, NP, 64 * id, 0, SEQ}), false, nullptr,
        { if (!done && 64 * id <= T0 + 32 * w + 30) { stick_block(qf, o0, o1, carry, ksb, vtb, r, hh, tq, 64 * id); done = __all(carry > 104.f); }
          if (lane == 0) flags[par_ * 8 + w] = done ? 1u : 0u; });
    float ss = 0.f;
#pragma unroll
    for (int i = 0; i < 16; ++i) ss += o0[i] * o0[i] + o1[i] * o1[i];
    ss = sum32(ss);
    const float rs = rsqrtf(ss * (1.f / 64.f) + EPS); const float* go = A.g_out + 512 + head * 64; bf16_t* dst = A.groups + token * DM + 512 + head * 64;
#pragma unroll
    for (int g = 0; g < 4; ++g) { const int d0 = 8 * g + 4 * hh;
        u32x2 wa; wa.x = cvtpk(o0[4 * g] * rs * go[d0], o0[4 * g + 1] * rs * go[d0 + 1]); wa.y = cvtpk(o0[4 * g + 2] * rs * go[d0 + 2], o0[4 * g + 3] * rs * go[d0 + 3]); *(u32x2*)(dst + d0) = wa;
        u32x2 wb; wb.x = cvtpk(o1[4 * g] * rs * go[32 + d0], o1[4 * g + 1] * rs * go[32 + d0 + 1]); wb.y = cvtpk(o1[4 * g + 2] * rs * go[32 + d0 + 2], o1[4 * g + 3] * rs * go[32 + d0 + 3]); *(u32x2*)(dst + 32 + d0) = wb; }
    __syncthreads();
}

struct CmpArgs { const bf16_t* proj; const bf16_t* w1t; const bf16_t* w2t; const float* cb; const float* g_kc; bf16_t* kcn; bf16_t* vcc; };
constexpr int HIDB = 528;
__device__ __forceinline__ void compress_item(const CmpArgs& A, int item, LAS unsigned char* lds, int tid) {
    asm volatile("" : "+v"(tid));
    const int kv = item >> 6, rt = item & 63, b = rt >> 3, j0 = (rt & 7) * 32;
    const int lane = tid & 63, w = __builtin_amdgcn_readfirstlane(tid >> 6), r = lane & 31, hh = lane >> 5;
    { const bf16_t* xsrc = A.proj + (size_t)b * SEQ * NP + (kv ? C_VCA : C_KCA);
      u32x4 stg[9];
#pragma unroll
      for (int q = 0; q < 9; ++q) { const int e2 = tid + 512 * q, t = e2 >> 3, c = e2 & 7; int tk = 16 * j0 + t; tk = tk < SEQ ? tk : SEQ - 1;
          if (e2 < 528 * 8) stg[q] = *(const u32x4*)(xsrc + (size_t)tk * NP + 8 * c); }
#pragma unroll
      for (int q = 0; q < 9; ++q) { const int e2 = tid + 512 * q, t = e2 >> 3, c = e2 & 7;
          if (e2 < 528 * 8) *(LAS u32x4*)(lds + (t ^ ((t >> 7) & 1)) * 128 + ((c ^ ((t >> 4) & 7)) * 16)) = stg[q]; } }
    __syncthreads();
    const bf16_t* wf = A.w1t + (size_t)kv * 256 * 2048 + ((size_t)w * 128 * 64 + lane) * 8;
    f32x16 acc;
#pragma unroll
    for (int i = 0; i < 16; ++i) acc[i] = 0.f;
#pragma unroll 8
    for (int pos = 0; pos < 32; ++pos) { const int t = 16 * r + pos; LAS const unsigned char* arow = lds + (t ^ ((t >> 7) & 1)) * 128; const int sw = (t >> 4) & 7;
#pragma unroll
        for (int q = 0; q < 4; ++q) { const bf16x8 af = *(LAS const bf16x8*)(arow + (((2 * q + hh) ^ sw) * 16)), bfr = *(const bf16x8*)(wf + (size_t)(4 * pos + q) * 512); acc = MFMA32(af, bfr, acc); } }
    __syncthreads();
    { const float bias = A.cb[kv * 256 + 32 * w + r];
#pragma unroll
      for (int i = 0; i < 16; ++i) { const float x = acc[i] + bias; const float hv = 0.5f * x * (1.f + tanhf(0.7978845608028654f * (x + 0.044715f * x * x * x)));
          *(LAS unsigned short*)(lds + crow(i, hh) * HIDB + (32 * w + r) * 2) = (unsigned short)(cvtpk(hv, hv) & 0xffffu); } }
    __syncthreads();
    if (w == 0) {
        f32x16 c0, c1;
#pragma unroll
        for (int i = 0; i < 16; ++i) { c0[i] = 0.f; c1[i] = 0.f; }
        const bf16_t* w2a = A.w2t + ((size_t)kv * 64 + r) * 256 + 8 * hh; const bf16_t* w2b = w2a + 32 * 256;
#pragma unroll
        for (int s = 0; s < 16; ++s) { const bf16x8 af = *(LAS const bf16x8*)(lds + r * HIDB + (16 * s + 8 * hh) * 2);
            c0 = MFMA32(af, *(const bf16x8*)(w2a + 16 * s), c0); c1 = MFMA32(af, *(const bf16x8*)(w2b + 16 * s), c1); }
        const float g0 = A.g_kc[r], g1 = A.g_kc[32 + r]; bf16_t* dst = (kv ? A.vcc : A.kcn) + ((size_t)b * 256 + j0) * 64;
#pragma unroll
        for (int i = 0; i < 16; ++i) { float v0 = c0[i], v1 = c1[i];
            if (!kv) { float ss = v0 * v0 + v1 * v1; ss += swz_f<1>(ss); ss += swz_f<2>(ss); ss += swz_f<4>(ss); ss += swz_f<8>(ss); ss += swz_f<16>(ss);
                const float rs = rsqrtf(ss * (1.f / 64.f) + EPS); v0 *= rs * g0; v1 *= rs * g1; }
            const int row = crow(i, hh);
            if (!kv) { dst[row * 64 + r] = (bf16_t)(cvtpk(v0, v0) & 0xffffu); dst[row * 64 + 32 + r] = (bf16_t)(cvtpk(v1, v1) & 0xffffu); }
            else { const int j = j0 + row; bf16_t* vt = A.vcc + ((size_t)b * 4 + (j >> 6)) * 4096 + (j & 63);
                vt[(size_t)r * 64] = (bf16_t)(cvtpk(v0, v0) & 0xffffu); vt[(size_t)(32 + r) * 64] = (bf16_t)(cvtpk(v1, v1) & 0xffffu); } }
    }
    __syncthreads();
}
#define RLX_AGENT __ATOMIC_RELAXED, __HIP_MEMORY_SCOPE_AGENT
#define XB_TMO      128
#define XB_XCNT(j)  (256  + 64 * (j))
#define XB_XSUB(j)  (1280 + 64 * (j))
#define XB_XGEN(j)  (2304 + 64 * (j))
#define XB_TOP      3328
#define XB_TOPGEN   3392
#define XCD_BAR_WORDS 3456
#define XB_SPIN_CAP (1u << 18)

__device__ __forceinline__ unsigned xb_ld(unsigned* p)              { return __hip_atomic_load(p, __ATOMIC_RELAXED, __HIP_MEMORY_SCOPE_AGENT); }
__device__ __forceinline__ unsigned xb_add(unsigned* p, unsigned v) { return __hip_atomic_fetch_add(p, v, __ATOMIC_RELAXED, __HIP_MEMORY_SCOPE_AGENT); }
__device__ __forceinline__ unsigned xb_xcc_id() { return (unsigned)__builtin_amdgcn_s_getreg((3 << 11) | 20) & 0xFu; }
#define XB_SPIN(cond, bar) do { unsigned _sp = 0; while (cond) { __builtin_amdgcn_s_sleep(1); \
    if ((++_sp & 255u) == 0u) { if (xb_ld(&(bar)[XB_TMO])) break; if (_sp > XB_SPIN_CAP) { atomicAdd(&(bar)[XB_TMO], 1u); break; } } } } while (0)

struct XcdBarrier {
    unsigned* bar; unsigned x;
    volatile LAS unsigned* st;
};

__device__ __forceinline__ XcdBarrier xcd_barrier_post(unsigned* bar, volatile LAS unsigned* st) {
    XcdBarrier b; b.bar = bar; b.x = xb_xcc_id(); b.st = st;
    if (threadIdx.x == 0) (void)xb_add(&bar[XB_XCNT(b.x)], 1u);
    return b;
}
__device__ __forceinline__ void xcd_barrier_complete(unsigned* bar, unsigned x, unsigned& nloc, unsigned& nx) {
    const unsigned G = gridDim.x * gridDim.y * gridDim.z;
    unsigned sum, cnt, mine, sp = 0u;
    for (;;) {
        sum = 0u; cnt = 0u; mine = 0u;
#pragma unroll
        for (unsigned j = 0; j < 16; ++j) { const unsigned c = xb_ld(&bar[XB_XCNT(j)]); sum += c; cnt += (c > 0u) ? 1u : 0u; mine = (j == x) ? c : mine; }
        if (sum == G) break;
        __builtin_amdgcn_s_sleep(1);
        if ((++sp & 255u) == 0u) { if (xb_ld(&bar[XB_TMO])) break; if (sp > XB_SPIN_CAP) { atomicAdd(&bar[XB_TMO], 1u); break; } }
    }
    nloc = mine > 0u ? mine : 1u; nx = cnt > 0u ? cnt : 1u;
}

__device__ __forceinline__ void xcd_barrier(const XcdBarrier& b) {
    asm volatile("s_waitcnt vmcnt(0)" ::: "memory");
    __syncthreads();
    if (threadIdx.x == 0) {
        unsigned* bar = b.bar;
        __builtin_amdgcn_s_waitcnt(0);
        unsigned nloc = b.st[0], nx = b.st[1];
        if (nloc == 0u) { xcd_barrier_complete(bar, b.x, nloc, nx); b.st[0] = nloc; b.st[1] = nx; }
        const unsigned old = xb_add(&bar[XB_XSUB(b.x)], 1u);
        const unsigned gen = old / nloc;
        if (old + 1u == (gen + 1u) * nloc) {
            __builtin_amdgcn_fence(__ATOMIC_RELEASE, "agent");
            asm volatile("s_waitcnt vmcnt(0)" ::: "memory");
            const unsigned og = xb_add(&bar[XB_TOP], 1u);
            const unsigned tg = og / nx;
            if (og + 1u == (tg + 1u) * nx) xb_add(&bar[XB_TOPGEN], 1u);
            else XB_SPIN(xb_ld(&bar[XB_TOPGEN]) == tg, bar);
            __builtin_amdgcn_fence(__ATOMIC_ACQUIRE, "agent");
            xb_add(&bar[XB_XGEN(b.x)], 1u);
            asm volatile("s_waitcnt vmcnt(0)" ::: "memory");
        } else {
            XB_SPIN(xb_ld(&bar[XB_XGEN(b.x)]) == gen, bar);
            __builtin_amdgcn_fence(__ATOMIC_ACQUIRE, "agent");
            asm volatile("s_waitcnt vmcnt(0)" ::: "memory");
        }
    }
    __syncthreads();
}

#ifndef REP_CMP
#define REP_CMP 1
#endif
#ifndef REP_STK
#define REP_STK 1
#endif
#ifndef REP_DIL
#define REP_DIL 1
#endif
#ifndef REP_NSA
#define REP_NSA 1
#endif
#ifndef REP_G1
#define REP_G1 1
#endif
#ifndef REP_G3
#define REP_G3 1
#endif
#ifndef REP_PRO
#define REP_PRO 1
#endif
#ifndef REP_PREP
#define REP_PREP 1
#endif
#ifndef RESID_BF16
#define RESID_BF16 1
#endif
#ifndef REP_CONV
#define REP_CONV 1
#endif
#ifndef REP_G2
#define REP_G2 1
#endif
#ifndef XSYNC
#define XSYNC 0
#endif
__global__ void __launch_bounds__(512, 2) fwd_kernel(Params p) {
    extern __shared__ __attribute__((aligned(16))) unsigned char lds_raw[];
    cg::grid_group grid = cg::this_grid();
    LAS unsigned char* lds = (LAS unsigned char*)lds_raw;
#define TID_SETUP() int tid = threadIdx.x; asm volatile("" : "+v"(tid)); const int lane = tid & 63, wave = __builtin_amdgcn_readfirstlane(tid >> 6), gw = blockIdx.x * 8 + wave; (void)lane; (void)gw
    const int G = gridDim.x, NGW = G * 8;
    unsigned char* ws = p.ws;
    volatile LAS unsigned* misc = (volatile LAS unsigned*)(lds + LDS_BYTES - 64);
    unsigned* barw = (unsigned*)(ws + WS_BAR);
    { int t0 = threadIdx.x; if (t0 < 2) misc[t0] = 0u;
      if (blockIdx.x == 0) for (int i = t0; i < XCD_BAR_WORDS; i += 512) barw[i] = 0u;
      __syncthreads(); }
    float* ss = (float*)(ws + WS_SS); bf16_t* kcn = (bf16_t*)(ws + WS_KCN); bf16_t* vcc = (bf16_t*)(ws + WS_VCC);
    bf16_t* xb = (bf16_t*)(ws + WS_XB); bf16_t* groups = (bf16_t*)(ws + WS_GR); bf16_t* proj = (bf16_t*)(ws + WS_PROJ); bf16_t* hbuf = proj;
    float* x1 = (float*)(ws + WS_X1); bf16_t* nkn = (bf16_t*)(ws + WS_X1); bf16_t* nvt = (bf16_t*)(ws + WS_X1 + 8 * MiB);
    bf16_t* dpo = (bf16_t*)((unsigned char*)p.out + DO_PO); float* dlse = (float*)((unsigned char*)p.out + DO_LSE);

#ifndef SKIP_PRO
    for (int rep_ = 0; rep_ < REP_PRO; ++rep_) { TID_SETUP(); prologue(p, lds, gw, NGW, wave, lane); }
#endif
    grid.sync();
    const XcdBarrier xbar = xcd_barrier_post(barw, misc);
    for (int xs_ = 0; xs_ < XSYNC; ++xs_) xcd_barrier(xbar);

    for (int l = 0; l < 2; ++l) {
        unsigned char* wl = ws + WS_W + (size_t)l * W_LAYER;
#ifndef SKIP_G1
        for (int rep_ = 0; rep_ < REP_G1; ++rep_)
        { pg8::Gemm g{xb, (const bf16_t*)(wl + W_IN), M, NP, DM}; pg8::StaticOrder S; S.init(M, NP, G, (int)blockIdx.x);
          EpiProj E{proj, ss + (size_t)(2 * l) * M};
          pg8::gemm_phase<EpiProj, pg8::StaticOrder, true, true>(lds, g, S, E); }
#endif
        xcd_barrier(xbar);
        {
            TID_SETUP();
            const float* g_out = p.in[17] + l * DM;
            {
              const CmpArgs CA{proj, (const bf16_t*)(ws + WS_W1T) + (size_t)l * 2 * 256 * 2048, (const bf16_t*)(ws + WS_W2T) + (size_t)l * 2 * 64 * 256, (const float*)(ws + WS_CB) + l * 512, p.in[5] + l * 64, kcn, vcc};
              const StickArgs SA{proj, groups, g_out}; const DilArgs DA{proj, dpo, dlse, p.in[15] + l * 64, p.in[16] + l * 64};
              volatile LAS int* slot = (volatile LAS int*)(lds + LDS_BYTES - 32);
              for (;;) { __syncthreads(); if (tid == 0) *slot = (int)atomicAdd(barw + 32 + 64 * l, 1u); __syncthreads(); const int it = *slot; if (it >= 128 + 512 + 1536 + 256 + 128) break;
                  if (it < 128) compress_item(CA, it, lds, tid); else if (it < 640) stick_item(SA, it - 128, lds, tid); else if (it < 2176) dil_item(DA, it - 640, lds, tid);
                  else if (it < 2432) { const int i0 = (it - 2176) * 64 + wave; conv_items<4>(proj, groups, p.in[14] + l * 768, g_out, i0, 8, lane); conv_items<4>(proj, groups, p.in[14] + l * 768, g_out, i0 + 32, 8, lane); }
                  else nsa_prep_item(proj, nkn, nvt, p.in[6] + l * 64, p.in[7] + l * 64, (it - 2432) * 8 + wave, lds + wave * 9216, lane); } }
        }
        xcd_barrier(xbar);
#ifndef SKIP_NSA
#ifndef SKIP_DIL
#endif
        for (int rep_ = 0; rep_ < REP_NSA; ++rep_)
        { TID_SETUP(); NsaArgs A{proj, groups, kcn, vcc, p.in[3] + l * 12, p.in[4] + l * 64, p.in[6] + l * 64, p.in[7] + l * 64, p.in[17] + l * DM, nkn, nvt};
          volatile LAS int* slot = (volatile LAS int*)(lds + LDS_BYTES - 32);
          for (;;) { __syncthreads(); if (tid == 0) *slot = (int)atomicAdd(barw + 64 * l, 1u); __syncthreads(); const int it = *slot; if (it >= 512 + 256) break;
              if (it < 512) nsa_item(A, it & 7, 63 - (it >> 3), lds, tid);
              else { const int i0 = (it - 512) * 64 + wave; dil_merge_items<4>(dpo, dlse, groups, p.in[17] + l * DM, i0, 8, lane); dil_merge_items<4>(dpo, dlse, groups, p.in[17] + l * DM, i0 + 32, 8, lane); } } }
#endif
        xcd_barrier(xbar);
#ifndef SKIP_G2
        { pg8::Gemm g{groups, (const bf16_t*)(wl + W_OUT), M, DM, DM}; pg8::StaticOrder S; S.init(M, DM, G, (int)blockIdx.x);
#if RESID_BF16
          EpiResid E{l == 0 ? p.in[0] : nullptr, xb, nullptr, xb, ss + (size_t)(2 * l + 1) * M};
#else
          EpiResid E{l == 0 ? p.in[0] : x1, nullptr, l == 0 ? x1 : p.out, xb, ss + (size_t)(2 * l + 1) * M};
#endif
          pg8::gemm_phase<EpiResid, pg8::StaticOrder, true, true>(lds, g, S, E);
          for (int rep_ = 1; rep_ < REP_G2; ++rep_) { E.ss = nullptr; pg8::gemm_phase<EpiResid, pg8::StaticOrder, true, true>(lds, g, S, E); } }
#endif
        xcd_barrier(xbar);
#ifndef SKIP_G3
        for (int rep_ = 0; rep_ < REP_G3; ++rep_)
        { pg8::Gemm g{xb, (const bf16_t*)(wl + W_GU), M, NGU, DM}; pg8::StaticOrder S; S.init(M, NGU, G, (int)blockIdx.x);
          EpiSwiGLU E{hbuf, ss + (size_t)(2 * l + 1) * M};
          pg8::gemm_phase<EpiSwiGLU, pg8::StaticOrder, true, true>(lds, g, S, E); }
#endif
        xcd_barrier(xbar);
#ifndef SKIP_G4
        { pg8::Gemm g{hbuf, (const bf16_t*)(wl + W_DN), M, DM, FF}; pg8::StaticOrder S; S.init(M, DM, G, (int)blockIdx.x);
          float* xio = l == 0 ? x1 : p.out;
#if RESID_BF16
          EpiResid E{nullptr, xb, l == 0 ? nullptr : p.out, l == 0 ? xb : nullptr, l == 0 ? ss + (size_t)2 * M : nullptr}; (void)xio;
#else
          EpiResid E{xio, nullptr, xio, l == 0 ? xb : nullptr, l == 0 ? ss + (size_t)2 * M : nullptr};
#endif
          pg8::gemm_phase<EpiResid, pg8::StaticOrder, true, true>(lds, g, S, E); }
#endif
        if (l == 0) xcd_barrier(xbar);
    }
}

extern "C" void kernel_launch(void* const* d_in, const int* in_sizes, int n_in, void* d_out, int out_size, void* d_ws, size_t ws_size, hipStream_t stream) {
    static int grid = 0;
    if (grid == 0) {
        if (n_in != 23 || out_size != M * DM || ws_size < WS_END) { fprintf(stderr, "kernel_launch: unexpected shapes (n_in %d, out %d, ws %zu)\n", n_in, out_size, ws_size); grid = -1; return; }
        int dev = 0, cus = 0, per_cu = 0;
        (void)hipGetDevice(&dev); (void)hipDeviceGetAttribute(&cus, hipDeviceAttributeMultiprocessorCount, dev);
        if (hipFuncSetAttribute((const void*)fwd_kernel, hipFuncAttributeMaxDynamicSharedMemorySize, LDS_BYTES) != hipSuccess) { fprintf(stderr, "kernel_launch: hipFuncSetAttribute failed\n"); grid = -1; return; }
        if (hipOccupancyMaxActiveBlocksPerMultiprocessor(&per_cu, (const void*)fwd_kernel, 512, LDS_BYTES) != hipSuccess || per_cu < 1) per_cu = 1;
        (void)hipGetLastError();
        grid = cus * 1;
        (void)per_cu;
    }
    if (grid < 0) return;
    Params p{};
    for (int i = 0; i < 23; ++i) p.in[i] = (const float*)d_in[i];
    p.out = (float*)d_out; p.ws = (unsigned char*)d_ws;
    void* args[] = {&p};
    hipError_t e = hipLaunchCooperativeKernel((const void*)fwd_kernel, dim3(grid), dim3(512), args, LDS_BYTES, stream);
    if (e != hipSuccess) fprintf(stderr, "cooperative launch failed: %s (grid %d)\n", hipGetErrorString(e), grid);
}
```

```cpp
#include <hip/hip_runtime.h>
#include <hip/hip_cooperative_groups.h>
#include <cstdio>
#include <cstdint>
namespace cg = cooperative_groups;
namespace pg8 {
#define PG8_LAS __attribute__((address_space(3)))
typedef unsigned short bf16_t;
typedef short bf16x8 __attribute__((ext_vector_type(8)));
typedef float f32x4 __attribute__((ext_vector_type(4)));
typedef unsigned u32x4 __attribute__((ext_vector_type(4)));
constexpr int BM = 256, BK = 64, HALF = 128, HTB = HALF * BK * 2  , STAGE_BYTES = 8 * HTB, NXCD = 8, WGM = 8;

__host__ __device__ __forceinline__ int lds_byte(int r, int c) { const int st = (r >> 4) * 2 + (c >> 5), rr = r & 15, cc = c & 31, ob = rr * 64 + cc * 2; return st * 1024 + (ob ^ (((ob >> 9) & 1) << 5)); }
__host__ __device__ __forceinline__ void stage_rc(int b, int& R, int& C) { const int st = b / 1024, sb = b % 1024, swz = sb ^ (((sb >> 9) & 1) << 5); R = (st >> 1) * 16 + swz / 64; C = (st & 1) * 32 + (swz % 64) / 2; }
__host__ __device__ __forceinline__ int perm32(int rho) { const int n = rho >> 4, i = rho & 15; return 8 * (i >> 2) + 4 * n + (i & 3); }

struct Unit { int pm, pn; };
struct Gemm { const bf16_t* A; const bf16_t* Bt; int M, N, K; };

struct StaticOrder {
    int nM, nN, nwg, G, c;
    __host__ __device__ void init(int M, int N, int G_, int c_) { nM = M / BM; nN = N / BM; nwg = nM * nN; G = G_; c = c_; }
    __host__ __device__ bool next(int i, Unit& u) const {
        const long L = (long)i * G + c; if (L >= nwg) return false;
        int wgid = (int)L; { const int q = nwg / NXCD, r = nwg % NXCD, xcd = wgid % NXCD, off = wgid / NXCD; wgid = (xcd < r ? xcd * (q + 1) : r * (q + 1) + (xcd - r) * q) + off; }
        const int nig = WGM * nN, gid = wgid / nig, fm = gid * WGM, gsz = (nM - fm) < WGM ? (nM - fm) : WGM;
        u.pm = fm + ((wgid % nig) % gsz); u.pn = (wgid % nig) / gsz; return true;
    }
    __device__ __forceinline__ void a_ready(const Unit&) const {}
    __device__ __forceinline__ void done(const Unit&) const {}
};

__device__ __forceinline__ unsigned cvt_pk_bf16(float lo, float hi) { unsigned r; asm volatile("v_cvt_pk_bf16_f32 %0, %1, %2" : "=v"(r) : "v"(lo), "v"(hi)); return r; }
template <class Epi, class Sched, bool ALIGN_EPI = false, bool SP2 = false>
__device__ __forceinline__ void gemm_phase(PG8_LAS unsigned char* lds, const Gemm g, const Sched& S, const Epi& E) {
    int tid_l = threadIdx.x; asm volatile("" : "+v"(tid_l));
    const int tid = tid_l, wid = __builtin_amdgcn_readfirstlane(tid >> 6), lane = tid & 63, wr = wid >> 2, wc = wid & 3, fr = lane & 15, fq = lane >> 4;
    const int K = g.K, nt = K / BK;
    unsigned voffA[2], voffB[2];
#pragma unroll
    for (int i = 0; i < 2; ++i) { int R, C; stage_rc(tid * 16 + i * 8192, R, C); const int Rb = Epi::PERM ? ((R & ~31) + perm32(R & 31)) : R;
        voffA[i] = (unsigned)(R * K + C) * 2u; voffB[i] = (unsigned)(Rb * K + C) * 2u; }
    const size_t kstep = (size_t)(BK * 2);
    const size_t hstep = (size_t)HALF * K * 2;
    const size_t tstep = 2 * hstep;
    const unsigned ldsw = (unsigned)wid * 1024u;
    const int aoff = lds_byte(wr * 64 + fr, fq * 8), boff = lds_byte(wc * 32 + fr, fq * 8);
#define PG8_SA(b, h) (((b) * 2 + (h)) * HTB)
#define PG8_SB(b, h) ((4 + (b) * 2 + (h)) * HTB)
#define PG8_STAGE(bufoff, gbase, voff) do { _Pragma("unroll") for (int _i = 0; _i < 2; ++_i) \
        __builtin_amdgcn_global_load_lds((const unsigned*)((const char*)(gbase) + (voff)[_i]), (PG8_LAS unsigned*)(lds + (bufoff) + ldsw + _i * 8192), 16, 0, 0); } while (0)
#define PG8_LDA(dst, b, h) do { _Pragma("unroll") for (int m = 0; m < 4; ++m) _Pragma("unroll") for (int k = 0; k < 2; ++k) dst[m][k] = *(const PG8_LAS bf16x8*)(lds + PG8_SA(b, h) + aoff + m * 2048 + k * 1024); } while (0)
#define PG8_LDB(dst, b, h) do { _Pragma("unroll") for (int n = 0; n < 2; ++n) _Pragma("unroll") for (int k = 0; k < 2; ++k) dst[n][k] = *(const PG8_LAS bf16x8*)(lds + PG8_SB(b, h) + boff + n * 2048 + k * 1024); } while (0)
#define PG8_MMA(ai, bj, At, Bt) do { __builtin_amdgcn_s_setprio(1); _Pragma("unroll") for (int m = 0; m < 4; ++m) _Pragma("unroll") for (int n = 0; n < 2; ++n) _Pragma("unroll") for (int k = 0; k < 2; ++k) \
        acc[ai][bj][m][n] = __builtin_amdgcn_mfma_f32_16x16x32_bf16(Bt[n][k], At[m][k], acc[ai][bj][m][n], 0, 0, 0); __builtin_amdgcn_s_setprio(0); } while (0)
#define PG8_WAIT_V(n) asm volatile("s_waitcnt vmcnt(" #n ")" ::: "memory")
#define PG8_WAIT_L(n) asm volatile("s_waitcnt lgkmcnt(" #n ")" ::: "memory")
#define PG8_BAR __builtin_amdgcn_s_barrier()
#define PG8_SCHED __builtin_amdgcn_sched_barrier(0)
    Unit cur, nxt; int ui = 0;
    if (!S.next(0, cur)) return;
    f32x4 acc[2][2][4][2];
#pragma unroll
    for (int a = 0; a < 2; ++a)
#pragma unroll
        for (int b = 0; b < 2; ++b)
#pragma unroll
            for (int m = 0; m < 4; ++m)
#pragma unroll
                for (int n = 0; n < 2; ++n) acc[a][b][m][n] = (f32x4){0.f, 0.f, 0.f, 0.f};
    bf16x8 At[4][2], B0[2][2], B1[2][2];
    const char* cA = (const char*)g.A + (size_t)cur.pm * tstep; const char* cB = (const char*)g.Bt + (size_t)cur.pn * tstep;
    S.a_ready(cur);
    if constexpr (SP2) {
        PG8_STAGE(PG8_SB(0, 0), cB, voffB); PG8_STAGE(PG8_SB(0, 1), cB + hstep, voffB); PG8_STAGE(PG8_SA(0, 0), cA, voffA); PG8_STAGE(PG8_SA(0, 1), cA + hstep, voffA);
        if (wr == 1) PG8_BAR;
        PG8_WAIT_V(2); PG8_BAR;
        PG8_STAGE(PG8_SB(1, 0), cB + kstep, voffB); PG8_STAGE(PG8_SA(1, 0), cA + kstep, voffA); PG8_STAGE(PG8_SB(1, 1), cB + hstep + kstep, voffB);
        PG8_WAIT_V(6); PG8_BAR;
    } else {
        PG8_STAGE(PG8_SB(0, 0), cB, voffB); PG8_STAGE(PG8_SA(0, 0), cA, voffA); PG8_STAGE(PG8_SB(0, 1), cB + hstep, voffB); PG8_STAGE(PG8_SA(0, 1), cA + hstep, voffA);
        if (wr == 1) PG8_BAR;
        PG8_WAIT_V(4); PG8_BAR;
        PG8_STAGE(PG8_SB(1, 0), cB + kstep, voffB); PG8_STAGE(PG8_SA(1, 0), cA + kstep, voffA); PG8_STAGE(PG8_SB(1, 1), cB + hstep + kstep, voffB);
        PG8_WAIT_V(6); PG8_BAR;
    }
    for (;;) {
        const bool has_next = S.next(ui + 1, nxt);
        const char* nA = has_next ? (const char*)g.A + (size_t)nxt.pm * tstep : cA; const char* nB = has_next ? (const char*)g.Bt + (size_t)nxt.pn * tstep : cB;
        for (int t = 0; t < nt; t += 2) {
            const bool last = (t == nt - 2);
            const char* a1 = cA + (size_t)(t + 1) * kstep;
            const char* a2 = last ? nA : cA + (size_t)(t + 2) * kstep; const char* b2 = last ? nB : cB + (size_t)(t + 2) * kstep;
            const char* a3 = a2 + kstep; const char* b3 = b2 + kstep;
            if (last && has_next) S.a_ready(nxt);
            if constexpr (SP2) {
            PG8_LDB(B0, 0, 0); PG8_LDB(B1, 0, 1); PG8_SCHED; PG8_LDA(At, 0, 0); PG8_STAGE(PG8_SA(1, 1), a1 + hstep, voffA);
            PG8_WAIT_V(8); PG8_WAIT_L(0); PG8_BAR; PG8_MMA(0, 0, At, B0); PG8_MMA(0, 1, At, B1); PG8_BAR; PG8_SCHED;
            PG8_LDA(At, 0, 1); PG8_STAGE(PG8_SB(0, 0), b2, voffB); PG8_STAGE(PG8_SB(0, 1), b2 + hstep, voffB); PG8_STAGE(PG8_SA(0, 0), a2, voffA);
            PG8_WAIT_V(8); PG8_WAIT_L(0); PG8_BAR; PG8_MMA(1, 0, At, B0); PG8_MMA(1, 1, At, B1); PG8_BAR; PG8_SCHED;
            PG8_LDB(B0, 1, 0); PG8_LDB(B1, 1, 1); PG8_SCHED; PG8_LDA(At, 1, 0); PG8_STAGE(PG8_SA(0, 1), a2 + hstep, voffA);
            PG8_WAIT_V(8); PG8_WAIT_L(0); PG8_BAR; PG8_MMA(0, 0, At, B0); PG8_MMA(0, 1, At, B1); PG8_BAR; PG8_SCHED;
            PG8_LDA(At, 1, 1); PG8_STAGE(PG8_SB(1, 0), b3, voffB); PG8_STAGE(PG8_SB(1, 1), b3 + hstep, voffB); PG8_STAGE(PG8_SA(1, 0), a3, voffA);
            PG8_WAIT_V(8); PG8_WAIT_L(0); PG8_BAR; PG8_MMA(1, 0, At, B0); PG8_MMA(1, 1, At, B1); PG8_BAR; PG8_SCHED;
            } else {
            PG8_LDB(B0, 0, 0); PG8_SCHED; PG8_LDA(At, 0, 0); PG8_STAGE(PG8_SA(1, 1), a1 + hstep, voffA);
            PG8_WAIT_L(8); PG8_BAR; PG8_WAIT_L(0); PG8_MMA(0, 0, At, B0); PG8_BAR; PG8_SCHED;
            PG8_LDB(B1, 0, 1); PG8_STAGE(PG8_SB(0, 0), b2, voffB);
            PG8_BAR; PG8_WAIT_L(0); PG8_MMA(0, 1, At, B1); PG8_BAR;
            PG8_LDA(At, 0, 1); PG8_STAGE(PG8_SA(0, 0), a2, voffA);
            PG8_BAR; PG8_WAIT_L(0); PG8_MMA(1, 0, At, B0); PG8_BAR; PG8_SCHED;
            PG8_STAGE(PG8_SB(0, 1), b2 + hstep, voffB);
            PG8_WAIT_V(6); PG8_BAR; PG8_MMA(1, 1, At, B1); PG8_BAR;
            PG8_LDB(B0, 1, 0); PG8_SCHED; PG8_LDA(At, 1, 0); PG8_STAGE(PG8_SA(0, 1), a2 + hstep, voffA);
            PG8_WAIT_L(8); PG8_BAR; PG8_WAIT_L(0); PG8_MMA(0, 0, At, B0); PG8_BAR; PG8_SCHED;
            PG8_LDB(B1, 1, 1); PG8_STAGE(PG8_SB(1, 0), b3, voffB);
            PG8_BAR; PG8_WAIT_L(0); PG8_MMA(0, 1, At, B1); PG8_BAR;
            PG8_LDA(At, 1, 1); PG8_STAGE(PG8_SA(1, 0), a3, voffA);
            PG8_BAR; PG8_WAIT_L(0); PG8_MMA(1, 0, At, B0); PG8_BAR; PG8_SCHED;
            PG8_STAGE(PG8_SB(1, 1), b3 + hstep, voffB);
            PG8_WAIT_V(6); PG8_BAR; PG8_MMA(1, 1, At, B1); PG8_BAR;
            }
        }
        if constexpr (ALIGN_EPI) { if (wr == 0) PG8_BAR; }
        if constexpr (!Epi::AFTER_DRAIN) { E(acc, cur, wr, wc, fr, fq); S.done(cur); }
        if (!has_next) break;
#pragma unroll
        for (int a = 0; a < 2; ++a)
#pragma unroll
            for (int b = 0; b < 2; ++b)
#pragma unroll
                for (int m = 0; m < 4; ++m)
#pragma unroll
                    for (int n = 0; n < 2; ++n) acc[a][b][m][n] = (f32x4){0.f, 0.f, 0.f, 0.f};
        cur = nxt; cA = nA; cB = nB; ++ui;
        if constexpr (ALIGN_EPI) { if (wr == 1) PG8_BAR; }
    }
    PG8_WAIT_V(0);
    if constexpr (!ALIGN_EPI) { if (wr == 0) PG8_BAR; }
    PG8_BAR;
    if constexpr (Epi::AFTER_DRAIN) { E.fused(acc, cur, wr, wc, fr, fq, lds, wid, lane); S.done(cur); }
#undef PG8_SA
#undef PG8_SB
#undef PG8_STAGE
#undef PG8_LDA
#undef PG8_LDB
#undef PG8_MMA
#undef PG8_WAIT_V
#undef PG8_WAIT_L
#undef PG8_BAR
#undef PG8_SCHED
}
}

typedef unsigned short bf16_t;
typedef unsigned u32x4 __attribute__((ext_vector_type(4)));
typedef unsigned u32x2 __attribute__((ext_vector_type(2)));
typedef float f32x4 __attribute__((ext_vector_type(4)));
#define LAS __attribute__((address_space(3)))

constexpr int NB = 8, SEQ = 4096, M = NB * SEQ, DM = 1024, NP = 3072, FF = 2816, NGU = 2 * FF, INC = 2956;
constexpr int C_QA = 0, C_KCA = 256, C_VCA = 320, C_KSA = 384, C_VSA = 448, C_KWA = 512, C_VWA = 576, C_CVB = 640, C_CVC = 896, C_CVU = 1152,
              C_QC = 1408, C_KC = 1664, C_VC = 1920, C_QD = 2176, C_KD = 2432, C_VD = 2688, C_GT = 2944;
constexpr float EPS = 1e-6f;
constexpr size_t MiB = 1u << 20;
constexpr size_t WS_SS = 0, WS_KCN = 1 * MiB, WS_VCC = 1 * MiB + 512 * 1024, WS_W = 2 * MiB;
constexpr size_t W_IN = 0, W_OUT = 6 * MiB, W_GU = 8 * MiB, W_DN = 19 * MiB, W_LAYER = 24 * MiB + 512 * 1024;
constexpr size_t WS_XB = 52 * MiB, WS_GR = 116 * MiB, WS_PROJ = 180 * MiB, WS_X1 = 372 * MiB, WS_W1T = 500 * MiB, WS_W2T = 504 * MiB, WS_CB = 504 * MiB + 256 * 1024, WS_BAR = 504 * MiB + 512 * 1024, WS_END = 505 * MiB;
constexpr size_t DO_PO = 0, DO_LSE = 48 * MiB;
constexpr int LDS_BYTES = 143360;

struct Params { const float* in[23]; float* out; unsigned char* ws; };

__device__ __forceinline__ float blo(unsigned u) { return __uint_as_float(u << 16); }
__device__ __forceinline__ float bhi(unsigned u) { return __uint_as_float(u & 0xffff0000u); }
__device__ __forceinline__ float bf2f(bf16_t h) { return __uint_as_float((unsigned)h << 16); }
__device__ __forceinline__ unsigned pk2(float lo, float hi) { return pg8::cvt_pk_bf16(lo, hi); }
template <int K> __device__ __forceinline__ unsigned swz_u(unsigned v) { return (unsigned)__builtin_amdgcn_ds_swizzle((int)v, (K << 10) | 0x1f); }
template <int K> __device__ __forceinline__ float swz_f(float v) { return __uint_as_float(swz_u<K>(__float_as_uint(v))); }
__device__ __forceinline__ float sum32(float v) { auto rr = __builtin_amdgcn_permlane32_swap(__float_as_uint(v), __float_as_uint(v), false, false); return __uint_as_float(rr[0]) + __uint_as_float(rr[1]); }
__device__ __forceinline__ float max32(float v) { auto rr = __builtin_amdgcn_permlane32_swap(__float_as_uint(v), __float_as_uint(v), false, false); return fmaxf(__uint_as_float(rr[0]), __uint_as_float(rr[1])); }
__device__ __forceinline__ unsigned or32(unsigned v) { auto rr = __builtin_amdgcn_permlane32_swap(v, v, false, false); return rr[0] | rr[1]; }
__device__ __forceinline__ float partner32(float v, int hh) { auto rr = __builtin_amdgcn_permlane32_swap(__float_as_uint(v), __float_as_uint(v), false, false); return __uint_as_float(hh ? rr[0] : rr[1]); }
__device__ __forceinline__ float wave_sum(float v) {
    v += swz_f<1>(v); v += swz_f<2>(v); v += swz_f<4>(v); v += swz_f<8>(v); v += swz_f<16>(v); return sum32(v);
}
#define LDS_WAIT() asm volatile("s_waitcnt lgkmcnt(0)" ::: "memory")
#define CFENCE() asm volatile("" ::: "memory")

struct EpiProj {
    static constexpr bool PERM = true, AFTER_DRAIN = false;
    bf16_t* O; const float* ss;
    __device__ __forceinline__ void operator()(const pg8::f32x4 (&acc)[2][2][4][2], const pg8::Unit& u, int wr, int wc, int fr, int fq) const {
        const int row0 = u.pm * 256 + wr * 64 + fr, col0 = u.pn * 256 + wc * 32 + 8 * fq;
#pragma unroll
        for (int ai = 0; ai < 2; ++ai)
#pragma unroll
            for (int m = 0; m < 4; ++m) {
                const int row = row0 + ai * 128 + m * 16; const float rs = rsqrtf(ss[row] * (1.f / DM) + EPS);
                bf16_t* rowp = O + (size_t)row * NP + col0;
#pragma unroll
                for (int bj = 0; bj < 2; ++bj) { const pg8::f32x4 v0 = acc[ai][bj][m][0] * rs, v1 = acc[ai][bj][m][1] * rs;
                    u32x4 w; w.x = pk2(v0[0], v0[1]); w.y = pk2(v0[2], v0[3]); w.z = pk2(v1[0], v1[1]); w.w = pk2(v1[2], v1[3]);
                    *(u32x4*)(rowp + bj * 128) = w; }
            }
    }
};
struct EpiSwiGLU {
    static constexpr bool PERM = true, AFTER_DRAIN = false;
    bf16_t* H; const float* ss;
    __device__ __forceinline__ void operator()(const pg8::f32x4 (&acc)[2][2][4][2], const pg8::Unit& u, int wr, int wc, int fr, int fq) const {
        const int row0 = u.pm * 256 + wr * 64 + fr, col0 = u.pn * 128 + wc * 32 + 8 * fq;
#pragma unroll
        for (int ai = 0; ai < 2; ++ai)
#pragma unroll
            for (int m = 0; m < 4; ++m) {
                const int row = row0 + ai * 128 + m * 16; const float rs = rsqrtf(ss[row] * (1.f / DM) + EPS), rs2 = rs * rs, nrs = rs * -1.4426950408889634f;
                float hv[8];
#pragma unroll
                for (int n = 0; n < 2; ++n)
#pragma unroll
                    for (int j = 0; j < 4; ++j) { const float ga = acc[ai][0][m][n][j], ua = acc[ai][1][m][n][j];
                        hv[4 * n + j] = (ga * ua) * (rs2 * __builtin_amdgcn_rcpf(1.f + __builtin_amdgcn_exp2f(ga * nrs))); }
                u32x4 w; w.x = pk2(hv[0], hv[1]); w.y = pk2(hv[2], hv[3]); w.z = pk2(hv[4], hv[5]); w.w = pk2(hv[6], hv[7]);
                *(u32x4*)(H + (size_t)row * FF + col0) = w;
            }
    }
};
struct EpiResid {
    static constexpr bool PERM = true, AFTER_DRAIN = false;
    const float* xin; const bf16_t* xin_b; float* xout; bf16_t* xb; float* ss;
    __device__ __forceinline__ void operator()(const pg8::f32x4 (&acc)[2][2][4][2], const pg8::Unit& u, int wr, int wc, int fr, int fq) const {
        const int row0 = u.pm * 256 + wr * 64 + fr, col0 = u.pn * 256 + wc * 32 + 8 * fq;
#pragma unroll
        for (int ai = 0; ai < 2; ++ai)
#pragma unroll
            for (int m = 0; m < 4; ++m) {
                const int row = row0 + ai * 128 + m * 16; const size_t off = (size_t)row * DM + col0; float sq = 0.f;
#pragma unroll
                for (int bj = 0; bj < 2; ++bj) { const size_t o = off + bj * 128; f32x4 xa, xc;
                    if (xin) { xa = *(const f32x4*)(xin + o); xc = *(const f32x4*)(xin + o + 4); }
                    else { const u32x4 r4 = *(const u32x4*)(xin_b + o); xa[0] = blo(r4.x); xa[1] = bhi(r4.x); xa[2] = blo(r4.y); xa[3] = bhi(r4.y); xc[0] = blo(r4.z); xc[1] = bhi(r4.z); xc[2] = blo(r4.w); xc[3] = bhi(r4.w); }
                    f32x4 va, vc;
                    va[0] = xa[0] + acc[ai][bj][m][0][0]; va[1] = xa[1] + acc[ai][bj][m][0][1]; va[2] = xa[2] + acc[ai][bj][m][0][2]; va[3] = xa[3] + acc[ai][bj][m][0][3];
                    vc[0] = xc[0] + acc[ai][bj][m][1][0]; vc[1] = xc[1] + acc[ai][bj][m][1][1]; vc[2] = xc[2] + acc[ai][bj][m][1][2]; vc[3] = xc[3] + acc[ai][bj][m][1][3];
                    if (xout) { *(f32x4*)(xout + o) = va; *(f32x4*)(xout + o + 4) = vc; }
                    if (xb) { u32x4 w; w.x = pk2(va[0], va[1]); w.y = pk2(va[2], va[3]); w.z = pk2(vc[0], vc[1]); w.w = pk2(vc[2], vc[3]); *(u32x4*)(xb + o) = w; }
                    sq += ((va[0] * va[0] + va[1] * va[1]) + (va[2] * va[2] + va[3] * va[3])) + ((vc[0] * vc[0] + vc[1] * vc[1]) + (vc[2] * vc[2] + vc[3] * vc[3])); }
                if (ss) { sq += swz_f<16>(sq); sq = sum32(sq); if (fq == 0) atomicAdd(ss + row, sq); }
            }
    }
};

#ifndef REP_PW
#define REP_PW 1
#endif
#ifndef REP_PC
#define REP_PC 1
#endif
#ifndef REP_PX
#define REP_PX 1
#endif
template <int MAP> __device__ __forceinline__ int dst_row(int c) {
    if (MAP == 0) return c < 640 ? c : (c < 652 ? 2944 + (c - 640) : c - 12);
    if (MAP == 1) return c;
    if (MAP == 2) return 256 * (c >> 7) + (c & 127);
    return 256 * (c >> 7) + 128 + (c & 127);
}
template <int MAP> __device__ __forceinline__ void transpose_item(const float* W, int K, int N, const float* gk, bf16_t* WT, LAS float* scr, int item, int lane) {
    const int nblk = (N + 63) / 64, kb = item / nblk, nb = item % nblk, k0 = 64 * kb, n0 = 64 * nb;
    const int nn = n0 + lane; const bool okn = nn < N;
#pragma unroll
    for (int i = 0; i < 64; ++i) { float v = okn ? W[(size_t)(k0 + i) * N + nn] : 0.f; if (gk) v *= gk[k0 + i]; scr[i * 65 + lane] = v; }
    LDS_WAIT();
    const int c = lane & 7;
#pragma unroll
    for (int j = 0; j < 8; ++j) { const int n = (lane >> 3) + 8 * j; const LAS float* s = scr + (8 * c) * 65 + n;
        if (n0 + n < N) { u32x4 o; o.x = pk2(s[0 * 65], s[1 * 65]); o.y = pk2(s[2 * 65], s[3 * 65]); o.z = pk2(s[4 * 65], s[5 * 65]); o.w = pk2(s[6 * 65], s[7 * 65]);
            if (MAP == 4) { const int nn2 = n0 + n, kk2 = k0 + 8 * c; *(u32x4*)(WT + ((size_t)(((nn2 >> 5) * (K >> 4) + (kk2 >> 4)) * 64 + ((kk2 >> 3) & 1) * 32 + (nn2 & 31)) * 8)) = o; }
            else *(u32x4*)(WT + (size_t)dst_row<MAP>(n0 + n) * K + k0 + 8 * c) = o; } }
    LDS_WAIT();
}
__device__ __forceinline__ void prologue(const Params& p, LAS unsigned char* lds, int gw, int NGW, int wave, int lane) {
    LAS float* scr = (LAS float*)(lds + wave * 16640);
    constexpr int I_IN = 16 * 47, I_OUT = 16 * 16, I_G = 16 * 44, I_DN = 44 * 16, I_L = I_IN + I_OUT + 2 * I_G + I_DN, I_Z = 116;
    for (int rw_ = 0; rw_ < REP_PW; ++rw_)
    for (int it = gw; it < 2 * (I_L + I_Z); it += NGW) {
        const int l = it / (I_L + I_Z); int r = it % (I_L + I_Z);
        unsigned char* wl = p.ws + WS_W + (size_t)l * W_LAYER;
        if (r < I_IN) { transpose_item<0>(p.in[2] + (size_t)l * DM * INC, DM, INC, p.in[1] + l * DM, (bf16_t*)(wl + W_IN), scr, r, lane); continue; } r -= I_IN;
        if (r < I_OUT) { transpose_item<1>(p.in[18] + (size_t)l * DM * DM, DM, DM, nullptr, (bf16_t*)(wl + W_OUT), scr, r, lane); continue; } r -= I_OUT;
        if (r < I_G) { transpose_item<2>(p.in[20] + (size_t)l * DM * FF, DM, FF, p.in[19] + l * DM, (bf16_t*)(wl + W_GU), scr, r, lane); continue; } r -= I_G;
        if (r < I_G) { transpose_item<3>(p.in[21] + (size_t)l * DM * FF, DM, FF, p.in[19] + l * DM, (bf16_t*)(wl + W_GU), scr, r, lane); continue; } r -= I_G;
        if (r < I_DN) { transpose_item<1>(p.in[22] + (size_t)l * FF * DM, FF, DM, nullptr, (bf16_t*)(wl + W_DN), scr, r, lane); continue; } r -= I_DN;
        { u32x4 z = {0u, 0u, 0u, 0u}; u32x4* d = (u32x4*)((bf16_t*)(wl + W_IN) + (size_t)(INC + r) * DM) + lane * 2; d[0] = z; d[1] = z; }
    }
    for (int rc_ = 0; rc_ < REP_PC; ++rc_)
    for (int it = gw; it < 4 * (128 + 4 + 32); it += NGW) {
        const int mi = it / 164, r = it % 164, l = mi >> 1, kv = mi & 1;
        const float* w1 = p.in[kv ? 12 : 10] + (size_t)l * 2048 * 256; const float* w2 = p.in[kv ? 13 : 11] + (size_t)l * 256 * 64; const float* pe = p.in[kv ? 9 : 8] + l * 2048;
        if (r < 128) transpose_item<4>(w1, 2048, 256, nullptr, (bf16_t*)(p.ws + WS_W1T) + (size_t)mi * 256 * 2048, scr, r, lane);
        else if (r < 132) transpose_item<1>(w2, 256, 64, nullptr, (bf16_t*)(p.ws + WS_W2T) + (size_t)mi * 64 * 256, scr, r - 128, lane);
        else { const int c = (r - 132) * 8 + (lane & 7), rg = lane >> 3; float acc = 0.f;
#pragma unroll 32
            for (int i = rg * 256; i < rg * 256 + 256; ++i) acc += pe[i] * w1[(size_t)i * 256 + c];
            acc += swz_f<8>(acc); acc += swz_f<16>(acc); acc = sum32(acc);
            if (rg == 0) ((float*)(p.ws + WS_CB))[mi * 256 + c] = acc; }
    }
    float* ss = (float*)(p.ws + WS_SS); bf16_t* xb = (bf16_t*)(p.ws + WS_XB);
    for (int rx_ = 0; rx_ < REP_PX; ++rx_)
    for (int m0 = gw; m0 < M; m0 += 4 * NGW) {
        f32x4 v[4][4];
#pragma unroll
        for (int rr = 0; rr < 4; ++rr) { const int m = m0 + rr * NGW; const f32x4* xr = (const f32x4*)(p.in[0] + (size_t)(m < M ? m : 0) * DM) + lane;
#pragma unroll
            for (int j = 0; j < 4; ++j) v[rr][j] = xr[64 * j]; }
#pragma unroll
        for (int rr = 0; rr < 4; ++rr) { const int m = m0 + rr * NGW; if (m < M) { u32x2* o8 = (u32x2*)(xb + (size_t)m * DM) + lane; float s = 0.f;
#pragma unroll
            for (int j = 0; j < 4; ++j) { const f32x4 t = v[rr][j]; s += (t[0] * t[0] + t[1] * t[1]) + (t[2] * t[2] + t[3] * t[3]); u32x2 w; w.x = pk2(t[0], t[1]); w.y = pk2(t[2], t[3]); o8[64 * j] = w; }
            s = wave_sum(s);
            if (lane == 0) { ss[m] = s; ss[M + m] = 0.f; ss[2 * M + m] = 0.f; ss[3 * M + m] = 0.f; } } }
    }
}

#define UNPACK8(v, k) const float k##0 = blo(v.x), k##1 = bhi(v.x), k##2 = blo(v.y), k##3 = bhi(v.y), k##4 = blo(v.z), k##5 = bhi(v.z), k##6 = blo(v.w), k##7 = bhi(v.w)
__device__ __forceinline__ void load_row64(float (&q)[64], const bf16_t* p) {
#pragma unroll
    for (int c = 0; c < 8; ++c) { const u32x4 v = *(const u32x4*)(p + 8 * c); UNPACK8(v, k);
        q[8 * c] = k0; q[8 * c + 1] = k1; q[8 * c + 2] = k2; q[8 * c + 3] = k3; q[8 * c + 4] = k4; q[8 * c + 5] = k5; q[8 * c + 6] = k6; q[8 * c + 7] = k7; }
}
template <bool SS> __device__ __forceinline__ float dot_row(const float (&q)[64], const bf16_t* p, float& kss) {
    float z = 0.f, s = 0.f;
#pragma unroll
    for (int c = 0; c < 8; ++c) { const u32x4 v = *(const u32x4*)(p + 8 * c); UNPACK8(v, k);
        z += (q[8 * c] * k0 + q[8 * c + 1] * k1) + (q[8 * c + 2] * k2 + q[8 * c + 3] * k3) + (q[8 * c + 4] * k4 + q[8 * c + 5] * k5) + (q[8 * c + 6] * k6 + q[8 * c + 7] * k7);
        if (SS) s += (k0 * k0 + k1 * k1) + (k2 * k2 + k3 * k3) + (k4 * k4 + k5 * k5) + (k6 * k6 + k7 * k7);
        if (c == 3) CFENCE(); }
    kss = s; return z;
}
__device__ __forceinline__ void axpy_row(float (&o)[64], float w, const bf16_t* p) {
#pragma unroll
    for (int c = 0; c < 8; ++c) { const u32x4 v = *(const u32x4*)(p + 8 * c); UNPACK8(v, k);
        o[8 * c] += w * k0; o[8 * c + 1] += w * k1; o[8 * c + 2] += w * k2; o[8 * c + 3] += w * k3; o[8 * c + 4] += w * k4; o[8 * c + 5] += w * k5; o[8 * c + 6] += w * k6; o[8 * c + 7] += w * k7;
        if (c == 3) CFENCE(); }
}
__device__ __forceinline__ float dot_row_f32(const float (&q)[64], const float* p) {
    float z = 0.f;
#pragma unroll
    for (int c = 0; c < 16; ++c) { const f32x4 v = *(const f32x4*)(p + 4 * c); z += (q[4 * c] * v[0] + q[4 * c + 1] * v[1]) + (q[4 * c + 2] * v[2] + q[4 * c + 3] * v[3]); if (c == 7) CFENCE(); }
    return z;
}
__device__ __forceinline__ void axpy_row_f32(float (&o)[64], float w, const float* p) {
#pragma unroll
    for (int c = 0; c < 16; ++c) { const f32x4 v = *(const f32x4*)(p + 4 * c); o[4 * c] += w * v[0]; o[4 * c + 1] += w * v[1]; o[4 * c + 2] += w * v[2]; o[4 * c + 3] += w * v[3]; if (c == 7) CFENCE(); }
}
__device__ __forceinline__ void store_group(const float (&o)[64], const float* g, bf16_t* dst) {
    float ss = 0.f;
#pragma unroll
    for (int d = 0; d < 64; ++d) ss += o[d] * o[d];
    const float rs = rsqrtf(ss * (1.f / 64.f) + EPS);
#pragma unroll
    for (int c = 0; c < 8; ++c) { u32x4 w;
        w.x = pk2(o[8 * c] * rs * g[8 * c], o[8 * c + 1] * rs * g[8 * c + 1]); w.y = pk2(o[8 * c + 2] * rs * g[8 * c + 2], o[8 * c + 3] * rs * g[8 * c + 3]);
        w.z = pk2(o[8 * c + 4] * rs * g[8 * c + 4], o[8 * c + 5] * rs * g[8 * c + 5]); w.w = pk2(o[8 * c + 6] * rs * g[8 * c + 6], o[8 * c + 7] * rs * g[8 * c + 7]);
        *(u32x4*)(dst + 8 * c) = w; }
}
__device__ __forceinline__ void load_q_norm(float (&q)[64], const bf16_t* p, const float* gq, const float* gx) {
    load_row64(q, p); float ss = 0.f;
#pragma unroll
    for (int d = 0; d < 64; ++d) ss += q[d] * q[d];
    const float rs = rsqrtf(ss * (1.f / 64.f) + EPS) * 0.125f;
#pragma unroll
    for (int d = 0; d < 64; ++d) q[d] = q[d] * rs * gq[d] * (gx ? gx[d] : 1.f);
}

__device__ __forceinline__ void stick_naive(const bf16_t* proj, bf16_t* groups, const float* g_out, int item, int lane) {
    const int tile = item & 63, h = (item >> 6) & 3, b = item >> 8, t = tile * 64 + lane;
    const bf16_t* base = proj + (size_t)b * SEQ * NP;
    float q[64]; load_row64(q, base + (size_t)t * NP + C_QC + h * 64);
#pragma unroll
    for (int d = 0; d < 64; ++d) q[d] *= 0.125f;
    float o[64];
#pragma unroll
    for (int d = 0; d < 64; ++d) o[d] = 0.f;
    float between = 0.f;
    for (int s = tile * 64 + 62; s >= 0; --s) {
        const bf16_t* kr = base + (size_t)s * NP + C_KC + h * 64; float dummy;
        const float z = dot_row<false>(q, kr, dummy); CFENCE();
        const bool act = s < t;
        const float sp = fmaxf(z, 0.f) + __logf(1.f + __expf(-fabsf(z)));
        const float w = act ? __expf((z - sp) - between) : 0.f;
        axpy_row(o, w, base + (size_t)s * NP + C_VC + h * 64); CFENCE();
        between += act ? sp : 0.f;
        if (s < tile * 64 && __all(between > 104.f)) break;
    }
    store_group(o, g_out + 512 + h * 64, groups + (size_t)(b * SEQ + t) * DM + 512 + h * 64);
}

__device__ __forceinline__ void dil_naive(const bf16_t* proj, bf16_t* groups, const float* gq, const float* gk, const float* g_out, int item, int lane) {
    const int tile = item & 63, h = (item >> 6) & 3, b = item >> 8, t = tile * 64 + lane;
    const bf16_t* base = proj + (size_t)b * SEQ * NP;
    float q[64]; load_q_norm(q, base + (size_t)t * NP + C_QD + h * 64, gq, gk);
    const float slope = exp2f(-(float)(2 * h + 2));
    float o[64];
#pragma unroll
    for (int d = 0; d < 64; ++d) o[d] = 0.f;
    float mx = -1e30f, l = 0.f;
    for (int cfg = 0; cfg < 3; ++cfg) {
        const int dil = cfg == 0 ? 1 : (cfg == 1 ? 4 : 16);
        for (int j = 0; j <= 128; ++j) {
            const int s = t - j * dil; const bool act = s >= 0;
            if (!__any(act)) break;
            if (act) {
                float kss; const float z = dot_row<true>(q, base + (size_t)s * NP + C_KD + h * 64, kss); CFENCE();
                const float sc = z * rsqrtf(kss * (1.f / 64.f) + EPS) - slope * (float)(j * dil);
                if (sc > mx) { const float corr = __expf(mx - sc); l *= corr;
#pragma unroll
                    for (int d = 0; d < 64; ++d) o[d] *= corr;
                    mx = sc; }
                const float pw = __expf(sc - mx); l += pw;
                axpy_row(o, pw, base + (size_t)s * NP + C_VD + h * 64); CFENCE();
            }
        }
    }
    const float inv = 1.f / l;
#pragma unroll
    for (int d = 0; d < 64; ++d) o[d] *= inv;
    store_group(o, g_out + 768 + h * 64, groups + (size_t)(b * SEQ + t) * DM + 768 + h * 64);
}

template <int NI> __device__ __forceinline__ void conv_items(const bf16_t* proj, bf16_t* groups, const float* cw, const float* g_out, int item0, int stride, int lane) {
    const int ch = (lane & 31) * 8;
    u32x4 cv[NI][3], uv[NI][3], bv[NI];
#pragma unroll
    for (int n = 0; n < NI; ++n) { const int token = (item0 + n * stride) * 2 + (lane >> 5), tpos = token & (SEQ - 1); const bf16_t* row = proj + (size_t)token * NP;
#pragma unroll
        for (int k = 0; k < 3; ++k) { const int back = 2 - k;
            if (tpos >= back) { cv[n][k] = *(const u32x4*)(row - (size_t)back * NP + C_CVC + ch); uv[n][k] = *(const u32x4*)(row - (size_t)back * NP + C_CVU + ch); }
            else { cv[n][k] = (u32x4){0u, 0u, 0u, 0u}; uv[n][k] = cv[n][k]; } }
        bv[n] = *(const u32x4*)(row + C_CVB + ch); }
    float wk[3][8];
#pragma unroll
    for (int k = 0; k < 3; ++k)
#pragma unroll
        for (int i = 0; i < 8; ++i) wk[k][i] = cw[k * 256 + ch + i];
    const float* go = g_out + 256 + ch;
#pragma unroll
    for (int n = 0; n < NI; ++n) { const int token = (item0 + n * stride) * 2 + (lane >> 5);
        float acc[8];
#pragma unroll
        for (int i = 0; i < 8; ++i) acc[i] = 0.f;
#pragma unroll
        for (int k = 0; k < 3; ++k) { UNPACK8(cv[n][k], c); UNPACK8(uv[n][k], u);
            acc[0] += wk[k][0] * (c0 * u0); acc[1] += wk[k][1] * (c1 * u1); acc[2] += wk[k][2] * (c2 * u2); acc[3] += wk[k][3] * (c3 * u3);
            acc[4] += wk[k][4] * (c4 * u4); acc[5] += wk[k][5] * (c5 * u5); acc[6] += wk[k][6] * (c6 * u6); acc[7] += wk[k][7] * (c7 * u7); }
        UNPACK8(bv[n], g);
        float y[8] = {g0 * acc[0], g1 * acc[1], g2 * acc[2], g3 * acc[3], g4 * acc[4], g5 * acc[5], g6 * acc[6], g7 * acc[7]};
        float ss = 0.f;
#pragma unroll
        for (int i = 0; i < 8; ++i) ss += y[i] * y[i];
        ss += swz_f<1>(ss); ss += swz_f<2>(ss); ss += swz_f<4>(ss);
        const float rs = rsqrtf(ss * (1.f / 64.f) + EPS);
        u32x4 w; w.x = pk2(y[0] * rs * go[0], y[1] * rs * go[1]); w.y = pk2(y[2] * rs * go[2], y[3] * rs * go[3]);
        w.z = pk2(y[4] * rs * go[4], y[5] * rs * go[5]); w.w = pk2(y[6] * rs * go[6], y[7] * rs * go[7]);
        *(u32x4*)(groups + (size_t)token * DM + 256 + ch) = w; }
}

typedef short bf16x8 __attribute__((ext_vector_type(8)));
typedef short s16x4 __attribute__((ext_vector_type(4)));
typedef float f32x16 __attribute__((ext_vector_type(16)));
typedef float f32x2_t __attribute__((ext_vector_type(2)));
typedef __bf16 bf16x2_t __attribute__((ext_vector_type(2)));
__device__ __forceinline__ unsigned cvtpk(float lo, float hi) { f32x2_t v = {lo, hi}; bf16x2_t b = __builtin_convertvector(v, bf16x2_t); return __builtin_bit_cast(unsigned, b); }
#define MFMA32(a, b, c) __builtin_amdgcn_mfma_f32_32x32x16_bf16((a), (b), (c), 0, 0, 0)
#define EXP2(x) __builtin_amdgcn_exp2f(x)
constexpr float LOG2E = 1.4426950408889634f;
constexpr int KSB = 144, VTB = 136, KS_BYTES = 64 * KSB, VT_BYTES = 64 * VTB;
__device__ __forceinline__ int crow(int i, int h) { return (i & 3) + 8 * (i >> 2) + 4 * h; }

struct KVSrc { const bf16_t* k; const bf16_t* v; long pitch; int first, lo, hi; };
__device__ __forceinline__ void kv_fetch(const KVSrc& s, int tid, u32x4& kc, u32x4& vc) {
    const int kl = tid >> 3, ch = tid & 7, i = s.first + kl;
    if (i >= s.lo && i < s.hi) { kc = *(const u32x4*)(s.k + (long)i * s.pitch + 8 * ch); vc = *(const u32x4*)(s.v + (long)i * s.pitch + 8 * ch); }
    else { kc = (u32x4){0u, 0u, 0u, 0u}; vc = kc; }
}
template <bool NORM> __device__ __forceinline__ void kv_store(u32x4 kc, u32x4 vc, const float (&g)[8], LAS unsigned char* ksb, LAS unsigned char* vtb, int tid) {
    const int kl = tid >> 3, ch = tid & 7;
    if (NORM) { UNPACK8(kc, k); float ss = (k0 * k0 + k1 * k1) + (k2 * k2 + k3 * k3) + (k4 * k4 + k5 * k5) + (k6 * k6 + k7 * k7);
        ss += swz_f<1>(ss); ss += swz_f<2>(ss); ss += swz_f<4>(ss);
        const float rs = rsqrtf(ss * (1.f / 64.f) + EPS);
        kc.x = cvtpk(k0 * rs * g[0], k1 * rs * g[1]); kc.y = cvtpk(k2 * rs * g[2], k3 * rs * g[3]); kc.z = cvtpk(k4 * rs * g[4], k5 * rs * g[5]); kc.w = cvtpk(k6 * rs * g[6], k7 * rs * g[7]); }
    *(LAS u32x4*)(ksb + kl * KSB + ch * 16) = kc;
    LAS unsigned short* vp = (LAS unsigned short*)(vtb + (8 * ch) * VTB + kl * 2);
    vp[0 * (VTB / 2)] = (unsigned short)(vc.x & 0xffffu); vp[1 * (VTB / 2)] = (unsigned short)(vc.x >> 16);
    vp[2 * (VTB / 2)] = (unsigned short)(vc.y & 0xffffu); vp[3 * (VTB / 2)] = (unsigned short)(vc.y >> 16);
    vp[4 * (VTB / 2)] = (unsigned short)(vc.z & 0xffffu); vp[5 * (VTB / 2)] = (unsigned short)(vc.z >> 16);
    vp[6 * (VTB / 2)] = (unsigned short)(vc.w & 0xffffu); vp[7 * (VTB / 2)] = (unsigned short)(vc.w >> 16);
}
template <bool NORM> __device__ __forceinline__ void load_qfrag(bf16x8 (&qf)[4], const bf16_t* qrow, const float* g1, const float* g2, float sc, int hh) {
    float f[32];
#pragma unroll
    for (int s = 0; s < 4; ++s) { const u32x4 v = *(const u32x4*)(qrow + 16 * s + 8 * hh); UNPACK8(v, k);
        f[8 * s] = k0; f[8 * s + 1] = k1; f[8 * s + 2] = k2; f[8 * s + 3] = k3; f[8 * s + 4] = k4; f[8 * s + 5] = k5; f[8 * s + 6] = k6; f[8 * s + 7] = k7; }
    if (NORM) { float ss = 0.f;
#pragma unroll
        for (int i = 0; i < 32; ++i) ss += f[i] * f[i];
        ss = sum32(ss); sc *= rsqrtf(ss * (1.f / 64.f) + EPS); }
#pragma unroll
    for (int s = 0; s < 4; ++s) { float v[8];
#pragma unroll
        for (int j = 0; j < 8; ++j) { const int d = 16 * s + 8 * hh + j; v[j] = f[8 * s + j] * sc * (g1 ? g1[d] : 1.f) * (g2 ? g2[d] : 1.f); }
        u32x4 w; w.x = cvtpk(v[0], v[1]); w.y = cvtpk(v[2], v[3]); w.z = cvtpk(v[4], v[5]); w.w = cvtpk(v[6], v[7]);
        qf[s] = __builtin_bit_cast(bf16x8, w); }
}

struct SfCmp { int tq, nvis, j0; float slope; __device__ __forceinline__ float operator()(float s, int kl) const { const int j = j0 + kl; return j < nvis ? s - slope * (float)(tq - 16 * j - 31) : -INFINITY; } };
struct SfSlc { int tq, key0; float slope; bool sel; __device__ __forceinline__ float operator()(float s, int kl) const { const int key = key0 + kl; return (sel && key <= tq) ? s - slope * (float)(tq - key) : -INFINITY; } };
struct SfWin { int tq, key0; float slope; __device__ __forceinline__ float operator()(float s, int kl) const { const int key = key0 + kl; return (key <= tq && tq - key <= 511) ? s - slope * (float)(tq - key) : -INFINITY; } };

__device__ __forceinline__ void pv_accum(const f32x16& s0, const f32x16& s1, f32x16& o0, f32x16& o1, LAS const unsigned char* vtb, int r, int hh) {
    __builtin_amdgcn_s_setprio(1);
#pragma unroll
    for (int kt = 0; kt < 2; ++kt)
#pragma unroll
        for (int sp = 0; sp < 2; ++sp) { u32x4 w;
            if (kt == 0) { w.x = cvtpk(s0[8 * sp], s0[8 * sp + 1]); w.y = cvtpk(s0[8 * sp + 2], s0[8 * sp + 3]); w.z = cvtpk(s0[8 * sp + 4], s0[8 * sp + 5]); w.w = cvtpk(s0[8 * sp + 6], s0[8 * sp + 7]); }
            else         { w.x = cvtpk(s1[8 * sp], s1[8 * sp + 1]); w.y = cvtpk(s1[8 * sp + 2], s1[8 * sp + 3]); w.z = cvtpk(s1[8 * sp + 4], s1[8 * sp + 5]); w.w = cvtpk(s1[8 * sp + 6], s1[8 * sp + 7]); }
            const bf16x8 pb = __builtin_bit_cast(bf16x8, w); const int ko = 32 * kt + 16 * sp + 4 * hh;
            { const s16x4 lo = *(LAS const s16x4*)(vtb + r * VTB + ko * 2), hi = *(LAS const s16x4*)(vtb + r * VTB + (ko + 8) * 2);
              o0 = MFMA32(__builtin_shufflevector(lo, hi, 0, 1, 2, 3, 4, 5, 6, 7), pb, o0); }
            { const s16x4 lo = *(LAS const s16x4*)(vtb + (32 + r) * VTB + ko * 2), hi = *(LAS const s16x4*)(vtb + (32 + r) * VTB + (ko + 8) * 2);
              o1 = MFMA32(__builtin_shufflevector(lo, hi, 0, 1, 2, 3, 4, 5, 6, 7), pb, o1); } }
    __builtin_amdgcn_s_setprio(0);
}
template <int MODE, class SF>
__device__ __forceinline__ void attn_block(const bf16x8 (&qf)[4], f32x16& o0, f32x16& o1, float& m, float& l, LAS const unsigned char* ksb, LAS const unsigned char* vtb, int r, int hh, const SF sf,
                                           float msafe_f, float inv_f, LAS float* imprw, int nbase, float& carry) {
    f32x16 s0, s1;
#pragma unroll
    for (int i = 0; i < 16; ++i) { s0[i] = 0.f; s1[i] = 0.f; }
    bf16x8 ka[4], kb2[4];
#pragma unroll
    for (int s = 0; s < 4; ++s) { ka[s] = *(LAS const bf16x8*)(ksb + r * KSB + (16 * s + 8 * hh) * 2); kb2[s] = *(LAS const bf16x8*)(ksb + (32 + r) * KSB + (16 * s + 8 * hh) * 2); }
    __builtin_amdgcn_s_setprio(1);
#pragma unroll
    for (int s = 0; s < 4; ++s) { s0 = MFMA32(ka[s], qf[s], s0); s1 = MFMA32(kb2[s], qf[s], s1); }
    __builtin_amdgcn_s_setprio(0);
    __builtin_amdgcn_sched_barrier(0);
#pragma unroll
    for (int i = 0; i < 16; ++i) { s0[i] = sf(s0[i], crow(i, hh)); s1[i] = sf(s1[i], 32 + crow(i, hh)); }
    if (MODE != 2) {
        float mloc = fmaxf(s0[0], s1[0]);
#pragma unroll
        for (int i = 1; i < 16; ++i) mloc = fmaxf(mloc, fmaxf(s0[i], s1[i]));
        mloc = max32(mloc);
        const float mnew = fmaxf(m, mloc), msafe = mnew == -INFINITY ? 0.f : mnew, corr = EXP2(m - msafe);
        float psum = 0.f;
#pragma unroll
        for (int i = 0; i < 16; ++i) { s0[i] = EXP2(s0[i] - msafe); s1[i] = EXP2(s1[i] - msafe); psum += s0[i] + s1[i]; }
        psum = sum32(psum);
        l = l * corr + psum; m = mnew;
        if (MODE == 0 && !__all(corr == 1.f)) {
#pragma unroll
            for (int i = 0; i < 16; ++i) { o0[i] *= corr; o1[i] *= corr; } }
    } else {
#pragma unroll
        for (int i = 0; i < 16; ++i) { s0[i] = EXP2(s0[i] - msafe_f) * inv_f; s1[i] = EXP2(s1[i] - msafe_f) * inv_f; }
#pragma unroll
        for (int kt = 0; kt < 2; ++kt) { float A[4], T[4], R[4];
#pragma unroll
            for (int g = 0; g < 4; ++g) { const float p0 = kt ? s1[4 * g] : s0[4 * g], p1 = kt ? s1[4 * g + 1] : s0[4 * g + 1], p2 = kt ? s1[4 * g + 2] : s0[4 * g + 2], p3 = kt ? s1[4 * g + 3] : s0[4 * g + 3];
                A[g] = 2.f * ((p0 + p1) + p2) + p3; T[g] = p3; R[g] = partner32(p3, hh); }
#pragma unroll
            for (int g = 0; g < 4; ++g) { const float prev = hh ? R[g] : (g ? R[g - 1] : carry);
                imprw[nbase + 8 * kt + 2 * g + hh] = A[g] + prev; }
            carry = R[3]; (void)T; }
    }
    __builtin_amdgcn_sched_barrier(0);
    if (MODE != 1) pv_accum(s0, s1, o0, o1, vtb, r, hh);
}


__device__ __forceinline__ void attn_block_full(const bf16x8 (&qf)[4], f32x16& o0, f32x16& o1, float& m, float& l, LAS const unsigned char* ksb, LAS const unsigned char* vtb, int r, int hh, float b0, float sl) {
    f32x16 s0, s1;
#pragma unroll
    for (int i = 0; i < 16; ++i) { s0[i] = 0.f; s1[i] = 0.f; }
    bf16x8 ka[4], kb2[4];
#pragma unroll
    for (int s = 0; s < 4; ++s) { ka[s] = *(LAS const bf16x8*)(ksb + r * KSB + (16 * s + 8 * hh) * 2); kb2[s] = *(LAS const bf16x8*)(ksb + (32 + r) * KSB + (16 * s + 8 * hh) * 2); }
    __builtin_amdgcn_s_setprio(1);
#pragma unroll
    for (int s = 0; s < 4; ++s) { s0 = MFMA32(ka[s], qf[s], s0); s1 = MFMA32(kb2[s], qf[s], s1); }
    __builtin_amdgcn_s_setprio(0);
    __builtin_amdgcn_sched_barrier(0);
#pragma unroll
    for (int i = 0; i < 16; ++i) { const float c = (float)((i & 3) + 8 * (i >> 2)); s0[i] = fmaf(sl, c, s0[i]); s1[i] = fmaf(sl, c + 32.f, s1[i]); }
    float mloc = fmaxf(s0[0], s1[0]);
#pragma unroll
    for (int i = 1; i < 16; ++i) mloc = fmaxf(mloc, fmaxf(s0[i], s1[i]));
    mloc = max32(mloc + b0);
    const float mnew = fmaxf(m, mloc), msafe = mnew == -INFINITY ? 0.f : mnew, corr = EXP2(m - msafe), c0 = b0 - msafe;
    float psum = 0.f;
#pragma unroll
    for (int i = 0; i < 16; ++i) { s0[i] = EXP2(s0[i] + c0); s1[i] = EXP2(s1[i] + c0); psum += s0[i] + s1[i]; }
    psum = sum32(psum);
    l = l * corr + psum; m = mnew;
#pragma unroll
    for (int i = 0; i < 16; ++i) { o0[i] *= corr; o1[i] *= corr; }
    __builtin_amdgcn_sched_barrier(0);
    pv_accum(s0, s1, o0, o1, vtb, r, hh);
}

#define KV_PIPELINE(FIRST, NEXT, SRC, NORM, GAIN, ...) do { \
    __syncthreads(); \
    int nxt_ = (FIRST), par_ = 0; u32x4 kc_, vc_; float g8_[8]; \
    { const float* gp_ = (GAIN); _Pragma("unroll") for (int j_ = 0; j_ < 8; ++j_) g8_[j_] = gp_ ? gp_[8 * (tid & 7) + j_] : 1.f; } \
    if (nxt_ >= 0) { const int id = nxt_; const KVSrc src_ = SRC; kv_fetch(src_, tid, kc_, vc_); } \
    while (nxt_ >= 0) { const int cur_ = nxt_; \
        LAS unsigned char* ksb = lds + par_ * KS_BYTES; LAS unsigned char* vtb = lds + 2 * KS_BYTES + par_ * VT_BYTES; \
        kv_store<NORM>(kc_, vc_, g8_, ksb, vtb, tid); \
        __syncthreads(); \
        { const int cur = cur_; nxt_ = (NEXT); } \
        if (nxt_ >= 0) { const int id = nxt_; const KVSrc src_ = SRC; kv_fetch(src_, tid, kc_, vc_); } \
        { const int id = cur_; __VA_ARGS__; } \
        par_ ^= 1; } } while (0)


__device__ __forceinline__ void kv_store_pre(u32x4 kc, u32x4 vc, LAS unsigned char* ksb, LAS unsigned char* vtb, int tid) {
    *(LAS u32x4*)(ksb + (tid >> 3) * KSB + (tid & 7) * 16) = kc;
    LAS u32x2* vp = (LAS u32x2*)(vtb + (tid >> 3) * VTB + (tid & 7) * 16); u32x2 a = {vc.x, vc.y}, b2 = {vc.z, vc.w}; vp[0] = a; vp[1] = b2;
}
#define KV_PIPELINE_PRE(FIRST, NEXT, KTILE, VTILE, ...) do { \
    __syncthreads(); \
    int nxt_ = (FIRST), par_ = 0; u32x4 kc_, vc_; \
    if (nxt_ >= 0) { const int id = nxt_; kc_ = *(const u32x4*)((KTILE) + tid * 8); vc_ = *(const u32x4*)((VTILE) + tid * 8); } \
    while (nxt_ >= 0) { const int cur_ = nxt_; \
        LAS unsigned char* ksb = lds + par_ * KS_BYTES; LAS unsigned char* vtb = lds + 2 * KS_BYTES + par_ * VT_BYTES; \
        kv_store_pre(kc_, vc_, ksb, vtb, tid); \
        __syncthreads(); \
        { const int cur = cur_; nxt_ = (NEXT); } \
        if (nxt_ >= 0) { const int id = nxt_; kc_ = *(const u32x4*)((KTILE) + tid * 8); vc_ = *(const u32x4*)((VTILE) + tid * 8); } \
        { const int id = cur_; __VA_ARGS__; } \
        par_ ^= 1; } } while (0)

__device__ __forceinline__ void nsa_prep_item(const bf16_t* proj, bf16_t* kn, bf16_t* vtn, const float* g_ks, const float* g_kw, int item, LAS unsigned char* scr, int lane) {
    const int b = item >> 7, which = (item >> 6) & 1, n = item & 63, ch = lane & 7, row0 = lane >> 3;
    const bf16_t* src = proj + ((size_t)b * SEQ + 64 * n) * NP + (which ? C_KWA : C_KSA) + 8 * ch;
    const float* g = (which ? g_kw : g_ks) + 8 * ch;
    float gg[8];
#pragma unroll
    for (int i = 0; i < 8; ++i) gg[i] = g[i];
    u32x4 kc[8], vc[8];
#pragma unroll
    for (int j = 0; j < 8; ++j) { const bf16_t* rp = src + (size_t)(row0 + 8 * j) * NP; kc[j] = *(const u32x4*)rp; vc[j] = *(const u32x4*)(rp + 64); }
    bf16_t* kdst = kn + (((size_t)b * 2 + which) * SEQ + 64 * n) * 64 + 8 * ch;
#pragma unroll
    for (int j = 0; j < 8; ++j) { const int row = row0 + 8 * j; UNPACK8(kc[j], k);
        float ss = (k0 * k0 + k1 * k1) + (k2 * k2 + k3 * k3) + (k4 * k4 + k5 * k5) + (k6 * k6 + k7 * k7);
        ss += swz_f<1>(ss); ss += swz_f<2>(ss); ss += swz_f<4>(ss);
        const float rs = rsqrtf(ss * (1.f / 64.f) + EPS); u32x4 o;
        o.x = cvtpk(k0 * rs * gg[0], k1 * rs * gg[1]); o.y = cvtpk(k2 * rs * gg[2], k3 * rs * gg[3]); o.z = cvtpk(k4 * rs * gg[4], k5 * rs * gg[5]); o.w = cvtpk(k6 * rs * gg[6], k7 * rs * gg[7]);
        *(u32x4*)(kdst + (size_t)row * 64) = o;
        LAS unsigned short* vp = (LAS unsigned short*)(scr + (8 * ch) * 144 + row * 2); const u32x4 v = vc[j];
        vp[0 * 72] = (unsigned short)(v.x & 0xffffu); vp[1 * 72] = (unsigned short)(v.x >> 16); vp[2 * 72] = (unsigned short)(v.y & 0xffffu); vp[3 * 72] = (unsigned short)(v.y >> 16);
        vp[4 * 72] = (unsigned short)(v.z & 0xffffu); vp[5 * 72] = (unsigned short)(v.z >> 16); vp[6 * 72] = (unsigned short)(v.w & 0xffffu); vp[7 * 72] = (unsigned short)(v.w >> 16); }
    LDS_WAIT();
    bf16_t* vdst = vtn + ((((size_t)b * 2 + which) * 64 + n) * 64 + lane) * 64;
#pragma unroll
    for (int c = 0; c < 8; ++c) *(u32x4*)(vdst + 8 * c) = *(LAS const u32x4*)(scr + lane * 144 + 16 * c);
    LDS_WAIT();
}

struct NsaArgs { const bf16_t* proj; bf16_t* groups; const bf16_t *kcn, *vcc; const float *b_gate, *g_q, *g_ks, *g_kw, *g_out; const bf16_t *kn, *vtn; };
constexpr int NSA_SLAB = 2 * KS_BYTES + 2 * VT_BYTES, NSA_ISUM = NSA_SLAB + 4 * 64 * 65 * 4, NSA_MASK = NSA_ISUM + 64 * 65 * 4, NSA_UMASK = NSA_MASK + 512;
__device__ __forceinline__ void nsa_item(const NsaArgs& A, int b, int tl, LAS unsigned char* lds, int tid) {
    asm volatile("" : "+v"(tid));
    const int lane = tid & 63, w = __builtin_amdgcn_readfirstlane(tid >> 6), head = w & 3, half = w >> 2, r = lane & 31, hh = lane >> 5;
    const int tq = tl * 64 + 32 * half + r, tokl = 32 * half + r; const size_t token = (size_t)b * SEQ + tq;
    const bf16_t* base = A.proj + (size_t)b * SEQ * NP;
    LAS float* slab = (LAS float*)(lds + NSA_SLAB); LAS float* isum = (LAS float*)(lds + NSA_ISUM);
    LAS unsigned* masks = (LAS unsigned*)(lds + NSA_MASK); LAS unsigned* umask = (LAS unsigned*)(lds + NSA_UMASK);
    const float slope = exp2f(-(float)(2 * head + 1)) * LOG2E;
    bf16x8 qf[4]; load_qfrag<true>(qf, base + (size_t)tq * NP + C_QA + head * 64, A.g_q, nullptr, 0.125f * LOG2E, hh);
    float gl[3];
#pragma unroll
    for (int br = 0; br < 3; ++br) { const float x = bf2f(base[(size_t)tq * NP + C_GT + head * 3 + br]) + A.b_gate[head * 3 + br]; gl[br] = 1.f / (1.f + __expf(-x)); }
    f32x16 of0, of1, o0, o1;
#pragma unroll
    for (int i = 0; i < 16; ++i) { of0[i] = 0.f; of1[i] = 0.f; }
    float dummy = 0.f;
    {
        const int nbc = (tl >> 4) + 1, nvis = tq >= 31 ? ((tq - 31) >> 4) + 1 : 0;
        const bf16_t* kc = A.kcn + (size_t)b * 256 * 64; const bf16_t* vc = A.vcc + (size_t)b * 256 * 64;
        float m = -INFINITY, l = 0.f;
        KV_PIPELINE_PRE(0, (cur + 1 < nbc ? cur + 1 : -1), kc + (size_t)id * 4096, vc + (size_t)id * 4096,
            { const SfCmp sf{tq, nvis, 64 * id, slope}; attn_block<1>(qf, o0, o1, m, l, ksb, vtb, r, hh, sf, 0.f, 0.f, nullptr, 0, dummy); });
        const float inv = l > 0.f ? 1.f / l : 0.f, msafe = m == -INFINITY ? 0.f : m; float carry = 0.f;
#pragma unroll
        for (int i = 0; i < 16; ++i) { o0[i] = 0.f; o1[i] = 0.f; }
        LAS float* imprw = slab + (head * 64 + tokl) * 65;
        KV_PIPELINE_PRE(0, (cur + 1 < nbc ? cur + 1 : -1), kc + (size_t)id * 4096, vc + (size_t)id * 4096,
            { const SfCmp sf{tq, nvis, 64 * id, slope}; attn_block<2>(qf, o0, o1, m, l, ksb, vtb, r, hh, sf, msafe, inv, imprw, 16 * id, carry); });
#pragma unroll
        for (int i = 0; i < 16; ++i) { of0[i] += gl[0] * o0[i]; of1[i] += gl[0] * o1[i]; }
    }
    __syncthreads();
    if (tl > 15) {
        for (int e = tid; e < 64 * 64; e += 512) { const int tk = e >> 6, n = e & 63, o = tk * 65 + n; isum[o] = ((slab[o] + slab[64 * 65 + o]) + slab[2 * 64 * 65 + o]) + slab[3 * 64 * 65 + o]; }
        __syncthreads();
        const int tk = tid >> 3, sub = tid & 7; float v[8]; int cnt[8];
#pragma unroll
        for (int k = 0; k < 8; ++k) { v[k] = isum[tk * 65 + 8 * sub + k]; cnt[k] = 0; }
        for (int mm = 1; mm <= tl - 2; ++mm) { const float vm = isum[tk * 65 + mm];
#pragma unroll
            for (int k = 0; k < 8; ++k) cnt[k] += (vm > v[k] || (vm == v[k] && mm < 8 * sub + k)) ? 1 : 0; }
        unsigned bits = 0u;
#pragma unroll
        for (int k = 0; k < 8; ++k) { const int n = 8 * sub + k; if (n >= 1 && n <= tl - 2 && cnt[k] < 13) bits |= 1u << k; }
        unsigned lo = sub < 4 ? bits << (8 * sub) : 0u, hi = sub >= 4 ? bits << (8 * (sub - 4)) : 0u;
        lo |= swz_u<1>(lo); hi |= swz_u<1>(hi); lo |= swz_u<2>(lo); hi |= swz_u<2>(hi); lo |= swz_u<4>(lo); hi |= swz_u<4>(hi);
        const unsigned long long mk = ((unsigned long long)hi << 32 | lo) | 1ull | (3ull << (tl - 1));
        if (sub == 0) { masks[2 * tk] = (unsigned)mk; masks[2 * tk + 1] = (unsigned)(mk >> 32); }
    } else if (tid < 64) { const unsigned long long mk = (2ull << tl) - 1ull; masks[2 * tid] = (unsigned)mk; masks[2 * tid + 1] = (unsigned)(mk >> 32); }
    __syncthreads();
    if (tid < 64) { unsigned lo = masks[2 * tid], hi = masks[2 * tid + 1];
        lo |= swz_u<1>(lo); hi |= swz_u<1>(hi); lo |= swz_u<2>(lo); hi |= swz_u<2>(hi); lo |= swz_u<4>(lo); hi |= swz_u<4>(hi);
        lo |= swz_u<8>(lo); hi |= swz_u<8>(hi); lo |= swz_u<16>(lo); hi |= swz_u<16>(hi); lo = or32(lo); hi = or32(hi);
        if (tid == 0) { umask[0] = lo; umask[1] = hi; } }
    __syncthreads();
    const unsigned long long um = (unsigned long long)umask[1] << 32 | umask[0];
    const unsigned long long mymask = (unsigned long long)masks[2 * tokl + 1] << 32 | masks[2 * tokl];
    LAS float* park = slab + w * 2048 + lane;
#pragma unroll
    for (int i = 0; i < 16; ++i) { park[i * 64] = of0[i]; park[(16 + i) * 64] = of1[i]; }
    {
        float m = -INFINITY, l = 0.f;
#pragma unroll
        for (int i = 0; i < 16; ++i) { o0[i] = 0.f; o1[i] = 0.f; }
        const bf16_t* kp = A.kn + (size_t)(b * 2) * SEQ * 64; const bf16_t* vp = A.vtn + (size_t)(b * 2) * 64 * 4096;
#define NSA_NEXTBIT(c) ({ const unsigned long long rem_ = ((c) >= 63) ? 0ull : (um & ~((2ull << (c)) - 1ull)); rem_ ? (int)__builtin_ctzll(rem_) : -1; })
        KV_PIPELINE_PRE((int)__builtin_ctzll(um), NSA_NEXTBIT(cur), kp + (size_t)id * 4096, vp + (size_t)id * 4096,
            { const bool sel = (mymask >> id) & 1ull;
              if (__any(sel)) {
                  if (id < tl) attn_block_full(qf, o0, o1, m, l, ksb, vtb, r, hh, sel ? -slope * (float)(tq - 64 * id - 4 * hh) : -INFINITY, slope);
                  else { const SfSlc sf{tq, 64 * id, slope, sel}; attn_block<0>(qf, o0, o1, m, l, ksb, vtb, r, hh, sf, 0.f, 0.f, nullptr, 0, dummy); } } });
        const float sc = gl[1] / l;
#pragma unroll
        for (int i = 0; i < 16; ++i) { park[i * 64] += sc * o0[i]; park[(16 + i) * 64] += sc * o1[i]; }
    }
    {
        float m = -INFINITY, l = 0.f;
#pragma unroll
        for (int i = 0; i < 16; ++i) { o0[i] = 0.f; o1[i] = 0.f; }
        const bf16_t* kp = A.kn + (size_t)(b * 2 + 1) * SEQ * 64; const bf16_t* vp = A.vtn + (size_t)(b * 2 + 1) * 64 * 4096; const int nlo = tl >= 8 ? tl - 8 : 0;
        KV_PIPELINE_PRE(nlo, (cur + 1 <= tl ? cur + 1 : -1), kp + (size_t)id * 4096, vp + (size_t)id * 4096,
            { if (id < tl && id >= tl - 7) attn_block_full(qf, o0, o1, m, l, ksb, vtb, r, hh, -slope * (float)(tq - 64 * id - 4 * hh), slope);
              else { const SfWin sf{tq, 64 * id, slope}; attn_block<0>(qf, o0, o1, m, l, ksb, vtb, r, hh, sf, 0.f, 0.f, nullptr, 0, dummy); } });
        const float sc = gl[2] / l;
#pragma unroll
        for (int i = 0; i < 16; ++i) { of0[i] = park[i * 64] + sc * o0[i]; of1[i] = park[(16 + i) * 64] + sc * o1[i]; }
    }
    {
        float ss = 0.f;
#pragma unroll
        for (int i = 0; i < 16; ++i) ss += of0[i] * of0[i] + of1[i] * of1[i];
        ss = sum32(ss);
        const float rs = rsqrtf(ss * (1.f / 64.f) + EPS); const float* go = A.g_out + head * 64; bf16_t* dst = A.groups + token * DM + head * 64;
#pragma unroll
        for (int g = 0; g < 4; ++g) { const int d0 = 8 * g + 4 * hh;
            u32x2 wa; wa.x = cvtpk(of0[4 * g] * rs * go[d0], of0[4 * g + 1] * rs * go[d0 + 1]); wa.y = cvtpk(of0[4 * g + 2] * rs * go[d0 + 2], of0[4 * g + 3] * rs * go[d0 + 3]);
            *(u32x2*)(dst + d0) = wa;
            u32x2 wb; wb.x = cvtpk(of1[4 * g] * rs * go[32 + d0], of1[4 * g + 1] * rs * go[32 + d0 + 1]); wb.y = cvtpk(of1[4 * g + 2] * rs * go[32 + d0 + 2], of1[4 * g + 3] * rs * go[32 + d0 + 3]);
            *(u32x2*)(dst + 32 + d0) = wb; }
    }
    __syncthreads();
}

struct SfDil { int iq, key0; float sl; __device__ __forceinline__ float operator()(float s, int kl) const { const int df = iq - key0 - kl; return (df >= 0 && df <= 128) ? s - sl * (float)df : -INFINITY; } };
struct DilArgs { const bf16_t* proj; bf16_t* po; float* plse; const float *g_q, *g_k; };
__device__ __forceinline__ void dil_item(const DilArgs& A, int item, LAS unsigned char* lds, int tid) {
    asm volatile("" : "+v"(tid));
    const int cfg = item >> 9, rem = item & 511, b = rem >> 6, head = (rem >> 4) & 3, sub = rem & 15;
    const int dil = cfg == 0 ? 1 : (cfg == 1 ? 4 : 16), nq = 16 / dil, c = sub / nq, qt = sub % nq, i0 = 256 * qt, L = SEQ / dil;
    const int lane = tid & 63, w = __builtin_amdgcn_readfirstlane(tid >> 6), r = lane & 31, hh = lane >> 5;
    const int iq = i0 + 32 * w + r, tq = c + dil * iq; const size_t token = (size_t)b * SEQ + tq;
    const bf16_t* base = A.proj + (size_t)b * SEQ * NP;
    const float slope = exp2f(-(float)(2 * head + 2)) * (float)dil * LOG2E;
    bf16x8 qf[4]; load_qfrag<true>(qf, base + (size_t)tq * NP + C_QD + head * 64, A.g_q, nullptr, 0.125f * LOG2E, hh);
    const bf16_t* kp = base + (size_t)c * NP + C_KD + head * 64; const bf16_t* vp = base + (size_t)c * NP + C_VD + head * 64;
    const int kb_lo = (i0 >> 6) >= 2 ? (i0 >> 6) - 2 : 0, kb_hi = (i0 >> 6) + 3, q_lo = i0 + 32 * w;
    f32x16 o0, o1;
#pragma unroll
    for (int i = 0; i < 16; ++i) { o0[i] = 0.f; o1[i] = 0.f; }
    float m = -INFINITY, l = 0.f, dummy = 0.f;
    KV_PIPELINE(kb_lo, (cur + 1 <= kb_hi ? cur + 1 : -1), (KVSrc{kp, vp, (long)dil * NP, 64 * id, 0, L}), true, A.g_k,
        { if (64 * id + 63 >= q_lo - 128 && 64 * id <= q_lo + 31) { const SfDil sf{iq, 64 * id, slope}; attn_block<0>(qf, o0, o1, m, l, ksb, vtb, r, hh, sf, 0.f, 0.f, nullptr, 0, dummy); } });
    const float inv = 1.f / l;
    bf16_t* dst = A.po + ((size_t)cfg * M + token) * 256 + head * 64;
#pragma unroll
    for (int g = 0; g < 4; ++g) { const int d0 = 8 * g + 4 * hh;
        u32x2 wa; wa.x = cvtpk(o0[4 * g] * inv, o0[4 * g + 1] * inv); wa.y = cvtpk(o0[4 * g + 2] * inv, o0[4 * g + 3] * inv); *(u32x2*)(dst + d0) = wa;
        u32x2 wb; wb.x = cvtpk(o1[4 * g] * inv, o1[4 * g + 1] * inv); wb.y = cvtpk(o1[4 * g + 2] * inv, o1[4 * g + 3] * inv); *(u32x2*)(dst + 32 + d0) = wb; }
    if (hh == 0) A.plse[((size_t)cfg * M + token) * 4 + head] = m + __log2f(l);
    __syncthreads();
}
template <int NI> __device__ __forceinline__ void dil_merge_items(const bf16_t* po, const float* plse, bf16_t* groups, const float* g_out, int item0, int stride, int lane) {
    const int pair = lane >> 3, ch = lane & 7, head = pair & 3;
    u32x4 pv[NI][3]; float ls[NI][3];
#pragma unroll
    for (int n = 0; n < NI; ++n) { const size_t token = (size_t)(item0 + n * stride) * 2 + (pair >> 2);
#pragma unroll
        for (int i = 0; i < 3; ++i) { ls[n][i] = plse[((size_t)i * M + token) * 4 + head]; pv[n][i] = *(const u32x4*)(po + ((size_t)i * M + token) * 256 + head * 64 + 8 * ch); } }
    const float* go = g_out + 768 + head * 64 + 8 * ch;
#pragma unroll
    for (int n = 0; n < NI; ++n) { const size_t token = (size_t)(item0 + n * stride) * 2 + (pair >> 2);
        const float mx = fmaxf(ls[n][0], fmaxf(ls[n][1], ls[n][2]));
        const float w0 = EXP2(ls[n][0] - mx), w1 = EXP2(ls[n][1] - mx), w2 = EXP2(ls[n][2] - mx), winv = 1.f / (w0 + w1 + w2);
        float o[8];
#pragma unroll
        for (int j = 0; j < 8; ++j) o[j] = 0.f;
#pragma unroll
        for (int i = 0; i < 3; ++i) { UNPACK8(pv[n][i], k); const float wi = (i == 0 ? w0 : (i == 1 ? w1 : w2)) * winv;
            o[0] += wi * k0; o[1] += wi * k1; o[2] += wi * k2; o[3] += wi * k3; o[4] += wi * k4; o[5] += wi * k5; o[6] += wi * k6; o[7] += wi * k7; }
        float ss = 0.f;
#pragma unroll
        for (int j = 0; j < 8; ++j) ss += o[j] * o[j];
        ss += swz_f<1>(ss); ss += swz_f<2>(ss); ss += swz_f<4>(ss);
        const float rs = rsqrtf(ss * (1.f / 64.f) + EPS);
        u32x4 wv; wv.x = cvtpk(o[0] * rs * go[0], o[1] * rs * go[1]); wv.y = cvtpk(o[2] * rs * go[2], o[3] * rs * go[3]); wv.z = cvtpk(o[4] * rs * go[4], o[5] * rs * go[5]); wv.w = cvtpk(o[6] * rs * go[6], o[7] * rs * go[7]);
        *(u32x4*)(groups + token * DM + 768 + head * 64 + 8 * ch) = wv; }
}

__device__ __forceinline__ void stick_block(const bf16x8 (&qf)[4], f32x16& o0, f32x16& o1, float& carry, LAS const unsigned char* ksb, LAS const unsigned char* vtb, int r, int hh, int tq, int key0) {
    f32x16 s0, s1;
#pragma unroll
    for (int i = 0; i < 16; ++i) { s0[i] = 0.f; s1[i] = 0.f; }
    bf16x8 ka[4], kb2[4];
#pragma unroll
    for (int s = 0; s < 4; ++s) { ka[s] = *(LAS const bf16x8*)(ksb + r * KSB + (16 * s + 8 * hh) * 2); kb2[s] = *(LAS const bf16x8*)(ksb + (32 + r) * KSB + (16 * s + 8 * hh) * 2); }
    __builtin_amdgcn_s_setprio(1);
#pragma unroll
    for (int s = 0; s < 4; ++s) { s0 = MFMA32(ka[s], qf[s], s0); s1 = MFMA32(kb2[s], qf[s], s1); }
    __builtin_amdgcn_s_setprio(0);
    __builtin_amdgcn_sched_barrier(0);
    float acc = carry;
#pragma unroll
    for (int kti = 0; kti < 2; ++kti) { const int kt = 1 - kti; float spm[16], G[4], R[4];
#pragma unroll
        for (int i = 0; i < 16; ++i) { const float z = kt ? s1[i] : s0[i]; const bool act = key0 + 32 * kt + crow(i, hh) < tq;
            const float sp = fmaxf(z, 0.f) + __log2f(1.f + EXP2(-fabsf(z)));
            spm[i] = act ? sp : 0.f; const float lw = act ? z - sp : -INFINITY; if (kt) s1[i] = lw; else s0[i] = lw; }
#pragma unroll
        for (int g = 0; g < 4; ++g) { G[g] = (spm[4 * g] + spm[4 * g + 1]) + (spm[4 * g + 2] + spm[4 * g + 3]); R[g] = partner32(G[g], hh); }
#pragma unroll
        for (int gi = 0; gi < 4; ++gi) { const int g = 3 - gi; float run = acc + (hh ? 0.f : R[g]);
#pragma unroll
            for (int ki = 0; ki < 4; ++ki) { const int i = 4 * g + 3 - ki; const float lw = kt ? s1[i] : s0[i]; const float wv = EXP2(lw - run); if (kt) s1[i] = wv; else s0[i] = wv; run += spm[i]; }
            acc += G[g] + R[g]; } }
    carry = acc;
    __builtin_amdgcn_sched_barrier(0);
    pv_accum(s0, s1, o0, o1, vtb, r, hh);
}
struct StickArgs { const bf16_t* proj; bf16_t* groups; const float* g_out; };
__device__ __forceinline__ void stick_item(const StickArgs& A, int item, LAS unsigned char* lds, int tid) {
    asm volatile("" : "+v"(tid));
    const int b = item >> 6, head = (item >> 4) & 3, qt = item & 15, T0 = 256 * qt;
    const int lane = tid & 63, w = __builtin_amdgcn_readfirstlane(tid >> 6), r = lane & 31, hh = lane >> 5, tq = T0 + 32 * w + r;
    const size_t token = (size_t)b * SEQ + tq;
    const bf16_t* base = A.proj + (size_t)b * SEQ * NP;
    bf16x8 qf[4]; load_qfrag<false>(qf, base + (size_t)tq * NP + C_QC + head * 64, nullptr, nullptr, 0.125f * LOG2E, hh);
    LAS unsigned* flags = (LAS unsigned*)(lds + NSA_SLAB);
    if (tid < 16) flags[tid] = 0u;
    f32x16 o0, o1;
#pragma unroll
    for (int i = 0; i < 16; ++i) { o0[i] = 0.f; o1[i] = 0.f; }
    float carry = 0.f; bool done = false;
    const bf16_t* kp = base + C_KC + head * 64; const bf16_t* vp = base + C_VC + head * 64;
#define STK_NEXT(c) ({ const LAS unsigned* f_ = flags + (par_ ^ 1) * 8; const unsigned ad_ = (f_[0] & f_[1]) & (f_[2] & f_[3]) & (f_[4] & f_[5]) & (f_[6] & f_[7]); ((c) > 0 && !ad_) ? (c) - 1 : -1; })
    KV_PIPELINE((T0 >> 6) + 3, STK_NEXT(cur), (KVSrc{kp, vp, NP, 64 * id, 0, SEQ}), false, nullptr,
        { if (!done && 64 * id <= T0 + 32 * w + 30) { stick_block(qf, o0, o1, carry, ksb, vtb, r, hh, tq, 64 * id); done = __all(carry > 150.1f); }
          if (lane == 0) flags[par_ * 8 + w] = done ? 1u : 0u; });
    float ss = 0.f;
#pragma unroll
    for (int i = 0; i < 16; ++i) ss += o0[i] * o0[i] + o1[i] * o1[i];
    ss = sum32(ss);
    const float rs = rsqrtf(ss * (1.f / 64.f) + EPS); const float* go = A.g_out + 512 + head * 64; bf16_t* dst = A.groups + token * DM + 512 + head * 64;
#pragma unroll
    for (int g = 0; g < 4; ++g) { const int d0 = 8 * g + 4 * hh;
        u32x2 wa; wa.x = cvtpk(o0[4 * g] * rs * go[d0], o0[4 * g + 1] * rs * go[d0 + 1]); wa.y = cvtpk(o0[4 * g + 2] * rs * go[d0 + 2], o0[4 * g + 3] * rs * go[d0 + 3]); *(u32x2*)(dst + d0) = wa;
        u32x2 wb; wb.x = cvtpk(o1[4 * g] * rs * go[32 + d0], o1[4 * g + 1] * rs * go[32 + d0 + 1]); wb.y = cvtpk(o1[4 * g + 2] * rs * go[32 + d0 + 2], o1[4 * g + 3] * rs * go[32 + d0 + 3]); *(u32x2*)(dst + 32 + d0) = wb; }
    __syncthreads();
}

struct CmpArgs { const bf16_t* proj; const bf16_t* w1t; const bf16_t* w2t; const float* cb; const float* g_kc; bf16_t* kcn; bf16_t* vcc; };
constexpr int HIDB = 528;
__device__ __forceinline__ void compress_item(const CmpArgs& A, int item, LAS unsigned char* lds, int tid) {
    asm volatile("" : "+v"(tid));
    const int kv = item >> 6, rt = item & 63, b = rt >> 3, j0 = (rt & 7) * 32;
    const int lane = tid & 63, w = __builtin_amdgcn_readfirstlane(tid >> 6), r = lane & 31, hh = lane >> 5;
    { const bf16_t* xsrc = A.proj + (size_t)b * SEQ * NP + (kv ? C_VCA : C_KCA);
      u32x4 stg[9];
#pragma unroll
      for (int q = 0; q < 9; ++q) { const int e2 = tid + 512 * q, t = e2 >> 3, c = e2 & 7; int tk = 16 * j0 + t; tk = tk < SEQ ? tk : SEQ - 1;
          if (e2 < 528 * 8) stg[q] = *(const u32x4*)(xsrc + (size_t)tk * NP + 8 * c); }
#pragma unroll
      for (int q = 0; q < 9; ++q) { const int e2 = tid + 512 * q, t = e2 >> 3, c = e2 & 7;
          if (e2 < 528 * 8) *(LAS u32x4*)(lds + (t ^ ((t >> 7) & 1)) * 128 + ((c ^ ((t >> 4) & 7)) * 16)) = stg[q]; } }
    __syncthreads();
    const bf16_t* wf = A.w1t + (size_t)kv * 256 * 2048 + ((size_t)w * 128 * 64 + lane) * 8;
    f32x16 acc;
#pragma unroll
    for (int i = 0; i < 16; ++i) acc[i] = 0.f;
#pragma unroll 8
    for (int pos = 0; pos < 32; ++pos) { const int t = 16 * r + pos; LAS const unsigned char* arow = lds + (t ^ ((t >> 7) & 1)) * 128; const int sw = (t >> 4) & 7;
#pragma unroll
        for (int q = 0; q < 4; ++q) { const bf16x8 af = *(LAS const bf16x8*)(arow + (((2 * q + hh) ^ sw) * 16)), bfr = *(const bf16x8*)(wf + (size_t)(4 * pos + q) * 512); acc = MFMA32(af, bfr, acc); } }
    __syncthreads();
    { const float bias = A.cb[kv * 256 + 32 * w + r];
#pragma unroll
      for (int i = 0; i < 16; ++i) { const float x = acc[i] + bias; const float hv = 0.5f * x * (1.f + tanhf(0.7978845608028654f * (x + 0.044715f * x * x * x)));
          *(LAS unsigned short*)(lds + crow(i, hh) * HIDB + (32 * w + r) * 2) = (unsigned short)(cvtpk(hv, hv) & 0xffffu); } }
    __syncthreads();
    if (w == 0) {
        f32x16 c0, c1;
#pragma unroll
        for (int i = 0; i < 16; ++i) { c0[i] = 0.f; c1[i] = 0.f; }
        const bf16_t* w2a = A.w2t + ((size_t)kv * 64 + r) * 256 + 8 * hh; const bf16_t* w2b = w2a + 32 * 256;
#pragma unroll
        for (int s = 0; s < 16; ++s) { const bf16x8 af = *(LAS const bf16x8*)(lds + r * HIDB + (16 * s + 8 * hh) * 2);
            c0 = MFMA32(af, *(const bf16x8*)(w2a + 16 * s), c0); c1 = MFMA32(af, *(const bf16x8*)(w2b + 16 * s), c1); }
        const float g0 = A.g_kc[r], g1 = A.g_kc[32 + r]; bf16_t* dst = (kv ? A.vcc : A.kcn) + ((size_t)b * 256 + j0) * 64;
#pragma unroll
        for (int i = 0; i < 16; ++i) { float v0 = c0[i], v1 = c1[i];
            if (!kv) { float ss = v0 * v0 + v1 * v1; ss += swz_f<1>(ss); ss += swz_f<2>(ss); ss += swz_f<4>(ss); ss += swz_f<8>(ss); ss += swz_f<16>(ss);
                const float rs = rsqrtf(ss * (1.f / 64.f) + EPS); v0 *= rs * g0; v1 *= rs * g1; }
            const int row = crow(i, hh);
            if (!kv) { dst[row * 64 + r] = (bf16_t)(cvtpk(v0, v0) & 0xffffu); dst[row * 64 + 32 + r] = (bf16_t)(cvtpk(v1, v1) & 0xffffu); }
            else { const int j = j0 + row; bf16_t* vt = A.vcc + ((size_t)b * 4 + (j >> 6)) * 4096 + (j & 63);
                vt[(size_t)r * 64] = (bf16_t)(cvtpk(v0, v0) & 0xffffu); vt[(size_t)(32 + r) * 64] = (bf16_t)(cvtpk(v1, v1) & 0xffffu); } }
    }
    __syncthreads();
}
#define RLX_AGENT __ATOMIC_RELAXED, __HIP_MEMORY_SCOPE_AGENT
#define XB_TMO      128
#define XB_XCNT(j)  (256  + 64 * (j))
#define XB_XSUB(j)  (1280 + 64 * (j))
#define XB_XGEN(j)  (2304 + 64 * (j))
#define XB_TOP      3328
#define XB_TOPGEN   3392
#define XCD_BAR_WORDS 3456
#define XB_SPIN_CAP (1u << 18)

__device__ __forceinline__ unsigned xb_ld(unsigned* p)              { return __hip_atomic_load(p, __ATOMIC_RELAXED, __HIP_MEMORY_SCOPE_AGENT); }
__device__ __forceinline__ unsigned xb_add(unsigned* p, unsigned v) { return __hip_atomic_fetch_add(p, v, __ATOMIC_RELAXED, __HIP_MEMORY_SCOPE_AGENT); }
__device__ __forceinline__ unsigned xb_xcc_id() { return (unsigned)__builtin_amdgcn_s_getreg((3 << 11) | 20) & 0xFu; }
#define XB_SPIN(cond, bar) do { unsigned _sp = 0; while (cond) { __builtin_amdgcn_s_sleep(1); \
    if ((++_sp & 255u) == 0u) { if (xb_ld(&(bar)[XB_TMO])) break; if (_sp > XB_SPIN_CAP) { atomicAdd(&(bar)[XB_TMO], 1u); break; } } } } while (0)

struct XcdBarrier {
    unsigned* bar; unsigned x;
    volatile LAS unsigned* st;
};

__device__ __forceinline__ XcdBarrier xcd_barrier_post(unsigned* bar, volatile LAS unsigned* st) {
    XcdBarrier b; b.bar = bar; b.x = xb_xcc_id(); b.st = st;
    if (threadIdx.x == 0) (void)xb_add(&bar[XB_XCNT(b.x)], 1u);
    return b;
}
__device__ __forceinline__ void xcd_barrier_complete(unsigned* bar, unsigned x, unsigned& nloc, unsigned& nx) {
    const unsigned G = gridDim.x * gridDim.y * gridDim.z;
    unsigned sum, cnt, mine, sp = 0u;
    for (;;) {
        sum = 0u; cnt = 0u; mine = 0u;
#pragma unroll
        for (unsigned j = 0; j < 16; ++j) { const unsigned c = xb_ld(&bar[XB_XCNT(j)]); sum += c; cnt += (c > 0u) ? 1u : 0u; mine = (j == x) ? c : mine; }
        if (sum == G) break;
        __builtin_amdgcn_s_sleep(1);
        if ((++sp & 255u) == 0u) { if (xb_ld(&bar[XB_TMO])) break; if (sp > XB_SPIN_CAP) { atomicAdd(&bar[XB_TMO], 1u); break; } }
    }
    nloc = mine > 0u ? mine : 1u; nx = cnt > 0u ? cnt : 1u;
}

__device__ __forceinline__ void xcd_barrier(const XcdBarrier& b) {
    asm volatile("s_waitcnt vmcnt(0)" ::: "memory");
    __syncthreads();
    if (threadIdx.x == 0) {
        unsigned* bar = b.bar;
        __builtin_amdgcn_s_waitcnt(0);
        unsigned nloc = b.st[0], nx = b.st[1];
        if (nloc == 0u) { xcd_barrier_complete(bar, b.x, nloc, nx); b.st[0] = nloc; b.st[1] = nx; }
        const unsigned old = xb_add(&bar[XB_XSUB(b.x)], 1u);
        const unsigned gen = old / nloc;
        if (old + 1u == (gen + 1u) * nloc) {
            __builtin_amdgcn_fence(__ATOMIC_RELEASE, "agent");
            asm volatile("s_waitcnt vmcnt(0)" ::: "memory");
            const unsigned og = xb_add(&bar[XB_TOP], 1u);
            const unsigned tg = og / nx;
            if (og + 1u == (tg + 1u) * nx) xb_add(&bar[XB_TOPGEN], 1u);
            else XB_SPIN(xb_ld(&bar[XB_TOPGEN]) == tg, bar);
            __builtin_amdgcn_fence(__ATOMIC_ACQUIRE, "agent");
            xb_add(&bar[XB_XGEN(b.x)], 1u);
            asm volatile("s_waitcnt vmcnt(0)" ::: "memory");
        } else {
            XB_SPIN(xb_ld(&bar[XB_XGEN(b.x)]) == gen, bar);
            __builtin_amdgcn_fence(__ATOMIC_ACQUIRE, "agent");
            asm volatile("s_waitcnt vmcnt(0)" ::: "memory");
        }
    }
    __syncthreads();
}

#ifndef REP_CMP
#define REP_CMP 1
#endif
#ifndef REP_STK
#define REP_STK 1
#endif
#ifndef REP_DIL
#define REP_DIL 1
#endif
#ifndef REP_NSA
#define REP_NSA 1
#endif
#ifndef REP_G1
#define REP_G1 1
#endif
#ifndef REP_G3
#define REP_G3 1
#endif
#ifndef REP_PRO
#define REP_PRO 1
#endif
#ifndef REP_PREP
#define REP_PREP 1
#endif
#ifndef RESID_BF16
#define RESID_BF16 1
#endif
#ifndef REP_CONV
#define REP_CONV 1
#endif
#ifndef REP_G2
#define REP_G2 1
#endif
#ifndef XSYNC
#define XSYNC 0
#endif
__global__ void __launch_bounds__(512, 2) fwd_kernel(Params p) {
    extern __shared__ __attribute__((aligned(16))) unsigned char lds_raw[];
    cg::grid_group grid = cg::this_grid();
    LAS unsigned char* lds = (LAS unsigned char*)lds_raw;
#define TID_SETUP() int tid = threadIdx.x; asm volatile("" : "+v"(tid)); const int lane = tid & 63, wave = __builtin_amdgcn_readfirstlane(tid >> 6), gw = blockIdx.x * 8 + wave; (void)lane; (void)gw
    const int G = gridDim.x, NGW = G * 8;
    unsigned char* ws = p.ws;
    volatile LAS unsigned* misc = (volatile LAS unsigned*)(lds + LDS_BYTES - 64);
    unsigned* barw = (unsigned*)(ws + WS_BAR);
    { int t0 = threadIdx.x; if (t0 < 2) misc[t0] = 0u;
      if (blockIdx.x == 0) for (int i = t0; i < XCD_BAR_WORDS; i += 512) barw[i] = 0u;
      __syncthreads(); }
    float* ss = (float*)(ws + WS_SS); bf16_t* kcn = (bf16_t*)(ws + WS_KCN); bf16_t* vcc = (bf16_t*)(ws + WS_VCC);
    bf16_t* xb = (bf16_t*)(ws + WS_XB); bf16_t* groups = (bf16_t*)(ws + WS_GR); bf16_t* proj = (bf16_t*)(ws + WS_PROJ); bf16_t* hbuf = proj;
    float* x1 = (float*)(ws + WS_X1); bf16_t* nkn = (bf16_t*)(ws + WS_X1); bf16_t* nvt = (bf16_t*)(ws + WS_X1 + 8 * MiB);
    bf16_t* dpo = (bf16_t*)((unsigned char*)p.out + DO_PO); float* dlse = (float*)((unsigned char*)p.out + DO_LSE);

#ifndef SKIP_PRO
    for (int rep_ = 0; rep_ < REP_PRO; ++rep_) { TID_SETUP(); prologue(p, lds, gw, NGW, wave, lane); }
#endif
    grid.sync();
    const XcdBarrier xbar = xcd_barrier_post(barw, misc);
    for (int xs_ = 0; xs_ < XSYNC; ++xs_) xcd_barrier(xbar);

    for (int l = 0; l < 2; ++l) {
        unsigned char* wl = ws + WS_W + (size_t)l * W_LAYER;
#ifndef SKIP_G1
        for (int rep_ = 0; rep_ < REP_G1; ++rep_)
        { pg8::Gemm g{xb, (const bf16_t*)(wl + W_IN), M, NP, DM}; pg8::StaticOrder S; S.init(M, NP, G, (int)blockIdx.x);
          EpiProj E{proj, ss + (size_t)(2 * l) * M};
          pg8::gemm_phase<EpiProj, pg8::StaticOrder, true, true>(lds, g, S, E); }
#endif
        xcd_barrier(xbar);
        {
            TID_SETUP();
            const float* g_out = p.in[17] + l * DM;
            {
              const CmpArgs CA{proj, (const bf16_t*)(ws + WS_W1T) + (size_t)l * 2 * 256 * 2048, (const bf16_t*)(ws + WS_W2T) + (size_t)l * 2 * 64 * 256, (const float*)(ws + WS_CB) + l * 512, p.in[5] + l * 64, kcn, vcc};
              const StickArgs SA{proj, groups, g_out}; const DilArgs DA{proj, dpo, dlse, p.in[15] + l * 64, p.in[16] + l * 64};
              volatile LAS int* slot = (volatile LAS int*)(lds + LDS_BYTES - 32);
              for (;;) { __syncthreads(); if (tid == 0) *slot = (int)atomicAdd(barw + 32 + 64 * l, 1u); __syncthreads(); const int it = *slot; if (it >= 128 + 512 + 1536 + 256 + 128) break;
                  if (it < 128) compress_item(CA, it, lds, tid); else if (it < 640) stick_item(SA, it - 128, lds, tid); else if (it < 2176) dil_item(DA, it - 640, lds, tid);
                  else if (it < 2432) { const int i0 = (it - 2176) * 64 + wave; conv_items<4>(proj, groups, p.in[14] + l * 768, g_out, i0, 8, lane); conv_items<4>(proj, groups, p.in[14] + l * 768, g_out, i0 + 32, 8, lane); }
                  else nsa_prep_item(proj, nkn, nvt, p.in[6] + l * 64, p.in[7] + l * 64, (it - 2432) * 8 + wave, lds + wave * 9216, lane); } }
        }
        xcd_barrier(xbar);
#ifndef SKIP_NSA
#ifndef SKIP_DIL
#endif
        for (int rep_ = 0; rep_ < REP_NSA; ++rep_)
        { TID_SETUP(); NsaArgs A{proj, groups, kcn, vcc, p.in[3] + l * 12, p.in[4] + l * 64, p.in[6] + l * 64, p.in[7] + l * 64, p.in[17] + l * DM, nkn, nvt};
          volatile LAS int* slot = (volatile LAS int*)(lds + LDS_BYTES - 32);
          for (;;) { __syncthreads(); if (tid == 0) *slot = (int)atomicAdd(barw + 64 * l, 1u); __syncthreads(); const int it = *slot; if (it >= 512 + 256) break;
              if (it < 512) nsa_item(A, it & 7, 63 - (it >> 3), lds, tid);
              else { const int i0 = (it - 512) * 64 + wave; dil_merge_items<4>(dpo, dlse, groups, p.in[17] + l * DM, i0, 8, lane); dil_merge_items<4>(dpo, dlse, groups, p.in[17] + l * DM, i0 + 32, 8, lane); } } }
#endif
        xcd_barrier(xbar);
#ifndef SKIP_G2
        { pg8::Gemm g{groups, (const bf16_t*)(wl + W_OUT), M, DM, DM}; pg8::StaticOrder S; S.init(M, DM, G, (int)blockIdx.x);
#if RESID_BF16
          EpiResid E{l == 0 ? p.in[0] : nullptr, xb, nullptr, xb, ss + (size_t)(2 * l + 1) * M};
#else
          EpiResid E{l == 0 ? p.in[0] : x1, nullptr, l == 0 ? x1 : p.out, xb, ss + (size_t)(2 * l + 1) * M};
#endif
          pg8::gemm_phase<EpiResid, pg8::StaticOrder, true, true>(lds, g, S, E);
          for (int rep_ = 1; rep_ < REP_G2; ++rep_) { E.ss = nullptr; pg8::gemm_phase<EpiResid, pg8::StaticOrder, true, true>(lds, g, S, E); } }
#endif
        xcd_barrier(xbar);
#ifndef SKIP_G3
        for (int rep_ = 0; rep_ < REP_G3; ++rep_)
        { pg8::Gemm g{xb, (const bf16_t*)(wl + W_GU), M, NGU, DM}; pg8::StaticOrder S; S.init(M, NGU, G, (int)blockIdx.x);
          EpiSwiGLU E{hbuf, ss + (size_t)(2 * l + 1) * M};
          pg8::gemm_phase<EpiSwiGLU, pg8::StaticOrder, true, true>(lds, g, S, E); }
#endif
        xcd_barrier(xbar);
#ifndef SKIP_G4
        { pg8::Gemm g{hbuf, (const bf16_t*)(wl + W_DN), M, DM, FF}; pg8::StaticOrder S; S.init(M, DM, G, (int)blockIdx.x);
          float* xio = l == 0 ? x1 : p.out;
#if RESID_BF16
          EpiResid E{nullptr, xb, l == 0 ? nullptr : p.out, l == 0 ? xb : nullptr, l == 0 ? ss + (size_t)2 * M : nullptr}; (void)xio;
#else
          EpiResid E{xio, nullptr, xio, l == 0 ? xb : nullptr, l == 0 ? ss + (size_t)2 * M : nullptr};
#endif
          pg8::gemm_phase<EpiResid, pg8::StaticOrder, true, true>(lds, g, S, E); }
#endif
        if (l == 0) xcd_barrier(xbar);
    }
}

extern "C" void kernel_launch(void* const* d_in, const int* in_sizes, int n_in, void* d_out, int out_size, void* d_ws, size_t ws_size, hipStream_t stream) {
    static int grid = 0;
    if (grid == 0) {
        if (n_in != 23 || out_size != M * DM || ws_size < WS_END) { fprintf(stderr, "kernel_launch: unexpected shapes (n_in %d, out %d, ws %zu)\n", n_in, out_size, ws_size); grid = -1; return; }
        int dev = 0, cus = 0, per_cu = 0;
        (void)hipGetDevice(&dev); (void)hipDeviceGetAttribute(&cus, hipDeviceAttributeMultiprocessorCount, dev);
        if (hipFuncSetAttribute((const void*)fwd_kernel, hipFuncAttributeMaxDynamicSharedMemorySize, LDS_BYTES) != hipSuccess) { fprintf(stderr, "kernel_launch: hipFuncSetAttribute failed\n"); grid = -1; return; }
        if (hipOccupancyMaxActiveBlocksPerMultiprocessor(&per_cu, (const void*)fwd_kernel, 512, LDS_BYTES) != hipSuccess || per_cu < 1) per_cu = 1;
        (void)hipGetLastError();
        grid = cus * 1;
        (void)per_cu;
    }
    if (grid < 0) return;
    Params p{};
    for (int i = 0; i < 23; ++i) p.in[i] = (const float*)d_in[i];
    p.out = (float*)d_out; p.ws = (unsigned char*)d_ws;
    void* args[] = {&p};
    hipError_t e = hipLaunchCooperativeKernel((const void*)fwd_kernel, dim3(grid), dim3(512), args, LDS_BYTES, stream);
    if (e != hipSuccess) fprintf(stderr, "cooperative launch failed: %s (grid %d)\n", hipGetErrorString(e), grid);
}
```

```cpp
#include <hip/hip_runtime.h>
#include <hip/hip_cooperative_groups.h>
#include <cstdio>
#include <cstdint>
namespace cg = cooperative_groups;
namespace pg8 {
#define PG8_LAS __attribute__((address_space(3)))
typedef unsigned short bf16_t;
typedef short bf16x8 __attribute__((ext_vector_type(8)));
typedef float f32x4 __attribute__((ext_vector_type(4)));
typedef unsigned u32x4 __attribute__((ext_vector_type(4)));
constexpr int BM = 256, BK = 64, HALF = 128, HTB = HALF * BK * 2  , STAGE_BYTES = 8 * HTB, NXCD = 8, WGM = 8;

__host__ __device__ __forceinline__ int lds_byte(int r, int c) { const int st = (r >> 4) * 2 + (c >> 5), rr = r & 15, cc = c & 31, ob = rr * 64 + cc * 2; return st * 1024 + (ob ^ (((ob >> 9) & 1) << 5)); }
__host__ __device__ __forceinline__ void stage_rc(int b, int& R, int& C) { const int st = b / 1024, sb = b % 1024, swz = sb ^ (((sb >> 9) & 1) << 5); R = (st >> 1) * 16 + swz / 64; C = (st & 1) * 32 + (swz % 64) / 2; }
__host__ __device__ __forceinline__ int perm32(int rho) { const int n = rho >> 4, i = rho & 15; return 8 * (i >> 2) + 4 * n + (i & 3); }

struct Unit { int pm, pn; };
struct Gemm { const bf16_t* A; const bf16_t* Bt; int M, N, K; };

struct StaticOrder {
    int nM, nN, nwg, G, c;
    __host__ __device__ void init(int M, int N, int G_, int c_) { nM = M / BM; nN = N / BM; nwg = nM * nN; G = G_; c = c_; }
    __host__ __device__ bool next(int i, Unit& u) const {
        const long L = (long)i * G + c; if (L >= nwg) return false;
        int wgid = (int)L; { const int q = nwg / NXCD, r = nwg % NXCD, xcd = wgid % NXCD, off = wgid / NXCD; wgid = (xcd < r ? xcd * (q + 1) : r * (q + 1) + (xcd - r) * q) + off; }
        const int nig = WGM * nN, gid = wgid / nig, fm = gid * WGM, gsz = (nM - fm) < WGM ? (nM - fm) : WGM;
        u.pm = fm + ((wgid % nig) % gsz); u.pn = (wgid % nig) / gsz; return true;
    }
    __device__ __forceinline__ void a_ready(const Unit&) const {}
    __device__ __forceinline__ void done(const Unit&) const {}
};

__device__ __forceinline__ unsigned cvt_pk_bf16(float lo, float hi) { unsigned r; asm volatile("v_cvt_pk_bf16_f32 %0, %1, %2" : "=v"(r) : "v"(lo), "v"(hi)); return r; }
template <class Epi, class Sched, bool ALIGN_EPI = false, bool SP2 = false>
__device__ __forceinline__ void gemm_phase(PG8_LAS unsigned char* lds, const Gemm g, const Sched& S, const Epi& E) {
    int tid_l = threadIdx.x; asm volatile("" : "+v"(tid_l));
    const int tid = tid_l, wid = __builtin_amdgcn_readfirstlane(tid >> 6), lane = tid & 63, wr = wid >> 2, wc = wid & 3, fr = lane & 15, fq = lane >> 4;
    const int K = g.K, nt = K / BK;
    unsigned voffA[2], voffB[2];
#pragma unroll
    for (int i = 0; i < 2; ++i) { int R, C; stage_rc(tid * 16 + i * 8192, R, C); const int Rb = Epi::PERM ? ((R & ~31) + perm32(R & 31)) : R;
        voffA[i] = (unsigned)(R * K + C) * 2u; voffB[i] = (unsigned)(Rb * K + C) * 2u; }
    const size_t kstep = (size_t)(BK * 2);
    const size_t hstep = (size_t)HALF * K * 2;
    const size_t tstep = 2 * hstep;
    const unsigned ldsw = (unsigned)wid * 1024u;
    const int aoff = lds_byte(wr * 64 + fr, fq * 8), boff = lds_byte(wc * 32 + fr, fq * 8);
#define PG8_SA(b, h) (((b) * 2 + (h)) * HTB)
#define PG8_SB(b, h) ((4 + (b) * 2 + (h)) * HTB)
#define PG8_STAGE(bufoff, gbase, voff) do { _Pragma("unroll") for (int _i = 0; _i < 2; ++_i) \
        __builtin_amdgcn_global_load_lds((const unsigned*)((const char*)(gbase) + (voff)[_i]), (PG8_LAS unsigned*)(lds + (bufoff) + ldsw + _i * 8192), 16, 0, 0); } while (0)
#define PG8_LDA(dst, b, h) do { _Pragma("unroll") for (int m = 0; m < 4; ++m) _Pragma("unroll") for (int k = 0; k < 2; ++k) dst[m][k] = *(const PG8_LAS bf16x8*)(lds + PG8_SA(b, h) + aoff + m * 2048 + k * 1024); } while (0)
#define PG8_LDB(dst, b, h) do { _Pragma("unroll") for (int n = 0; n < 2; ++n) _Pragma("unroll") for (int k = 0; k < 2; ++k) dst[n][k] = *(const PG8_LAS bf16x8*)(lds + PG8_SB(b, h) + boff + n * 2048 + k * 1024); } while (0)
#define PG8_MMA(ai, bj, At, Bt) do { __builtin_amdgcn_s_setprio(1); _Pragma("unroll") for (int m = 0; m < 4; ++m) _Pragma("unroll") for (int n = 0; n < 2; ++n) _Pragma("unroll") for (int k = 0; k < 2; ++k) \
        acc[ai][bj][m][n] = __builtin_amdgcn_mfma_f32_16x16x32_bf16(Bt[n][k], At[m][k], acc[ai][bj][m][n], 0, 0, 0); __builtin_amdgcn_s_setprio(0); } while (0)
#define PG8_WAIT_V(n) asm volatile("s_waitcnt vmcnt(" #n ")" ::: "memory")
#define PG8_WAIT_L(n) asm volatile("s_waitcnt lgkmcnt(" #n ")" ::: "memory")
#define PG8_BAR __builtin_amdgcn_s_barrier()
#define PG8_SCHED __builtin_amdgcn_sched_barrier(0)
    Unit cur, nxt; int ui = 0;
    if (!S.next(0, cur)) return;
    f32x4 acc[2][2][4][2];
#pragma unroll
    for (int a = 0; a < 2; ++a)
#pragma unroll
        for (int b = 0; b < 2; ++b)
#pragma unroll
            for (int m = 0; m < 4; ++m)
#pragma unroll
                for (int n = 0; n < 2; ++n) acc[a][b][m][n] = (f32x4){0.f, 0.f, 0.f, 0.f};
    bf16x8 At[4][2], B0[2][2], B1[2][2];
    const char* cA = (const char*)g.A + (size_t)cur.pm * tstep; const char* cB = (const char*)g.Bt + (size_t)cur.pn * tstep;
    S.a_ready(cur);
    if constexpr (SP2) {
        PG8_STAGE(PG8_SB(0, 0), cB, voffB); PG8_STAGE(PG8_SB(0, 1), cB + hstep, voffB); PG8_STAGE(PG8_SA(0, 0), cA, voffA); PG8_STAGE(PG8_SA(0, 1), cA + hstep, voffA);
        if (wr == 1) PG8_BAR;
        PG8_WAIT_V(2); PG8_BAR;
        PG8_STAGE(PG8_SB(1, 0), cB + kstep, voffB); PG8_STAGE(PG8_SA(1, 0), cA + kstep, voffA); PG8_STAGE(PG8_SB(1, 1), cB + hstep + kstep, voffB);
        PG8_WAIT_V(6); PG8_BAR;
    } else {
        PG8_STAGE(PG8_SB(0, 0), cB, voffB); PG8_STAGE(PG8_SA(0, 0), cA, voffA); PG8_STAGE(PG8_SB(0, 1), cB + hstep, voffB); PG8_STAGE(PG8_SA(0, 1), cA + hstep, voffA);
        if (wr == 1) PG8_BAR;
        PG8_WAIT_V(4); PG8_BAR;
        PG8_STAGE(PG8_SB(1, 0), cB + kstep, voffB); PG8_STAGE(PG8_SA(1, 0), cA + kstep, voffA); PG8_STAGE(PG8_SB(1, 1), cB + hstep + kstep, voffB);
        PG8_WAIT_V(6); PG8_BAR;
    }
    for (;;) {
        const bool has_next = S.next(ui + 1, nxt);
        const char* nA = has_next ? (const char*)g.A + (size_t)nxt.pm * tstep : cA; const char* nB = has_next ? (const char*)g.Bt + (size_t)nxt.pn * tstep : cB;
        for (int t = 0; t < nt; t += 2) {
            const bool last = (t == nt - 2);
            const char* a1 = cA + (size_t)(t + 1) * kstep;
            const char* a2 = last ? nA : cA + (size_t)(t + 2) * kstep; const char* b2 = last ? nB : cB + (size_t)(t + 2) * kstep;
            const char* a3 = a2 + kstep; const char* b3 = b2 + kstep;
            if (last && has_next) S.a_ready(nxt);
            if constexpr (SP2) {
            PG8_LDB(B0, 0, 0); PG8_LDB(B1, 0, 1); PG8_SCHED; PG8_LDA(At, 0, 0); PG8_STAGE(PG8_SA(1, 1), a1 + hstep, voffA);
            PG8_WAIT_V(8); PG8_WAIT_L(0); PG8_BAR; PG8_MMA(0, 0, At, B0); PG8_MMA(0, 1, At, B1); PG8_BAR; PG8_SCHED;
            PG8_LDA(At, 0, 1); PG8_STAGE(PG8_SB(0, 0), b2, voffB); PG8_STAGE(PG8_SB(0, 1), b2 + hstep, voffB); PG8_STAGE(PG8_SA(0, 0), a2, voffA);
            PG8_WAIT_V(8); PG8_WAIT_L(0); PG8_BAR; PG8_MMA(1, 0, At, B0); PG8_MMA(1, 1, At, B1); PG8_BAR; PG8_SCHED;
            PG8_LDB(B0, 1, 0); PG8_LDB(B1, 1, 1); PG8_SCHED; PG8_LDA(At, 1, 0); PG8_STAGE(PG8_SA(0, 1), a2 + hstep, voffA);
            PG8_WAIT_V(8); PG8_WAIT_L(0); PG8_BAR; PG8_MMA(0, 0, At, B0); PG8_MMA(0, 1, At, B1); PG8_BAR; PG8_SCHED;
            PG8_LDA(At, 1, 1); PG8_STAGE(PG8_SB(1, 0), b3, voffB); PG8_STAGE(PG8_SB(1, 1), b3 + hstep, voffB); PG8_STAGE(PG8_SA(1, 0), a3, voffA);
            PG8_WAIT_V(8); PG8_WAIT_L(0); PG8_BAR; PG8_MMA(1, 0, At, B0); PG8_MMA(1, 1, At, B1); PG8_BAR; PG8_SCHED;
            } else {
            PG8_LDB(B0, 0, 0); PG8_SCHED; PG8_LDA(At, 0, 0); PG8_STAGE(PG8_SA(1, 1), a1 + hstep, voffA);
            PG8_WAIT_L(8); PG8_BAR; PG8_WAIT_L(0); PG8_MMA(0, 0, At, B0); PG8_BAR; PG8_SCHED;
            PG8_LDB(B1, 0, 1); PG8_STAGE(PG8_SB(0, 0), b2, voffB);
            PG8_BAR; PG8_WAIT_L(0); PG8_MMA(0, 1, At, B1); PG8_BAR;
            PG8_LDA(At, 0, 1); PG8_STAGE(PG8_SA(0, 0), a2, voffA);
            PG8_BAR; PG8_WAIT_L(0); PG8_MMA(1, 0, At, B0); PG8_BAR; PG8_SCHED;
            PG8_STAGE(PG8_SB(0, 1), b2 + hstep, voffB);
            PG8_WAIT_V(6); PG8_BAR; PG8_MMA(1, 1, At, B1); PG8_BAR;
            PG8_LDB(B0, 1, 0); PG8_SCHED; PG8_LDA(At, 1, 0); PG8_STAGE(PG8_SA(0, 1), a2 + hstep, voffA);
            PG8_WAIT_L(8); PG8_BAR; PG8_WAIT_L(0); PG8_MMA(0, 0, At, B0); PG8_BAR; PG8_SCHED;
            PG8_LDB(B1, 1, 1); PG8_STAGE(PG8_SB(1, 0), b3, voffB);
            PG8_BAR; PG8_WAIT_L(0); PG8_MMA(0, 1, At, B1); PG8_BAR;
            PG8_LDA(At, 1, 1); PG8_STAGE(PG8_SA(1, 0), a3, voffA);
            PG8_BAR; PG8_WAIT_L(0); PG8_MMA(1, 0, At, B0); PG8_BAR; PG8_SCHED;
            PG8_STAGE(PG8_SB(1, 1), b3 + hstep, voffB);
            PG8_WAIT_V(6); PG8_BAR; PG8_MMA(1, 1, At, B1); PG8_BAR;
            }
        }
        if constexpr (ALIGN_EPI) { if (wr == 0) PG8_BAR; }
        if constexpr (!Epi::AFTER_DRAIN) { E(acc, cur, wr, wc, fr, fq); S.done(cur); }
        if (!has_next) break;
#pragma unroll
        for (int a = 0; a < 2; ++a)
#pragma unroll
            for (int b = 0; b < 2; ++b)
#pragma unroll
                for (int m = 0; m < 4; ++m)
#pragma unroll
                    for (int n = 0; n < 2; ++n) acc[a][b][m][n] = (f32x4){0.f, 0.f, 0.f, 0.f};
        cur = nxt; cA = nA; cB = nB; ++ui;
        if constexpr (ALIGN_EPI) { if (wr == 1) PG8_BAR; }
    }
    PG8_WAIT_V(0);
    if constexpr (!ALIGN_EPI) { if (wr == 0) PG8_BAR; }
    PG8_BAR;
    if constexpr (Epi::AFTER_DRAIN) { E.fused(acc, cur, wr, wc, fr, fq, lds, wid, lane); S.done(cur); }
#undef PG8_SA
#undef PG8_SB
#undef PG8_STAGE
#undef PG8_LDA
#undef PG8_LDB
#undef PG8_MMA
#undef PG8_WAIT_V
#undef PG8_WAIT_L
#undef PG8_BAR
#undef PG8_SCHED
}
}

typedef unsigned short bf16_t;
typedef unsigned u32x4 __attribute__((ext_vector_type(4)));
typedef unsigned u32x2 __attribute__((ext_vector_type(2)));
typedef float f32x4 __attribute__((ext_vector_type(4)));
#define LAS __attribute__((address_space(3)))

constexpr int NB = 8, SEQ = 4096, M = NB * SEQ, DM = 1024, NP = 3072, FF = 2816, NGU = 2 * FF, INC = 2956;
constexpr int C_QA = 0, C_KCA = 256, C_VCA = 320, C_KSA = 384, C_VSA = 448, C_KWA = 512, C_VWA = 576, C_CVB = 640, C_CVC = 896, C_CVU = 1152,
              C_QC = 1408, C_KC = 1664, C_VC = 1920, C_QD = 2176, C_KD = 2432, C_VD = 2688, C_GT = 2944;
constexpr float EPS = 1e-6f;
constexpr size_t MiB = 1u << 20;
constexpr size_t WS_SS = 0, WS_KCN = 1 * MiB, WS_VCC = 1 * MiB + 512 * 1024, WS_W = 2 * MiB;
constexpr size_t W_IN = 0, W_OUT = 6 * MiB, W_GU = 8 * MiB, W_DN = 19 * MiB, W_LAYER = 24 * MiB + 512 * 1024;
constexpr size_t WS_XB = 52 * MiB, WS_GR = 116 * MiB, WS_PROJ = 180 * MiB, WS_X1 = 372 * MiB, WS_W1T = 500 * MiB, WS_W2T = 504 * MiB, WS_CB = 504 * MiB + 256 * 1024, WS_BAR = 504 * MiB + 512 * 1024, WS_END = 505 * MiB;
constexpr size_t DO_PO = 0, DO_LSE = 48 * MiB;
constexpr int LDS_BYTES = 143360;

struct Params { const float* in[23]; float* out; unsigned char* ws; };

__device__ __forceinline__ float blo(unsigned u) { return __uint_as_float(u << 16); }
__device__ __forceinline__ float bhi(unsigned u) { return __uint_as_float(u & 0xffff0000u); }
__device__ __forceinline__ float bf2f(bf16_t h) { return __uint_as_float((unsigned)h << 16); }
typedef float pk_f32x2_t __attribute__((ext_vector_type(2))); typedef __bf16 pk_bf16x2_t __attribute__((ext_vector_type(2)));
__device__ __forceinline__ unsigned pk2(float lo, float hi) { pk_f32x2_t v = {lo, hi}; pk_bf16x2_t b = __builtin_convertvector(v, pk_bf16x2_t); return __builtin_bit_cast(unsigned, b); }
template <int K> __device__ __forceinline__ unsigned swz_u(unsigned v) { return (unsigned)__builtin_amdgcn_ds_swizzle((int)v, (K << 10) | 0x1f); }
template <int K> __device__ __forceinline__ float swz_f(float v) { return __uint_as_float(swz_u<K>(__float_as_uint(v))); }
__device__ __forceinline__ float sum32(float v) { auto rr = __builtin_amdgcn_permlane32_swap(__float_as_uint(v), __float_as_uint(v), false, false); return __uint_as_float(rr[0]) + __uint_as_float(rr[1]); }
__device__ __forceinline__ float max32(float v) { auto rr = __builtin_amdgcn_permlane32_swap(__float_as_uint(v), __float_as_uint(v), false, false); return fmaxf(__uint_as_float(rr[0]), __uint_as_float(rr[1])); }
__device__ __forceinline__ unsigned or32(unsigned v) { auto rr = __builtin_amdgcn_permlane32_swap(v, v, false, false); return rr[0] | rr[1]; }
__device__ __forceinline__ float partner32(float v, int hh) { auto rr = __builtin_amdgcn_permlane32_swap(__float_as_uint(v), __float_as_uint(v), false, false); return __uint_as_float(hh ? rr[0] : rr[1]); }
__device__ __forceinline__ float wave_sum(float v) {
    v += swz_f<1>(v); v += swz_f<2>(v); v += swz_f<4>(v); v += swz_f<8>(v); v += swz_f<16>(v); return sum32(v);
}
#define LDS_WAIT() asm volatile("s_waitcnt lgkmcnt(0)" ::: "memory")
#define CFENCE() asm volatile("" ::: "memory")

struct EpiProj {
    static constexpr bool PERM = true, AFTER_DRAIN = false;
    bf16_t* O; const float* ss;
    __device__ __forceinline__ void operator()(const pg8::f32x4 (&acc)[2][2][4][2], const pg8::Unit& u, int wr, int wc, int fr, int fq) const {
        const int row0 = u.pm * 256 + wr * 64 + fr, col0 = u.pn * 256 + wc * 32 + 8 * fq;
#pragma unroll
        for (int ai = 0; ai < 2; ++ai)
#pragma unroll
            for (int m = 0; m < 4; ++m) {
                const int row = row0 + ai * 128 + m * 16; const float rs = __builtin_amdgcn_rsqf(ss[row] * (1.f / DM) + EPS);
                bf16_t* rowp = O + (size_t)row * NP + col0;
#pragma unroll
                for (int bj = 0; bj < 2; ++bj) { const pg8::f32x4 v0 = acc[ai][bj][m][0] * rs, v1 = acc[ai][bj][m][1] * rs;
                    u32x4 w; w.x = pk2(v0[0], v0[1]); w.y = pk2(v0[2], v0[3]); w.z = pk2(v1[0], v1[1]); w.w = pk2(v1[2], v1[3]);
                    *(u32x4*)(rowp + bj * 128) = w; }
            }
    }
};
struct EpiSwiGLU {
    static constexpr bool PERM = true, AFTER_DRAIN = false;
    bf16_t* H; const float* ss;
    __device__ __forceinline__ void operator()(const pg8::f32x4 (&acc)[2][2][4][2], const pg8::Unit& u, int wr, int wc, int fr, int fq) const {
        const int row0 = u.pm * 256 + wr * 64 + fr, col0 = u.pn * 128 + wc * 32 + 8 * fq;
#pragma unroll
        for (int ai = 0; ai < 2; ++ai)
#pragma unroll
            for (int m = 0; m < 4; ++m) {
                const int row = row0 + ai * 128 + m * 16; const float rs = __builtin_amdgcn_rsqf(ss[row] * (1.f / DM) + EPS), rs2 = rs * rs, nrs = rs * -1.4426950408889634f;
                float hv[8];
#pragma unroll
                for (int n = 0; n < 2; ++n)
#pragma unroll
                    for (int j = 0; j < 4; ++j) { const float ga = acc[ai][0][m][n][j], ua = acc[ai][1][m][n][j];
                        hv[4 * n + j] = (ga * ua) * (rs2 * __builtin_amdgcn_rcpf(1.f + __builtin_amdgcn_exp2f(ga * nrs))); }
                u32x4 w; w.x = pk2(hv[0], hv[1]); w.y = pk2(hv[2], hv[3]); w.z = pk2(hv[4], hv[5]); w.w = pk2(hv[6], hv[7]);
                *(u32x4*)(H + (size_t)row * FF + col0) = w;
            }
    }
};
struct EpiResid {
    static constexpr bool PERM = true, AFTER_DRAIN = false;
    const float* xin; const bf16_t* xin_b; float* xout; bf16_t* xb; float* ss;
    __device__ __forceinline__ void operator()(const pg8::f32x4 (&acc)[2][2][4][2], const pg8::Unit& u, int wr, int wc, int fr, int fq) const {
        const int row0 = u.pm * 256 + wr * 64 + fr, col0 = u.pn * 256 + wc * 32 + 8 * fq;
#pragma unroll
        for (int ai = 0; ai < 2; ++ai)
#pragma unroll
            for (int m = 0; m < 4; ++m) {
                const int row = row0 + ai * 128 + m * 16; const size_t off = (size_t)row * DM + col0; float sq = 0.f;
#pragma unroll
                for (int bj = 0; bj < 2; ++bj) { const size_t o = off + bj * 128; f32x4 xa, xc;
                    if (xin) { xa = *(const f32x4*)(xin + o); xc = *(const f32x4*)(xin + o + 4); }
                    else { const u32x4 r4 = *(const u32x4*)(xin_b + o); xa[0] = blo(r4.x); xa[1] = bhi(r4.x); xa[2] = blo(r4.y); xa[3] = bhi(r4.y); xc[0] = blo(r4.z); xc[1] = bhi(r4.z); xc[2] = blo(r4.w); xc[3] = bhi(r4.w); }
                    f32x4 va, vc;
                    va[0] = xa[0] + acc[ai][bj][m][0][0]; va[1] = xa[1] + acc[ai][bj][m][0][1]; va[2] = xa[2] + acc[ai][bj][m][0][2]; va[3] = xa[3] + acc[ai][bj][m][0][3];
                    vc[0] = xc[0] + acc[ai][bj][m][1][0]; vc[1] = xc[1] + acc[ai][bj][m][1][1]; vc[2] = xc[2] + acc[ai][bj][m][1][2]; vc[3] = xc[3] + acc[ai][bj][m][1][3];
                    if (xout) { *(f32x4*)(xout + o) = va; *(f32x4*)(xout + o + 4) = vc; }
                    if (xb) { u32x4 w; w.x = pk2(va[0], va[1]); w.y = pk2(va[2], va[3]); w.z = pk2(vc[0], vc[1]); w.w = pk2(vc[2], vc[3]); *(u32x4*)(xb + o) = w; }
                    sq += ((va[0] * va[0] + va[1] * va[1]) + (va[2] * va[2] + va[3] * va[3])) + ((vc[0] * vc[0] + vc[1] * vc[1]) + (vc[2] * vc[2] + vc[3] * vc[3])); }
                if (ss) { sq += swz_f<16>(sq); sq = sum32(sq); if (fq == 0) atomicAdd(ss + row, sq); }
            }
    }
};

#ifndef REP_PW
#define REP_PW 1
#endif
#ifndef REP_PC
#define REP_PC 1
#endif
#ifndef REP_PX
#define REP_PX 1
#endif
template <int MAP> __device__ __forceinline__ int dst_row(int c) {
    if (MAP == 0) return c < 640 ? c : (c < 652 ? 2944 + (c - 640) : c - 12);
    if (MAP == 1) return c;
    if (MAP == 2) return 256 * (c >> 7) + (c & 127);
    return 256 * (c >> 7) + 128 + (c & 127);
}
template <int MAP> __device__ __forceinline__ void transpose_item(const float* W, int K, int N, const float* gk, bf16_t* WT, LAS float* scr, int item, int lane) {
    const int nblk = (N + 63) / 64, kb = item / nblk, nb = item % nblk, k0 = 64 * kb, n0 = 64 * nb;
    const int nn = n0 + lane; const bool okn = nn < N;
#pragma unroll
    for (int i = 0; i < 64; ++i) { float v = okn ? W[(size_t)(k0 + i) * N + nn] : 0.f; if (gk) v *= gk[k0 + i]; scr[i * 65 + lane] = v; }
    LDS_WAIT();
    const int c = lane & 7;
#pragma unroll
    for (int j = 0; j < 8; ++j) { const int n = (lane >> 3) + 8 * j; const LAS float* s = scr + (8 * c) * 65 + n;
        if (n0 + n < N) { u32x4 o; o.x = pk2(s[0 * 65], s[1 * 65]); o.y = pk2(s[2 * 65], s[3 * 65]); o.z = pk2(s[4 * 65], s[5 * 65]); o.w = pk2(s[6 * 65], s[7 * 65]);
            if (MAP == 4) { const int nn2 = n0 + n, kk2 = k0 + 8 * c; *(u32x4*)(WT + ((size_t)(((nn2 >> 5) * (K >> 4) + (kk2 >> 4)) * 64 + ((kk2 >> 3) & 1) * 32 + (nn2 & 31)) * 8)) = o; }
            else *(u32x4*)(WT + (size_t)dst_row<MAP>(n0 + n) * K + k0 + 8 * c) = o; } }
    LDS_WAIT();
}
__device__ __forceinline__ void prologue(const Params& p, LAS unsigned char* lds, int gw, int NGW, int wave, int lane) {
    LAS float* scr = (LAS float*)(lds + wave * 16640);
    constexpr int I_IN = 16 * 47, I_OUT = 16 * 16, I_G = 16 * 44, I_DN = 44 * 16, I_L = I_IN + I_OUT + 2 * I_G + I_DN, I_Z = 116;
    for (int rw_ = 0; rw_ < REP_PW; ++rw_)
    for (int it = gw; it < 2 * (I_L + I_Z); it += NGW) {
        const int l = it / (I_L + I_Z); int r = it % (I_L + I_Z);
        unsigned char* wl = p.ws + WS_W + (size_t)l * W_LAYER;
        if (r < I_IN) { transpose_item<0>(p.in[2] + (size_t)l * DM * INC, DM, INC, p.in[1] + l * DM, (bf16_t*)(wl + W_IN), scr, r, lane); continue; } r -= I_IN;
        if (r < I_OUT) { transpose_item<1>(p.in[18] + (size_t)l * DM * DM, DM, DM, nullptr, (bf16_t*)(wl + W_OUT), scr, r, lane); continue; } r -= I_OUT;
        if (r < I_G) { transpose_item<2>(p.in[20] + (size_t)l * DM * FF, DM, FF, p.in[19] + l * DM, (bf16_t*)(wl + W_GU), scr, r, lane); continue; } r -= I_G;
        if (r < I_G) { transpose_item<3>(p.in[21] + (size_t)l * DM * FF, DM, FF, p.in[19] + l * DM, (bf16_t*)(wl + W_GU), scr, r, lane); continue; } r -= I_G;
        if (r < I_DN) { transpose_item<1>(p.in[22] + (size_t)l * FF * DM, FF, DM, nullptr, (bf16_t*)(wl + W_DN), scr, r, lane); continue; } r -= I_DN;
        { u32x4 z = {0u, 0u, 0u, 0u}; u32x4* d = (u32x4*)((bf16_t*)(wl + W_IN) + (size_t)(INC + r) * DM) + lane * 2; d[0] = z; d[1] = z; }
    }
    for (int rc_ = 0; rc_ < REP_PC; ++rc_)
    for (int it = gw; it < 4 * (128 + 4 + 32); it += NGW) {
        const int mi = it / 164, r = it % 164, l = mi >> 1, kv = mi & 1;
        const float* w1 = p.in[kv ? 12 : 10] + (size_t)l * 2048 * 256; const float* w2 = p.in[kv ? 13 : 11] + (size_t)l * 256 * 64; const float* pe = p.in[kv ? 9 : 8] + l * 2048;
        if (r < 128) transpose_item<4>(w1, 2048, 256, nullptr, (bf16_t*)(p.ws + WS_W1T) + (size_t)mi * 256 * 2048, scr, r, lane);
        else if (r < 132) transpose_item<1>(w2, 256, 64, nullptr, (bf16_t*)(p.ws + WS_W2T) + (size_t)mi * 64 * 256, scr, r - 128, lane);
        else { const int c = (r - 132) * 8 + (lane & 7), rg = lane >> 3; float acc = 0.f;
#pragma unroll 32
            for (int i = rg * 256; i < rg * 256 + 256; ++i) acc += pe[i] * w1[(size_t)i * 256 + c];
            acc += swz_f<8>(acc); acc += swz_f<16>(acc); acc = sum32(acc);
            if (rg == 0) ((float*)(p.ws + WS_CB))[mi * 256 + c] = acc; }
    }
    float* ss = (float*)(p.ws + WS_SS); bf16_t* xb = (bf16_t*)(p.ws + WS_XB);
    for (int rx_ = 0; rx_ < REP_PX; ++rx_)
    for (int m0 = gw; m0 < M; m0 += 4 * NGW) {
        f32x4 v[4][4];
#pragma unroll
        for (int rr = 0; rr < 4; ++rr) { const int m = m0 + rr * NGW; const f32x4* xr = (const f32x4*)(p.in[0] + (size_t)(m < M ? m : 0) * DM) + lane;
#pragma unroll
            for (int j = 0; j < 4; ++j) v[rr][j] = xr[64 * j]; }
#pragma unroll
        for (int rr = 0; rr < 4; ++rr) { const int m = m0 + rr * NGW; if (m < M) { u32x2* o8 = (u32x2*)(xb + (size_t)m * DM) + lane; float s = 0.f;
#pragma unroll
            for (int j = 0; j < 4; ++j) { const f32x4 t = v[rr][j]; s += (t[0] * t[0] + t[1] * t[1]) + (t[2] * t[2] + t[3] * t[3]); u32x2 w; w.x = pk2(t[0], t[1]); w.y = pk2(t[2], t[3]); o8[64 * j] = w; }
            s = wave_sum(s);
            if (lane == 0) { ss[m] = s; ss[M + m] = 0.f; ss[2 * M + m] = 0.f; ss[3 * M + m] = 0.f; } } }
    }
}

#define UNPACK8(v, k) const float k##0 = blo(v.x), k##1 = bhi(v.x), k##2 = blo(v.y), k##3 = bhi(v.y), k##4 = blo(v.z), k##5 = bhi(v.z), k##6 = blo(v.w), k##7 = bhi(v.w)
__device__ __forceinline__ void load_row64(float (&q)[64], const bf16_t* p) {
#pragma unroll
    for (int c = 0; c < 8; ++c) { const u32x4 v = *(const u32x4*)(p + 8 * c); UNPACK8(v, k);
        q[8 * c] = k0; q[8 * c + 1] = k1; q[8 * c + 2] = k2; q[8 * c + 3] = k3; q[8 * c + 4] = k4; q[8 * c + 5] = k5; q[8 * c + 6] = k6; q[8 * c + 7] = k7; }
}
template <bool SS> __device__ __forceinline__ float dot_row(const float (&q)[64], const bf16_t* p, float& kss) {
    float z = 0.f, s = 0.f;
#pragma unroll
    for (int c = 0; c < 8; ++c) { const u32x4 v = *(const u32x4*)(p + 8 * c); UNPACK8(v, k);
        z += (q[8 * c] * k0 + q[8 * c + 1] * k1) + (q[8 * c + 2] * k2 + q[8 * c + 3] * k3) + (q[8 * c + 4] * k4 + q[8 * c + 5] * k5) + (q[8 * c + 6] * k6 + q[8 * c + 7] * k7);
        if (SS) s += (k0 * k0 + k1 * k1) + (k2 * k2 + k3 * k3) + (k4 * k4 + k5 * k5) + (k6 * k6 + k7 * k7);
        if (c == 3) CFENCE(); }
    kss = s; return z;
}
__device__ __forceinline__ void axpy_row(float (&o)[64], float w, const bf16_t* p) {
#pragma unroll
    for (int c = 0; c < 8; ++c) { const u32x4 v = *(const u32x4*)(p + 8 * c); UNPACK8(v, k);
        o[8 * c] += w * k0; o[8 * c + 1] += w * k1; o[8 * c + 2] += w * k2; o[8 * c + 3] += w * k3; o[8 * c + 4] += w * k4; o[8 * c + 5] += w * k5; o[8 * c + 6] += w * k6; o[8 * c + 7] += w * k7;
        if (c == 3) CFENCE(); }
}
__device__ __forceinline__ float dot_row_f32(const float (&q)[64], const float* p) {
    float z = 0.f;
#pragma unroll
    for (int c = 0; c < 16; ++c) { const f32x4 v = *(const f32x4*)(p + 4 * c); z += (q[4 * c] * v[0] + q[4 * c + 1] * v[1]) + (q[4 * c + 2] * v[2] + q[4 * c + 3] * v[3]); if (c == 7) CFENCE(); }
    return z;
}
__device__ __forceinline__ void axpy_row_f32(float (&o)[64], float w, const float* p) {
#pragma unroll
    for (int c = 0; c < 16; ++c) { const f32x4 v = *(const f32x4*)(p + 4 * c); o[4 * c] += w * v[0]; o[4 * c + 1] += w * v[1]; o[4 * c + 2] += w * v[2]; o[4 * c + 3] += w * v[3]; if (c == 7) CFENCE(); }
}
__device__ __forceinline__ void store_group(const float (&o)[64], const float* g, bf16_t* dst) {
    float ss = 0.f;
#pragma unroll
    for (int d = 0; d < 64; ++d) ss += o[d] * o[d];
    const float rs = rsqrtf(ss * (1.f / 64.f) + EPS);
#pragma unroll
    for (int c = 0; c < 8; ++c) { u32x4 w;
        w.x = pk2(o[8 * c] * rs * g[8 * c], o[8 * c + 1] * rs * g[8 * c + 1]); w.y = pk2(o[8 * c + 2] * rs * g[8 * c + 2], o[8 * c + 3] * rs * g[8 * c + 3]);
        w.z = pk2(o[8 * c + 4] * rs * g[8 * c + 4], o[8 * c + 5] * rs * g[8 * c + 5]); w.w = pk2(o[8 * c + 6] * rs * g[8 * c + 6], o[8 * c + 7] * rs * g[8 * c + 7]);
        *(u32x4*)(dst + 8 * c) = w; }
}
__device__ __forceinline__ void load_q_norm(float (&q)[64], const bf16_t* p, const float* gq, const float* gx) {
    load_row64(q, p); float ss = 0.f;
#pragma unroll
    for (int d = 0; d < 64; ++d) ss += q[d] * q[d];
    const float rs = rsqrtf(ss * (1.f / 64.f) + EPS) * 0.125f;
#pragma unroll
    for (int d = 0; d < 64; ++d) q[d] = q[d] * rs * gq[d] * (gx ? gx[d] : 1.f);
}

__device__ __forceinline__ void stick_naive(const bf16_t* proj, bf16_t* groups, const float* g_out, int item, int lane) {
    const int tile = item & 63, h = (item >> 6) & 3, b = item >> 8, t = tile * 64 + lane;
    const bf16_t* base = proj + (size_t)b * SEQ * NP;
    float q[64]; load_row64(q, base + (size_t)t * NP + C_QC + h * 64);
#pragma unroll
    for (int d = 0; d < 64; ++d) q[d] *= 0.125f;
    float o[64];
#pragma unroll
    for (int d = 0; d < 64; ++d) o[d] = 0.f;
    float between = 0.f;
    for (int s = tile * 64 + 62; s >= 0; --s) {
        const bf16_t* kr = base + (size_t)s * NP + C_KC + h * 64; float dummy;
        const float z = dot_row<false>(q, kr, dummy); CFENCE();
        const bool act = s < t;
        const float sp = fmaxf(z, 0.f) + __logf(1.f + __expf(-fabsf(z)));
        const float w = act ? __expf((z - sp) - between) : 0.f;
        axpy_row(o, w, base + (size_t)s * NP + C_VC + h * 64); CFENCE();
        between += act ? sp : 0.f;
        if (s < tile * 64 && __all(between > 104.f)) break;
    }
    store_group(o, g_out + 512 + h * 64, groups + (size_t)(b * SEQ + t) * DM + 512 + h * 64);
}

__device__ __forceinline__ void dil_naive(const bf16_t* proj, bf16_t* groups, const float* gq, const float* gk, const float* g_out, int item, int lane) {
    const int tile = item & 63, h = (item >> 6) & 3, b = item >> 8, t = tile * 64 + lane;
    const bf16_t* base = proj + (size_t)b * SEQ * NP;
    float q[64]; load_q_norm(q, base + (size_t)t * NP + C_QD + h * 64, gq, gk);
    const float slope = exp2f(-(float)(2 * h + 2));
    float o[64];
#pragma unroll
    for (int d = 0; d < 64; ++d) o[d] = 0.f;
    float mx = -1e30f, l = 0.f;
    for (int cfg = 0; cfg < 3; ++cfg) {
        const int dil = cfg == 0 ? 1 : (cfg == 1 ? 4 : 16);
        for (int j = 0; j <= 128; ++j) {
            const int s = t - j * dil; const bool act = s >= 0;
            if (!__any(act)) break;
            if (act) {
                float kss; const float z = dot_row<true>(q, base + (size_t)s * NP + C_KD + h * 64, kss); CFENCE();
                const float sc = z * rsqrtf(kss * (1.f / 64.f) + EPS) - slope * (float)(j * dil);
                if (sc > mx) { const float corr = __expf(mx - sc); l *= corr;
#pragma unroll
                    for (int d = 0; d < 64; ++d) o[d] *= corr;
                    mx = sc; }
                const float pw = __expf(sc - mx); l += pw;
                axpy_row(o, pw, base + (size_t)s * NP + C_VD + h * 64); CFENCE();
            }
        }
    }
    const float inv = 1.f / l;
#pragma unroll
    for (int d = 0; d < 64; ++d) o[d] *= inv;
    store_group(o, g_out + 768 + h * 64, groups + (size_t)(b * SEQ + t) * DM + 768 + h * 64);
}

template <int NI> __device__ __forceinline__ void conv_items(const bf16_t* proj, bf16_t* groups, const float* cw, const float* g_out, int item0, int stride, int lane) {
    const int ch = (lane & 31) * 8;
    u32x4 cv[NI][3], uv[NI][3], bv[NI];
#pragma unroll
    for (int n = 0; n < NI; ++n) { const int token = (item0 + n * stride) * 2 + (lane >> 5), tpos = token & (SEQ - 1); const bf16_t* row = proj + (size_t)token * NP;
#pragma unroll
        for (int k = 0; k < 3; ++k) { const int back = 2 - k;
            if (tpos >= back) { cv[n][k] = *(const u32x4*)(row - (size_t)back * NP + C_CVC + ch); uv[n][k] = *(const u32x4*)(row - (size_t)back * NP + C_CVU + ch); }
            else { cv[n][k] = (u32x4){0u, 0u, 0u, 0u}; uv[n][k] = cv[n][k]; } }
        bv[n] = *(const u32x4*)(row + C_CVB + ch); }
    float wk[3][8];
#pragma unroll
    for (int k = 0; k < 3; ++k)
#pragma unroll
        for (int i = 0; i < 8; ++i) wk[k][i] = cw[k * 256 + ch + i];
    const float* go = g_out + 256 + ch;
#pragma unroll
    for (int n = 0; n < NI; ++n) { const int token = (item0 + n * stride) * 2 + (lane >> 5);
        float acc[8];
#pragma unroll
        for (int i = 0; i < 8; ++i) acc[i] = 0.f;
#pragma unroll
        for (int k = 0; k < 3; ++k) { UNPACK8(cv[n][k], c); UNPACK8(uv[n][k], u);
            acc[0] += wk[k][0] * (c0 * u0); acc[1] += wk[k][1] * (c1 * u1); acc[2] += wk[k][2] * (c2 * u2); acc[3] += wk[k][3] * (c3 * u3);
            acc[4] += wk[k][4] * (c4 * u4); acc[5] += wk[k][5] * (c5 * u5); acc[6] += wk[k][6] * (c6 * u6); acc[7] += wk[k][7] * (c7 * u7); }
        UNPACK8(bv[n], g);
        float y[8] = {g0 * acc[0], g1 * acc[1], g2 * acc[2], g3 * acc[3], g4 * acc[4], g5 * acc[5], g6 * acc[6], g7 * acc[7]};
        float ss = 0.f;
#pragma unroll
        for (int i = 0; i < 8; ++i) ss += y[i] * y[i];
        ss += swz_f<1>(ss); ss += swz_f<2>(ss); ss += swz_f<4>(ss);
        const float rs = rsqrtf(ss * (1.f / 64.f) + EPS);
        u32x4 w; w.x = pk2(y[0] * rs * go[0], y[1] * rs * go[1]); w.y = pk2(y[2] * rs * go[2], y[3] * rs * go[3]);
        w.z = pk2(y[4] * rs * go[4], y[5] * rs * go[5]); w.w = pk2(y[6] * rs * go[6], y[7] * rs * go[7]);
        *(u32x4*)(groups + (size_t)token * DM + 256 + ch) = w; }
}

typedef short bf16x8 __attribute__((ext_vector_type(8)));
typedef short s16x4 __attribute__((ext_vector_type(4)));
typedef float f32x16 __attribute__((ext_vector_type(16)));
typedef float f32x2_t __attribute__((ext_vector_type(2)));
typedef __bf16 bf16x2_t __attribute__((ext_vector_type(2)));
__device__ __forceinline__ unsigned cvtpk(float lo, float hi) { f32x2_t v = {lo, hi}; bf16x2_t b = __builtin_convertvector(v, bf16x2_t); return __builtin_bit_cast(unsigned, b); }
#define MFMA32(a, b, c) __builtin_amdgcn_mfma_f32_32x32x16_bf16((a), (b), (c), 0, 0, 0)
#define EXP2(x) __builtin_amdgcn_exp2f(x)
constexpr float LOG2E = 1.4426950408889634f;
constexpr int KSB = 144, VTB = 136, KS_BYTES = 64 * KSB, VT_BYTES = 64 * VTB;
__device__ __forceinline__ int crow(int i, int h) { return (i & 3) + 8 * (i >> 2) + 4 * h; }

struct KVSrc { const bf16_t* k; const bf16_t* v; long pitch; int first, lo, hi; };
__device__ __forceinline__ void kv_fetch(const KVSrc& s, int tid, u32x4& kc, u32x4& vc) {
    const int kl = tid >> 3, ch = tid & 7, i = s.first + kl;
    if (i >= s.lo && i < s.hi) { kc = *(const u32x4*)(s.k + (long)i * s.pitch + 8 * ch); vc = *(const u32x4*)(s.v + (long)i * s.pitch + 8 * ch); }
    else { kc = (u32x4){0u, 0u, 0u, 0u}; vc = kc; }
}
template <bool NORM> __device__ __forceinline__ void kv_store(u32x4 kc, u32x4 vc, const float (&g)[8], LAS unsigned char* ksb, LAS unsigned char* vtb, int tid) {
    const int kl = tid >> 3, ch = tid & 7;
    if (NORM) { UNPACK8(kc, k); float ss = (k0 * k0 + k1 * k1) + (k2 * k2 + k3 * k3) + (k4 * k4 + k5 * k5) + (k6 * k6 + k7 * k7);
        ss += swz_f<1>(ss); ss += swz_f<2>(ss); ss += swz_f<4>(ss);
        const float rs = rsqrtf(ss * (1.f / 64.f) + EPS);
        kc.x = cvtpk(k0 * rs * g[0], k1 * rs * g[1]); kc.y = cvtpk(k2 * rs * g[2], k3 * rs * g[3]); kc.z = cvtpk(k4 * rs * g[4], k5 * rs * g[5]); kc.w = cvtpk(k6 * rs * g[6], k7 * rs * g[7]); }
    *(LAS u32x4*)(ksb + kl * KSB + ch * 16) = kc;
    LAS unsigned short* vp = (LAS unsigned short*)(vtb + (8 * ch) * VTB + kl * 2);
    vp[0 * (VTB / 2)] = (unsigned short)(vc.x & 0xffffu); vp[1 * (VTB / 2)] = (unsigned short)(vc.x >> 16);
    vp[2 * (VTB / 2)] = (unsigned short)(vc.y & 0xffffu); vp[3 * (VTB / 2)] = (unsigned short)(vc.y >> 16);
    vp[4 * (VTB / 2)] = (unsigned short)(vc.z & 0xffffu); vp[5 * (VTB / 2)] = (unsigned short)(vc.z >> 16);
    vp[6 * (VTB / 2)] = (unsigned short)(vc.w & 0xffffu); vp[7 * (VTB / 2)] = (unsigned short)(vc.w >> 16);
}
template <bool NORM> __device__ __forceinline__ void load_qfrag(bf16x8 (&qf)[4], const bf16_t* qrow, const float* g1, const float* g2, float sc, int hh) {
    float f[32];
#pragma unroll
    for (int s = 0; s < 4; ++s) { const u32x4 v = *(const u32x4*)(qrow + 16 * s + 8 * hh); UNPACK8(v, k);
        f[8 * s] = k0; f[8 * s + 1] = k1; f[8 * s + 2] = k2; f[8 * s + 3] = k3; f[8 * s + 4] = k4; f[8 * s + 5] = k5; f[8 * s + 6] = k6; f[8 * s + 7] = k7; }
    if (NORM) { float ss = 0.f;
#pragma unroll
        for (int i = 0; i < 32; ++i) ss += f[i] * f[i];
        ss = sum32(ss); sc *= rsqrtf(ss * (1.f / 64.f) + EPS); }
#pragma unroll
    for (int s = 0; s < 4; ++s) { float v[8];
#pragma unroll
        for (int j = 0; j < 8; ++j) { const int d = 16 * s + 8 * hh + j; v[j] = f[8 * s + j] * sc * (g1 ? g1[d] : 1.f) * (g2 ? g2[d] : 1.f); }
        u32x4 w; w.x = cvtpk(v[0], v[1]); w.y = cvtpk(v[2], v[3]); w.z = cvtpk(v[4], v[5]); w.w = cvtpk(v[6], v[7]);
        qf[s] = __builtin_bit_cast(bf16x8, w); }
}

struct SfCmp { int tq, nvis, j0; float slope; __device__ __forceinline__ float operator()(float s, int kl) const { const int j = j0 + kl; return j < nvis ? s - slope * (float)(tq - 16 * j - 31) : -INFINITY; } };
struct SfSlc { int tq, key0; float slope; bool sel; __device__ __forceinline__ float operator()(float s, int kl) const { const int key = key0 + kl; return (sel && key <= tq) ? s - slope * (float)(tq - key) : -INFINITY; } };
struct SfWin { int tq, key0; float slope; __device__ __forceinline__ float operator()(float s, int kl) const { const int key = key0 + kl; return (key <= tq && tq - key <= 511) ? s - slope * (float)(tq - key) : -INFINITY; } };

__device__ __forceinline__ void pv_accum(const f32x16& s0, const f32x16& s1, f32x16& o0, f32x16& o1, LAS const unsigned char* vtb, int r, int hh) {
    __builtin_amdgcn_s_setprio(1);
#pragma unroll
    for (int kt = 0; kt < 2; ++kt)
#pragma unroll
        for (int sp = 0; sp < 2; ++sp) { u32x4 w;
            if (kt == 0) { w.x = cvtpk(s0[8 * sp], s0[8 * sp + 1]); w.y = cvtpk(s0[8 * sp + 2], s0[8 * sp + 3]); w.z = cvtpk(s0[8 * sp + 4], s0[8 * sp + 5]); w.w = cvtpk(s0[8 * sp + 6], s0[8 * sp + 7]); }
            else         { w.x = cvtpk(s1[8 * sp], s1[8 * sp + 1]); w.y = cvtpk(s1[8 * sp + 2], s1[8 * sp + 3]); w.z = cvtpk(s1[8 * sp + 4], s1[8 * sp + 5]); w.w = cvtpk(s1[8 * sp + 6], s1[8 * sp + 7]); }
            const bf16x8 pb = __builtin_bit_cast(bf16x8, w); const int ko = 32 * kt + 16 * sp + 4 * hh;
            { const s16x4 lo = *(LAS const s16x4*)(vtb + r * VTB + ko * 2), hi = *(LAS const s16x4*)(vtb + r * VTB + (ko + 8) * 2);
              o0 = MFMA32(__builtin_shufflevector(lo, hi, 0, 1, 2, 3, 4, 5, 6, 7), pb, o0); }
            { const s16x4 lo = *(LAS const s16x4*)(vtb + (32 + r) * VTB + ko * 2), hi = *(LAS const s16x4*)(vtb + (32 + r) * VTB + (ko + 8) * 2);
              o1 = MFMA32(__builtin_shufflevector(lo, hi, 0, 1, 2, 3, 4, 5, 6, 7), pb, o1); } }
    __builtin_amdgcn_s_setprio(0);
}
template <int MODE, class SF>
__device__ __forceinline__ void attn_block(const bf16x8 (&qf)[4], f32x16& o0, f32x16& o1, float& m, float& l, LAS const unsigned char* ksb, LAS const unsigned char* vtb, int r, int hh, const SF sf,
                                           float msafe_f, float inv_f, LAS float* imprw, int nbase, float& carry) {
    f32x16 s0, s1;
#pragma unroll
    for (int i = 0; i < 16; ++i) { s0[i] = 0.f; s1[i] = 0.f; }
    bf16x8 ka[4], kb2[4];
#pragma unroll
    for (int s = 0; s < 4; ++s) { ka[s] = *(LAS const bf16x8*)(ksb + r * KSB + (16 * s + 8 * hh) * 2); kb2[s] = *(LAS const bf16x8*)(ksb + (32 + r) * KSB + (16 * s + 8 * hh) * 2); }
    __builtin_amdgcn_s_setprio(1);
#pragma unroll
    for (int s = 0; s < 4; ++s) { s0 = MFMA32(ka[s], qf[s], s0); s1 = MFMA32(kb2[s], qf[s], s1); }
    __builtin_amdgcn_s_setprio(0);
    __builtin_amdgcn_sched_barrier(0);
#pragma unroll
    for (int i = 0; i < 16; ++i) { s0[i] = sf(s0[i], crow(i, hh)); s1[i] = sf(s1[i], 32 + crow(i, hh)); }
    if (MODE != 2) {
        float mloc = fmaxf(s0[0], s1[0]);
#pragma unroll
        for (int i = 1; i < 16; ++i) mloc = fmaxf(mloc, fmaxf(s0[i], s1[i]));
        mloc = max32(mloc);
        const float mnew = fmaxf(m, mloc), msafe = mnew == -INFINITY ? 0.f : mnew, corr = EXP2(m - msafe);
        float psum = 0.f;
#pragma unroll
        for (int i = 0; i < 16; ++i) { s0[i] = EXP2(s0[i] - msafe); s1[i] = EXP2(s1[i] - msafe); psum += s0[i] + s1[i]; }
        psum = sum32(psum);
        l = l * corr + psum; m = mnew;
        if (MODE == 0 && !__all(corr == 1.f)) {
#pragma unroll
            for (int i = 0; i < 16; ++i) { o0[i] *= corr; o1[i] *= corr; } }
    } else {
#pragma unroll
        for (int i = 0; i < 16; ++i) { s0[i] = EXP2(s0[i] - msafe_f) * inv_f; s1[i] = EXP2(s1[i] - msafe_f) * inv_f; }
#pragma unroll
        for (int kt = 0; kt < 2; ++kt) { float A[4], T[4], R[4];
#pragma unroll
            for (int g = 0; g < 4; ++g) { const float p0 = kt ? s1[4 * g] : s0[4 * g], p1 = kt ? s1[4 * g + 1] : s0[4 * g + 1], p2 = kt ? s1[4 * g + 2] : s0[4 * g + 2], p3 = kt ? s1[4 * g + 3] : s0[4 * g + 3];
                A[g] = 2.f * ((p0 + p1) + p2) + p3; T[g] = p3; R[g] = partner32(p3, hh); }
#pragma unroll
            for (int g = 0; g < 4; ++g) { const float prev = hh ? R[g] : (g ? R[g - 1] : carry);
                imprw[nbase + 8 * kt + 2 * g + hh] = A[g] + prev; }
            carry = R[3]; (void)T; }
    }
    __builtin_amdgcn_sched_barrier(0);
    if (MODE != 1) pv_accum(s0, s1, o0, o1, vtb, r, hh);
}


__device__ __forceinline__ void attn_block_full(const bf16x8 (&qf)[4], f32x16& o0, f32x16& o1, float& m, float& l, LAS const unsigned char* ksb, LAS const unsigned char* vtb, int r, int hh, float b0, float sl) {
    f32x16 s0, s1;
#pragma unroll
    for (int i = 0; i < 16; ++i) { s0[i] = 0.f; s1[i] = 0.f; }
    bf16x8 ka[4], kb2[4];
#pragma unroll
    for (int s = 0; s < 4; ++s) { ka[s] = *(LAS const bf16x8*)(ksb + r * KSB + (16 * s + 8 * hh) * 2); kb2[s] = *(LAS const bf16x8*)(ksb + (32 + r) * KSB + (16 * s + 8 * hh) * 2); }
    __builtin_amdgcn_s_setprio(1);
#pragma unroll
    for (int s = 0; s < 4; ++s) { s0 = MFMA32(ka[s], qf[s], s0); s1 = MFMA32(kb2[s], qf[s], s1); }
    __builtin_amdgcn_s_setprio(0);
    __builtin_amdgcn_sched_barrier(0);
#pragma unroll
    for (int i = 0; i < 16; ++i) { const float c = (float)((i & 3) + 8 * (i >> 2)); s0[i] = fmaf(sl, c, s0[i]); s1[i] = fmaf(sl, c + 32.f, s1[i]); }
    float mloc = fmaxf(s0[0], s1[0]);
#pragma unroll
    for (int i = 1; i < 16; ++i) mloc = fmaxf(mloc, fmaxf(s0[i], s1[i]));
    mloc = max32(mloc + b0);
    const float mnew = fmaxf(m, mloc), msafe = mnew == -INFINITY ? 0.f : mnew, corr = EXP2(m - msafe), c0 = b0 - msafe;
    float psum = 0.f;
#pragma unroll
    for (int i = 0; i < 16; ++i) { s0[i] = EXP2(s0[i] + c0); s1[i] = EXP2(s1[i] + c0); psum += s0[i] + s1[i]; }
    psum = sum32(psum);
    l = l * corr + psum; m = mnew;
#pragma unroll
    for (int i = 0; i < 16; ++i) { o0[i] *= corr; o1[i] *= corr; }
    __builtin_amdgcn_sched_barrier(0);
    pv_accum(s0, s1, o0, o1, vtb, r, hh);
}

#define KV_PIPELINE(FIRST, NEXT, SRC, NORM, GAIN, ...) do { \
    __syncthreads(); \
    int nxt_ = (FIRST), par_ = 0; u32x4 kc_, vc_; float g8_[8]; \
    { const float* gp_ = (GAIN); _Pragma("unroll") for (int j_ = 0; j_ < 8; ++j_) g8_[j_] = gp_ ? gp_[8 * (tid & 7) + j_] : 1.f; } \
    if (nxt_ >= 0) { const int id = nxt_; const KVSrc src_ = SRC; kv_fetch(src_, tid, kc_, vc_); } \
    while (nxt_ >= 0) { const int cur_ = nxt_; \
        LAS unsigned char* ksb = lds + par_ * KS_BYTES; LAS unsigned char* vtb = lds + 2 * KS_BYTES + par_ * VT_BYTES; \
        kv_store<NORM>(kc_, vc_, g8_, ksb, vtb, tid); \
        __syncthreads(); \
        { const int cur = cur_; nxt_ = (NEXT); } \
        if (nxt_ >= 0) { const int id = nxt_; const KVSrc src_ = SRC; kv_fetch(src_, tid, kc_, vc_); } \
        { const int id = cur_; __VA_ARGS__; } \
        par_ ^= 1; } } while (0)


__device__ __forceinline__ void kv_store_pre(u32x4 kc, u32x4 vc, LAS unsigned char* ksb, LAS unsigned char* vtb, int tid) {
    *(LAS u32x4*)(ksb + (tid >> 3) * KSB + (tid & 7) * 16) = kc;
    LAS u32x2* vp = (LAS u32x2*)(vtb + (tid >> 3) * VTB + (tid & 7) * 16); u32x2 a = {vc.x, vc.y}, b2 = {vc.z, vc.w}; vp[0] = a; vp[1] = b2;
}
#define KV_PIPELINE_PRE(FIRST, NEXT, KTILE, VTILE, ...) do { \
    __syncthreads(); \
    int nxt_ = (FIRST), par_ = 0; u32x4 kc_, vc_; \
    if (nxt_ >= 0) { const int id = nxt_; kc_ = *(const u32x4*)((KTILE) + tid * 8); vc_ = *(const u32x4*)((VTILE) + tid * 8); } \
    while (nxt_ >= 0) { const int cur_ = nxt_; \
        LAS unsigned char* ksb = lds + par_ * KS_BYTES; LAS unsigned char* vtb = lds + 2 * KS_BYTES + par_ * VT_BYTES; \
        kv_store_pre(kc_, vc_, ksb, vtb, tid); \
        __syncthreads(); \
        { const int cur = cur_; nxt_ = (NEXT); } \
        if (nxt_ >= 0) { const int id = nxt_; kc_ = *(const u32x4*)((KTILE) + tid * 8); vc_ = *(const u32x4*)((VTILE) + tid * 8); } \
        { const int id = cur_; __VA_ARGS__; } \
        par_ ^= 1; } } while (0)

__device__ __forceinline__ void nsa_prep_item(const bf16_t* proj, bf16_t* kn, bf16_t* vtn, const float* g_ks, const float* g_kw, int item, LAS unsigned char* scr, int lane) {
    const int b = item >> 7, which = (item >> 6) & 1, n = item & 63, ch = lane & 7, row0 = lane >> 3;
    const bf16_t* src = proj + ((size_t)b * SEQ + 64 * n) * NP + (which ? C_KWA : C_KSA) + 8 * ch;
    const float* g = (which ? g_kw : g_ks) + 8 * ch;
    float gg[8];
#pragma unroll
    for (int i = 0; i < 8; ++i) gg[i] = g[i];
    u32x4 kc[8], vc[8];
#pragma unroll
    for (int j = 0; j < 8; ++j) { const bf16_t* rp = src + (size_t)(row0 + 8 * j) * NP; kc[j] = *(const u32x4*)rp; vc[j] = *(const u32x4*)(rp + 64); }
    bf16_t* kdst = kn + (((size_t)b * 2 + which) * SEQ + 64 * n) * 64 + 8 * ch;
#pragma unroll
    for (int j = 0; j < 8; ++j) { const int row = row0 + 8 * j; UNPACK8(kc[j], k);
        float ss = (k0 * k0 + k1 * k1) + (k2 * k2 + k3 * k3) + (k4 * k4 + k5 * k5) + (k6 * k6 + k7 * k7);
        ss += swz_f<1>(ss); ss += swz_f<2>(ss); ss += swz_f<4>(ss);
        const float rs = rsqrtf(ss * (1.f / 64.f) + EPS); u32x4 o;
        o.x = cvtpk(k0 * rs * gg[0], k1 * rs * gg[1]); o.y = cvtpk(k2 * rs * gg[2], k3 * rs * gg[3]); o.z = cvtpk(k4 * rs * gg[4], k5 * rs * gg[5]); o.w = cvtpk(k6 * rs * gg[6], k7 * rs * gg[7]);
        *(u32x4*)(kdst + (size_t)row * 64) = o;
        LAS unsigned short* vp = (LAS unsigned short*)(scr + (8 * ch) * 144 + row * 2); const u32x4 v = vc[j];
        vp[0 * 72] = (unsigned short)(v.x & 0xffffu); vp[1 * 72] = (unsigned short)(v.x >> 16); vp[2 * 72] = (unsigned short)(v.y & 0xffffu); vp[3 * 72] = (unsigned short)(v.y >> 16);
        vp[4 * 72] = (unsigned short)(v.z & 0xffffu); vp[5 * 72] = (unsigned short)(v.z >> 16); vp[6 * 72] = (unsigned short)(v.w & 0xffffu); vp[7 * 72] = (unsigned short)(v.w >> 16); }
    LDS_WAIT();
    bf16_t* vdst = vtn + ((((size_t)b * 2 + which) * 64 + n) * 64 + lane) * 64;
#pragma unroll
    for (int c = 0; c < 8; ++c) *(u32x4*)(vdst + 8 * c) = *(LAS const u32x4*)(scr + lane * 144 + 16 * c);
    LDS_WAIT();
}

struct NsaArgs { const bf16_t* proj; bf16_t* groups; const bf16_t *kcn, *vcc; const float *b_gate, *g_q, *g_ks, *g_kw, *g_out; const bf16_t *kn, *vtn; };
constexpr int NSA_SLAB = 2 * KS_BYTES + 2 * VT_BYTES, NSA_ISUM = NSA_SLAB + 4 * 64 * 65 * 4, NSA_MASK = NSA_ISUM + 64 * 65 * 4, NSA_UMASK = NSA_MASK + 512;
__device__ __forceinline__ void nsa_item(const NsaArgs& A, int b, int tl, LAS unsigned char* lds, int tid) {
    asm volatile("" : "+v"(tid));
    const int lane = tid & 63, w = __builtin_amdgcn_readfirstlane(tid >> 6), head = w & 3, half = w >> 2, r = lane & 31, hh = lane >> 5;
    const int tq = tl * 64 + 32 * half + r, tokl = 32 * half + r; const size_t token = (size_t)b * SEQ + tq;
    const bf16_t* base = A.proj + (size_t)b * SEQ * NP;
    LAS float* slab = (LAS float*)(lds + NSA_SLAB); LAS float* isum = (LAS float*)(lds + NSA_ISUM);
    LAS unsigned* masks = (LAS unsigned*)(lds + NSA_MASK); LAS unsigned* umask = (LAS unsigned*)(lds + NSA_UMASK);
    const float slope = exp2f(-(float)(2 * head + 1)) * LOG2E;
    bf16x8 qf[4]; load_qfrag<true>(qf, base + (size_t)tq * NP + C_QA + head * 64, A.g_q, nullptr, 0.125f * LOG2E, hh);
    float gl[3];
#pragma unroll
    for (int br = 0; br < 3; ++br) { const float x = bf2f(base[(size_t)tq * NP + C_GT + head * 3 + br]) + A.b_gate[head * 3 + br]; gl[br] = 1.f / (1.f + __expf(-x)); }
    f32x16 of0, of1, o0, o1;
#pragma unroll
    for (int i = 0; i < 16; ++i) { of0[i] = 0.f; of1[i] = 0.f; }
    float dummy = 0.f;
    {
        const int nbc = (tl >> 4) + 1, nvis = tq >= 31 ? ((tq - 31) >> 4) + 1 : 0;
        const bf16_t* kc = A.kcn + (size_t)b * 256 * 64; const bf16_t* vc = A.vcc + (size_t)b * 256 * 64;
        float m = -INFINITY, l = 0.f;
        KV_PIPELINE_PRE(0, (cur + 1 < nbc ? cur + 1 : -1), kc + (size_t)id * 4096, vc + (size_t)id * 4096,
            { const SfCmp sf{tq, nvis, 64 * id, slope}; attn_block<1>(qf, o0, o1, m, l, ksb, vtb, r, hh, sf, 0.f, 0.f, nullptr, 0, dummy); });
        const float inv = l > 0.f ? 1.f / l : 0.f, msafe = m == -INFINITY ? 0.f : m; float carry = 0.f;
#pragma unroll
        for (int i = 0; i < 16; ++i) { o0[i] = 0.f; o1[i] = 0.f; }
        LAS float* imprw = slab + (head * 64 + tokl) * 65;
        KV_PIPELINE_PRE(0, (cur + 1 < nbc ? cur + 1 : -1), kc + (size_t)id * 4096, vc + (size_t)id * 4096,
            { const SfCmp sf{tq, nvis, 64 * id, slope}; attn_block<2>(qf, o0, o1, m, l, ksb, vtb, r, hh, sf, msafe, inv, imprw, 16 * id, carry); });
#pragma unroll
        for (int i = 0; i < 16; ++i) { of0[i] += gl[0] * o0[i]; of1[i] += gl[0] * o1[i]; }
    }
    __syncthreads();
    if (tl > 15) {
        for (int e = tid; e < 64 * 64; e += 512) { const int tk = e >> 6, n = e & 63, o = tk * 65 + n; isum[o] = ((slab[o] + slab[64 * 65 + o]) + slab[2 * 64 * 65 + o]) + slab[3 * 64 * 65 + o]; }
        __syncthreads();
        const int tk = tid >> 3, sub = tid & 7; float v[8]; int cnt[8];
#pragma unroll
        for (int k = 0; k < 8; ++k) { v[k] = isum[tk * 65 + 8 * sub + k]; cnt[k] = 0; }
        for (int mm = 1; mm <= tl - 2; ++mm) { const float vm = isum[tk * 65 + mm];
#pragma unroll
            for (int k = 0; k < 8; ++k) cnt[k] += (vm > v[k] || (vm == v[k] && mm < 8 * sub + k)) ? 1 : 0; }
        unsigned bits = 0u;
#pragma unroll
        for (int k = 0; k < 8; ++k) { const int n = 8 * sub + k; if (n >= 1 && n <= tl - 2 && cnt[k] < 13) bits |= 1u << k; }
        unsigned lo = sub < 4 ? bits << (8 * sub) : 0u, hi = sub >= 4 ? bits << (8 * (sub - 4)) : 0u;
        lo |= swz_u<1>(lo); hi |= swz_u<1>(hi); lo |= swz_u<2>(lo); hi |= swz_u<2>(hi); lo |= swz_u<4>(lo); hi |= swz_u<4>(hi);
        const unsigned long long mk = ((unsigned long long)hi << 32 | lo) | 1ull | (3ull << (tl - 1));
        if (sub == 0) { masks[2 * tk] = (unsigned)mk; masks[2 * tk + 1] = (unsigned)(mk >> 32); }
    } else if (tid < 64) { const unsigned long long mk = (2ull << tl) - 1ull; masks[2 * tid] = (unsigned)mk; masks[2 * tid + 1] = (unsigned)(mk >> 32); }
    __syncthreads();
    if (tid < 64) { unsigned lo = masks[2 * tid], hi = masks[2 * tid + 1];
        lo |= swz_u<1>(lo); hi |= swz_u<1>(hi); lo |= swz_u<2>(lo); hi |= swz_u<2>(hi); lo |= swz_u<4>(lo); hi |= swz_u<4>(hi);
        lo |= swz_u<8>(lo); hi |= swz_u<8>(hi); lo |= swz_u<16>(lo); hi |= swz_u<16>(hi); lo = or32(lo); hi = or32(hi);
        if (tid == 0) { umask[0] = lo; umask[1] = hi; } }
    __syncthreads();
    const unsigned long long um = (unsigned long long)umask[1] << 32 | umask[0];
    const unsigned long long mymask = (unsigned long long)masks[2 * tokl + 1] << 32 | masks[2 * tokl];
    LAS float* park = slab + w * 2048 + lane;
#pragma unroll
    for (int i = 0; i < 16; ++i) { park[i * 64] = of0[i]; park[(16 + i) * 64] = of1[i]; }
    {
        float m = -INFINITY, l = 0.f;
#pragma unroll
        for (int i = 0; i < 16; ++i) { o0[i] = 0.f; o1[i] = 0.f; }
        const bf16_t* kp = A.kn + (size_t)(b * 2) * SEQ * 64; const bf16_t* vp = A.vtn + (size_t)(b * 2) * 64 * 4096;
#define NSA_NEXTBIT(c) ({ const unsigned long long rem_ = ((c) >= 63) ? 0ull : (um & ~((2ull << (c)) - 1ull)); rem_ ? (int)__builtin_ctzll(rem_) : -1; })
        KV_PIPELINE_PRE((int)__builtin_ctzll(um), NSA_NEXTBIT(cur), kp + (size_t)id * 4096, vp + (size_t)id * 4096,
            { const bool sel = (mymask >> id) & 1ull;
              if (__any(sel)) {
                  if (id < tl) attn_block_full(qf, o0, o1, m, l, ksb, vtb, r, hh, sel ? -slope * (float)(tq - 64 * id - 4 * hh) : -INFINITY, slope);
                  else { const SfSlc sf{tq, 64 * id, slope, sel}; attn_block<0>(qf, o0, o1, m, l, ksb, vtb, r, hh, sf, 0.f, 0.f, nullptr, 0, dummy); } } });
        const float sc = gl[1] / l;
#pragma unroll
        for (int i = 0; i < 16; ++i) { park[i * 64] += sc * o0[i]; park[(16 + i) * 64] += sc * o1[i]; }
    }
    {
        float m = -INFINITY, l = 0.f;
#pragma unroll
        for (int i = 0; i < 16; ++i) { o0[i] = 0.f; o1[i] = 0.f; }
        const bf16_t* kp = A.kn + (size_t)(b * 2 + 1) * SEQ * 64; const bf16_t* vp = A.vtn + (size_t)(b * 2 + 1) * 64 * 4096; const int nlo = tl >= 8 ? tl - 8 : 0;
        KV_PIPELINE_PRE(nlo, (cur + 1 <= tl ? cur + 1 : -1), kp + (size_t)id * 4096, vp + (size_t)id * 4096,
            { if (id < tl && id >= tl - 7) attn_block_full(qf, o0, o1, m, l, ksb, vtb, r, hh, -slope * (float)(tq - 64 * id - 4 * hh), slope);
              else { const SfWin sf{tq, 64 * id, slope}; attn_block<0>(qf, o0, o1, m, l, ksb, vtb, r, hh, sf, 0.f, 0.f, nullptr, 0, dummy); } });
        const float sc = gl[2] / l;
#pragma unroll
        for (int i = 0; i < 16; ++i) { of0[i] = park[i * 64] + sc * o0[i]; of1[i] = park[(16 + i) * 64] + sc * o1[i]; }
    }
    {
        float ss = 0.f;
#pragma unroll
        for (int i = 0; i < 16; ++i) ss += of0[i] * of0[i] + of1[i] * of1[i];
        ss = sum32(ss);
        const float rs = rsqrtf(ss * (1.f / 64.f) + EPS); const float* go = A.g_out + head * 64; bf16_t* dst = A.groups + token * DM + head * 64;
#pragma unroll
        for (int g = 0; g < 4; ++g) { const int d0 = 8 * g + 4 * hh;
            u32x2 wa; wa.x = cvtpk(of0[4 * g] * rs * go[d0], of0[4 * g + 1] * rs * go[d0 + 1]); wa.y = cvtpk(of0[4 * g + 2] * rs * go[d0 + 2], of0[4 * g + 3] * rs * go[d0 + 3]);
            *(u32x2*)(dst + d0) = wa;
            u32x2 wb; wb.x = cvtpk(of1[4 * g] * rs * go[32 + d0], of1[4 * g + 1] * rs * go[32 + d0 + 1]); wb.y = cvtpk(of1[4 * g + 2] * rs * go[32 + d0 + 2], of1[4 * g + 3] * rs * go[32 + d0 + 3]);
            *(u32x2*)(dst + 32 + d0) = wb; }
    }
    __syncthreads();
}

struct SfDil { int iq, key0; float sl; __device__ __forceinline__ float operator()(float s, int kl) const { const int df = iq - key0 - kl; return (df >= 0 && df <= 128) ? s - sl * (float)df : -INFINITY; } };
struct DilArgs { const bf16_t* proj; bf16_t* po; float* plse; const float *g_q, *g_k; };
__device__ __forceinline__ void dil_item(const DilArgs& A, int item, LAS unsigned char* lds, int tid) {
    asm volatile("" : "+v"(tid));
    const int cfg = item >> 9, rem = item & 511, b = rem >> 6, head = (rem >> 4) & 3, sub = rem & 15;
    const int dil = cfg == 0 ? 1 : (cfg == 1 ? 4 : 16), nq = 16 / dil, c = sub / nq, qt = sub % nq, i0 = 256 * qt, L = SEQ / dil;
    const int lane = tid & 63, w = __builtin_amdgcn_readfirstlane(tid >> 6), r = lane & 31, hh = lane >> 5;
    const int iq = i0 + 32 * w + r, tq = c + dil * iq; const size_t token = (size_t)b * SEQ + tq;
    const bf16_t* base = A.proj + (size_t)b * SEQ * NP;
    const float slope = exp2f(-(float)(2 * head + 2)) * (float)dil * LOG2E;
    bf16x8 qf[4]; load_qfrag<true>(qf, base + (size_t)tq * NP + C_QD + head * 64, A.g_q, nullptr, 0.125f * LOG2E, hh);
    const bf16_t* kp = base + (size_t)c * NP + C_KD + head * 64; const bf16_t* vp = base + (size_t)c * NP + C_VD + head * 64;
    const int kb_lo = (i0 >> 6) >= 2 ? (i0 >> 6) - 2 : 0, kb_hi = (i0 >> 6) + 3, q_lo = i0 + 32 * w;
    f32x16 o0, o1;
#pragma unroll
    for (int i = 0; i < 16; ++i) { o0[i] = 0.f; o1[i] = 0.f; }
    float m = -INFINITY, l = 0.f, dummy = 0.f;
    KV_PIPELINE(kb_lo, (cur + 1 <= kb_hi ? cur + 1 : -1), (KVSrc{kp, vp, (long)dil * NP, 64 * id, 0, L}), true, A.g_k,
        { if (64 * id + 63 >= q_lo - 128 && 64 * id <= q_lo + 31) { const SfDil sf{iq, 64 * id, slope}; attn_block<0>(qf, o0, o1, m, l, ksb, vtb, r, hh, sf, 0.f, 0.f, nullptr, 0, dummy); } });
    const float inv = 1.f / l;
    bf16_t* dst = A.po + ((size_t)cfg * M + token) * 256 + head * 64;
#pragma unroll
    for (int g = 0; g < 4; ++g) { const int d0 = 8 * g + 4 * hh;
        u32x2 wa; wa.x = cvtpk(o0[4 * g] * inv, o0[4 * g + 1] * inv); wa.y = cvtpk(o0[4 * g + 2] * inv, o0[4 * g + 3] * inv); *(u32x2*)(dst + d0) = wa;
        u32x2 wb; wb.x = cvtpk(o1[4 * g] * inv, o1[4 * g + 1] * inv); wb.y = cvtpk(o1[4 * g + 2] * inv, o1[4 * g + 3] * inv); *(u32x2*)(dst + 32 + d0) = wb; }
    if (hh == 0) A.plse[((size_t)cfg * M + token) * 4 + head] = m + __log2f(l);
    __syncthreads();
}
template <int NI> __device__ __forceinline__ void dil_merge_items(const bf16_t* po, const float* plse, bf16_t* groups, const float* g_out, int item0, int stride, int lane) {
    const int pair = lane >> 3, ch = lane & 7, head = pair & 3;
    u32x4 pv[NI][3]; float ls[NI][3];
#pragma unroll
    for (int n = 0; n < NI; ++n) { const size_t token = (size_t)(item0 + n * stride) * 2 + (pair >> 2);
#pragma unroll
        for (int i = 0; i < 3; ++i) { ls[n][i] = plse[((size_t)i * M + token) * 4 + head]; pv[n][i] = *(const u32x4*)(po + ((size_t)i * M + token) * 256 + head * 64 + 8 * ch); } }
    const float* go = g_out + 768 + head * 64 + 8 * ch;
#pragma unroll
    for (int n = 0; n < NI; ++n) { const size_t token = (size_t)(item0 + n * stride) * 2 + (pair >> 2);
        const float mx = fmaxf(ls[n][0], fmaxf(ls[n][1], ls[n][2]));
        const float w0 = EXP2(ls[n][0] - mx), w1 = EXP2(ls[n][1] - mx), w2 = EXP2(ls[n][2] - mx), winv = 1.f / (w0 + w1 + w2);
        float o[8];
#pragma unroll
        for (int j = 0; j < 8; ++j) o[j] = 0.f;
#pragma unroll
        for (int i = 0; i < 3; ++i) { UNPACK8(pv[n][i], k); const float wi = (i == 0 ? w0 : (i == 1 ? w1 : w2)) * winv;
            o[0] += wi * k0; o[1] += wi * k1; o[2] += wi * k2; o[3] += wi * k3; o[4] += wi * k4; o[5] += wi * k5; o[6] += wi * k6; o[7] += wi * k7; }
        float ss = 0.f;
#pragma unroll
        for (int j = 0; j < 8; ++j) ss += o[j] * o[j];
        ss += swz_f<1>(ss); ss += swz_f<2>(ss); ss += swz_f<4>(ss);
        const float rs = rsqrtf(ss * (1.f / 64.f) + EPS);
        u32x4 wv; wv.x = cvtpk(o[0] * rs * go[0], o[1] * rs * go[1]); wv.y = cvtpk(o[2] * rs * go[2], o[3] * rs * go[3]); wv.z = cvtpk(o[4] * rs * go[4], o[5] * rs * go[5]); wv.w = cvtpk(o[6] * rs * go[6], o[7] * rs * go[7]);
        *(u32x4*)(groups + token * DM + 768 + head * 64 + 8 * ch) = wv; }
}

__device__ __forceinline__ void stick_block(const bf16x8 (&qf)[4], f32x16& o0, f32x16& o1, float& carry, LAS const unsigned char* ksb, LAS const unsigned char* vtb, int r, int hh, int tq, int key0) {
    f32x16 s0, s1;
#pragma unroll
    for (int i = 0; i < 16; ++i) { s0[i] = 0.f; s1[i] = 0.f; }
    bf16x8 ka[4], kb2[4];
#pragma unroll
    for (int s = 0; s < 4; ++s) { ka[s] = *(LAS const bf16x8*)(ksb + r * KSB + (16 * s + 8 * hh) * 2); kb2[s] = *(LAS const bf16x8*)(ksb + (32 + r) * KSB + (16 * s + 8 * hh) * 2); }
    __builtin_amdgcn_s_setprio(1);
#pragma unroll
    for (int s = 0; s < 4; ++s) { s0 = MFMA32(ka[s], qf[s], s0); s1 = MFMA32(kb2[s], qf[s], s1); }
    __builtin_amdgcn_s_setprio(0);
    __builtin_amdgcn_sched_barrier(0);
    float acc = carry;
#pragma unroll
    for (int kti = 0; kti < 2; ++kti) { const int kt = 1 - kti; float spm[16], G[4], R[4];
#pragma unroll
        for (int i = 0; i < 16; ++i) { const float z = kt ? s1[i] : s0[i]; const bool act = key0 + 32 * kt + crow(i, hh) < tq;
            const float sp = fmaxf(z, 0.f) + __log2f(1.f + EXP2(-fabsf(z)));
            spm[i] = act ? sp : 0.f; const float lw = act ? z - sp : -INFINITY; if (kt) s1[i] = lw; else s0[i] = lw; }
#pragma unroll
        for (int g = 0; g < 4; ++g) { G[g] = (spm[4 * g] + spm[4 * g + 1]) + (spm[4 * g + 2] + spm[4 * g + 3]); R[g] = partner32(G[g], hh); }
#pragma unroll
        for (int gi = 0; gi < 4; ++gi) { const int g = 3 - gi; float run = acc + (hh ? 0.f : R[g]);
#pragma unroll
            for (int ki = 0; ki < 4; ++ki) { const int i = 4 * g + 3 - ki; const float lw = kt ? s1[i] : s0[i]; const float wv = EXP2(lw - run); if (kt) s1[i] = wv; else s0[i] = wv; run += spm[i]; }
            acc += G[g] + R[g]; } }
    carry = acc;
    __builtin_amdgcn_sched_barrier(0);
    pv_accum(s0, s1, o0, o1, vtb, r, hh);
}
struct StickArgs { const bf16_t* proj; bf16_t* groups; const float* g_out; };
__device__ __forceinline__ void stick_item(const StickArgs& A, int item, LAS unsigned char* lds, int tid) {
    asm volatile("" : "+v"(tid));
    const int b = item >> 6, head = (item >> 4) & 3, qt = item & 15, T0 = 256 * qt;
    const int lane = tid & 63, w = __builtin_amdgcn_readfirstlane(tid >> 6), r = lane & 31, hh = lane >> 5, tq = T0 + 32 * w + r;
    const size_t token = (size_t)b * SEQ + tq;
    const bf16_t* base = A.proj + (size_t)b * SEQ * NP;
    bf16x8 qf[4]; load_qfrag<false>(qf, base + (size_t)tq * NP + C_QC + head * 64, nullptr, nullptr, 0.125f * LOG2E, hh);
    LAS unsigned* flags = (LAS unsigned*)(lds + NSA_SLAB);
    if (tid < 16) flags[tid] = 0u;
    f32x16 o0, o1;
#pragma unroll
    for (int i = 0; i < 16; ++i) { o0[i] = 0.f; o1[i] = 0.f; }
    float carry = 0.f; bool done = false;
    const bf16_t* kp = base + C_KC + head * 64; const bf16_t* vp = base + C_VC + head * 64;
#define STK_NEXT(c) ({ const LAS unsigned* f_ = flags + (par_ ^ 1) * 8; const unsigned ad_ = (f_[0] & f_[1]) & (f_[2] & f_[3]) & (f_[4] & f_[5]) & (f_[6] & f_[7]); ((c) > 0 && !ad_) ? (c) - 1 : -1; })
    KV_PIPELINE((T0 >> 6) + 3, STK_NEXT(cur), (KVSrc{kp, vp, NP, 64 * id, 0, SEQ}), false, nullptr,
        { if (!done && 64 * id <= T0 + 32 * w + 30) { stick_block(qf, o0, o1, carry, ksb, vtb, r, hh, tq, 64 * id); done = __all(carry > 150.1f); }
          if (lane == 0) flags[par_ * 8 + w] = done ? 1u : 0u; });
    float ss = 0.f;
#pragma unroll
    for (int i = 0; i < 16; ++i) ss += o0[i] * o0[i] + o1[i] * o1[i];
    ss = sum32(ss);
    const float rs = rsqrtf(ss * (1.f / 64.f) + EPS); const float* go = A.g_out + 512 + head * 64; bf16_t* dst = A.groups + token * DM + 512 + head * 64;
#pragma unroll
    for (int g = 0; g < 4; ++g) { const int d0 = 8 * g + 4 * hh;
        u32x2 wa; wa.x = cvtpk(o0[4 * g] * rs * go[d0], o0[4 * g + 1] * rs * go[d0 + 1]); wa.y = cvtpk(o0[4 * g + 2] * rs * go[d0 + 2], o0[4 * g + 3] * rs * go[d0 + 3]); *(u32x2*)(dst + d0) = wa;
        u32x2 wb; wb.x = cvtpk(o1[4 * g] * rs * go[32 + d0], o1[4 * g + 1] * rs * go[32 + d0 + 1]); wb.y = cvtpk(o1[4 * g + 2] * rs * go[32 + d0 + 2], o1[4 * g + 3] * rs * go[32 + d0 + 3]); *(u32x2*)(dst + 32 + d0) = wb; }
    __syncthreads();
}

struct CmpArgs { const bf16_t* proj; const bf16_t* w1t; const bf16_t* w2t; const float* cb; const float* g_kc; bf16_t* kcn; bf16_t* vcc; };
constexpr int HIDB = 528;
__device__ __forceinline__ void compress_item(const CmpArgs& A, int item, LAS unsigned char* lds, int tid) {
    asm volatile("" : "+v"(tid));
    const int kv = item >> 6, rt = item & 63, b = rt >> 3, j0 = (rt & 7) * 32;
    const int lane = tid & 63, w = __builtin_amdgcn_readfirstlane(tid >> 6), r = lane & 31, hh = lane >> 5;
    { const bf16_t* xsrc = A.proj + (size_t)b * SEQ * NP + (kv ? C_VCA : C_KCA);
      u32x4 stg[9];
#pragma unroll
      for (int q = 0; q < 9; ++q) { const int e2 = tid + 512 * q, t = e2 >> 3, c = e2 & 7; int tk = 16 * j0 + t; tk = tk < SEQ ? tk : SEQ - 1;
          if (e2 < 528 * 8) stg[q] = *(const u32x4*)(xsrc + (size_t)tk * NP + 8 * c); }
#pragma unroll
      for (int q = 0; q < 9; ++q) { const int e2 = tid + 512 * q, t = e2 >> 3, c = e2 & 7;
          if (e2 < 528 * 8) *(LAS u32x4*)(lds + (t ^ ((t >> 7) & 1)) * 128 + ((c ^ ((t >> 4) & 7)) * 16)) = stg[q]; } }
    __syncthreads();
    const bf16_t* wf = A.w1t + (size_t)kv * 256 * 2048 + ((size_t)w * 128 * 64 + lane) * 8;
    f32x16 acc;
#pragma unroll
    for (int i = 0; i < 16; ++i) acc[i] = 0.f;
#pragma unroll 8
    for (int pos = 0; pos < 32; ++pos) { const int t = 16 * r + pos; LAS const unsigned char* arow = lds + (t ^ ((t >> 7) & 1)) * 128; const int sw = (t >> 4) & 7;
#pragma unroll
        for (int q = 0; q < 4; ++q) { const bf16x8 af = *(LAS const bf16x8*)(arow + (((2 * q + hh) ^ sw) * 16)), bfr = *(const bf16x8*)(wf + (size_t)(4 * pos + q) * 512); acc = MFMA32(af, bfr, acc); } }
    __syncthreads();
    { const float bias = A.cb[kv * 256 + 32 * w + r];
#pragma unroll
      for (int i = 0; i < 16; ++i) { const float x = acc[i] + bias; const float hv = 0.5f * x * (1.f + tanhf(0.7978845608028654f * (x + 0.044715f * x * x * x)));
          *(LAS unsigned short*)(lds + crow(i, hh) * HIDB + (32 * w + r) * 2) = (unsigned short)(cvtpk(hv, hv) & 0xffffu); } }
    __syncthreads();
    if (w == 0) {
        f32x16 c0, c1;
#pragma unroll
        for (int i = 0; i < 16; ++i) { c0[i] = 0.f; c1[i] = 0.f; }
        const bf16_t* w2a = A.w2t + ((size_t)kv * 64 + r) * 256 + 8 * hh; const bf16_t* w2b = w2a + 32 * 256;
#pragma unroll
        for (int s = 0; s < 16; ++s) { const bf16x8 af = *(LAS const bf16x8*)(lds + r * HIDB + (16 * s + 8 * hh) * 2);
            c0 = MFMA32(af, *(const bf16x8*)(w2a + 16 * s), c0); c1 = MFMA32(af, *(const bf16x8*)(w2b + 16 * s), c1); }
        const float g0 = A.g_kc[r], g1 = A.g_kc[32 + r]; bf16_t* dst = (kv ? A.vcc : A.kcn) + ((size_t)b * 256 + j0) * 64;
#pragma unroll
        for (int i = 0; i < 16; ++i) { float v0 = c0[i], v1 = c1[i];
            if (!kv) { float ss = v0 * v0 + v1 * v1; ss += swz_f<1>(ss); ss += swz_f<2>(ss); ss += swz_f<4>(ss); ss += swz_f<8>(ss); ss += swz_f<16>(ss);
                const float rs = rsqrtf(ss * (1.f / 64.f) + EPS); v0 *= rs * g0; v1 *= rs * g1; }
            const int row = crow(i, hh);
            if (!kv) { dst[row * 64 + r] = (bf16_t)(cvtpk(v0, v0) & 0xffffu); dst[row * 64 + 32 + r] = (bf16_t)(cvtpk(v1, v1) & 0xffffu); }
            else { const int j = j0 + row; bf16_t* vt = A.vcc + ((size_t)b * 4 + (j >> 6)) * 4096 + (j & 63);
                vt[(size_t)r * 64] = (bf16_t)(cvtpk(v0, v0) & 0xffffu); vt[(size_t)(32 + r) * 64] = (bf16_t)(cvtpk(v1, v1) & 0xffffu); } }
    }
    __syncthreads();
}
#define RLX_AGENT __ATOMIC_RELAXED, __HIP_MEMORY_SCOPE_AGENT
#define XB_TMO      128
#define XB_XCNT(j)  (256  + 64 * (j))
#define XB_XSUB(j)  (1280 + 64 * (j))
#define XB_XGEN(j)  (2304 + 64 * (j))
#define XB_TOP      3328
#define XB_TOPGEN   3392
#define XCD_BAR_WORDS 3456
#define XB_SPIN_CAP (1u << 18)

__device__ __forceinline__ unsigned xb_ld(unsigned* p)              { return __hip_atomic_load(p, __ATOMIC_RELAXED, __HIP_MEMORY_SCOPE_AGENT); }
__device__ __forceinline__ unsigned xb_add(unsigned* p, unsigned v) { return __hip_atomic_fetch_add(p, v, __ATOMIC_RELAXED, __HIP_MEMORY_SCOPE_AGENT); }
__device__ __forceinline__ unsigned xb_xcc_id() { return (unsigned)__builtin_amdgcn_s_getreg((3 << 11) | 20) & 0xFu; }
#define XB_SPIN(cond, bar) do { unsigned _sp = 0; while (cond) { __builtin_amdgcn_s_sleep(1); \
    if ((++_sp & 255u) == 0u) { if (xb_ld(&(bar)[XB_TMO])) break; if (_sp > XB_SPIN_CAP) { atomicAdd(&(bar)[XB_TMO], 1u); break; } } } } while (0)

struct XcdBarrier {
    unsigned* bar; unsigned x;
    volatile LAS unsigned* st;
};

__device__ __forceinline__ XcdBarrier xcd_barrier_post(unsigned* bar, volatile LAS unsigned* st) {
    XcdBarrier b; b.bar = bar; b.x = xb_xcc_id(); b.st = st;
    if (threadIdx.x == 0) (void)xb_add(&bar[XB_XCNT(b.x)], 1u);
    return b;
}
__device__ __forceinline__ void xcd_barrier_complete(unsigned* bar, unsigned x, unsigned& nloc, unsigned& nx) {
    const unsigned G = gridDim.x * gridDim.y * gridDim.z;
    unsigned sum, cnt, mine, sp = 0u;
    for (;;) {
        sum = 0u; cnt = 0u; mine = 0u;
#pragma unroll
        for (unsigned j = 0; j < 16; ++j) { const unsigned c = xb_ld(&bar[XB_XCNT(j)]); sum += c; cnt += (c > 0u) ? 1u : 0u; mine = (j == x) ? c : mine; }
        if (sum == G) break;
        __builtin_amdgcn_s_sleep(1);
        if ((++sp & 255u) == 0u) { if (xb_ld(&bar[XB_TMO])) break; if (sp > XB_SPIN_CAP) { atomicAdd(&bar[XB_TMO], 1u); break; } }
    }
    nloc = mine > 0u ? mine : 1u; nx = cnt > 0u ? cnt : 1u;
}

__device__ __forceinline__ void xcd_barrier(const XcdBarrier& b) {
    asm volatile("s_waitcnt vmcnt(0)" ::: "memory");
    __syncthreads();
    if (threadIdx.x == 0) {
        unsigned* bar = b.bar;
        __builtin_amdgcn_s_waitcnt(0);
        unsigned nloc = b.st[0], nx = b.st[1];
        if (nloc == 0u) { xcd_barrier_complete(bar, b.x, nloc, nx); b.st[0] = nloc; b.st[1] = nx; }
        const unsigned old = xb_add(&bar[XB_XSUB(b.x)], 1u);
        const unsigned gen = old / nloc;
        if (old + 1u == (gen + 1u) * nloc) {
            __builtin_amdgcn_fence(__ATOMIC_RELEASE, "agent");
            asm volatile("s_waitcnt vmcnt(0)" ::: "memory");
            const unsigned og = xb_add(&bar[XB_TOP], 1u);
            const unsigned tg = og / nx;
            if (og + 1u == (tg + 1u) * nx) xb_add(&bar[XB_TOPGEN], 1u);
            else XB_SPIN(xb_ld(&bar[XB_TOPGEN]) == tg, bar);
            __builtin_amdgcn_fence(__ATOMIC_ACQUIRE, "agent");
            xb_add(&bar[XB_XGEN(b.x)], 1u);
            asm volatile("s_waitcnt vmcnt(0)" ::: "memory");
        } else {
            XB_SPIN(xb_ld(&bar[XB_XGEN(b.x)]) == gen, bar);
            __builtin_amdgcn_fence(__ATOMIC_ACQUIRE, "agent");
            asm volatile("s_waitcnt vmcnt(0)" ::: "memory");
        }
    }
    __syncthreads();
}

#ifndef REP_CMP
#define REP_CMP 1
#endif
#ifndef REP_STK
#define REP_STK 1
#endif
#ifndef REP_DIL
#define REP_DIL 1
#endif
#ifndef REP_NSA
#define REP_NSA 1
#endif
#ifndef REP_G1
#define REP_G1 1
#endif
#ifndef REP_G3
#define REP_G3 1
#endif
#ifndef REP_PRO
#define REP_PRO 1
#endif
#ifndef REP_PREP
#define REP_PREP 1
#endif
#ifndef RESID_BF16
#define RESID_BF16 1
#endif
#ifndef REP_CONV
#define REP_CONV 1
#endif
#ifndef REP_G2
#define REP_G2 1
#endif
#ifndef XSYNC
#define XSYNC 0
#endif
__global__ void __launch_bounds__(512, 2) fwd_kernel(Params p) {
    extern __shared__ __attribute__((aligned(16))) unsigned char lds_raw[];
    cg::grid_group grid = cg::this_grid();
    LAS unsigned char* lds = (LAS unsigned char*)lds_raw;
#define TID_SETUP() int tid = threadIdx.x; asm volatile("" : "+v"(tid)); const int lane = tid & 63, wave = __builtin_amdgcn_readfirstlane(tid >> 6), gw = blockIdx.x * 8 + wave; (void)lane; (void)gw
    const int G = gridDim.x, NGW = G * 8;
    unsigned char* ws = p.ws;
    volatile LAS unsigned* misc = (volatile LAS unsigned*)(lds + LDS_BYTES - 64);
    unsigned* barw = (unsigned*)(ws + WS_BAR);
    { int t0 = threadIdx.x; if (t0 < 2) misc[t0] = 0u;
      if (blockIdx.x == 0) for (int i = t0; i < XCD_BAR_WORDS; i += 512) barw[i] = 0u;
      __syncthreads(); }
    float* ss = (float*)(ws + WS_SS); bf16_t* kcn = (bf16_t*)(ws + WS_KCN); bf16_t* vcc = (bf16_t*)(ws + WS_VCC);
    bf16_t* xb = (bf16_t*)(ws + WS_XB); bf16_t* groups = (bf16_t*)(ws + WS_GR); bf16_t* proj = (bf16_t*)(ws + WS_PROJ); bf16_t* hbuf = proj;
    float* x1 = (float*)(ws + WS_X1); bf16_t* nkn = (bf16_t*)(ws + WS_X1); bf16_t* nvt = (bf16_t*)(ws + WS_X1 + 8 * MiB);
    bf16_t* dpo = (bf16_t*)((unsigned char*)p.out + DO_PO); float* dlse = (float*)((unsigned char*)p.out + DO_LSE);

#ifndef SKIP_PRO
    for (int rep_ = 0; rep_ < REP_PRO; ++rep_) { TID_SETUP(); prologue(p, lds, gw, NGW, wave, lane); }
#endif
    grid.sync();
    const XcdBarrier xbar = xcd_barrier_post(barw, misc);
    for (int xs_ = 0; xs_ < XSYNC; ++xs_) xcd_barrier(xbar);

    for (int l = 0; l < 2; ++l) {
        unsigned char* wl = ws + WS_W + (size_t)l * W_LAYER;
#ifndef SKIP_G1
        for (int rep_ = 0; rep_ < REP_G1; ++rep_)
        { pg8::Gemm g{xb, (const bf16_t*)(wl + W_IN), M, NP, DM}; pg8::StaticOrder S; S.init(M, NP, G, (int)blockIdx.x);
          EpiProj E{proj, ss + (size_t)(2 * l) * M};
          pg8::gemm_phase<EpiProj, pg8::StaticOrder, true, true>(lds, g, S, E); }
#endif
        xcd_barrier(xbar);
        {
            TID_SETUP();
            const float* g_out = p.in[17] + l * DM;
            {
              const CmpArgs CA{proj, (const bf16_t*)(ws + WS_W1T) + (size_t)l * 2 * 256 * 2048, (const bf16_t*)(ws + WS_W2T) + (size_t)l * 2 * 64 * 256, (const float*)(ws + WS_CB) + l * 512, p.in[5] + l * 64, kcn, vcc};
              const StickArgs SA{proj, groups, g_out}; const DilArgs DA{proj, dpo, dlse, p.in[15] + l * 64, p.in[16] + l * 64};
              volatile LAS int* slot = (volatile LAS int*)(lds + LDS_BYTES - 32);
              for (;;) { __syncthreads(); if (tid == 0) *slot = (int)atomicAdd(barw + 32 + 64 * l, 1u); __syncthreads(); const int it = *slot; if (it >= 128 + 512 + 1536 + 256 + 128) break;
                  if (it < 128) compress_item(CA, it, lds, tid); else if (it < 640) stick_item(SA, it - 128, lds, tid); else if (it < 2176) dil_item(DA, it - 640, lds, tid);
                  else if (it < 2432) { const int i0 = (it - 2176) * 64 + wave; conv_items<4>(proj, groups, p.in[14] + l * 768, g_out, i0, 8, lane); conv_items<4>(proj, groups, p.in[14] + l * 768, g_out, i0 + 32, 8, lane); }
                  else nsa_prep_item(proj, nkn, nvt, p.in[6] + l * 64, p.in[7] + l * 64, (it - 2432) * 8 + wave, lds + wave * 9216, lane); } }
        }
        xcd_barrier(xbar);
#ifndef SKIP_NSA
#ifndef SKIP_DIL
#endif
        for (int rep_ = 0; rep_ < REP_NSA; ++rep_)
        { TID_SETUP(); NsaArgs A{proj, groups, kcn, vcc, p.in[3] + l * 12, p.in[4] + l * 64, p.in[6] + l * 64, p.in[7] + l * 64, p.in[17] + l * DM, nkn, nvt};
          volatile LAS int* slot = (volatile LAS int*)(lds + LDS_BYTES - 32);
          for (;;) { __syncthreads(); if (tid == 0) *slot = (int)atomicAdd(barw + 64 * l, 1u); __syncthreads(); const int it = *slot; if (it >= 512 + 256) break;
              if (it < 512) nsa_item(A, it & 7, 63 - (it >> 3), lds, tid);
              else { const int i0 = (it - 512) * 64 + wave; dil_merge_items<4>(dpo, dlse, groups, p.in[17] + l * DM, i0, 8, lane); dil_merge_items<4>(dpo, dlse, groups, p.in[17] + l * DM, i0 + 32, 8, lane); } } }
#endif
        xcd_barrier(xbar);
#ifndef SKIP_G2
        { pg8::Gemm g{groups, (const bf16_t*)(wl + W_OUT), M, DM, DM}; pg8::StaticOrder S; S.init(M, DM, G, (int)blockIdx.x);
#if RESID_BF16
          EpiResid E{l == 0 ? p.in[0] : nullptr, xb, nullptr, xb, ss + (size_t)(2 * l + 1) * M};
#else
          EpiResid E{l == 0 ? p.in[0] : x1, nullptr, l == 0 ? x1 : p.out, xb, ss + (size_t)(2 * l + 1) * M};
#endif
          pg8::gemm_phase<EpiResid, pg8::StaticOrder, true, true>(lds, g, S, E);
          for (int rep_ = 1; rep_ < REP_G2; ++rep_) { E.ss = nullptr; pg8::gemm_phase<EpiResid, pg8::StaticOrder, true, true>(lds, g, S, E); } }
#endif
        xcd_barrier(xbar);
#ifndef SKIP_G3
        for (int rep_ = 0; rep_ < REP_G3; ++rep_)
        { pg8::Gemm g{xb, (const bf16_t*)(wl + W_GU), M, NGU, DM}; pg8::StaticOrder S; S.init(M, NGU, G, (int)blockIdx.x);
          EpiSwiGLU E{hbuf, ss + (size_t)(2 * l + 1) * M};
          pg8::gemm_phase<EpiSwiGLU, pg8::StaticOrder, true, true>(lds, g, S, E); }
#endif
        xcd_barrier(xbar);
#ifndef SKIP_G4
        { pg8::Gemm g{hbuf, (const bf16_t*)(wl + W_DN), M, DM, FF}; pg8::StaticOrder S; S.init(M, DM, G, (int)blockIdx.x);
          float* xio = l == 0 ? x1 : p.out;
#if RESID_BF16
          EpiResid E{nullptr, xb, l == 0 ? nullptr : p.out, l == 0 ? xb : nullptr, l == 0 ? ss + (size_t)2 * M : nullptr}; (void)xio;
#else
          EpiResid E{xio, nullptr, xio, l == 0 ? xb : nullptr, l == 0 ? ss + (size_t)2 * M : nullptr};
#endif
          pg8::gemm_phase<EpiResid, pg8::StaticOrder, true, true>(lds, g, S, E); }
#endif
        if (l == 0) xcd_barrier(xbar);
    }
}

extern "C" void kernel_launch(void* const* d_in, const int* in_sizes, int n_in, void* d_out, int out_size, void* d_ws, size_t ws_size, hipStream_t stream) {
    static int grid = 0;
    if (grid == 0) {
        if (n_in != 23 || out_size != M * DM || ws_size < WS_END) { fprintf(stderr, "kernel_launch: unexpected shapes (n_in %d, out %d, ws %zu)\n", n_in, out_size, ws_size); grid = -1; return; }
        int dev = 0, cus = 0, per_cu = 0;
        (void)hipGetDevice(&dev); (void)hipDeviceGetAttribute(&cus, hipDeviceAttributeMultiprocessorCount, dev);
        if (hipFuncSetAttribute((const void*)fwd_kernel, hipFuncAttributeMaxDynamicSharedMemorySize, LDS_BYTES) != hipSuccess) { fprintf(stderr, "kernel_launch: hipFuncSetAttribute failed\n"); grid = -1; return; }
        if (hipOccupancyMaxActiveBlocksPerMultiprocessor(&per_cu, (const void*)fwd_kernel, 512, LDS_BYTES) != hipSuccess || per_cu < 1) per_cu = 1;
        (void)hipGetLastError();
        grid = cus * 1;
        (void)per_cu;
    }
    if (grid < 0) return;
    Params p{};
    for (int i = 0; i < 23; ++i) p.in[i] = (const float*)d_in[i];
    p.out = (float*)d_out; p.ws = (unsigned char*)d_ws;
    void* args[] = {&p};
    hipError_t e = hipLaunchCooperativeKernel((const void*)fwd_kernel, dim3(grid), dim3(512), args, LDS_BYTES, stream);
    if (e != hipSuccess) fprintf(stderr, "cooperative launch failed: %s (grid %d)\n", hipGetErrorString(e), grid);
}
```
